# Optimizing an MI355X kernel written in HIP

```python
import math
import jax, jax.numpy as jnp
from jax import lax
import numpy as np

D_MODEL = 1024
BATCH = 8
SEQ = 8192
DEPTH = 2

GRID_W = 64
CTX_LEN = 256
NORM_EPS = 1e-6

RW_HEADS = 4
RW_HD = 64
RW_W = RW_HEADS * RW_HD
RW_DECAY_RANK = 64
RW_ICLR_RANK = 64
RW_GATE_RANK = 128
RW_GN_EPS = 64e-5
RW_SPLITS = [RW_W, 2 * RW_W, 3 * RW_W, 3 * RW_W + RW_DECAY_RANK, 3 * RW_W + RW_DECAY_RANK + RW_ICLR_RANK]
RW_COLS = 3 * RW_W + RW_DECAY_RANK + RW_ICLR_RANK + RW_GATE_RANK

SSM_HEADS = 8
SSM_HD = 64
SSM_W = SSM_HEADS * SSM_HD
SSM_GROUPS = 2
SSM_STATE = 64
SSM_CHUNK = 128
SSM_CONV = 3
SSM_CONV_CH = SSM_W + 2 * SSM_GROUPS * SSM_STATE
SSM_COLS = SSM_W + SSM_CONV_CH + SSM_HEADS

GLA_HEADS = 4
GLA_DK = 32
GLA_DV = 64
GLA_KW = GLA_HEADS * GLA_DK
GLA_VW = GLA_HEADS * GLA_DV
GLA_GATE_RANK = 16
GLA_TAU = 16.0
GLA_CHUNK = 64
GLA_COLS = 2 * GLA_KW + GLA_VW + GLA_GATE_RANK + GLA_VW

IN_COLS = RW_COLS + SSM_COLS + GLA_COLS
MIX_W = RW_W + SSM_W + GLA_VW

N_GROUPS = 4
EXPERTS_PER_GROUP = 4
N_EXPERTS = N_GROUPS * EXPERTS_PER_GROUP
TOP_K = 2
D_EXPERT = 512

kernel_name = 'hybrid_rwkv7_ssd_gla_hmoe_diffusion_block'


def rmsnorm(h, g):
    hf = h.astype(jnp.float32)
    hf = hf * lax.rsqrt(jnp.mean(hf * hf, -1, keepdims=True) + NORM_EPS)
    return (hf * g.astype(jnp.float32)).astype(h.dtype)


def modulate(h, shift, scale):
    return h * (1 + scale[:, None]) + shift[:, None]


def head_layernorm(y, g, b):
    yf = y.astype(jnp.float32)
    mu = jnp.mean(yf, -1, keepdims=True)
    var = jnp.mean(jnp.square(yf - mu), -1, keepdims=True)
    yn = (yf - mu) * lax.rsqrt(var + RW_GN_EPS)
    return yn.reshape(y.shape[:2] + (-1,)) * g + b


def head_rmsnorm(y, g):
    yf = y.astype(jnp.float32)
    yn = yf * lax.rsqrt(jnp.mean(yf * yf, -1, keepdims=True) + NORM_EPS)
    return yn.reshape(y.shape[:2] + (-1,)) * g


def token_shift(u, mu_prev, mu_next):
    pad = jnp.zeros_like(u[:, :1])
    prev = jnp.concatenate([pad, u[:, :-1]], 1)
    nxt = jnp.concatenate([u[:, 1:], pad], 1)
    return u + mu_prev * (prev - u) + mu_next * (nxt - u)


def dwconv_grid(u, w, b, rows):
    bsz, n, ch = u.shape
    img = u.reshape(bsz, rows, n // rows, ch)
    out = lax.conv_general_dilated(img, w[:, :, None, :].astype(u.dtype), (1, 1), 'SAME',
                                   dimension_numbers=('NHWC', 'HWIO', 'NHWC'), feature_group_count=ch)
    return out.reshape(bsz, n, ch) + b


def rwkv7_scan(r, w, k, v, a, b, s0):
    def step(s, inp):
        r_t, w_t, k_t, v_t, a_t, b_t = inp
        sa = jnp.einsum('bhvk,bhk->bhv', s, a_t)
        s = s * w_t[:, :, None, :] + sa[..., None] * b_t[:, :, None, :] + v_t[..., None] * k_t[:, :, None, :]
        return s, jnp.einsum('bhvk,bhk->bhv', s, r_t)
    xs = tuple(jnp.moveaxis(z.astype(jnp.float32), 1, 0) for z in (r, w, k, v, a, b))
    s_fin, ys = lax.scan(step, s0, xs)
    return jnp.moveaxis(ys, 0, 1), s_fin


def ssd_chunked(x, dA, bm, cm, s0):
    bsz, t, h, p = x.shape
    n = bm.shape[-1]
    L = SSM_CHUNK
    nc = t // L
    x = x.astype(jnp.float32).reshape(bsz, nc, L, h, p)
    bm = bm.astype(jnp.float32).reshape(bsz, nc, L, h, n)
    cm = cm.astype(jnp.float32).reshape(bsz, nc, L, h, n)
    a_cs = jnp.cumsum(dA.astype(jnp.float32).reshape(bsz, nc, L, h).transpose(0, 3, 1, 2), -1)
    causal = jnp.tril(jnp.ones((L, L), bool))
    decay_in = jnp.exp(jnp.where(causal, a_cs[..., :, None] - a_cs[..., None, :], -jnp.inf))
    scores = jnp.einsum('bclhn,bcshn->bhcls', cm, bm) * decay_in
    y_diag = jnp.einsum('bhcls,bcshp->bclhp', scores, x)
    decay_to_end = jnp.exp(a_cs[..., -1:] - a_cs)
    states = jnp.einsum('bclhn,bhcl,bclhp->bchpn', bm, decay_to_end, x)
    states = jnp.concatenate([s0.astype(jnp.float32)[:, None], states], 1)
    chunk_cs = jnp.cumsum(jnp.pad(a_cs[..., -1], ((0, 0), (0, 0), (1, 0))), -1)
    causal_c = jnp.tril(jnp.ones((nc + 1, nc + 1), bool))
    decay_chunk = jnp.exp(jnp.where(causal_c, chunk_cs[..., :, None] - chunk_cs[..., None, :], -jnp.inf))
    states = jnp.einsum('bhzc,bchpn->bzhpn', decay_chunk, states)
    y_off = jnp.einsum('bclhn,bchpn,bhcl->bclhp', cm, states[:, :-1], jnp.exp(a_cs))
    return (y_diag + y_off).reshape(bsz, t, h, p), states[:, -1]


def gla_chunked(q, k, v, logg, s0):
    bsz, t, h, dk = q.shape
    dv = v.shape[-1]
    L = GLA_CHUNK
    nc = t // L
    rs = lambda z: z.astype(jnp.float32).reshape(bsz, nc, L, h, z.shape[-1])
    q, k, v, logg = rs(q), rs(k), rs(v), rs(logg)
    b_cs = jnp.cumsum(logg, 2)
    ref = b_cs[:, :, L // 2:L // 2 + 1]
    att = jnp.einsum('bclhd,bcshd->bchls', q * jnp.exp(b_cs - ref), k * jnp.exp(ref - b_cs))
    att = jnp.where(jnp.tril(jnp.ones((L, L), bool)), att, 0.0)
    o_intra = jnp.einsum('bchls,bcshe->bclhe', att, v)
    b_end = b_cs[:, :, -1]
    kv = jnp.einsum('bcshd,bcshe->bchde', k * jnp.exp(b_end[:, :, None] - b_cs), v)
    def step(s, inp):
        kv_c, be_c = inp
        return s * jnp.exp(be_c)[..., None] + kv_c, s
    s_fin, s_start = lax.scan(step, s0.astype(jnp.float32), (jnp.moveaxis(kv, 1, 0), jnp.moveaxis(b_end, 1, 0)))
    o_inter = jnp.einsum('bclhd,bchde->bclhe', q * jnp.exp(b_cs), jnp.moveaxis(s_start, 0, 1))
    return (o_intra + o_inter).reshape(bsz, t, h, dv), s_fin


def bidir(scan_fn, ctx_fwd, lat_fwd, ctx_bwd, lat_bwd, s0, ctx_out):
    flip = lambda zs: tuple(jnp.flip(z, 1) for z in zs)
    yc_f, sc_f = scan_fn(*ctx_fwd, s0)
    yl_f, _ = scan_fn(*lat_fwd, sc_f)
    yc_b, sc_b = scan_fn(*flip(ctx_bwd), s0)
    yl_b, _ = scan_fn(*flip(lat_bwd), sc_b)
    yl = yl_f + jnp.flip(yl_b, 1)
    yc = yc_f + jnp.flip(yc_b, 1) if ctx_out else None
    return yc, yl


def rwkv_group(u_c, u_l, mu_prev, mu_next, w0, w2, a0, a2, g2, k_k, k_a, r_k, gn_g, gn_b, ctx_out):
    def heads(z):
        return z.reshape(z.shape[:2] + (RW_HEADS, RW_HD))

    def prep(u):
        r, k, v, wl, al, gl = jnp.split(token_shift(u, mu_prev, mu_next), RW_SPLITS, -1)
        return r, k, v, jnp.tanh(wl), al, gl

    def scan_inputs(p, d):
        r, k, v, wl, al, _ = p
        w_log = -jax.nn.softplus(-(w0[d] + wl @ w2[d])) - 0.5
        decay = jnp.exp(-jnp.exp(w_log.astype(jnp.float32)))
        a = jax.nn.sigmoid(a0[d] + al @ a2[d])
        kk = heads(k * k_k).astype(jnp.float32)
        kk = kk * lax.rsqrt(jnp.sum(kk * kk, -1, keepdims=True) + 1e-12)
        k_mod = k * (1 + (a - 1) * k_a)
        return (heads(r), heads(decay), heads(k_mod), heads(v), -kk, kk * heads(a))

    def finish(p, y):
        r, k, v, _, _, gl = p
        bonus = jnp.sum(heads(r * k * r_k), -1, keepdims=True) * heads(v)
        out = head_layernorm(y, gn_g, gn_b) + bonus.reshape(r.shape)
        return (out * (jax.nn.sigmoid(gl) @ g2)).astype(r.dtype)

    pc, pl = prep(u_c), prep(u_l)
    s0 = jnp.zeros((u_l.shape[0], RW_HEADS, RW_HD, RW_HD), jnp.float32)
    yc, yl = bidir(rwkv7_scan, scan_inputs(pc, 0), scan_inputs(pl, 0), scan_inputs(pc, 1), scan_inputs(pl, 1), s0, ctx_out)
    return (finish(pc, yc) if ctx_out else None), finish(pl, yl)


def ssm_group(u_c, u_l, rows, conv_w, conv_b, dt_bias, a_log, d_skip, norm_g, ctx_out):
    def prep(u, grid_rows):
        bsz, t = u.shape[:2]
        z, xbc, dt = jnp.split(u, [SSM_W, SSM_W + SSM_CONV_CH], -1)
        xbc = jax.nn.silu(dwconv_grid(xbc, conv_w, conv_b, grid_rows))
        xs, bm, cm = jnp.split(xbc, [SSM_W, SSM_W + SSM_GROUPS * SSM_STATE], -1)
        rep = SSM_HEADS // SSM_GROUPS
        bm = jnp.repeat(bm.reshape(bsz, t, SSM_GROUPS, SSM_STATE), rep, axis=2)
        cm = jnp.repeat(cm.reshape(bsz, t, SSM_GROUPS, SSM_STATE), rep, axis=2)
        return z, xs.reshape(bsz, t, SSM_HEADS, SSM_HD), bm, cm, dt

    def scan_inputs(p, d):
        _, xs, bm, cm, dt = p
        dtp = jax.nn.softplus(dt.astype(jnp.float32) + dt_bias[d])
        dA = -jnp.exp(a_log[d]) * dtp
        return (xs * dtp[..., None], dA, bm, cm)

    def finish(p, y):
        z, xs = p[0], p[1]
        y = (y + d_skip[:, None] * xs).reshape(z.shape[:2] + (SSM_W,))
        return rmsnorm(y * jax.nn.silu(z), norm_g).astype(z.dtype)

    pc, pl = prep(u_c, 1), prep(u_l, rows)
    s0 = jnp.zeros((u_l.shape[0], SSM_HEADS, SSM_HD, SSM_STATE), jnp.float32)
    yc, yl = bidir(ssd_chunked, scan_inputs(pc, 0), scan_inputs(pl, 0), scan_inputs(pc, 1), scan_inputs(pl, 1), s0, ctx_out)
    return (finish(pc, yc) if ctx_out else None), finish(pl, yl)


def gla_group(u_c, u_l, ga2, gb, norm_g, ctx_out):
    def heads(z):
        return z.reshape(z.shape[:2] + (GLA_HEADS, -1))

    def prep(u):
        q, k, v, gl, r = jnp.split(u, [GLA_KW, 2 * GLA_KW, 2 * GLA_KW + GLA_VW, 2 * GLA_KW + GLA_VW + GLA_GATE_RANK], -1)
        return heads(q) * GLA_DK ** -0.5, heads(k), heads(v), gl, r

    def scan_inputs(p, d):
        q, k, v, gl, _ = p
        logg = jax.nn.log_sigmoid((gl @ ga2[d] + gb[d]).astype(jnp.float32)) / GLA_TAU
        return (q, k, v, heads(logg))

    def finish(p, y):
        r = p[4]
        return (head_rmsnorm(y, norm_g) * jax.nn.silu(r)).astype(r.dtype)

    pc, pl = prep(u_c), prep(u_l)
    s0 = jnp.zeros((u_l.shape[0], GLA_HEADS, GLA_DK, GLA_DV), jnp.float32)
    yc, yl = bidir(gla_chunked, scan_inputs(pc, 0), scan_inputs(pl, 0), scan_inputs(pc, 1), scan_inputs(pl, 1), s0, ctx_out)
    return (finish(pc, yc) if ctx_out else None), finish(pl, yl)


def mixer(hc, hl, rows, w_in, w_out, rw_p, ssm_p, gla_p, ctx_out):
    cut = [RW_COLS, RW_COLS + SSM_COLS]
    rc, sc, gc = jnp.split(hc @ w_in, cut, -1)
    rl, sl, gl = jnp.split(hl @ w_in, cut, -1)
    a_c, a_l = rwkv_group(rc, rl, *rw_p, ctx_out)
    b_c, b_l = ssm_group(sc, sl, rows, *ssm_p, ctx_out)
    g_c, g_l = gla_group(gc, gl, *gla_p, ctx_out)
    out_l = jnp.concatenate([a_l, b_l, g_l], -1) @ w_out
    out_c = jnp.concatenate([a_c, b_c, g_c], -1) @ w_out if ctx_out else None
    return out_c, out_l


def hier_moe(h, rg_w, rg_b, re_w, re_b, w1, w3, w2):
    bsz, t, d = h.shape
    tok = h.reshape(bsz * t, d)
    g_logits = (tok @ rg_w + rg_b).astype(jnp.float32)
    g_prob = jax.nn.softmax(g_logits, -1)
    _, g_sel = lax.top_k(g_logits, 1)
    p_group = jnp.take_along_axis(g_prob, g_sel, 1)
    e_logits = (tok @ re_w + re_b).astype(jnp.float32).reshape(-1, N_GROUPS, EXPERTS_PER_GROUP)
    e_logits = jnp.take_along_axis(e_logits, g_sel[:, :, None], 1)[:, 0]
    top_p, top_i = lax.top_k(jax.nn.softmax(e_logits, -1), TOP_K)
    weight = p_group * top_p / jnp.sum(top_p, -1, keepdims=True)
    expert_id = g_sel * EXPERTS_PER_GROUP + top_i
    combine = jnp.sum(jax.nn.one_hot(expert_id, N_EXPERTS, dtype=jnp.float32) * weight[..., None], 1).astype(tok.dtype)
    out = jnp.zeros_like(tok)
    for e in range(N_EXPERTS):
        hid = jax.nn.silu(tok @ w1[e]) * (tok @ w3[e])
        out = out + combine[:, e:e + 1] * (hid @ w2[e])
    return out.reshape(bsz, t, d)


def setup_inputs(seed: int = 0) -> dict:
    key = jax.random.key(seed)
    ks = iter(jax.random.split(key, 64))
    nrm = lambda shape, s: jax.random.normal(next(ks), shape, jnp.float32) * s
    uni = lambda shape, lo, hi: jax.random.uniform(next(ks), shape, jnp.float32, lo, hi)
    L, D = DEPTH, D_MODEL
    dt = jnp.exp(uni((L, 2, SSM_HEADS), math.log(1e-3), math.log(1e-1)))
    return {
        'x': nrm((BATCH, SEQ, D), 1.0),
        'c': nrm((BATCH, D), 1.0),
        'ctx': nrm((BATCH, CTX_LEN, D), 1.0),
        'c_ctx': nrm((D,), 1.0),
        'ada_w': nrm((L, D, 6 * D), 0.5 * D ** -0.5),
        'ada_b': nrm((L, 6 * D), 0.02),
        'norm1_g': 1.0 + nrm((L, D), 0.1),
        'norm2_g': 1.0 + nrm((L, D), 0.1),
        'w_in': nrm((L, D, IN_COLS), D ** -0.5),
        'w_out': nrm((L, MIX_W, D), MIX_W ** -0.5),
        'rw_mu_prev': uni((L, RW_COLS), 0.0, 0.5),
        'rw_mu_next': uni((L, RW_COLS), 0.0, 0.5),
        'rw_w0': uni((L, 2, RW_W), -6.0, 1.0),
        'rw_w2': nrm((L, 2, RW_DECAY_RANK, RW_W), 0.1 * RW_DECAY_RANK ** -0.5),
        'rw_a0': nrm((L, 2, RW_W), 0.1),
        'rw_a2': nrm((L, 2, RW_ICLR_RANK, RW_W), 0.1 * RW_ICLR_RANK ** -0.5),
        'rw_g2': nrm((L, RW_GATE_RANK, RW_W), RW_GATE_RANK ** -0.5),
        'rw_k_k': 0.85 + nrm((L, RW_W), 0.05),
        'rw_k_a': 1.0 + nrm((L, RW_W), 0.05),
        'rw_r_k': nrm((L, RW_W), 0.1),
        'rw_gn_g': 1.0 + nrm((L, RW_W), 0.1),
        'rw_gn_b': nrm((L, RW_W), 0.02),
        'ssm_conv_w': nrm((L, SSM_CONV, SSM_CONV, SSM_CONV_CH), (SSM_CONV * SSM_CONV) ** -0.5),
        'ssm_conv_b': nrm((L, SSM_CONV_CH), 0.02),
        'ssm_dt_bias': dt + jnp.log(-jnp.expm1(-dt)),
        'ssm_a_log': jnp.log(uni((L, 2, SSM_HEADS), 1.0, 16.0)),
        'ssm_d': 1.0 + nrm((L, SSM_HEADS), 0.1),
        'ssm_norm_g': 1.0 + nrm((L, SSM_W), 0.1),
        'gla_ga2': nrm((L, 2, GLA_GATE_RANK, GLA_KW), GLA_GATE_RANK ** -0.5),
        'gla_gb': nrm((L, 2, GLA_KW), 0.5),
        'gla_norm_g': 1.0 + nrm((L, GLA_VW), 0.1),
        'moe_rg_w': nrm((L, D, N_GROUPS), D ** -0.5),
        'moe_rg_b': nrm((L, N_GROUPS), 0.01),
        'moe_re_w': nrm((L, D, N_EXPERTS), D ** -0.5),
        'moe_re_b': nrm((L, N_EXPERTS), 0.01),
        'moe_w1': nrm((L, N_EXPERTS, D, D_EXPERT), D ** -0.5),
        'moe_w3': nrm((L, N_EXPERTS, D, D_EXPERT), D ** -0.5),
        'moe_w2': nrm((L, N_EXPERTS, D_EXPERT, D), D_EXPERT ** -0.5),
        'final_g': 1.0 + nrm((D,), 0.1),
    }


def reference(x, c, ctx, c_ctx, ada_w, ada_b, norm1_g, norm2_g, w_in, w_out,
              rw_mu_prev, rw_mu_next, rw_w0, rw_w2, rw_a0, rw_a2, rw_g2, rw_k_k, rw_k_a, rw_r_k, rw_gn_g, rw_gn_b,
              ssm_conv_w, ssm_conv_b, ssm_dt_bias, ssm_a_log, ssm_d, ssm_norm_g,
              gla_ga2, gla_gb, gla_norm_g,
              moe_rg_w, moe_rg_b, moe_re_w, moe_re_b, moe_w1, moe_w3, moe_w2, final_g):
    rows = x.shape[1] // GRID_W
    cond_l = jax.nn.silu(c)
    cond_c = jax.nn.silu(c_ctx)[None]
    for l in range(DEPTH):
        ctx_out = l < DEPTH - 1
        mod_l = jnp.split(cond_l @ ada_w[l] + ada_b[l], 6, -1)
        mod_c = jnp.split(cond_c @ ada_w[l] + ada_b[l], 6, -1)
        hl = modulate(rmsnorm(x, norm1_g[l]), mod_l[0], mod_l[1])
        hc = modulate(rmsnorm(ctx, norm1_g[l]), mod_c[0], mod_c[1])
        rw_p = (rw_mu_prev[l], rw_mu_next[l], rw_w0[l], rw_w2[l], rw_a0[l], rw_a2[l], rw_g2[l],
                rw_k_k[l], rw_k_a[l], rw_r_k[l], rw_gn_g[l], rw_gn_b[l])
        ssm_p = (ssm_conv_w[l], ssm_conv_b[l], ssm_dt_bias[l], ssm_a_log[l], ssm_d[l], ssm_norm_g[l])
        gla_p = (gla_ga2[l], gla_gb[l], gla_norm_g[l])
        mc, ml = mixer(hc, hl, rows, w_in[l], w_out[l], rw_p, ssm_p, gla_p, ctx_out)
        moe_p = (moe_rg_w[l], moe_rg_b[l], moe_re_w[l], moe_re_b[l], moe_w1[l], moe_w3[l], moe_w2[l])
        x = x + mod_l[2][:, None] * ml
        x = x + mod_l[5][:, None] * hier_moe(modulate(rmsnorm(x, norm2_g[l]), mod_l[3], mod_l[4]), *moe_p)
        if ctx_out:
            ctx = ctx + mod_c[2][:, None] * mc
            ctx = ctx + mod_c[5][:, None] * hier_moe(modulate(rmsnorm(ctx, norm2_g[l]), mod_c[3], mod_c[4]), *moe_p)
    return rmsnorm(x, final_g)
```

```cpp
#include <hip/hip_runtime.h>
#include <cstdio>
#include <cstdint>

#define GAS __attribute__((address_space(1)))
#define LAS __attribute__((address_space(3)))
typedef unsigned short bf16;
typedef short bf16x8 __attribute__((ext_vector_type(8)));
typedef float f32x4 __attribute__((ext_vector_type(4)));
typedef float f32x2 __attribute__((ext_vector_type(2)));
typedef unsigned u32x4 __attribute__((ext_vector_type(4)));
typedef unsigned u32x2 __attribute__((ext_vector_type(2)));
typedef _Float16 h16;
typedef _Float16 h16x8 __attribute__((ext_vector_type(8)));
typedef _Float16 h16x4 __attribute__((ext_vector_type(4)));

#ifndef MK_ONE_LAUNCH
#define MK_ONE_LAUNCH 0
#endif
#ifndef MK_PHMASK
#define MK_PHMASK 0xffffffffu
#endif
#define HAS(k) ((MK_PHMASK >> (k)) & 1u)

constexpr int D = 1024, NB = 8, TL = 8192, TC = 256, TB = TL + TC, T = NB * TB;
constexpr int NTILE64 = TB / 64;
constexpr int IN_COLS = 3096, IN_PAD = 3328;
constexpr int NCLS = 24, MAXSLOT = T + NCLS * 256;
constexpr int NUNIT64 = NB * NTILE64;

constexpr size_t MiB = 1u << 20;
constexpr size_t WS_CTL = 0, CTL_ZERO_BYTES = 1 * MiB;
constexpr size_t WS_MOD = 1 * MiB;
constexpr size_t WS_CNT = 2 * MiB;
constexpr size_t WS_TOKINFO = 3 * MiB;
constexpr size_t WS_LIST = 5 * MiB;
constexpr size_t WS_WSLOT = 6 * MiB;
constexpr size_t WS_CTX = 8 * MiB;
constexpr size_t WS_WIN = 16 * MiB;
constexpr size_t WS_WOUT = 23 * MiB;
constexpr size_t WS_W13 = 25 * MiB;
constexpr size_t WS_W2T = 57 * MiB;
constexpr size_t WS_ACT = 74 * MiB;
constexpr size_t WS_REC = 74 * MiB;
constexpr size_t WS_RECS = WS_REC, WS_RECD = WS_REC + (size_t)T * 4 * 192 * 2;
constexpr size_t WS_YSSD = 206 * MiB;
constexpr size_t WS_TOKS = 206 * MiB;
constexpr size_t WS_URW = 371 * MiB;
constexpr size_t WS_YRW = 371 * MiB;
constexpr size_t WS_H1 = 371 * MiB;
constexpr size_t WS_UXBC = 503 * MiB;
constexpr size_t WS_OGLA = 503 * MiB;
constexpr size_t WS_UZ = 602 * MiB;
constexpr size_t WS_UGLA = 668 * MiB;
constexpr size_t WS_UMISC = 767 * MiB;
constexpr size_t WS_XBCA = 776 * MiB;
constexpr size_t WS_BONUS = 875 * MiB;
constexpr size_t WS_GATE = 908 * MiB;
constexpr size_t WS_END = 941 * MiB;
static_assert(WS_RECD + (size_t)T * 8 * 192 * 2 <= WS_URW, "records fit");
static_assert(WS_YSSD + (size_t)2 * T * 512 * 2 <= WS_URW, "yssd fits");
static_assert(WS_TOKS + (size_t)MAXSLOT * 1024 * 2 <= WS_H1, "toks fits");
static_assert(WS_H1 + (size_t)MAXSLOT * 1024 * 2 <= WS_UMISC, "h1 fits");

constexpr int CW_BAR = 4096;

constexpr int RING_BYTES = 131072;
constexpr int LDSCTL_OFF = RING_BYTES, MISC_OFF = LDSCTL_OFF + 320, CSTAB_OFF = LDSCTL_OFF + 1024;
constexpr int LDS_BYTES = 147456;

#define RLX_AGENT __ATOMIC_RELAXED, __HIP_MEMORY_SCOPE_AGENT
#define LDS_WAIT() asm volatile("s_waitcnt lgkmcnt(0)" ::: "memory")
#define VM_WAIT() asm volatile("s_waitcnt vmcnt(0)" ::: "memory")
__device__ __forceinline__ float bf2f(unsigned short h) { return __uint_as_float(((unsigned)h) << 16); }
__device__ __forceinline__ unsigned f2bf(float f) { unsigned u = __float_as_uint(f); return (u + 0x7fffu + ((u >> 16) & 1u)) >> 16; }
__device__ __forceinline__ unsigned pk2(float lo, float hi) { return f2bf(lo) | (f2bf(hi) << 16); }
__device__ __forceinline__ float sigm(float x) { return 1.f / (1.f + __expf(-x)); }
__device__ __forceinline__ float siluf(float x) { return x / (1.f + __expf(-x)); }
__device__ __forceinline__ float softplusf_(float x) { return x > 20.f ? x : log1pf(__expf(x)); }
__device__ __forceinline__ void unpack8(u32x4 v, float* o) {
    o[0] = __uint_as_float(v.x << 16); o[1] = __uint_as_float(v.x & 0xffff0000u); o[2] = __uint_as_float(v.y << 16); o[3] = __uint_as_float(v.y & 0xffff0000u);
    o[4] = __uint_as_float(v.z << 16); o[5] = __uint_as_float(v.z & 0xffff0000u); o[6] = __uint_as_float(v.w << 16); o[7] = __uint_as_float(v.w & 0xffff0000u);
}
__device__ __forceinline__ u32x4 pack8(const float* o) { u32x4 v; v.x = pk2(o[0], o[1]); v.y = pk2(o[2], o[3]); v.z = pk2(o[4], o[5]); v.w = pk2(o[6], o[7]); return v; }
__device__ __forceinline__ float wave_sum(float v) {
#pragma unroll
    for (int o = 1; o < 64; o <<= 1) v += __shfl_xor(v, o);
    return v;
}
template <int CTRL> __device__ __forceinline__ float dpp_mov(float v) { return __int_as_float(__builtin_amdgcn_update_dpp(0, __float_as_int(v), CTRL, 0xf, 0xf, false)); }
__device__ __forceinline__ float sum8(float v) { v += dpp_mov<0xB1>(v); v += dpp_mov<0x4E>(v); v += dpp_mov<0x141>(v); return v; }
__device__ __forceinline__ float sum16(float v) { v = sum8(v); v += dpp_mov<0x140>(v); return v; }

namespace pg8 {
constexpr int BM = 256, BK = 64, HALF = 128, HTB = HALF * BK * 2, STAGE_BYTES = 8 * HTB, NXCD = 8, WGM = 8;
__host__ __device__ __forceinline__ int lds_byte(int r, int c) { const int st = (r >> 4) * 2 + (c >> 5), rr = r & 15, cc = c & 31, ob = rr * 64 + cc * 2; return st * 1024 + (ob ^ (((ob >> 9) & 1) << 5)); }
__host__ __device__ __forceinline__ void stage_rc(int b, int& R, int& C) { const int st = b / 1024, sb = b % 1024, swz = sb ^ (((sb >> 9) & 1) << 5); R = (st >> 1) * 16 + swz / 64; C = (st & 1) * 32 + (swz % 64) / 2; }
__host__ __device__ __forceinline__ int perm32(int rho) { const int n = rho >> 4, i = rho & 15; return 8 * (i >> 2) + 4 * n + (i & 3); }
struct Unit { int pm, pn, aux; };
__device__ __forceinline__ const GAS char* uni_ptr(const char* p) { const unsigned long long v = (unsigned long long)p;
    const unsigned lo = __builtin_amdgcn_readfirstlane((unsigned)v), hi = __builtin_amdgcn_readfirstlane((unsigned)(v >> 32)); return (const GAS char*)(((unsigned long long)hi << 32) | lo); }
__device__ __forceinline__ unsigned cvt_pk_bf16(float lo, float hi) { unsigned r; asm volatile("v_cvt_pk_bf16_f32 %0, %1, %2" : "=v"(r) : "v"(lo), "v"(hi)); return r; }

template <class Epi, class Sched, bool ALIGN_EPI, bool KSPLIT, int LDB>
__device__ __forceinline__ void gemm_phase(LAS unsigned char* lds, const int tid, const Sched& S, const Epi& E) {
    constexpr int K = 1024, nt = K / BK, ntb = KSPLIT ? nt / 2 : nt;
    const int wid = __builtin_amdgcn_readfirstlane(tid >> 6), lane = tid & 63, wr = wid >> 2, wc = wid & 3, fr = lane & 15, fq = lane >> 4;
    unsigned voffA[2], voffB[2];
#pragma unroll
    for (int i = 0; i < 2; ++i) { int R, C; stage_rc(tid * 16 + i * 8192, R, C); const int Rb = Epi::PERM ? ((R & ~31) + perm32(R & 31)) : R;
        voffA[i] = (unsigned)(R * K + C) * 2u; voffB[i] = (unsigned)(Rb * LDB + C) * 2u; }
    constexpr size_t kstep = (size_t)(BK * 2);
    constexpr size_t hstepA = (size_t)HALF * K * 2, hstepB = (size_t)HALF * LDB * 2;
    const unsigned ldsw = (unsigned)wid * 1024u;
    const int aoff = lds_byte(wr * 64 + fr, fq * 8), boff = lds_byte(wc * 32 + fr, fq * 8);
#define PG8_SA(b, h) (((b) * 2 + (h)) * HTB)
#define PG8_SB(b, h) ((4 + (b) * 2 + (h)) * HTB)
#define PG8_STAGE(bufoff, gbase, voff) do { const GAS char* _gb = uni_ptr(gbase); _Pragma("unroll") for (int _i = 0; _i < 2; ++_i) \
        __builtin_amdgcn_global_load_lds((const GAS unsigned*)(_gb + (voff)[_i]), (LAS unsigned*)(lds + (bufoff) + ldsw + _i * 8192), 16, 0, 0); } while (0)
#define PG8_LDA(dst, b, h) do { _Pragma("unroll") for (int m = 0; m < 4; ++m) _Pragma("unroll") for (int k = 0; k < 2; ++k) dst[m][k] = *(const LAS bf16x8*)(lds + PG8_SA(b, h) + aoff + m * 2048 + k * 1024); } while (0)
#define PG8_LDB(dst, b, h) do { _Pragma("unroll") for (int n = 0; n < 2; ++n) _Pragma("unroll") for (int k = 0; k < 2; ++k) dst[n][k] = *(const LAS bf16x8*)(lds + PG8_SB(b, h) + boff + n * 2048 + k * 1024); } while (0)
#define PG8_MMA(ai, bj, At, Bt) do { __builtin_amdgcn_s_setprio(1); _Pragma("unroll") for (int m = 0; m < 4; ++m) _Pragma("unroll") for (int n = 0; n < 2; ++n) _Pragma("unroll") for (int k = 0; k < 2; ++k) \
        acc[ai][bj][m][n] = __builtin_amdgcn_mfma_f32_16x16x32_bf16(Bt[n][k], At[m][k], acc[ai][bj][m][n], 0, 0, 0); __builtin_amdgcn_s_setprio(0); } while (0)
#define PG8_WAIT_V(n) asm volatile("s_waitcnt vmcnt(" #n ")" ::: "memory")
#define PG8_WAIT_L(n) asm volatile("s_waitcnt lgkmcnt(" #n ")" ::: "memory")
#define PG8_BAR __builtin_amdgcn_s_barrier()
#define PG8_SCHED __builtin_amdgcn_sched_barrier(0)
    Unit cur, nxt; int ui = 0;
    if (!S.next(0, cur)) return;
    f32x4 acc[2][2][4][2];
#pragma unroll
    for (int a = 0; a < 2; ++a)
#pragma unroll
        for (int b = 0; b < 2; ++b)
#pragma unroll
            for (int m = 0; m < 4; ++m)
#pragma unroll
                for (int n = 0; n < 2; ++n) acc[a][b][m][n] = (f32x4){0.f, 0.f, 0.f, 0.f};
    bf16x8 At[4][2], B0[2][2], B1[2][2];
    const char* cA = S.aptr(cur); const char* cB = S.bptr(cur);
    {
        PG8_STAGE(PG8_SB(0, 0), cB, voffB); PG8_STAGE(PG8_SB(0, 1), cB + hstepB, voffB); PG8_STAGE(PG8_SA(0, 0), cA, voffA); PG8_STAGE(PG8_SA(0, 1), cA + hstepA, voffA);
        if (wr == 1) PG8_BAR;
        PG8_WAIT_V(2); PG8_BAR;
        PG8_STAGE(PG8_SB(1, 0), cB + kstep, voffB); PG8_STAGE(PG8_SA(1, 0), cA + kstep, voffA); PG8_STAGE(PG8_SB(1, 1), cB + hstepB + kstep, voffB);
        PG8_WAIT_V(6); PG8_BAR;
    }
    for (;;) {
        const bool has_next = S.next(ui + 1, nxt);
#pragma unroll 1
        for (int t = 0; t < nt; t += 2) {
            const bool last = (t == nt - 2);
            const char* a1 = cA + (size_t)(t + 1) * kstep;
            const char* a2; const char* b2;
            if (last) { a2 = has_next ? S.aptr(nxt) : cA; b2 = has_next ? S.bptr(nxt) : cB; }
            else { a2 = cA + (size_t)(t + 2) * kstep; if (KSPLIT && t + 2 >= ntb) b2 = S.bptr2(cur) + (size_t)(t + 2 - ntb) * kstep; else b2 = cB + (size_t)(t + 2) * kstep; }
            const char* a3 = a2 + kstep; const char* b3 = b2 + kstep;
            PG8_LDB(B0, 0, 0); PG8_LDB(B1, 0, 1); PG8_SCHED; PG8_LDA(At, 0, 0); PG8_STAGE(PG8_SA(1, 1), a1 + hstepA, voffA);
            PG8_WAIT_V(8); PG8_WAIT_L(0); PG8_BAR; PG8_MMA(0, 0, At, B0); PG8_MMA(0, 1, At, B1); PG8_BAR; PG8_SCHED;
            PG8_LDA(At, 0, 1); PG8_STAGE(PG8_SB(0, 0), b2, voffB); PG8_STAGE(PG8_SB(0, 1), b2 + hstepB, voffB); PG8_STAGE(PG8_SA(0, 0), a2, voffA);
            PG8_WAIT_V(8); PG8_WAIT_L(0); PG8_BAR; PG8_MMA(1, 0, At, B0); PG8_MMA(1, 1, At, B1); PG8_BAR; PG8_SCHED;
            PG8_LDB(B0, 1, 0); PG8_LDB(B1, 1, 1); PG8_SCHED; PG8_LDA(At, 1, 0); PG8_STAGE(PG8_SA(0, 1), a2 + hstepA, voffA);
            PG8_WAIT_V(8); PG8_WAIT_L(0); PG8_BAR; PG8_MMA(0, 0, At, B0); PG8_MMA(0, 1, At, B1); PG8_BAR; PG8_SCHED;
            PG8_LDA(At, 1, 1); PG8_STAGE(PG8_SB(1, 0), b3, voffB); PG8_STAGE(PG8_SB(1, 1), b3 + hstepB, voffB); PG8_STAGE(PG8_SA(1, 0), a3, voffA);
            PG8_WAIT_V(8); PG8_WAIT_L(0); PG8_BAR; PG8_MMA(1, 0, At, B0); PG8_MMA(1, 1, At, B1); PG8_BAR; PG8_SCHED;
        }
        if constexpr (ALIGN_EPI) { if (wr == 0) PG8_BAR; }
        E(acc, cur, wr, wc, fr, fq);
        if (!has_next) break;
#pragma unroll
        for (int a = 0; a < 2; ++a)
#pragma unroll
            for (int b = 0; b < 2; ++b)
#pragma unroll
                for (int m = 0; m < 4; ++m)
#pragma unroll
                    for (int n = 0; n < 2; ++n) acc[a][b][m][n] = (f32x4){0.f, 0.f, 0.f, 0.f};
        cur = nxt; cA = S.aptr(cur); cB = S.bptr(cur); ++ui;
        if constexpr (ALIGN_EPI) { if (wr == 1) PG8_BAR; }
    }
    PG8_WAIT_V(0);
    if constexpr (!ALIGN_EPI) { if (wr == 0) PG8_BAR; }
    PG8_BAR;
#undef PG8_SA
#undef PG8_SB
#undef PG8_STAGE
#undef PG8_LDA
#undef PG8_LDB
#undef PG8_MMA
#undef PG8_WAIT_V
#undef PG8_WAIT_L
#undef PG8_BAR
#undef PG8_SCHED
}
}

#define XB_TMO      128
#define XB_XCNT(j)  (256  + 64 * (j))
#define XB_XSUB(j)  (1280 + 64 * (j))
#define XB_XGEN(j)  (2304 + 64 * (j))
#define XB_TOP      3328
#define XB_TOPGEN   3392
#define XCD_BAR_WORDS 3456
#define XB_SPIN_CAP (1u << 25)
__device__ __forceinline__ unsigned xb_ld(unsigned* p)              { return __hip_atomic_load(p, __ATOMIC_RELAXED, __HIP_MEMORY_SCOPE_AGENT); }
__device__ __forceinline__ unsigned xb_add(unsigned* p, unsigned v) { return __hip_atomic_fetch_add(p, v, __ATOMIC_RELAXED, __HIP_MEMORY_SCOPE_AGENT); }
__device__ __forceinline__ unsigned xb_xcc_id() { return (unsigned)__builtin_amdgcn_s_getreg((3 << 11) | 20) & 0xFu; }
#define XB_SPIN(cond, bar) do { unsigned _sp = 0; while (cond) { __builtin_amdgcn_s_sleep(1); \
    if ((++_sp & 255u) == 0u) { if (xb_ld(&(bar)[XB_TMO])) break; if (_sp > XB_SPIN_CAP) { atomicAdd(&(bar)[XB_TMO], 1u); break; } } } } while (0)
struct XcdBarrier { unsigned* bar; unsigned x; volatile LAS unsigned* st; };
__device__ __forceinline__ XcdBarrier xcd_barrier_post(unsigned* bar, volatile LAS unsigned* st) {
    XcdBarrier b; b.bar = bar; b.x = xb_xcc_id(); b.st = st;
    if (threadIdx.x == 0) (void)xb_add(&bar[XB_XCNT(b.x)], 1u);
    return b;
}
__device__ __forceinline__ void xcd_barrier_complete(unsigned* bar, unsigned x, unsigned& nloc, unsigned& nx) {
    const unsigned G = gridDim.x * gridDim.y * gridDim.z;
    unsigned sum, cnt, mine, sp = 0u;
    for (;;) {
        sum = 0u; cnt = 0u; mine = 0u;
#pragma unroll 1
        for (unsigned j = 0; j < 16; ++j) { const unsigned c = xb_ld(&bar[XB_XCNT(j)]); sum += c; cnt += (c > 0u) ? 1u : 0u; mine = (j == x) ? c : mine; }
        if (sum == G) break;
        __builtin_amdgcn_s_sleep(1);
        if ((++sp & 255u) == 0u) { if (xb_ld(&bar[XB_TMO])) break; if (sp > XB_SPIN_CAP) { atomicAdd(&bar[XB_TMO], 1u); break; } }
    }
    nloc = mine > 0u ? mine : 1u; nx = cnt > 0u ? cnt : 1u;
}
__device__ __forceinline__ void xcd_barrier(const XcdBarrier& b) {
    asm volatile("s_waitcnt vmcnt(0)" ::: "memory");
    __syncthreads();
    if (threadIdx.x == 0) {
        unsigned* bar = b.bar;
        __builtin_amdgcn_s_waitcnt(0);
        unsigned nloc = b.st[0], nx = b.st[1];
        if (nloc == 0u) { xcd_barrier_complete(bar, b.x, nloc, nx); b.st[0] = nloc; b.st[1] = nx; }
        const unsigned old = xb_add(&bar[XB_XSUB(b.x)], 1u);
        const unsigned gen = old / nloc;
        if (old + 1u == (gen + 1u) * nloc) {
            __builtin_amdgcn_fence(__ATOMIC_RELEASE, "agent");
            asm volatile("s_waitcnt vmcnt(0)" ::: "memory");
            const unsigned og = xb_add(&bar[XB_TOP], 1u);
            const unsigned tg = og / nx;
            if (og + 1u == (tg + 1u) * nx) xb_add(&bar[XB_TOPGEN], 1u);
            else XB_SPIN(xb_ld(&bar[XB_TOPGEN]) == tg, bar);
            __builtin_amdgcn_fence(__ATOMIC_ACQUIRE, "agent");
            xb_add(&bar[XB_XGEN(b.x)], 1u);
            asm volatile("s_waitcnt vmcnt(0)" ::: "memory");
        } else {
            XB_SPIN(xb_ld(&bar[XB_XGEN(b.x)]) == gen, bar);
            __builtin_amdgcn_fence(__ATOMIC_ACQUIRE, "agent");
            asm volatile("s_waitcnt vmcnt(0)" ::: "memory");
        }
    }
    __syncthreads();
}

struct Args { const float* in[39]; float* out; unsigned char* ws; int ph_lo, ph_hi; };
struct Frame {
    LAS unsigned char* lds;
    int tid, lane, wave, G, bid;
    float* out; unsigned char* ws;
    int l;
};
#define AS4 __attribute__((address_space(4)))
#define PH_ENTER(F0) Frame F = (F0); { GAS unsigned char* _w = (GAS unsigned char*)F.ws; GAS float* _o = (GAS float*)F.out; \
    asm volatile("" : "+s"(_w), "+s"(_o), "+v"(F.tid), "+s"(F.wave), "+s"(F.bid), "+s"(F.G), "+s"(F.l)); F.ws = (unsigned char*)_w; F.out = (float*)_o; } F.lane = F.tid & 63
__device__ __forceinline__ const AS4 Args* kargs() { const AS4 Args* p = (const AS4 Args*)__builtin_amdgcn_kernarg_segment_ptr(); asm volatile("" : "+s"(p)); return p; }
#define INP(i) ((const float*)(GAS const float*)(KA->in[i]))
#define LP(i, stride) (INP(i) + (size_t)F.l * (stride))

__device__ __forceinline__ const float* xin_row(const float* xl, const float* xc, int row) {
    const int b = row / TB, p = row % TB;
    if (p < TC) return xc + ((size_t)b * TC + p) * D;
    return xl + ((size_t)b * TL + (p - TC)) * D;
}
__device__ __forceinline__ float* xcur_row(const Frame& F, int row) {
    const int b = row / TB, p = row % TB;
    if (p < TC) return (float*)(F.ws + WS_CTX) + ((size_t)b * TC + p) * D;
    return F.out + ((size_t)b * TL + (p - TC)) * D;
}
__device__ __forceinline__ int mod_index(int row) { const int b = row / TB, p = row % TB; return p < TC ? 8 : b; }

__device__ __forceinline__ int in_colmap(int n) {
    if (n < 2304) return n;
    if (n < 2816) return n + 8;
    if (n < 3072) return n + 24;
    if (n < 3080) return n - 768;
    if (n < 3096) return n - 256;
    return -1;
}
__device__ __forceinline__ void tr_item(const float* src, int ldsrc, int scol, bf16* dst, int K, int n0, int k0, LAS float* scr, int lane) {
#pragma unroll 8
    for (int i = 0; i < 32; ++i) { const int kk = 2 * i + (lane >> 5); scr[kk * 33 + (lane & 31)] = scol >= 0 ? src[(size_t)(k0 + kk) * ldsrc + scol] : 0.f; }
    LDS_WAIT(); asm volatile("" ::: "memory");
    const int c = lane & 7;
#pragma unroll
    for (int j = 0; j < 4; ++j) { const int n = (lane >> 3) + 8 * j; const LAS float* s = scr + (8 * c) * 33 + n;
        u32x4 o; o.x = pk2(s[0 * 33], s[1 * 33]); o.y = pk2(s[2 * 33], s[3 * 33]); o.z = pk2(s[4 * 33], s[5 * 33]); o.w = pk2(s[6 * 33], s[7 * 33]);
        *(GAS u32x4*)(dst + (size_t)(n0 + n) * K + k0 + 8 * c) = o; }
    LDS_WAIT(); asm volatile("" ::: "memory");
}
__device__ __forceinline__ void phase_convert(const Frame& F0) {
    PH_ENTER(F0);
    const AS4 Args* KA = kargs();
    LAS float* scr = (LAS float*)(F.lds + F.wave * 16384);
    const int gw = F.bid * 8 + F.wave, NGW = F.G * 8, l = F.l, lane = F.lane;
    constexpr int I_A = 16 * 104, I_B = 16 * 32, I_C = 16 * 16 * 32, I_D = 16 * 8 * 32;
    for (int it = gw; it < I_A + I_B + I_C + I_D; it += NGW) {
        int r = it;
        if (r < I_A) { const int kb = r / 104, nb = r % 104; tr_item(INP(8) + (size_t)l * D * IN_COLS, IN_COLS, in_colmap(nb * 32 + (lane & 31)), (bf16*)(F.ws + WS_WIN), D, nb * 32, kb * 64, scr, lane); continue; }
        r -= I_A;
        if (r < I_B) { const int kb = r / 32, nb = r % 32; tr_item(INP(9) + (size_t)l * D * D, D, nb * 32 + (lane & 31), (bf16*)(F.ws + WS_WOUT), D, nb * 32, kb * 64, scr, lane); continue; }
        r -= I_B;
        if (r < I_C) { const int e = r / 512, rr = r % 512, kb = rr / 32, nb = rr % 32; const int n0 = nb * 32, j = n0 >> 8, wi = n0 & 255;
            const float* src = (wi < 128 ? INP(35) : INP(36)) + (size_t)(l * 16 + e) * D * 512;
            tr_item(src, 512, 128 * j + (wi & 127) + (lane & 31), (bf16*)(F.ws + WS_W13) + (size_t)e * D * D, D, n0, kb * 64, scr, lane); continue; }
        r -= I_C;
        { const int e = r / 256, rr = r % 256, kb = rr / 32, nb = rr % 32;
            tr_item(INP(37) + (size_t)(l * 16 + e) * 512 * D, D, nb * 32 + (lane & 31), (bf16*)(F.ws + WS_W2T) + (size_t)e * D * 512, 512, nb * 32, kb * 64, scr, lane); }
    }
}
__device__ __forceinline__ void phase_mods(const Frame& F0) {
    PH_ENTER(F0);
    const AS4 Args* KA = kargs();
    LAS float* cond = (LAS float*)F.lds;
    LAS float* red = (LAS float*)(F.lds + 40960);
    for (int i = F.tid; i < 9 * D; i += 512) { const float v = i < 8 * D ? INP(1)[i] : INP(3)[i - 8 * D]; cond[i] = siluf(v); }
    __syncthreads();
    float* mod = (float*)(F.ws + WS_MOD);
    for (int u = F.bid; u < 2 * 96; u += F.G) {
        const int l = u / 96, cb = u % 96, col = cb * 64 + F.lane;
        const float* W = INP(4) + (size_t)l * D * 6144;
        float acc[9];
#pragma unroll
        for (int i = 0; i < 9; ++i) acc[i] = 0.f;
        for (int k = F.wave * 128; k < F.wave * 128 + 128; ++k) { const float w = W[(size_t)k * 6144 + col];
#pragma unroll
            for (int i = 0; i < 9; ++i) acc[i] += cond[i * D + k] * w; }
#pragma unroll
        for (int i = 0; i < 9; ++i) red[(F.wave * 9 + i) * 64 + F.lane] = acc[i];
        __syncthreads();
        for (int o = F.tid; o < 9 * 64; o += 512) { const int i = o / 64, ln = o % 64; float s = 0.f;
#pragma unroll
            for (int w = 0; w < 8; ++w) s += red[(w * 9 + i) * 64 + ln];
            mod[((size_t)l * 9 + i) * 6144 + cb * 64 + ln] = s + INP(5)[(size_t)l * 6144 + cb * 64 + ln]; }
        __syncthreads();
    }
}

__device__ __forceinline__ void phase_norm1(const Frame& F0) {
    PH_ENTER(F0);
    const AS4 Args* KA = kargs();
    const float* xl = F.l == 0 ? INP(0) : (const float*)F.out; const float* xc = F.l == 0 ? INP(2) : (const float*)(F.ws + WS_CTX);
    const int gw = F.bid * 8 + F.wave, NGW = F.G * 8, lane = F.lane;
    const float* g = LP(6, D);
    const float* mod = (const float*)(F.ws + WS_MOD) + (size_t)F.l * 9 * 6144;
    bf16* H = (bf16*)(F.ws + WS_ACT);
    for (int row = gw; row < T; row += NGW) {
        const f32x4* xr = (const f32x4*)xin_row(xl, xc, row) + lane;
        const float* mrow = mod + (size_t)mod_index(row) * 6144;
        f32x4 v[4]; float s = 0.f;
#pragma unroll
        for (int j = 0; j < 4; ++j) { v[j] = xr[64 * j]; s += (v[j].x * v[j].x + v[j].y * v[j].y) + (v[j].z * v[j].z + v[j].w * v[j].w); }
        const float rs = rsqrtf(wave_sum(s) * (1.f / D) + 1e-6f);
        u32x2* o8 = (u32x2*)(H + (size_t)row * D) + lane;
#pragma unroll
        for (int j = 0; j < 4; ++j) { const int c = 4 * lane + 256 * j;
            const f32x4 gg = *(const f32x4*)(g + c), sh = *(const f32x4*)(mrow + c), sc = *(const f32x4*)(mrow + D + c);
            const f32x4 h = (v[j] * rs * gg) * (sc + 1.f) + sh;
            u32x2 w; w.x = pk2(h.x, h.y); w.y = pk2(h.z, h.w); o8[64 * j] = w; }
    }
}

struct SchedStatic {
    int nM, nN, nwg, G, c; const unsigned char* ws; size_t offA, offB;
    __device__ __forceinline__ bool next(int i, pg8::Unit& u) const {
        const long L = (long)i * G + c; if (L >= nwg) return false;
        int wgid = (int)L; { const int q = nwg / 8, r = nwg % 8, xcd = wgid % 8, off = wgid / 8; wgid = (xcd < r ? xcd * (q + 1) : r * (q + 1) + (xcd - r) * q) + off; }
        const int nig = 8 * nN, gid = wgid / nig, fm = gid * 8, gsz = (nM - fm) < 8 ? (nM - fm) : 8;
        u.pm = fm + ((wgid % nig) % gsz); u.pn = (wgid % nig) / gsz; u.aux = 0; return true;
    }
    __device__ __forceinline__ const char* aptr(const pg8::Unit& u) const { return (const char*)ws + offA + (size_t)u.pm * (256 * 1024 * 2); }
    __device__ __forceinline__ const char* bptr(const pg8::Unit& u) const { return (const char*)ws + offB + (size_t)u.pn * (256 * 1024 * 2); }
    __device__ __forceinline__ const char* bptr2(const pg8::Unit& u) const { return bptr(u); }
};
struct EpiU {
    static constexpr bool PERM = true;
    unsigned char* ws;
    __device__ __forceinline__ void operator()(const f32x4 (&acc)[2][2][4][2], const pg8::Unit& u, int wr, int wc, int fr, int fq) const {
        const int row0 = u.pm * 256 + wr * 64 + fr, pn = u.pn;
        float* u_misc = (float*)(ws + WS_UMISC);
        if (pn < 12) {
            bf16* base; int ld, c0;
            if (pn < 4) { base = (bf16*)(ws + WS_URW); ld = 1024; c0 = pn * 256; } else if (pn < 6) { base = (bf16*)(ws + WS_UZ); ld = 512; c0 = (pn - 4) * 256; }
            else if (pn < 9) { base = (bf16*)(ws + WS_UXBC); ld = 768; c0 = (pn - 6) * 256; } else { base = (bf16*)(ws + WS_UGLA); ld = 768; c0 = (pn - 9) * 256; }
            const int col0 = c0 + wc * 32 + 8 * fq;
#pragma unroll
            for (int ai = 0; ai < 2; ++ai)
#pragma unroll
                for (int m = 0; m < 4; ++m) { bf16* rowp = base + (size_t)(row0 + ai * 128 + m * 16) * ld + col0;
#pragma unroll
                    for (int bj = 0; bj < 2; ++bj) { const f32x4 v0 = acc[ai][bj][m][0], v1 = acc[ai][bj][m][1];
                        u32x4 w; w.x = pg8::cvt_pk_bf16(v0[0], v0[1]); w.y = pg8::cvt_pk_bf16(v0[2], v0[3]); w.z = pg8::cvt_pk_bf16(v1[0], v1[1]); w.w = pg8::cvt_pk_bf16(v1[2], v1[3]);
                        *(u32x4*)(rowp + bj * 128) = w; } }
        } else if (wc == 0) {
#pragma unroll
            for (int ai = 0; ai < 2; ++ai)
#pragma unroll
                for (int m = 0; m < 4; ++m) { float* rp = u_misc + (size_t)(row0 + ai * 128 + m * 16) * 32 + 8 * fq;
                    *(f32x4*)rp = acc[ai][0][m][0]; *(f32x4*)(rp + 4) = acc[ai][0][m][1]; }
        }
    }
};
struct EpiRes {
    static constexpr bool PERM = false;
    const float* xin_lat; const float* xin_ctx; float* out; unsigned char* ws; int l;
    __device__ __forceinline__ void operator()(const f32x4 (&acc)[2][2][4][2], const pg8::Unit& u, int wr, int wc, int fr, int fq) const {
        const int b = u.pm / 33, tb = u.pm % 33;
        const float* mod = (const float*)(ws + WS_MOD) + (size_t)l * 9 * 6144;
        const float* xi; float* xo; const float* mrow;
        if (tb == 0) { xi = xin_ctx + (size_t)b * TC * D; xo = (float*)(ws + WS_CTX) + (size_t)b * TC * D; mrow = mod + (size_t)8 * 6144 + 2 * D; }
        else { const size_t o = ((size_t)b * TL + (size_t)(tb - 1) * 256) * D; xi = xin_lat + o; xo = out + o; mrow = mod + (size_t)b * 6144 + 2 * D; }
        const int r0 = wr * 64 + fr, col0 = u.pn * 256 + wc * 32 + 4 * fq;
#pragma unroll
        for (int ai = 0; ai < 2; ++ai)
#pragma unroll
            for (int m = 0; m < 4; ++m) { const size_t off = (size_t)(r0 + ai * 128 + m * 16) * D + col0;
#pragma unroll
                for (int bj = 0; bj < 2; ++bj)
#pragma unroll
                    for (int n = 0; n < 2; ++n) { const f32x4 xv = *(const f32x4*)(xi + off + bj * 128 + n * 16); const f32x4 gv = *(const f32x4*)(mrow + col0 + bj * 128 + n * 16);
                        *(f32x4*)(xo + off + bj * 128 + n * 16) = xv + gv * acc[ai][bj][m][n]; }
                asm volatile("" ::: "memory"); }
    }
};
__device__ __forceinline__ void cls_experts(int cls, int& ea, int& eb) {
    const int g = cls / 6, pr = cls % 6;
    const int pa = pr < 3 ? 0 : (pr < 5 ? 1 : 2);
    const int pb = pr == 0 ? 1 : (pr == 1 ? 2 : (pr == 2 ? 3 : (pr == 3 ? 2 : 3)));
    ea = g * 4 + pa; eb = g * 4 + pb;
}
template <int NJ> struct SchedMoE {
    int ntiles, G, c; const LAS int* cs; const unsigned char* ws;
    __device__ __forceinline__ bool next(int i, pg8::Unit& u) const {
        const long L = (long)i * G + c; if (L >= (long)ntiles * NJ) return false;
        const int tile = (int)(L / NJ), j = (int)(L % NJ), slot0 = tile * 256;
        int cls = 0;
#pragma unroll 1
        for (int k = 1; k < NCLS; ++k) cls = (slot0 >= cs[k]) ? k : cls;
        u.pm = tile; u.pn = j; u.aux = cls; return true;
    }
    __device__ __forceinline__ const char* aptr(const pg8::Unit& u) const { return (const char*)ws + (NJ == 8 ? WS_TOKS : WS_H1) + (size_t)u.pm * (256 * 1024 * 2); }
    __device__ __forceinline__ const char* bptr(const pg8::Unit& u) const { int ea, eb; cls_experts(u.aux, ea, eb);
        if (NJ == 8) { const int e = u.pn < 4 ? ea : eb; return (const char*)ws + WS_W13 + ((size_t)e * D + (size_t)(u.pn & 3) * 256) * D * 2; }
        return (const char*)ws + WS_W2T + ((size_t)ea * D + (size_t)u.pn * 256) * 512 * 2; }
    __device__ __forceinline__ const char* bptr2(const pg8::Unit& u) const { int ea, eb; cls_experts(u.aux, ea, eb);
        return (const char*)ws + WS_W2T + ((size_t)eb * D + (size_t)u.pn * 256) * 512 * 2; }
};
struct EpiSwiGLU {
    static constexpr bool PERM = true;
    unsigned char* ws;
    __device__ __forceinline__ void operator()(const f32x4 (&acc)[2][2][4][2], const pg8::Unit& u, int wr, int wc, int fr, int fq) const {
        bf16* H1 = (bf16*)(ws + WS_H1); const f32x2* wslot = (const f32x2*)(ws + WS_WSLOT);
        const int row0 = u.pm * 256 + wr * 64 + fr, j = u.pn;
        const int col0 = (j >> 2) * 512 + (j & 3) * 128 + wc * 32 + 8 * fq;
#pragma unroll
        for (int ai = 0; ai < 2; ++ai)
#pragma unroll
            for (int m = 0; m < 4; ++m) { const int row = row0 + ai * 128 + m * 16; const f32x2 wv = wslot[row]; const float w = j < 4 ? wv.x : wv.y;
                float o[8];
#pragma unroll
                for (int n = 0; n < 2; ++n)
#pragma unroll
                    for (int i = 0; i < 4; ++i) { const float gt = acc[ai][0][m][n][i], up = acc[ai][1][m][n][i]; o[n * 4 + i] = siluf(gt) * up * w; }
                u32x4 wv4; wv4.x = pg8::cvt_pk_bf16(o[0], o[1]); wv4.y = pg8::cvt_pk_bf16(o[2], o[3]); wv4.z = pg8::cvt_pk_bf16(o[4], o[5]); wv4.w = pg8::cvt_pk_bf16(o[6], o[7]);
                *(u32x4*)(H1 + (size_t)row * D + col0) = wv4; }
    }
};
struct EpiScatter {
    static constexpr bool PERM = false;
    float* x_lat; unsigned char* ws; int l;
    __device__ __forceinline__ void operator()(const f32x4 (&acc)[2][2][4][2], const pg8::Unit& u, int wr, int wc, int fr, int fq) const {
        const int* list = (const int*)(ws + WS_LIST); float* x_ctx = (float*)(ws + WS_CTX); const float* mod = (const float*)(ws + WS_MOD) + (size_t)l * 9 * 6144;
        const int row0 = u.pm * 256 + wr * 64 + fr, col0 = u.pn * 256 + wc * 32 + 4 * fq;
#pragma unroll
        for (int ai = 0; ai < 2; ++ai)
#pragma unroll
            for (int m = 0; m < 4; ++m) { const int tok = list[row0 + ai * 128 + m * 16];
                if (tok >= 0) { const int b = tok / TB, p = tok % TB;
                    float* xr = p < TC ? x_ctx + ((size_t)b * TC + p) * D : x_lat + ((size_t)b * TL + (p - TC)) * D;
                    const float* mrow = mod + (size_t)(p < TC ? 8 : b) * 6144 + 5 * D;
#pragma unroll
                    for (int bj = 0; bj < 2; ++bj)
#pragma unroll
                        for (int n = 0; n < 2; ++n) { const int c = col0 + bj * 128 + n * 16; const f32x4 gv = *(const f32x4*)(mrow + c);
                            *(f32x4*)(xr + c) = *(const f32x4*)(xr + c) + gv * acc[ai][bj][m][n]; } }
                asm volatile("" ::: "memory"); }
    }
};

__device__ __forceinline__ void phase_prep(const Frame& F0) {
    PH_ENTER(F0);
    const AS4 Args* KA = kargs();
    const int tid = F.tid, lane = F.lane;
    const bf16* URW = (const bf16*)(F.ws + WS_URW); const bf16* UXBC = (const bf16*)(F.ws + WS_UXBC);
    bf16* XBCA = (bf16*)(F.ws + WS_XBCA);
    h16* RECS = (h16*)(F.ws + WS_RECS); h16* RECD = (h16*)(F.ws + WS_RECD); h16* BONUS = (h16*)(F.ws + WS_BONUS); h16* GATE = (h16*)(F.ws + WS_GATE);
    const float* mup = LP(10, 1024); const float* mun = LP(11, 1024);
    const float* w0 = LP(12, 512); const float* w2 = LP(13, 2 * 64 * 256); const float* a0 = LP(14, 512); const float* a2 = LP(15, 2 * 64 * 256);
    const float* g2 = LP(16, 128 * 256); const float* k_k = LP(17, 256); const float* k_a = LP(18, 256); const float* r_k = LP(19, 256);
    const float* cw = LP(22, 9 * 768); const float* cb = LP(23, 768);
    LAS float* WL = (LAS float*)F.lds;
    LAS float* AL = (LAS float*)(F.lds + 8192);
    LAS float* GS = (LAS float*)(F.lds + 16384);
    for (int u = F.bid; u < NUNIT64; u += F.G) {
        const int b = u / NTILE64, tl = u % NTILE64, p0 = tl * 64;
        const int seg_lo = p0 < TC ? 0 : TC, seg_hi = p0 < TC ? TC : TB;
        const size_t rowbase = (size_t)b * TB;
        for (int item = tid; item < 64 * 96; item += 512) {
            const int t = item / 96, cg = item % 96, ch0 = cg * 8, p = p0 + t;
            float acc[8];
            { const f32x4 b0 = *(const f32x4*)(cb + ch0), b1 = *(const f32x4*)(cb + ch0 + 4); acc[0] = b0.x; acc[1] = b0.y; acc[2] = b0.z; acc[3] = b0.w; acc[4] = b1.x; acc[5] = b1.y; acc[6] = b1.z; acc[7] = b1.w; }
            if (p >= TC) {
                const int tok = p - TC, gr = tok >> 6, gc = tok & 63;
#pragma unroll
                for (int dy = 0; dy < 3; ++dy) { const int y = gr + dy - 1; if (y < 0 || y >= 128) continue;
#pragma unroll
                    for (int dx = 0; dx < 3; ++dx) { const int x = gc + dx - 1; if (x < 0 || x >= 64) continue;
                        const u32x4 raw = *(const u32x4*)(UXBC + (rowbase + TC + y * 64 + x) * 768 + ch0); float v[8]; unpack8(raw, v);
                        const float* wp = cw + (dy * 3 + dx) * 768 + ch0; const f32x4 wa = *(const f32x4*)wp, wb = *(const f32x4*)(wp + 4);
                        acc[0] += v[0] * wa.x; acc[1] += v[1] * wa.y; acc[2] += v[2] * wa.z; acc[3] += v[3] * wa.w; acc[4] += v[4] * wb.x; acc[5] += v[5] * wb.y; acc[6] += v[6] * wb.z; acc[7] += v[7] * wb.w; } }
            } else {
#pragma unroll
                for (int dx = 0; dx < 3; ++dx) { const int x = p + dx - 1; if (x < 0 || x >= TC) continue;
                    const u32x4 raw = *(const u32x4*)(UXBC + (rowbase + x) * 768 + ch0); float v[8]; unpack8(raw, v);
                    const float* wp = cw + (3 + dx) * 768 + ch0; const f32x4 wa = *(const f32x4*)wp, wb = *(const f32x4*)(wp + 4);
                    acc[0] += v[0] * wa.x; acc[1] += v[1] * wa.y; acc[2] += v[2] * wa.z; acc[3] += v[3] * wa.w; acc[4] += v[4] * wb.x; acc[5] += v[5] * wb.y; acc[6] += v[6] * wb.z; acc[7] += v[7] * wb.w; }
            }
#pragma unroll
            for (int i = 0; i < 8; ++i) acc[i] = siluf(acc[i]);
            *(u32x4*)(XBCA + (rowbase + p) * 768 + ch0) = pack8(acc);
        }
        for (int hf = 0; hf < 2; ++hf) {
            const int q0 = p0 + 32 * hf;
            __syncthreads();
            {
                const int t = tid >> 4, cg = tid & 15, p = q0 + t, c0 = 768 + 16 * cg;
                const bf16* ur = URW + (rowbase + p) * 1024 + c0;
                float uc[16], up[16], un[16];
                { const u32x4 r0 = *(const u32x4*)ur, r1 = *(const u32x4*)(ur + 8); unpack8(r0, uc); unpack8(r1, uc + 8); }
                if (p - 1 >= seg_lo) { const u32x4 r0 = *(const u32x4*)(ur - 1024), r1 = *(const u32x4*)(ur - 1024 + 8); unpack8(r0, up); unpack8(r1, up + 8); }
                else {
#pragma unroll
                    for (int i = 0; i < 16; ++i) up[i] = 0.f; }
                if (p + 1 < seg_hi) { const u32x4 r0 = *(const u32x4*)(ur + 1024), r1 = *(const u32x4*)(ur + 1024 + 8); unpack8(r0, un); unpack8(r1, un + 8); }
                else {
#pragma unroll
                    for (int i = 0; i < 16; ++i) un[i] = 0.f; }
#pragma unroll
                for (int i = 0; i < 16; ++i) { const int c = c0 + i; const float s = uc[i] + mup[c] * (up[i] - uc[i]) + mun[c] * (un[i] - uc[i]);
                    if (cg < 4) WL[t * 64 + (c - 768)] = tanhf(s); else if (cg < 8) AL[t * 64 + (c - 832)] = s; else GS[t * 128 + (c - 896)] = sigm(s); }
            }
            __syncthreads();
            {
                const int c = tid & 255, th = tid >> 8, h = c >> 6, cl = c & 63;
                float aw0[16], aw1[16], aa0[16], aa1[16], ag[16];
#pragma unroll
                for (int t = 0; t < 16; ++t) { aw0[t] = 0.f; aw1[t] = 0.f; aa0[t] = 0.f; aa1[t] = 0.f; ag[t] = 0.f; }
                for (int j = 0; j < 64; j += 4) {
                    float w20[4], w21[4], a20[4], a21[4];
#pragma unroll
                    for (int jj = 0; jj < 4; ++jj) { w20[jj] = w2[(size_t)(j + jj) * 256 + c]; w21[jj] = w2[(size_t)(64 + j + jj) * 256 + c]; a20[jj] = a2[(size_t)(j + jj) * 256 + c]; a21[jj] = a2[(size_t)(64 + j + jj) * 256 + c]; }
#pragma unroll
                    for (int t = 0; t < 16; ++t) { const f32x4 x = *(const LAS f32x4*)(WL + (th * 16 + t) * 64 + j), y = *(const LAS f32x4*)(AL + (th * 16 + t) * 64 + j);
                        aw0[t] += x.x * w20[0] + x.y * w20[1] + x.z * w20[2] + x.w * w20[3]; aw1[t] += x.x * w21[0] + x.y * w21[1] + x.z * w21[2] + x.w * w21[3];
                        aa0[t] += y.x * a20[0] + y.y * a20[1] + y.z * a20[2] + y.w * a20[3]; aa1[t] += y.x * a21[0] + y.y * a21[1] + y.z * a21[2] + y.w * a21[3]; }
                }
                for (int j = 0; j < 128; j += 4) {
                    float gg[4];
#pragma unroll
                    for (int jj = 0; jj < 4; ++jj) gg[jj] = g2[(size_t)(j + jj) * 256 + c];
#pragma unroll
                    for (int t = 0; t < 16; ++t) { const f32x4 x = *(const LAS f32x4*)(GS + (th * 16 + t) * 128 + j); ag[t] += x.x * gg[0] + x.y * gg[1] + x.z * gg[2] + x.w * gg[3]; }
                }
                const float kkc = k_k[c], kac = k_a[c], rkc = r_k[c];
                const float w00 = w0[c], w01 = w0[256 + c], a00 = a0[c], a01 = a0[256 + c];
                const float mpr = mup[c], mnr = mun[c], mpk = mup[256 + c], mnk = mun[256 + c], mpv = mup[512 + c], mnv = mun[512 + c];
                const int pq = q0 + th * 16;
                float ur_p, uk_p, uv_p, ur_c, uk_c, uv_c, ur_n, uk_n, uv_n;
                { const bf16* rp = URW + (rowbase + pq) * 1024 + c;
                    ur_c = bf2f(rp[0]); uk_c = bf2f(rp[256]); uv_c = bf2f(rp[512]);
                    if (pq - 1 >= seg_lo) { ur_p = bf2f(rp[-1024]); uk_p = bf2f(rp[-1024 + 256]); uv_p = bf2f(rp[-1024 + 512]); } else { ur_p = 0.f; uk_p = 0.f; uv_p = 0.f; } }
#pragma unroll
                for (int t = 0; t < 16; ++t) {
                    const int p = pq + t; const bf16* rp = URW + (rowbase + p) * 1024 + c;
                    if (p + 1 < seg_hi) { ur_n = bf2f(rp[1024]); uk_n = bf2f(rp[1024 + 256]); uv_n = bf2f(rp[1024 + 512]); } else { ur_n = 0.f; uk_n = 0.f; uv_n = 0.f; }
                    const float r = ur_c + mpr * (ur_p - ur_c) + mnr * (ur_n - ur_c);
                    const float k = uk_c + mpk * (uk_p - uk_c) + mnk * (uk_n - uk_c);
                    const float v = uv_c + mpv * (uv_p - uv_c) + mnv * (uv_n - uv_c);
                    const float kr = k * kkc;
                    const float ss = wave_sum(kr * kr), bs = wave_sum(r * k * rkc);
                    const float kk = kr * rsqrtf(ss + 1e-12f);
                    const size_t rs = (((size_t)b * 4 + h) * TB + p) * 192 + cl;
                    RECS[rs] = (h16)r; RECS[rs + 64] = (h16)v; RECS[rs + 128] = (h16)kk;
#pragma unroll
                    for (int d = 0; d < 2; ++d) {
                        const float xw = (d ? w01 : w00) + (d ? aw1[t] : aw0[t]);
                        const float e = 0.60653066f * sigm(xw);
                        const float om = -expm1f(-e);
                        const float a = sigm((d ? a01 : a00) + (d ? aa1[t] : aa0[t]));
                        const float kmod = k * (1.f + (a - 1.f) * kac), bb = kk * a;
                        const size_t rd = ((((size_t)b * 4 + h) * 2 + d) * TB + p) * 192 + cl;
                        RECD[rd] = (h16)om; RECD[rd + 64] = (h16)kmod; RECD[rd + 128] = (h16)bb;
                    }
                    BONUS[(rowbase + p) * 256 + c] = (h16)(bs * v); GATE[(rowbase + p) * 256 + c] = (h16)ag[t];
                    ur_p = ur_c; uk_p = uk_c; uv_p = uv_c; ur_c = ur_n; uk_c = uk_n; uv_c = uv_n;
                }
            }
        }
        __syncthreads();
    }
}

__device__ __forceinline__ void phase_scan_rwkv(const Frame& F0) {
    PH_ENTER(F0);
    const int tid = F.tid;
    const h16* RECS = (const h16*)(F.ws + WS_RECS); const h16* RECD = (const h16*)(F.ws + WS_RECD);
    bf16* YRW = (bf16*)(F.ws + WS_YRW);
    LAS float* Av = (LAS float*)F.lds; LAS float* Wv = Av + 2048; LAS float* Kv = Wv + 2048; LAS float* Bv = Kv + 2048; LAS float* Rv = Bv + 2048; LAS float* Vv = Rv + 2048; LAS float* yb = Vv + 2048;
    for (int u = F.bid; u < 256; u += F.G) {
        const int chain = u >> 2, q = u & 3, d = chain & 1, bh = chain >> 1, b = bh >> 2, h = bh & 3;
        const int rl = tid >> 4, seg = tid & 15, row = q * 16 + (rl & 15);
        float S0 = 0.f, S1 = 0.f, S2 = 0.f, S3 = 0.f;
        for (int it = 0; it < 264; ++it) {
            const int ti = d == 0 ? it : (it < 8 ? 7 - it : 263 - (it - 8)), p0 = ti * 32;
            __syncthreads();
            for (int ch = tid; ch < 1536; ch += 512) {
                const int isD = ch >= 768, cc = isD ? ch - 768 : ch, tok = cc / 24, rem = cc % 24, vec = rem >> 3, c8 = (rem & 7) * 8;
                const h16* src = isD ? RECD + ((size_t)chain * TB + p0) * 192 : RECS + ((size_t)bh * TB + p0) * 192;
                const h16x8 hv = *(const h16x8*)(src + (size_t)cc * 8);
                float f[8];
#pragma unroll
                for (int i = 0; i < 8; ++i) f[i] = (float)hv[i];
                LAS float* dst;
                if (!isD) { dst = vec == 0 ? Rv : (vec == 1 ? Vv : Av); if (vec == 2) {
#pragma unroll
                        for (int i = 0; i < 8; ++i) f[i] = -f[i]; } }
                else { dst = vec == 0 ? Wv : (vec == 1 ? Kv : Bv); if (vec == 0) {
#pragma unroll
                        for (int i = 0; i < 8; ++i) f[i] = 1.f - f[i]; } }
                *(LAS f32x4*)(dst + tok * 64 + c8) = (f32x4){f[0], f[1], f[2], f[3]}; *(LAS f32x4*)(dst + tok * 64 + c8 + 4) = (f32x4){f[4], f[5], f[6], f[7]};
            }
            __syncthreads();
            if (tid < 256) {
#pragma unroll 4
                for (int s = 0; s < 32; ++s) {
                    const int tt = d == 0 ? s : 31 - s;
                    const f32x4 a4 = *(const LAS f32x4*)(Av + tt * 64 + 4 * seg), w4 = *(const LAS f32x4*)(Wv + tt * 64 + 4 * seg), k4 = *(const LAS f32x4*)(Kv + tt * 64 + 4 * seg);
                    const f32x4 b4 = *(const LAS f32x4*)(Bv + tt * 64 + 4 * seg), r4 = *(const LAS f32x4*)(Rv + tt * 64 + 4 * seg);
                    const float vv = Vv[tt * 64 + row];
                    float sa = S0 * a4.x + S1 * a4.y + S2 * a4.z + S3 * a4.w;
                    sa = sum16(sa);
                    S0 = S0 * w4.x + sa * b4.x + vv * k4.x; S1 = S1 * w4.y + sa * b4.y + vv * k4.y; S2 = S2 * w4.z + sa * b4.z + vv * k4.z; S3 = S3 * w4.w + sa * b4.w + vv * k4.w;
                    float y = S0 * r4.x + S1 * r4.y + S2 * r4.z + S3 * r4.w;
                    y = sum16(y);
                    if (seg == 0) yb[tt * 16 + rl] = y;
                }
            }
            __syncthreads();
            { const int tok = tid >> 4, r2 = tid & 15;
                YRW[((size_t)d * T + (size_t)b * TB + p0 + tok) * 256 + h * 64 + q * 16 + r2] = (bf16)f2bf(yb[tok * 16 + r2]); }
        }
        __syncthreads();
    }
}
__device__ __forceinline__ void phase_scan_ssd(const Frame& F0) {
    PH_ENTER(F0);
    const AS4 Args* KA = kargs();
    const int tid = F.tid;
    const bf16* XBCA = (const bf16*)(F.ws + WS_XBCA); const float* UM = (const float*)(F.ws + WS_UMISC);
    bf16* YS = (bf16*)(F.ws + WS_YSSD);
    const float* dtb = LP(24, 16); const float* alog = LP(25, 16);
    LAS float* X = (LAS float*)F.lds; LAS float* Bm = X + 64 * 32; LAS float* Cm = Bm + 64 * 64; LAS float* dec = Cm + 64 * 64; LAS float* dtp = dec + 64; LAS float* yb = dtp + 64;
    for (int u = F.bid; u < 256; u += F.G) {
        const int chain = u >> 1, half = u & 1, d = chain & 1, bh = chain >> 1, b = bh >> 3, h = bh & 7, g = h >> 2;
        const int row = tid >> 4, seg = tid & 15;
        const float dtbias = dtb[d * 8 + h], aexp = -__expf(alog[d * 8 + h]);
        float S0 = 0.f, S1 = 0.f, S2 = 0.f, S3 = 0.f;
        for (int it = 0; it < 132; ++it) {
            const int ti = d == 0 ? it : (it < 4 ? 3 - it : 131 - (it - 4)), p0 = ti * 64;
            __syncthreads();
            { const int t = tid >> 3, part = tid & 7; const size_t grow = (size_t)b * TB + p0 + t; const bf16* xr = XBCA + grow * 768; float f[8];
                if (part < 4) { unpack8(*(const u32x4*)(xr + h * 64 + half * 32 + 8 * part), f);
#pragma unroll
                    for (int i = 0; i < 8; ++i) X[t * 32 + 8 * part + i] = f[i]; }
                unpack8(*(const u32x4*)(xr + 512 + g * 64 + 8 * part), f);
#pragma unroll
                for (int i = 0; i < 8; ++i) Bm[t * 64 + 8 * part + i] = f[i];
                unpack8(*(const u32x4*)(xr + 640 + g * 64 + 8 * part), f);
#pragma unroll
                for (int i = 0; i < 8; ++i) Cm[t * 64 + 8 * part + i] = f[i];
                if (part == 0) { const float dv = softplusf_(UM[grow * 32 + h] + dtbias); dtp[t] = dv; dec[t] = __expf(aexp * dv); } }
            __syncthreads();
#pragma unroll 4
            for (int s = 0; s < 64; ++s) {
                const int tt = d == 0 ? s : 63 - s;
                const float xv = X[tt * 32 + row] * dtp[tt], de = dec[tt];
                const f32x4 b4 = *(const LAS f32x4*)(Bm + tt * 64 + 4 * seg), c4 = *(const LAS f32x4*)(Cm + tt * 64 + 4 * seg);
                S0 = S0 * de + xv * b4.x; S1 = S1 * de + xv * b4.y; S2 = S2 * de + xv * b4.z; S3 = S3 * de + xv * b4.w;
                float y = S0 * c4.x + S1 * c4.y + S2 * c4.z + S3 * c4.w;
                y = sum16(y);
                if (seg == 0) yb[tt * 32 + row] = y;
            }
            __syncthreads();
            { const int tok = tid >> 3, c4 = (tid & 7) * 4; const LAS float* yp = yb + tok * 32 + c4;
                u32x2 w; w.x = pk2(yp[0], yp[1]); w.y = pk2(yp[2], yp[3]);
                *(u32x2*)(YS + ((size_t)d * T + (size_t)b * TB + p0 + tok) * 512 + h * 64 + half * 32 + c4) = w; }
        }
        __syncthreads();
    }
}
__device__ __forceinline__ void phase_scan_gla(const Frame& F0) {
    PH_ENTER(F0);
    const AS4 Args* KA = kargs();
    const int tid = F.tid;
    const bf16* UG = (const bf16*)(F.ws + WS_UGLA); const float* UM = (const float*)(F.ws + WS_UMISC);
    bf16* OG = (bf16*)(F.ws + WS_OGLA);
    const float* ga2 = LP(28, 2 * 16 * 128); const float* gb = LP(29, 256);
    LAS float* Q = (LAS float*)F.lds; LAS float* Kk = Q + 64 * 32; LAS float* Al = Kk + 64 * 32; LAS float* Vv = Al + 64 * 32; LAS float* ob = Vv + 64 * 64;
    for (int u = F.bid; u < 64; u += F.G) {
        const int chain = u, d = chain & 1, bh = chain >> 1, b = bh >> 2, h = bh & 3;
        const int dvc = tid >> 3, dkg = tid & 7;
        float S0 = 0.f, S1 = 0.f, S2 = 0.f, S3 = 0.f;
        for (int it = 0; it < 132; ++it) {
            const int ti = d == 0 ? it : (it < 4 ? 3 - it : 131 - (it - 4)), p0 = ti * 64;
            __syncthreads();
            { const int t = tid >> 3, part = tid & 7; const size_t grow = (size_t)b * TB + p0 + t; const bf16* ur = UG + grow * 768; float f[8];
                if (part < 4) { unpack8(*(const u32x4*)(ur + h * 32 + 8 * part), f);
#pragma unroll
                    for (int i = 0; i < 8; ++i) Q[t * 32 + 8 * part + i] = f[i] * 0.17677669529663687f; }
                else { unpack8(*(const u32x4*)(ur + 128 + h * 32 + 8 * (part - 4)), f);
#pragma unroll
                    for (int i = 0; i < 8; ++i) Kk[t * 32 + 8 * (part - 4) + i] = f[i]; }
                unpack8(*(const u32x4*)(ur + 256 + h * 64 + 8 * part), f);
#pragma unroll
                for (int i = 0; i < 8; ++i) Vv[t * 64 + 8 * part + i] = f[i];
                float gl[16];
#pragma unroll
                for (int j = 0; j < 4; ++j) { const f32x4 g4 = *(const f32x4*)(UM + grow * 32 + 8 + 4 * j); gl[4 * j] = g4.x; gl[4 * j + 1] = g4.y; gl[4 * j + 2] = g4.z; gl[4 * j + 3] = g4.w; }
#pragma unroll
                for (int i = 0; i < 4; ++i) { const int dk = 4 * part + i, col = h * 32 + dk; float z = gb[d * 128 + col];
#pragma unroll
                    for (int j = 0; j < 16; ++j) z += gl[j] * ga2[(size_t)(d * 16 + j) * 128 + col];
                    const float ls = -softplusf_(-z) * (1.f / 16.f); Al[t * 32 + dk] = __expf(ls); } }
            __syncthreads();
#pragma unroll 4
            for (int s = 0; s < 64; ++s) {
                const int tt = d == 0 ? s : 63 - s;
                const f32x4 a4 = *(const LAS f32x4*)(Al + tt * 32 + 4 * dkg), k4 = *(const LAS f32x4*)(Kk + tt * 32 + 4 * dkg), q4 = *(const LAS f32x4*)(Q + tt * 32 + 4 * dkg);
                const float v = Vv[tt * 64 + dvc];
                S0 = S0 * a4.x + k4.x * v; S1 = S1 * a4.y + k4.y * v; S2 = S2 * a4.z + k4.z * v; S3 = S3 * a4.w + k4.w * v;
                float o = S0 * q4.x + S1 * q4.y + S2 * q4.z + S3 * q4.w;
                o = sum8(o);
                if (dkg == 0) ob[tt * 64 + dvc] = o;
            }
            __syncthreads();
            { const int tok = tid >> 3, c8 = (tid & 7) * 8; const LAS float* op = ob + tok * 64 + c8; float f[8];
#pragma unroll
                for (int i = 0; i < 8; ++i) f[i] = op[i];
                *(u32x4*)(OG + ((size_t)d * T + (size_t)b * TB + p0 + tok) * 256 + h * 64 + c8) = pack8(f); }
        }
        __syncthreads();
    }
}

__device__ __forceinline__ void phase_finish(const Frame& F0) {
    PH_ENTER(F0);
    const AS4 Args* KA = kargs();
    const int gw = F.bid * 8 + F.wave, NGW = F.G * 8, lane = F.lane;
    const bf16* YRW = (const bf16*)(F.ws + WS_YRW); const bf16* YS = (const bf16*)(F.ws + WS_YSSD); const bf16* OG = (const bf16*)(F.ws + WS_OGLA);
    const h16* BONUS = (const h16*)(F.ws + WS_BONUS); const h16* GATE = (const h16*)(F.ws + WS_GATE);
    const bf16* XBCA = (const bf16*)(F.ws + WS_XBCA); const bf16* UZ = (const bf16*)(F.ws + WS_UZ); const bf16* UG = (const bf16*)(F.ws + WS_UGLA);
    bf16* MIX = (bf16*)(F.ws + WS_ACT);
    const float* gng = LP(20, 256); const float* gnb = LP(21, 256); const float* dsk = LP(26, 8); const float* sng = LP(27, 512); const float* gln = LP(30, 256);
    for (int row = gw; row < T; row += NGW) {
        const size_t r = (size_t)row;
        {
            const int c = 4 * lane;
            const u32x2 f0 = *(const u32x2*)(YRW + r * 256 + c), f1 = *(const u32x2*)(YRW + ((size_t)T + r) * 256 + c);
            float y[4] = { bf2f(f0.x & 0xffff) + bf2f(f1.x & 0xffff), bf2f(f0.x >> 16) + bf2f(f1.x >> 16), bf2f(f0.y & 0xffff) + bf2f(f1.y & 0xffff), bf2f(f0.y >> 16) + bf2f(f1.y >> 16) };
            const float mu = sum16((y[0] + y[1]) + (y[2] + y[3])) * (1.f / 64.f);
            float q = 0.f;
#pragma unroll
            for (int i = 0; i < 4; ++i) { y[i] -= mu; q += y[i] * y[i]; }
            const float rs = rsqrtf(sum16(q) * (1.f / 64.f) + 64e-5f);
            const h16x4 bo = *(const h16x4*)(BONUS + r * 256 + c), ga = *(const h16x4*)(GATE + r * 256 + c);
            const f32x4 gg = *(const f32x4*)(gng + c), gb4 = *(const f32x4*)(gnb + c);
            float o[4];
#pragma unroll
            for (int i = 0; i < 4; ++i) o[i] = (y[i] * rs * gg[i] + gb4[i] + (float)bo[i]) * (float)ga[i];
            u32x2 w; w.x = pk2(o[0], o[1]); w.y = pk2(o[2], o[3]); *(u32x2*)(MIX + r * D + c) = w;
        }
        {
            const int c = 8 * lane, h = lane >> 3;
            float yf[8], ybk[8], xs[8], z[8];
            unpack8(*(const u32x4*)(YS + r * 512 + c), yf); unpack8(*(const u32x4*)(YS + ((size_t)T + r) * 512 + c), ybk);
            unpack8(*(const u32x4*)(XBCA + r * 768 + c), xs); unpack8(*(const u32x4*)(UZ + r * 512 + c), z);
            const float ds = dsk[h]; float g[8], ss = 0.f;
#pragma unroll
            for (int i = 0; i < 8; ++i) { g[i] = (yf[i] + ybk[i] + ds * xs[i]) * siluf(z[i]); ss += g[i] * g[i]; }
            const float rs = rsqrtf(wave_sum(ss) * (1.f / 512.f) + 1e-6f);
            const f32x4 n0 = *(const f32x4*)(sng + c), n1 = *(const f32x4*)(sng + c + 4);
            float o[8];
#pragma unroll
            for (int i = 0; i < 4; ++i) { o[i] = g[i] * rs * n0[i]; o[4 + i] = g[4 + i] * rs * n1[i]; }
            *(u32x4*)(MIX + r * D + 256 + c) = pack8(o);
        }
        {
            const int c = 4 * lane;
            const u32x2 f0 = *(const u32x2*)(OG + r * 256 + c), f1 = *(const u32x2*)(OG + ((size_t)T + r) * 256 + c), rr = *(const u32x2*)(UG + r * 768 + 512 + c);
            float o[4] = { bf2f(f0.x & 0xffff) + bf2f(f1.x & 0xffff), bf2f(f0.x >> 16) + bf2f(f1.x >> 16), bf2f(f0.y & 0xffff) + bf2f(f1.y & 0xffff), bf2f(f0.y >> 16) + bf2f(f1.y >> 16) };
            const float rv[4] = { bf2f(rr.x & 0xffff), bf2f(rr.x >> 16), bf2f(rr.y & 0xffff), bf2f(rr.y >> 16) };
            const float rs = rsqrtf(sum16((o[0] * o[0] + o[1] * o[1]) + (o[2] * o[2] + o[3] * o[3])) * (1.f / 64.f) + 1e-6f);
            const f32x4 gn = *(const f32x4*)(gln + c);
#pragma unroll
            for (int i = 0; i < 4; ++i) o[i] = o[i] * rs * gn[i] * siluf(rv[i]);
            u32x2 w; w.x = pk2(o[0], o[1]); w.y = pk2(o[2], o[3]); *(u32x2*)(MIX + r * D + 768 + c) = w;
        }
    }
}

__device__ __forceinline__ void phase_router(const Frame& F0) {
    PH_ENTER(F0);
    const AS4 Args* KA = kargs();
    const int tid = F.tid, lane = F.lane, wave = F.wave;
    LAS float* RW = (LAS float*)F.lds;
    LAS int* lcnt = (LAS int*)(F.lds + 81920);
    const float* rgw = LP(31, D * 4); const float* rew = LP(33, D * 16); const float* rgb = LP(32, 4); const float* reb = LP(34, 16);
    for (int i = tid; i < 20 * D; i += 512) { const int e = i / D, k = i % D; RW[i] = e < 4 ? rgw[k * 4 + e] : rew[k * 16 + (e - 4)]; }
    if (tid < NCLS) lcnt[tid] = 0;
    __syncthreads();
    const float* g = LP(7, D);
    const float* mod = (const float*)(F.ws + WS_MOD) + (size_t)F.l * 9 * 6144;
    bf16* TOK = (bf16*)(F.ws + WS_ACT);
    int4* TI = (int4*)(F.ws + WS_TOKINFO);
    int* CNT = (int*)(F.ws + WS_CNT);
    for (int u = F.bid; u < NUNIT64; u += F.G) {
        for (int rr = 0; rr < 8; ++rr) {
            const int row = u * 64 + wave * 8 + rr;
            const f32x4* xr = (const f32x4*)xcur_row(F, row) + lane;
            const float* mrow = mod + (size_t)mod_index(row) * 6144;
            f32x4 v[4]; float s = 0.f;
#pragma unroll
            for (int j = 0; j < 4; ++j) { v[j] = xr[64 * j]; s += (v[j].x * v[j].x + v[j].y * v[j].y) + (v[j].z * v[j].z + v[j].w * v[j].w); }
            const float rs = rsqrtf(wave_sum(s) * (1.f / D) + 1e-6f);
            u32x2* o8 = (u32x2*)(TOK + (size_t)row * D) + lane;
#pragma unroll
            for (int j = 0; j < 4; ++j) { const int c = 4 * lane + 256 * j;
                const f32x4 gg = *(const f32x4*)(g + c), sh = *(const f32x4*)(mrow + 3 * D + c), sc = *(const f32x4*)(mrow + 4 * D + c);
                v[j] = (v[j] * rs * gg) * (sc + 1.f) + sh;
                u32x2 w; w.x = pk2(v[j].x, v[j].y); w.y = pk2(v[j].z, v[j].w); o8[64 * j] = w; }
            float lg[20];
#pragma unroll
            for (int e = 0; e < 20; ++e) { float a = 0.f;
#pragma unroll
                for (int j = 0; j < 4; ++j) { const f32x4 w = *(const LAS f32x4*)(RW + e * D + 4 * lane + 256 * j); a += (v[j].x * w.x + v[j].y * w.y) + (v[j].z * w.z + v[j].w * w.w); }
                lg[e] = wave_sum(a); }
            float gl0 = lg[0] + rgb[0], gl1 = lg[1] + rgb[1], gl2 = lg[2] + rgb[2], gl3 = lg[3] + rgb[3];
            int gs = 0; float gm = gl0;
            if (gl1 > gm) { gm = gl1; gs = 1; } if (gl2 > gm) { gm = gl2; gs = 2; } if (gl3 > gm) { gm = gl3; gs = 3; }
            const float pg = 1.f / (__expf(gl0 - gm) + __expf(gl1 - gm) + __expf(gl2 - gm) + __expf(gl3 - gm));
            float e0, e1, e2, e3;
            e0 = gs == 0 ? lg[4] : (gs == 1 ? lg[8] : (gs == 2 ? lg[12] : lg[16])); e1 = gs == 0 ? lg[5] : (gs == 1 ? lg[9] : (gs == 2 ? lg[13] : lg[17]));
            e2 = gs == 0 ? lg[6] : (gs == 1 ? lg[10] : (gs == 2 ? lg[14] : lg[18])); e3 = gs == 0 ? lg[7] : (gs == 1 ? lg[11] : (gs == 2 ? lg[15] : lg[19]));
            e0 += reb[gs * 4 + 0]; e1 += reb[gs * 4 + 1]; e2 += reb[gs * 4 + 2]; e3 += reb[gs * 4 + 3];
            int i1 = 0; float m1 = e0;
            if (e1 > m1) { m1 = e1; i1 = 1; } if (e2 > m1) { m1 = e2; i1 = 2; } if (e3 > m1) { m1 = e3; i1 = 3; }
            int i2 = -1; float m2 = -3.0e38f;
            if (i1 != 0 && e0 > m2) { m2 = e0; i2 = 0; } if (i1 != 1 && e1 > m2) { m2 = e1; i2 = 1; } if (i1 != 2 && e2 > m2) { m2 = e2; i2 = 2; } if (i1 != 3 && e3 > m2) { m2 = e3; i2 = 3; }
            const float p1 = 1.f, p2 = __expf(m2 - m1);
            const float w1 = pg * p1 / (p1 + p2), w2 = pg * p2 / (p1 + p2);
            const int lo = i1 < i2 ? i1 : i2, hi = i1 < i2 ? i2 : i1;
            const int pr = lo == 0 ? hi - 1 : (lo == 1 ? hi + 1 : 5);
            const int cls = gs * 6 + pr;
            const float wa = i1 < i2 ? w1 : w2, wb = i1 < i2 ? w2 : w1;
            if (lane == 0) { const int rank = atomicAdd((int*)(lcnt + cls), 1);
                TI[row] = make_int4(cls, __float_as_int(wa), __float_as_int(wb), rank); }
        }
        __syncthreads();
        if (tid < NCLS) { CNT[u * NCLS + tid] = lcnt[tid]; lcnt[tid] = 0; }
        __syncthreads();
    }
}

__device__ __forceinline__ void phase_scatter(const Frame& F0) {
    PH_ENTER(F0);
    const int tid = F.tid, lane = F.lane, wave = F.wave;
    LAS int* C = (LAS int*)F.lds;
    LAS int* tot = (LAS int*)(F.lds + 102400);
    LAS int* cs = (LAS int*)(F.lds + 102400 + 128);
    LAS int* base = (LAS int*)(F.lds + 102400 + 256);
    const int* CNT = (const int*)(F.ws + WS_CNT);
    int* MI = (int*)(F.ws + WS_CNT) + NUNIT64 * NCLS;
    for (int i = tid; i < NUNIT64 * NCLS; i += 512) C[i] = CNT[i];
    __syncthreads();
    if (tid < NCLS) { int s = 0; for (int u = 0; u < NUNIT64; ++u) s += C[u * NCLS + tid]; tot[tid] = s; }
    __syncthreads();
    if (tid == 0) { int s = 0; for (int c = 0; c < NCLS; ++c) { cs[c] = s; s += (tot[c] + 255) & ~255; } cs[NCLS] = s; }
    __syncthreads();
    if (F.bid == 0 && tid <= NCLS) MI[tid] = cs[tid];
    const bf16* TOK = (const bf16*)(F.ws + WS_ACT); bf16* TOKS = (bf16*)(F.ws + WS_TOKS);
    const int4* TI = (const int4*)(F.ws + WS_TOKINFO);
    int* LIST = (int*)(F.ws + WS_LIST); f32x2* WSL = (f32x2*)(F.ws + WS_WSLOT);
    for (int c = F.bid; c < NCLS; c += F.G) {
        const int s0 = cs[c] + tot[c], s1 = cs[c + 1];
        for (int s = s0 + wave; s < s1; s += 8) { u32x4* dst = (u32x4*)(TOKS + (size_t)s * D) + lane; dst[0] = (u32x4){0, 0, 0, 0}; dst[64] = (u32x4){0, 0, 0, 0};
            if (lane == 0) { LIST[s] = -1; WSL[s] = (f32x2){0.f, 0.f}; } }
    }
    for (int u = F.bid; u < NUNIT64; u += F.G) {
        __syncthreads();
        if (tid < NCLS * 16) { const int c = tid >> 4, s = tid & 15; int part = 0; for (int uu = s; uu < u; uu += 16) part += C[uu * NCLS + c];
            float pf = sum16((float)part);
            if (s == 0) base[c] = cs[c] + (int)pf; }
        __syncthreads();
        for (int rr = 0; rr < 8; ++rr) {
            const int row = u * 64 + wave * 8 + rr;
            const int4 ti = TI[row];
            const int slot = base[ti.x] + ti.w;
            const u32x4* src = (const u32x4*)(TOK + (size_t)row * D) + lane; u32x4* dst = (u32x4*)(TOKS + (size_t)slot * D) + lane;
            dst[0] = src[0]; dst[64] = src[64];
            if (lane == 0) { LIST[slot] = row; WSL[slot] = (f32x2){__int_as_float(ti.y), __int_as_float(ti.z)}; }
        }
    }
}

__device__ __forceinline__ void phase_final(const Frame& F0) {
    PH_ENTER(F0);
    const AS4 Args* KA = kargs();
    const int gw = F.bid * 8 + F.wave, NGW = F.G * 8, lane = F.lane;
    const float* g = INP(38);
    for (int row = gw; row < NB * TL; row += NGW) {
        f32x4* xr = (f32x4*)(F.out + (size_t)row * D) + lane;
        f32x4 v[4]; float s = 0.f;
#pragma unroll
        for (int j = 0; j < 4; ++j) { v[j] = xr[64 * j]; s += (v[j].x * v[j].x + v[j].y * v[j].y) + (v[j].z * v[j].z + v[j].w * v[j].w); }
        const float rs = rsqrtf(wave_sum(s) * (1.f / D) + 1e-6f);
#pragma unroll
        for (int j = 0; j < 4; ++j) { const f32x4 gg = *(const f32x4*)(g + 4 * lane + 256 * j); xr[64 * j] = v[j] * rs * gg; }
    }
}

constexpr int PH_PER_LAYER = 12, PH_FINAL = 1 + 2 * PH_PER_LAYER, PH_END = PH_FINAL + 1;
__global__ void __launch_bounds__(512, 2) mk_fwd(Args args) {
    extern __shared__ __attribute__((aligned(16))) unsigned char lds_raw[];
    Frame F0;
    F0.lds = (LAS unsigned char*)lds_raw;
    F0.tid = threadIdx.x; F0.lane = F0.tid & 63; F0.wave = __builtin_amdgcn_readfirstlane(F0.tid >> 6);
    F0.G = gridDim.x; F0.bid = blockIdx.x; F0.out = args.out; F0.ws = args.ws; F0.l = 0;
    for (int u = F0.tid; u < (LDS_BYTES - LDSCTL_OFF) / 4; u += 512) ((LAS unsigned*)(F0.lds + LDSCTL_OFF))[u] = 0u;
    __syncthreads();
    const int lo = args.ph_lo, hi = args.ph_hi;
    const bool use_bar = (hi - lo) > 1;
    XcdBarrier bar; bar.bar = (unsigned*)(F0.ws + WS_CTL) + CW_BAR; bar.x = 0; bar.st = nullptr;
    if (use_bar) bar = xcd_barrier_post((unsigned*)(F0.ws + WS_CTL) + CW_BAR, (volatile LAS unsigned*)(F0.lds + MISC_OFF) + 8);
#define IN(k) (lo <= (k) && (k) < hi)
#define SEAM(k) do { if (IN(k) && IN((k) + 1)) { XcdBarrier bb = bar; GAS unsigned* _b = (GAS unsigned*)bb.bar; asm volatile("" : "+s"(_b)); bb.bar = (unsigned*)_b; xcd_barrier(bb); } } while (0)
    if (HAS(12) && IN(0)) { phase_mods(F0); } SEAM(0);
#pragma unroll 1
    for (int l = 0; l < 2; ++l) {
        F0.l = l;
        const int pb = 1 + PH_PER_LAYER * l;
        if (HAS(0) && IN(pb + 0)) { phase_convert(F0); } SEAM(pb + 0);
        if (HAS(1) && IN(pb + 1)) { phase_norm1(F0); } SEAM(pb + 1);
        if (HAS(2) && IN(pb + 2)) {
            PH_ENTER(F0);
            SchedStatic S; S.nM = T / 256; S.nN = IN_PAD / 256; S.nwg = S.nM * S.nN; S.G = F.G; S.c = F.bid; S.ws = F.ws; S.offA = WS_ACT; S.offB = WS_WIN;
            EpiU E{F.ws};
            pg8::gemm_phase<EpiU, SchedStatic, true, false, 1024>(F.lds, F.tid, S, E);
        } SEAM(pb + 2);
        if (HAS(3) && IN(pb + 3)) { phase_prep(F0); } SEAM(pb + 3);
        if (HAS(4) && IN(pb + 4)) { phase_scan_rwkv(F0); } SEAM(pb + 4);
        if (HAS(5) && IN(pb + 5)) { phase_scan_ssd(F0); phase_scan_gla(F0); } SEAM(pb + 5);
        if (HAS(6) && IN(pb + 6)) { phase_finish(F0); } SEAM(pb + 6);
        if (HAS(7) && IN(pb + 7)) {
            PH_ENTER(F0);
            const AS4 Args* KA = kargs();
            SchedStatic S; S.nM = T / 256; S.nN = D / 256; S.nwg = S.nM * S.nN; S.G = F.G; S.c = F.bid; S.ws = F.ws; S.offA = WS_ACT; S.offB = WS_WOUT;
            EpiRes E{F.l == 0 ? INP(0) : (const float*)F.out, F.l == 0 ? INP(2) : (const float*)(F.ws + WS_CTX), F.out, F.ws, F.l};
            pg8::gemm_phase<EpiRes, SchedStatic, true, false, 1024>(F.lds, F.tid, S, E);
        } SEAM(pb + 7);
        if (HAS(8) && IN(pb + 8)) { phase_router(F0); } SEAM(pb + 8);
        if (HAS(9) && IN(pb + 9)) { phase_scatter(F0); } SEAM(pb + 9);
        if (IN(pb + 10) || IN(pb + 11)) {
            PH_ENTER(F0);
            LAS int* cs = (LAS int*)(F.lds + CSTAB_OFF);
            const int* MI = (const int*)(F.ws + WS_CNT) + NUNIT64 * NCLS;
            __syncthreads();
            if (F.tid <= NCLS) cs[F.tid] = MI[F.tid];
            __syncthreads();
        }
        if (HAS(10) && IN(pb + 10)) {
            PH_ENTER(F0);
            LAS int* cs = (LAS int*)(F.lds + CSTAB_OFF);
            SchedMoE<8> S; S.ntiles = cs[NCLS] / 256; S.G = F.G; S.c = F.bid; S.cs = cs; S.ws = F.ws;
            EpiSwiGLU E{F.ws};
            pg8::gemm_phase<EpiSwiGLU, SchedMoE<8>, true, false, 1024>(F.lds, F.tid, S, E);
        } SEAM(pb + 10);
        if (HAS(11) && IN(pb + 11)) {
            PH_ENTER(F0);
            LAS int* cs = (LAS int*)(F.lds + CSTAB_OFF);
            SchedMoE<4> S; S.ntiles = cs[NCLS] / 256; S.G = F.G; S.c = F.bid; S.cs = cs; S.ws = F.ws;
            EpiScatter E{F.out, F.ws, F.l};
            pg8::gemm_phase<EpiScatter, SchedMoE<4>, true, true, 512>(F.lds, F.tid, S, E);
        } SEAM(pb + 11);
    }
    if (HAS(13) && IN(PH_FINAL)) { phase_final(F0); }
#undef IN
#undef SEAM
}

extern "C" void kernel_launch(void* const* d_in, const int* in_sizes, int n_in, void* d_out, int out_size, void* d_ws, size_t ws_size, hipStream_t stream) {
    static int grid = 0;
    if (grid == 0) {
        if (n_in != 39 || ws_size < WS_END) { fprintf(stderr, "kernel_launch: unexpected n_in %d / ws %zu\n", n_in, ws_size); grid = -1; return; }
        int dev = 0, cus = 0;
        if (hipGetDevice(&dev) != hipSuccess || hipDeviceGetAttribute(&cus, hipDeviceAttributeMultiprocessorCount, dev) != hipSuccess) { grid = -1; return; }
        if (hipFuncSetAttribute((const void*)mk_fwd, hipFuncAttributeMaxDynamicSharedMemorySize, LDS_BYTES) != hipSuccess) { fprintf(stderr, "kernel_launch: hipFuncSetAttribute failed\n"); grid = -1; return; }
        int per_cu = 0;
        (void)hipOccupancyMaxActiveBlocksPerMultiprocessor(&per_cu, (const void*)mk_fwd, 512, LDS_BYTES);
        (void)hipGetLastError();
        grid = cus;
    }
    if (grid < 0) return;
    (void)hipMemsetAsync((char*)d_ws + WS_CTL, 0, CTL_ZERO_BYTES, stream);
    Args a{};
    for (int i = 0; i < 39; ++i) a.in[i] = (const float*)d_in[i];
    a.out = (float*)d_out; a.ws = (unsigned char*)d_ws;
#if MK_ONE_LAUNCH
    a.ph_lo = 0; a.ph_hi = PH_END;
    hipLaunchKernelGGL(mk_fwd, dim3(grid), dim3(512), LDS_BYTES, stream, a);
#else
    for (int ph = 0; ph < PH_END; ++ph) { a.ph_lo = ph; a.ph_hi = ph + 1; hipLaunchKernelGGL(mk_fwd, dim3(grid), dim3(512), LDS_BYTES, stream, a); }
#endif
}
```

```cpp
#include <hip/hip_runtime.h>
#include <cstdio>
#include <cstdint>

#define GAS __attribute__((address_space(1)))
#define LAS __attribute__((address_space(3)))
typedef unsigned short bf16;
typedef short bf16x8 __attribute__((ext_vector_type(8)));
typedef float f32x4 __attribute__((ext_vector_type(4)));
typedef float f32x2 __attribute__((ext_vector_type(2)));
typedef unsigned u32x4 __attribute__((ext_vector_type(4)));
typedef unsigned u32x2 __attribute__((ext_vector_type(2)));
typedef _Float16 h16;
typedef _Float16 h16x8 __attribute__((ext_vector_type(8)));
typedef _Float16 h16x4 __attribute__((ext_vector_type(4)));

#ifndef MK_ONE_LAUNCH
#define MK_ONE_LAUNCH 1
#endif
#ifndef MK_PHMASK
#define MK_PHMASK 0xffffffffu
#endif
#define HAS(k) ((MK_PHMASK >> (k)) & 1u)
#ifndef MK_REP
#define MK_REP 0u
#endif
#define REP(k) (((MK_REP >> (k)) & 1u) ? 2 : 1)
#ifndef MK_SUB
#define MK_SUB 0u
#endif
#ifndef MK_PROBE_RW
#define MK_PROBE_RW 0
#endif
#define SUBREP(k) for (int _r = 0; _r < ((((MK_SUB) >> (k)) & 1u) ? 2 : 1); ++_r)

constexpr int D = 1024, NB = 8, TL = 8192, TC = 256, TB = TL + TC, T = NB * TB;
constexpr int NTILE64 = TB / 64;
constexpr int IN_COLS = 3096, IN_PAD = 3328;
constexpr int NCLS = 24, MAXSLOT = T + NCLS * 256;
constexpr int NUNIT64 = NB * NTILE64;

constexpr size_t MiB = 1u << 20;
constexpr size_t WS_CTL = 0, CTL_ZERO_BYTES = 1 * MiB;
constexpr size_t WS_MOD = 1 * MiB;
constexpr size_t WS_CNT = 2 * MiB;
constexpr size_t WS_TOKINFO = 3 * MiB;
constexpr size_t WS_LIST = 5 * MiB;
constexpr size_t WS_WSLOT = 6 * MiB;
constexpr size_t WS_CTX = 8 * MiB;
constexpr size_t WS_WIN = 16 * MiB;
constexpr size_t WS_WOUT = 23 * MiB;
constexpr size_t WS_W13 = 25 * MiB;
constexpr size_t WS_W2T = 57 * MiB;
constexpr size_t WS_ACT = 74 * MiB;
constexpr size_t WS_REC = 74 * MiB;
constexpr size_t WS_RECS = WS_REC, WS_RECD = WS_REC + (size_t)T * 4 * 256 * 2;
constexpr size_t WS_LOWR = 73 * MiB;
constexpr size_t WS_TOKS = 206 * MiB;
constexpr size_t WS_URW = 371 * MiB;
constexpr size_t WS_SS = 371 * MiB;
constexpr size_t WS_GS = 503 * MiB;
constexpr size_t WS_YRW = 536 * MiB;
constexpr size_t WS_SDEC = 7 * MiB;
constexpr size_t WS_H1 = 371 * MiB;
constexpr size_t WS_UXBC = 503 * MiB;
constexpr size_t WS_UZ = 602 * MiB;
constexpr size_t WS_UGLA = 668 * MiB;
constexpr size_t WS_UMISC = 767 * MiB;
constexpr size_t WS_XBCA = 776 * MiB;
constexpr size_t WS_BONUS = 875 * MiB;
constexpr size_t WS_GATE = 908 * MiB;
constexpr size_t WS_GDEC = 941 * MiB;
constexpr size_t WS_RPL = 943 * MiB;
constexpr size_t WS_END = 946 * MiB;
static_assert(WS_RECD + (size_t)T * 8 * 128 * 2 <= WS_URW, "records fit");
static_assert(WS_SS + (size_t)128 * 132 * 4096 * 2 <= WS_GS && WS_GS + (size_t)64 * 132 * 2048 * 2 <= WS_YRW && WS_YRW + (size_t)2 * T * 256 * 2 <= WS_UZ, "state buffers fit");
static_assert(WS_TOKS + (size_t)MAXSLOT * 1024 * 2 <= WS_H1, "toks fits");
static_assert(WS_H1 + (size_t)MAXSLOT * 1024 * 2 <= WS_UMISC, "h1 fits");

constexpr int CW_BAR = 4096;

constexpr int RING_BYTES = 131072;
constexpr int LDS_BYTES = 163840;
constexpr int LDSCTL_OFF = LDS_BYTES - 2048, MISC_OFF = LDSCTL_OFF + 320, CSTAB_OFF = LDSCTL_OFF + 1024;

#define RLX_AGENT __ATOMIC_RELAXED, __HIP_MEMORY_SCOPE_AGENT
#define LDS_WAIT() asm volatile("s_waitcnt lgkmcnt(0)" ::: "memory")
#define LDS_BARRIER() asm volatile("s_waitcnt lgkmcnt(0)\n\ts_barrier" ::: "memory")
#define VM_WAIT() asm volatile("s_waitcnt vmcnt(0)" ::: "memory")
__device__ __forceinline__ float bf2f(unsigned short h) { return __uint_as_float(((unsigned)h) << 16); }
typedef __bf16 hwbf16x2 __attribute__((ext_vector_type(2)));
__device__ __forceinline__ unsigned pk2(float lo, float hi) { const f32x2 v = {lo, hi}; const hwbf16x2 b = __builtin_convertvector(v, hwbf16x2); return __builtin_bit_cast(unsigned, b); }
__device__ __forceinline__ unsigned f2bf(float f) { return pk2(f, 0.f) & 0xffffu; }
__device__ __forceinline__ float sigm(float x) { return 1.f / (1.f + __expf(-x)); }
__device__ __forceinline__ float siluf(float x) { return x / (1.f + __expf(-x)); }
__device__ __forceinline__ float softplusf_(float x) { return x > 20.f ? x : log1pf(__expf(x)); }
__device__ __forceinline__ void unpack8(u32x4 v, float* o) {
    o[0] = __uint_as_float(v.x << 16); o[1] = __uint_as_float(v.x & 0xffff0000u); o[2] = __uint_as_float(v.y << 16); o[3] = __uint_as_float(v.y & 0xffff0000u);
    o[4] = __uint_as_float(v.z << 16); o[5] = __uint_as_float(v.z & 0xffff0000u); o[6] = __uint_as_float(v.w << 16); o[7] = __uint_as_float(v.w & 0xffff0000u);
}
__device__ __forceinline__ u32x4 pack8(const float* o) { u32x4 v; v.x = pk2(o[0], o[1]); v.y = pk2(o[2], o[3]); v.z = pk2(o[4], o[5]); v.w = pk2(o[6], o[7]); return v; }
__device__ __forceinline__ int launder_i(int v) { asm volatile("" : "+v"(v)); return v; }
template <int CTRL> __device__ __forceinline__ float dpp_mov(float v) { return __int_as_float(__builtin_amdgcn_update_dpp(0, __float_as_int(v), CTRL, 0xf, 0xf, false)); }
__device__ __forceinline__ float sum8(float v) { v += dpp_mov<0xB1>(v); v += dpp_mov<0x4E>(v); v += dpp_mov<0x141>(v); return v; }
__device__ __forceinline__ float sum16(float v) { v = sum8(v); v += dpp_mov<0x140>(v); return v; }
__device__ __forceinline__ float wave_sum(float v) {
    v = sum16(v);
    v += __int_as_float(__builtin_amdgcn_update_dpp(0, __float_as_int(v), 0x142, 0xa, 0xf, false));
    v += __int_as_float(__builtin_amdgcn_update_dpp(0, __float_as_int(v), 0x143, 0xc, 0xf, false));
    return __int_as_float(__builtin_amdgcn_readlane(__float_as_int(v), 63));
}

namespace pg8 {
constexpr int BM = 256, BK = 64, HALF = 128, HTB = HALF * BK * 2, STAGE_BYTES = 8 * HTB, NXCD = 8, WGM = 8;
__host__ __device__ __forceinline__ int lds_byte(int r, int c) { const int st = (r >> 4) * 2 + (c >> 5), rr = r & 15, cc = c & 31, ob = rr * 64 + cc * 2; return st * 1024 + (ob ^ (((ob >> 9) & 1) << 5)); }
__host__ __device__ __forceinline__ void stage_rc(int b, int& R, int& C) { const int st = b / 1024, sb = b % 1024, swz = sb ^ (((sb >> 9) & 1) << 5); R = (st >> 1) * 16 + swz / 64; C = (st & 1) * 32 + (swz % 64) / 2; }
__host__ __device__ __forceinline__ int perm32(int rho) { const int n = rho >> 4, i = rho & 15; return 8 * (i >> 2) + 4 * n + (i & 3); }
struct Unit { int pm, pn, aux; };
__device__ __forceinline__ const GAS char* uni_ptr(const char* p) { const unsigned long long v = (unsigned long long)p;
    const unsigned lo = __builtin_amdgcn_readfirstlane((unsigned)v), hi = __builtin_amdgcn_readfirstlane((unsigned)(v >> 32)); return (const GAS char*)(((unsigned long long)hi << 32) | lo); }
__device__ __forceinline__ unsigned cvt_pk_bf16(float lo, float hi) { unsigned r; asm volatile("v_cvt_pk_bf16_f32 %0, %1, %2" : "=v"(r) : "v"(lo), "v"(hi)); return r; }

template <class Epi, class Sched, bool ALIGN_EPI, bool KSPLIT, int LDB, bool GATHER = false>
__device__ __forceinline__ void gemm_phase(LAS unsigned char* lds, const int tid, const Sched& S, const Epi& E) {
    constexpr int K = 1024, nt = K / BK, ntb = KSPLIT ? nt / 2 : nt;
    const int wid = __builtin_amdgcn_readfirstlane(tid >> 6), lane = tid & 63, wr = wid >> 2, wc = wid & 3, fr = lane & 15, fq = lane >> 4;
    unsigned voffA[2], voffB[2];
#pragma unroll
    for (int i = 0; i < 2; ++i) { int R, C; stage_rc(tid * 16 + i * 8192, R, C); const int Rb = Epi::PERM ? ((R & ~31) + perm32(R & 31)) : R;
        voffA[i] = (unsigned)(R * K + C) * 2u; voffB[i] = (unsigned)(Rb * LDB + C) * 2u; }
    unsigned cvA[2][2], nvA[2][2]; int arow[2][2];
#pragma unroll
    for (int i = 0; i < 2; ++i) { int R, C; stage_rc(tid * 16 + i * 8192, R, C); arow[0][i] = R; arow[1][i] = C * 2; }
    constexpr size_t kstep = (size_t)(BK * 2);
    constexpr size_t hstepA = (size_t)HALF * K * 2, hstepB = (size_t)HALF * LDB * 2;
    const unsigned ldsw = (unsigned)wid * 1024u;
    const int aoff = lds_byte(wr * 64 + fr, fq * 8), boff = lds_byte(wc * 32 + fr, fq * 8);
#define PG8_SA(b, h) (((b) * 2 + (h)) * HTB)
#define PG8_SB(b, h) ((4 + (b) * 2 + (h)) * HTB)
#define PG8_STAGE(bufoff, gbase, voff) do { const GAS char* _gb = (const GAS char*)(gbase); _Pragma("unroll") for (int _i = 0; _i < 2; ++_i) \
        __builtin_amdgcn_global_load_lds((const GAS unsigned*)(_gb + (voff)[_i]), (LAS unsigned*)(lds + (bufoff) + ldsw + _i * 8192), 16, 0, 0); } while (0)
#define PG8_LDA(dst, b, h) do { _Pragma("unroll") for (int m = 0; m < 4; ++m) _Pragma("unroll") for (int k = 0; k < 2; ++k) dst[m][k] = *(const LAS bf16x8*)(lds + PG8_SA(b, h) + aoff + m * 2048 + k * 1024); } while (0)
#define PG8_LDB(dst, b, h) do { _Pragma("unroll") for (int n = 0; n < 2; ++n) _Pragma("unroll") for (int k = 0; k < 2; ++k) dst[n][k] = *(const LAS bf16x8*)(lds + PG8_SB(b, h) + boff + n * 2048 + k * 1024); } while (0)
#define PG8_MMA(ai, bj, At, Bt) do { __builtin_amdgcn_s_setprio(1); _Pragma("unroll") for (int m = 0; m < 4; ++m) _Pragma("unroll") for (int n = 0; n < 2; ++n) _Pragma("unroll") for (int k = 0; k < 2; ++k) \
        acc[ai][bj][m][n] = __builtin_amdgcn_mfma_f32_16x16x32_bf16(Bt[n][k], At[m][k], acc[ai][bj][m][n], 0, 0, 0); __builtin_amdgcn_s_setprio(0); } while (0)
#define PG8_WAIT_V(n) asm volatile("s_waitcnt vmcnt(" #n ")" ::: "memory")
#define PG8_WAIT_L(n) asm volatile("s_waitcnt lgkmcnt(" #n ")" ::: "memory")
#define PG8_BAR __builtin_amdgcn_s_barrier()
#define PG8_SCHED __builtin_amdgcn_sched_barrier(0)
    Unit cur, nxt; int ui = 0;
    if (!S.next(0, cur)) return;
    f32x4 acc[2][2][4][2];
#pragma unroll
    for (int a = 0; a < 2; ++a)
#pragma unroll
        for (int b = 0; b < 2; ++b)
#pragma unroll
            for (int m = 0; m < 4; ++m)
#pragma unroll
                for (int n = 0; n < 2; ++n) acc[a][b][m][n] = (f32x4){0.f, 0.f, 0.f, 0.f};
    bf16x8 At[4][2], B0[2][2], B1[2][2];
    const char* cA = (const char*)uni_ptr(S.aptr(cur)); const char* cB = (const char*)uni_ptr(S.bptr(cur));
#define PG8_LOADROWS(dst, u) do { if constexpr (GATHER) { const int* rl_ = S.rowlist(u); _Pragma("unroll") for (int hh = 0; hh < 2; ++hh) _Pragma("unroll") for (int i = 0; i < 2; ++i) { \
        const int r_ = rl_[hh * HALF + arow[0][i]]; dst[hh][i] = (unsigned)(r_ < 0 ? 0 : r_) * (unsigned)(K * 2) + (unsigned)arow[1][i]; } } } while (0)
    PG8_LOADROWS(cvA, cur);
#define PG8_STAGE_A(bufoff, gbase, half, next) do { if constexpr (GATHER) { PG8_STAGE(bufoff, gbase, (next) ? nvA[half] : cvA[half]); } else { PG8_STAGE(bufoff, (gbase) + (half) * hstepA, voffA); } } while (0)
    {
        PG8_STAGE(PG8_SB(0, 0), cB, voffB); PG8_STAGE(PG8_SB(0, 1), cB + hstepB, voffB); PG8_STAGE_A(PG8_SA(0, 0), cA, 0, false); PG8_STAGE_A(PG8_SA(0, 1), cA, 1, false);
        if (wr == 1) PG8_BAR;
        PG8_WAIT_V(2); PG8_BAR;
        PG8_STAGE(PG8_SB(1, 0), cB + kstep, voffB); PG8_STAGE_A(PG8_SA(1, 0), cA + kstep, 0, false); PG8_STAGE(PG8_SB(1, 1), cB + hstepB + kstep, voffB);
        PG8_WAIT_V(6); PG8_BAR;
    }
    for (;;) {
        const bool has_next = S.next(ui + 1, nxt);
        if (has_next) PG8_LOADROWS(nvA, nxt); else { _Pragma("unroll") for (int hh = 0; hh < 2; ++hh) _Pragma("unroll") for (int i = 0; i < 2; ++i) nvA[hh][i] = cvA[hh][i]; }
#pragma unroll 1
        for (int t = 0; t < nt; t += 2) {
            const bool last = (t == nt - 2);
            const char* a1 = cA + (size_t)(t + 1) * kstep;
            const char* a2; const char* b2;
            if (last) { a2 = has_next ? S.aptr(nxt) : cA; b2 = has_next ? S.bptr(nxt) : cB; }
            else { a2 = cA + (size_t)(t + 2) * kstep; if (KSPLIT && t + 2 >= ntb) b2 = S.bptr2(cur) + (size_t)(t + 2 - ntb) * kstep; else b2 = cB + (size_t)(t + 2) * kstep; }
            a2 = (const char*)uni_ptr(a2); b2 = (const char*)uni_ptr(b2);
            const char* a3 = a2 + kstep; const char* b3 = b2 + kstep;
            PG8_LDB(B0, 0, 0); PG8_LDB(B1, 0, 1); PG8_SCHED; PG8_LDA(At, 0, 0); PG8_STAGE_A(PG8_SA(1, 1), a1, 1, false);
            PG8_WAIT_V(8); PG8_WAIT_L(0); PG8_BAR; PG8_MMA(0, 0, At, B0); PG8_MMA(0, 1, At, B1); PG8_BAR; PG8_SCHED;
            PG8_LDA(At, 0, 1); PG8_STAGE(PG8_SB(0, 0), b2, voffB); PG8_STAGE(PG8_SB(0, 1), b2 + hstepB, voffB); PG8_STAGE_A(PG8_SA(0, 0), a2, 0, last);
            PG8_WAIT_V(8); PG8_WAIT_L(0); PG8_BAR; PG8_MMA(1, 0, At, B0); PG8_MMA(1, 1, At, B1); PG8_BAR; PG8_SCHED;
            PG8_LDB(B0, 1, 0); PG8_LDB(B1, 1, 1); PG8_SCHED; PG8_LDA(At, 1, 0); PG8_STAGE_A(PG8_SA(0, 1), a2, 1, last);
            PG8_WAIT_V(8); PG8_WAIT_L(0); PG8_BAR; PG8_MMA(0, 0, At, B0); PG8_MMA(0, 1, At, B1); PG8_BAR; PG8_SCHED;
            PG8_LDA(At, 1, 1); PG8_STAGE(PG8_SB(1, 0), b3, voffB); PG8_STAGE(PG8_SB(1, 1), b3 + hstepB, voffB); PG8_STAGE_A(PG8_SA(1, 0), a3, 0, last);
            PG8_WAIT_V(8); PG8_WAIT_L(0); PG8_BAR; PG8_MMA(1, 0, At, B0); PG8_MMA(1, 1, At, B1); PG8_BAR; PG8_SCHED;
        }
        if constexpr (ALIGN_EPI) { if (wr == 0) PG8_BAR; }
        E(acc, cur, wr, wc, fr, fq);
        if (!has_next) break;
#pragma unroll
        for (int a = 0; a < 2; ++a)
#pragma unroll
            for (int b = 0; b < 2; ++b)
#pragma unroll
                for (int m = 0; m < 4; ++m)
#pragma unroll
                    for (int n = 0; n < 2; ++n) acc[a][b][m][n] = (f32x4){0.f, 0.f, 0.f, 0.f};
        cur = nxt; cA = (const char*)uni_ptr(S.aptr(cur)); cB = (const char*)uni_ptr(S.bptr(cur)); ++ui;
        if constexpr (GATHER) { _Pragma("unroll") for (int hh = 0; hh < 2; ++hh) _Pragma("unroll") for (int i = 0; i < 2; ++i) cvA[hh][i] = nvA[hh][i]; }
        if constexpr (ALIGN_EPI) { if (wr == 1) PG8_BAR; }
    }
    PG8_WAIT_V(0);
    if constexpr (!ALIGN_EPI) { if (wr == 0) PG8_BAR; }
    PG8_BAR;
#undef PG8_SA
#undef PG8_LOADROWS
#undef PG8_STAGE_A
#undef PG8_SB
#undef PG8_STAGE
#undef PG8_LDA
#undef PG8_LDB
#undef PG8_MMA
#undef PG8_WAIT_V
#undef PG8_WAIT_L
#undef PG8_BAR
#undef PG8_SCHED
}
}

#define XB_TMO      128
#define XB_XCNT(j)  (256  + 64 * (j))
#define XB_XSUB(j)  (1280 + 64 * (j))
#define XB_XGEN(j)  (2304 + 64 * (j))
#define XB_TOP      3328
#define XB_TOPGEN   3392
#define XCD_BAR_WORDS 3456
#define XB_SPIN_CAP (1u << 25)
__device__ __forceinline__ unsigned xb_ld(unsigned* p)              { return __hip_atomic_load(p, __ATOMIC_RELAXED, __HIP_MEMORY_SCOPE_AGENT); }
__device__ __forceinline__ unsigned xb_add(unsigned* p, unsigned v) { return __hip_atomic_fetch_add(p, v, __ATOMIC_RELAXED, __HIP_MEMORY_SCOPE_AGENT); }
__device__ __forceinline__ unsigned xb_xcc_id() { return (unsigned)__builtin_amdgcn_s_getreg((3 << 11) | 20) & 0xFu; }
#define XB_SPIN(cond, bar) do { unsigned _sp = 0; while (cond) { __builtin_amdgcn_s_sleep(1); \
    if ((++_sp & 255u) == 0u) { if (xb_ld(&(bar)[XB_TMO])) break; if (_sp > XB_SPIN_CAP) { atomicAdd(&(bar)[XB_TMO], 1u); break; } } } } while (0)
struct XcdBarrier { unsigned* bar; unsigned x; volatile LAS unsigned* st; };
__device__ __forceinline__ XcdBarrier xcd_barrier_post(unsigned* bar, volatile LAS unsigned* st) {
    XcdBarrier b; b.bar = bar; b.x = xb_xcc_id(); b.st = st;
    if (threadIdx.x == 0) (void)xb_add(&bar[XB_XCNT(b.x)], 1u);
    return b;
}
__device__ __forceinline__ void xcd_barrier_complete(unsigned* bar, unsigned x, unsigned& nloc, unsigned& nx) {
    const unsigned G = gridDim.x * gridDim.y * gridDim.z;
    unsigned sum, cnt, mine, sp = 0u;
    for (;;) {
        sum = 0u; cnt = 0u; mine = 0u;
#pragma unroll 1
        for (unsigned j = 0; j < 16; ++j) { const unsigned c = xb_ld(&bar[XB_XCNT(j)]); sum += c; cnt += (c > 0u) ? 1u : 0u; mine = (j == x) ? c : mine; }
        if (sum == G) break;
        __builtin_amdgcn_s_sleep(1);
        if ((++sp & 255u) == 0u) { if (xb_ld(&bar[XB_TMO])) break; if (sp > XB_SPIN_CAP) { atomicAdd(&bar[XB_TMO], 1u); break; } }
    }
    nloc = mine > 0u ? mine : 1u; nx = cnt > 0u ? cnt : 1u;
}
__device__ __forceinline__ void xcd_barrier(const XcdBarrier& b) {
    asm volatile("s_waitcnt vmcnt(0)" ::: "memory");
    __syncthreads();
    if (threadIdx.x == 0) {
        unsigned* bar = b.bar;
        __builtin_amdgcn_s_waitcnt(0);
        unsigned nloc = b.st[0], nx = b.st[1];
        if (nloc == 0u) { xcd_barrier_complete(bar, b.x, nloc, nx); b.st[0] = nloc; b.st[1] = nx; }
        const unsigned old = xb_add(&bar[XB_XSUB(b.x)], 1u);
        const unsigned gen = old / nloc;
        if (old + 1u == (gen + 1u) * nloc) {
            __builtin_amdgcn_fence(__ATOMIC_RELEASE, "agent");
            asm volatile("s_waitcnt vmcnt(0)" ::: "memory");
            const unsigned og = xb_add(&bar[XB_TOP], 1u);
            const unsigned tg = og / nx;
            if (og + 1u == (tg + 1u) * nx) xb_add(&bar[XB_TOPGEN], 1u);
            else XB_SPIN(xb_ld(&bar[XB_TOPGEN]) == tg, bar);
            __builtin_amdgcn_fence(__ATOMIC_ACQUIRE, "agent");
            xb_add(&bar[XB_XGEN(b.x)], 1u);
            asm volatile("s_waitcnt vmcnt(0)" ::: "memory");
        } else {
            XB_SPIN(xb_ld(&bar[XB_XGEN(b.x)]) == gen, bar);
            __builtin_amdgcn_fence(__ATOMIC_ACQUIRE, "agent");
            asm volatile("s_waitcnt vmcnt(0)" ::: "memory");
        }
    }
    __syncthreads();
}

struct Args { const float* in[39]; float* out; unsigned char* ws; int ph_lo, ph_hi; };
struct Frame {
    LAS unsigned char* lds;
    int tid, lane, wave, G, bid;
    float* out; unsigned char* ws;
    int l;
};
#define AS4 __attribute__((address_space(4)))
#define PH_ENTER(F0) Frame F = (F0); { GAS unsigned char* _w = (GAS unsigned char*)F.ws; GAS float* _o = (GAS float*)F.out; \
    asm volatile("" : "+s"(_w), "+s"(_o), "+v"(F.tid), "+s"(F.wave), "+s"(F.bid), "+s"(F.G), "+s"(F.l)); F.ws = (unsigned char*)_w; F.out = (float*)_o; } F.lane = F.tid & 63
__device__ __forceinline__ const AS4 Args* kargs() { const AS4 Args* p = (const AS4 Args*)__builtin_amdgcn_kernarg_segment_ptr(); asm volatile("" : "+s"(p)); return p; }
#define INP(i) ((const float*)(GAS const float*)(KA->in[i]))
#define LP(i, stride) (INP(i) + (size_t)F.l * (stride))

__device__ __forceinline__ const float* xin_row(const float* xl, const float* xc, int row) {
    const int b = row / TB, p = row % TB;
    if (p < TC) return xc + ((size_t)b * TC + p) * D;
    return xl + ((size_t)b * TL + (p - TC)) * D;
}
__device__ __forceinline__ float* xcur_row(const Frame& F, int row) {
    const int b = row / TB, p = row % TB;
    if (p < TC) return (float*)(F.ws + WS_CTX) + ((size_t)b * TC + p) * D;
    return F.out + ((size_t)b * TL + (p - TC)) * D;
}
__device__ __forceinline__ int n_units(bool skipctx) { return skipctx ? NB * 128 : NUNIT64; }
__device__ __forceinline__ int unit_of(bool skipctx, int j) { return skipctx ? (j >> 7) * NTILE64 + 4 + (j & 127) : j; }
__device__ __forceinline__ int mod_index(int row) { const int b = row / TB, p = row % TB; return p < TC ? 8 : b; }

__device__ __forceinline__ int in_colmap(int n) {
    if (n < 2304) return n;
    if (n < 2816) return n + 8;
    if (n < 3072) return n + 24;
    if (n < 3080) return n - 768;
    if (n < 3096) return n - 256;
    return -1;
}
__device__ __forceinline__ void tr_item(const float* src, int ldsrc, int scol, bf16* dst, int K, int n0, int k0, LAS float* scr, int lane) {
#pragma unroll 8
    for (int i = 0; i < 32; ++i) { const int kk = 2 * i + (lane >> 5); scr[kk * 33 + (lane & 31)] = scol >= 0 ? src[(size_t)(k0 + kk) * ldsrc + scol] : 0.f; }
    LDS_WAIT(); asm volatile("" ::: "memory");
    const int c = lane & 7;
#pragma unroll
    for (int j = 0; j < 4; ++j) { const int n = (lane >> 3) + 8 * j; const LAS float* s = scr + (8 * c) * 33 + n;
        u32x4 o; o.x = pk2(s[0 * 33], s[1 * 33]); o.y = pk2(s[2 * 33], s[3 * 33]); o.z = pk2(s[4 * 33], s[5 * 33]); o.w = pk2(s[6 * 33], s[7 * 33]);
        *(GAS u32x4*)(dst + (size_t)(n0 + n) * K + k0 + 8 * c) = o; }
    LDS_WAIT(); asm volatile("" ::: "memory");
}
__device__ __forceinline__ void phase_convert(const Frame& F0) {
    PH_ENTER(F0);
    const AS4 Args* KA = kargs();
    LAS float* scr = (LAS float*)(F.lds + F.wave * 16384);
    const int gw = F.bid * 8 + F.wave, NGW = F.G * 8, l = F.l, lane = F.lane;
    constexpr int I_A = 16 * 104, I_B = 16 * 32, I_C = 16 * 16 * 32, I_D = 16 * 8 * 32, I_E = 48;
    for (int it = gw; it < I_A + I_B + I_C + I_D + I_E; it += NGW) {
        int r = it;
        if (r < I_A) { const int kb = r / 104, nb = r % 104; tr_item(INP(8) + (size_t)l * D * IN_COLS, IN_COLS, in_colmap(nb * 32 + (lane & 31)), (bf16*)(F.ws + WS_WIN), D, nb * 32, kb * 64, scr, lane); continue; }
        r -= I_A;
        if (r < I_B) { const int kb = r / 32, nb = r % 32; tr_item(INP(9) + (size_t)l * D * D, D, nb * 32 + (lane & 31), (bf16*)(F.ws + WS_WOUT), D, nb * 32, kb * 64, scr, lane); continue; }
        r -= I_B;
        if (r < I_C) { const int e = r / 512, rr = r % 512, kb = rr / 32, nb = rr % 32; const int n0 = nb * 32, j = n0 >> 8, wi = n0 & 255;
            const float* src = (wi < 128 ? INP(35) : INP(36)) + (size_t)(l * 16 + e) * D * 512;
            tr_item(src, 512, 128 * j + (wi & 127) + (lane & 31), (bf16*)(F.ws + WS_W13) + (size_t)e * D * D, D, n0, kb * 64, scr, lane); continue; }
        r -= I_C;
        if (r < I_D) { const int e = r / 256, rr = r % 256, kb = rr / 32, nb = rr % 32;
            tr_item(INP(37) + (size_t)(l * 16 + e) * 512 * D, D, nb * 32 + (lane & 31), (bf16*)(F.ws + WS_W2T) + (size_t)e * D * 512, 512, nb * 32, kb * 64, scr, lane); continue; }
        r -= I_D;
        { bf16* LW = (bf16*)(F.ws + WS_LOWR);
            if (r < 16) { const int d = r >> 3, nb = r & 7; tr_item(INP(13) + (size_t)(l * 2 + d) * 64 * 256, 256, nb * 32 + (lane & 31), LW + (size_t)d * 256 * 64, 64, nb * 32, 0, scr, lane); }
            else if (r < 32) { const int d = (r - 16) >> 3, nb = r & 7; tr_item(INP(15) + (size_t)(l * 2 + d) * 64 * 256, 256, nb * 32 + (lane & 31), LW + 32768 + (size_t)d * 256 * 64, 64, nb * 32, 0, scr, lane); }
            else { const int kb = (r - 32) >> 3, nb = r & 7; tr_item(INP(16) + (size_t)l * 128 * 256, 256, nb * 32 + (lane & 31), LW + 65536, 128, nb * 32, kb * 64, scr, lane); } }
    }
}
__device__ __forceinline__ void phase_mods(const Frame& F0) {
    PH_ENTER(F0);
    const AS4 Args* KA = kargs();
    LAS float* cond = (LAS float*)F.lds;
    LAS float* red = (LAS float*)(F.lds + 40960);
    for (int i = F.tid; i < 9 * D; i += 512) { const float v = i < 8 * D ? INP(1)[i] : INP(3)[i - 8 * D]; cond[i] = siluf(v); }
    LDS_BARRIER();
    float* mod = (float*)(F.ws + WS_MOD);
    for (int u = F.bid; u < 2 * 96; u += F.G) {
        const int l = u / 96, cb = u % 96, col = cb * 64 + F.lane;
        const float* W = INP(4) + (size_t)l * D * 6144;
        float acc[9];
#pragma unroll
        for (int i = 0; i < 9; ++i) acc[i] = 0.f;
#pragma unroll 1
        for (int k0 = F.wave * 128; k0 < F.wave * 128 + 128; k0 += 16) { float w[16];
#pragma unroll
            for (int kk = 0; kk < 16; ++kk) w[kk] = W[(size_t)(k0 + kk) * 6144 + col];
#pragma unroll
            for (int kk = 0; kk < 16; kk += 4)
#pragma unroll
                for (int i = 0; i < 9; ++i) { const f32x4 c4 = *(const LAS f32x4*)(cond + i * D + k0 + kk); acc[i] += c4.x * w[kk] + c4.y * w[kk + 1] + c4.z * w[kk + 2] + c4.w * w[kk + 3]; } }
#pragma unroll
        for (int i = 0; i < 9; ++i) red[(F.wave * 9 + i) * 64 + F.lane] = acc[i];
        LDS_BARRIER();
        for (int o = F.tid; o < 9 * 64; o += 512) { const int i = o / 64, ln = o % 64; float s = 0.f;
#pragma unroll
            for (int w = 0; w < 8; ++w) s += red[(w * 9 + i) * 64 + ln];
            mod[((size_t)l * 9 + i) * 6144 + cb * 64 + ln] = s + INP(5)[(size_t)l * 6144 + cb * 64 + ln]; }
        LDS_BARRIER();
    }
}

__device__ __forceinline__ void phase_norm1(const Frame& F0) {
    PH_ENTER(F0);
    const AS4 Args* KA = kargs();
    const float* xl = F.l == 0 ? INP(0) : (const float*)F.out; const float* xc = F.l == 0 ? INP(2) : (const float*)(F.ws + WS_CTX);
    const int gw = F.bid * 8 + F.wave, NGW = F.G * 8, lane = F.lane;
    const float* g = LP(6, D);
    const float* mod = (const float*)(F.ws + WS_MOD) + (size_t)F.l * 9 * 6144;
    bf16* H = (bf16*)(F.ws + WS_ACT);
    const int R = (T + NGW - 1) / NGW, r0 = gw * R, r1 = min(T, r0 + R);
    f32x4 A[4], B[4], nv[4]; int curmi = -1;
    if (r0 < r1) { const f32x4* xr = (const f32x4*)xin_row(xl, xc, r0) + lane;
#pragma unroll
        for (int j = 0; j < 4; ++j) nv[j] = xr[64 * j]; }
    for (int row = r0; row < r1; ++row) {
        f32x4 v[4];
#pragma unroll
        for (int j = 0; j < 4; ++j) v[j] = nv[j];
        if (row + 1 < r1) { const f32x4* xr = (const f32x4*)xin_row(xl, xc, row + 1) + lane;
#pragma unroll
            for (int j = 0; j < 4; ++j) nv[j] = xr[64 * j]; }
        const int mi = mod_index(row);
        if (mi != curmi) { curmi = mi; const float* mrow = mod + (size_t)mi * 6144;
#pragma unroll
            for (int j = 0; j < 4; ++j) { const int c = 4 * lane + 256 * j; A[j] = *(const f32x4*)(g + c) * (*(const f32x4*)(mrow + D + c) + 1.f); B[j] = *(const f32x4*)(mrow + c); } }
        float s = 0.f;
#pragma unroll
        for (int j = 0; j < 4; ++j) s += (v[j].x * v[j].x + v[j].y * v[j].y) + (v[j].z * v[j].z + v[j].w * v[j].w);
        const float rs = rsqrtf(wave_sum(s) * (1.f / D) + 1e-6f);
        u32x2* o8 = (u32x2*)(H + (size_t)row * D) + lane;
#pragma unroll
        for (int j = 0; j < 4; ++j) { const f32x4 h = v[j] * rs * A[j] + B[j]; u32x2 w; w.x = pk2(h.x, h.y); w.y = pk2(h.z, h.w); o8[64 * j] = w; }
    }
}

struct SchedStatic {
    int nM, nN, nwg, G, c; const unsigned char* ws; size_t offA, offB; int skipctx;
    __device__ __forceinline__ bool next(int i, pg8::Unit& u) const {
        const long L = (long)i * G + c; if (L >= nwg) return false;
        int wgid = (int)L; { const int q = nwg / 8, r = nwg % 8, xcd = wgid % 8, off = wgid / 8; wgid = (xcd < r ? xcd * (q + 1) : r * (q + 1) + (xcd - r) * q) + off; }
        const int nig = 8 * nN, gid = wgid / nig, fm = gid * 8, gsz = (nM - fm) < 8 ? (nM - fm) : 8;
        u.pm = fm + ((wgid % nig) % gsz); u.pn = (wgid % nig) / gsz; u.aux = 0;
        if (skipctx) u.pm = (u.pm >> 5) * 33 + 1 + (u.pm & 31);
        return true;
    }
    __device__ __forceinline__ const char* aptr(const pg8::Unit& u) const { return (const char*)ws + offA + (size_t)u.pm * (256 * 1024 * 2); }
    __device__ __forceinline__ const char* bptr(const pg8::Unit& u) const { return (const char*)ws + offB + (size_t)u.pn * (256 * 1024 * 2); }
    __device__ __forceinline__ const char* bptr2(const pg8::Unit& u) const { return bptr(u); }
    __device__ __forceinline__ const int* rowlist(const pg8::Unit&) const { return nullptr; }
};
struct EpiU {
    static constexpr bool PERM = true;
    unsigned char* ws;
    __device__ __forceinline__ void operator()(const f32x4 (&acc)[2][2][4][2], const pg8::Unit& u, int wr, int wc, int fr, int fq) const {
        const int row0 = u.pm * 256 + wr * 64 + fr, pn = u.pn;
        float* u_misc = (float*)(ws + WS_UMISC);
        if (pn < 12) {
            bf16* base; int ld, c0;
            if (pn < 4) { base = (bf16*)(ws + WS_URW); ld = 1024; c0 = pn * 256; } else if (pn < 6) { base = (bf16*)(ws + WS_UZ); ld = 512; c0 = (pn - 4) * 256; }
            else if (pn < 9) { base = (bf16*)(ws + WS_UXBC); ld = 768; c0 = (pn - 6) * 256; } else { base = (bf16*)(ws + WS_UGLA); ld = 768; c0 = (pn - 9) * 256; }
            const int col0 = c0 + wc * 32 + 8 * fq;
#pragma unroll
            for (int ai = 0; ai < 2; ++ai)
#pragma unroll
                for (int m = 0; m < 4; ++m) { bf16* rowp = base + (size_t)(row0 + ai * 128 + m * 16) * ld + col0;
#pragma unroll
                    for (int bj = 0; bj < 2; ++bj) { const f32x4 v0 = acc[ai][bj][m][0], v1 = acc[ai][bj][m][1];
                        u32x4 w; w.x = pg8::cvt_pk_bf16(v0[0], v0[1]); w.y = pg8::cvt_pk_bf16(v0[2], v0[3]); w.z = pg8::cvt_pk_bf16(v1[0], v1[1]); w.w = pg8::cvt_pk_bf16(v1[2], v1[3]);
                        *(u32x4*)(rowp + bj * 128) = w; } }
        } else if (wc == 0) {
#pragma unroll
            for (int ai = 0; ai < 2; ++ai)
#pragma unroll
                for (int m = 0; m < 4; ++m) { float* rp = u_misc + (size_t)(row0 + ai * 128 + m * 16) * 32 + 8 * fq;
                    *(f32x4*)rp = acc[ai][0][m][0]; *(f32x4*)(rp + 4) = acc[ai][0][m][1]; }
        }
    }
};
struct EpiRes {
    static constexpr bool PERM = false;
    const float* xin_lat; const float* xin_ctx; float* out; unsigned char* ws; int l;
    __device__ __forceinline__ void operator()(const f32x4 (&acc)[2][2][4][2], const pg8::Unit& u, int wr, int wc, int fr, int fq) const {
        const int b = u.pm / 33, tb = u.pm % 33;
        const float* mod = (const float*)(ws + WS_MOD) + (size_t)l * 9 * 6144;
        const float* xi; float* xo; const float* mrow;
        if (tb == 0) { xi = xin_ctx + (size_t)b * TC * D; xo = (float*)(ws + WS_CTX) + (size_t)b * TC * D; mrow = mod + (size_t)8 * 6144 + 2 * D; }
        else { const size_t o = ((size_t)b * TL + (size_t)(tb - 1) * 256) * D; xi = xin_lat + o; xo = out + o; mrow = mod + (size_t)b * 6144 + 2 * D; }
        const int r0 = wr * 64 + fr, col0 = u.pn * 256 + wc * 32 + 4 * fq;
#pragma unroll
        for (int ai = 0; ai < 2; ++ai)
#pragma unroll
            for (int m = 0; m < 4; ++m) { const size_t off = (size_t)(r0 + ai * 128 + m * 16) * D + col0;
#pragma unroll
                for (int bj = 0; bj < 2; ++bj)
#pragma unroll
                    for (int n = 0; n < 2; ++n) { const f32x4 xv = *(const f32x4*)(xi + off + bj * 128 + n * 16); const f32x4 gv = *(const f32x4*)(mrow + col0 + bj * 128 + n * 16);
                        *(f32x4*)(xo + off + bj * 128 + n * 16) = xv + gv * acc[ai][bj][m][n]; }
                asm volatile("" ::: "memory"); }
    }
};
__device__ __forceinline__ void cls_experts(int cls, int& ea, int& eb) {
    const int g = cls / 6, pr = cls % 6;
    const int pa = pr < 3 ? 0 : (pr < 5 ? 1 : 2);
    const int pb = pr == 0 ? 1 : (pr == 1 ? 2 : (pr == 2 ? 3 : (pr == 3 ? 2 : 3)));
    ea = g * 4 + pa; eb = g * 4 + pb;
}
template <int NJ> struct SchedMoE {
    int ntiles, G, c; const LAS int* cs; const unsigned char* ws;
    __device__ __forceinline__ bool next(int i, pg8::Unit& u) const {
        const long L = (long)i * G + c; if (L >= (long)ntiles * NJ) return false;
        const int tile = (int)(L / NJ), j = (int)(L % NJ), slot0 = tile * 256;
        int cls = 0;
#pragma unroll 1
        for (int k = 1; k < NCLS; ++k) cls = (slot0 >= cs[k]) ? k : cls;
        u.pm = tile; u.pn = j; u.aux = cls; return true;
    }
    __device__ __forceinline__ const char* aptr(const pg8::Unit& u) const { return NJ == 8 ? (const char*)ws + WS_ACT : (const char*)ws + WS_H1 + (size_t)u.pm * (256 * 1024 * 2); }
    __device__ __forceinline__ const int* rowlist(const pg8::Unit& u) const { return (const int*)(ws + WS_LIST) + u.pm * 256; }
    __device__ __forceinline__ const char* bptr(const pg8::Unit& u) const { int ea, eb; cls_experts(u.aux, ea, eb);
        if (NJ == 8) { const int e = u.pn < 4 ? ea : eb; return (const char*)ws + WS_W13 + ((size_t)e * D + (size_t)(u.pn & 3) * 256) * D * 2; }
        return (const char*)ws + WS_W2T + ((size_t)ea * D + (size_t)u.pn * 256) * 512 * 2; }
    __device__ __forceinline__ const char* bptr2(const pg8::Unit& u) const { int ea, eb; cls_experts(u.aux, ea, eb);
        return (const char*)ws + WS_W2T + ((size_t)eb * D + (size_t)u.pn * 256) * 512 * 2; }
};
struct EpiSwiGLU {
    static constexpr bool PERM = true;
    unsigned char* ws;
    __device__ __forceinline__ void operator()(const f32x4 (&acc)[2][2][4][2], const pg8::Unit& u, int wr, int wc, int fr, int fq) const {
        bf16* H1 = (bf16*)(ws + WS_H1); const f32x2* wslot = (const f32x2*)(ws + WS_WSLOT);
        const int row0 = u.pm * 256 + wr * 64 + fr, j = u.pn;
        const int col0 = (j >> 2) * 512 + (j & 3) * 128 + wc * 32 + 8 * fq;
#pragma unroll
        for (int ai = 0; ai < 2; ++ai)
#pragma unroll
            for (int m = 0; m < 4; ++m) { const int row = row0 + ai * 128 + m * 16; const f32x2 wv = wslot[row]; const float w = j < 4 ? wv.x : wv.y;
                float o[8];
#pragma unroll
                for (int n = 0; n < 2; ++n)
#pragma unroll
                    for (int i = 0; i < 4; ++i) { const float gt = acc[ai][0][m][n][i], up = acc[ai][1][m][n][i]; o[n * 4 + i] = siluf(gt) * up * w; }
                u32x4 wv4; wv4.x = pg8::cvt_pk_bf16(o[0], o[1]); wv4.y = pg8::cvt_pk_bf16(o[2], o[3]); wv4.z = pg8::cvt_pk_bf16(o[4], o[5]); wv4.w = pg8::cvt_pk_bf16(o[6], o[7]);
                *(u32x4*)(H1 + (size_t)row * D + col0) = wv4; }
    }
};
struct EpiScatter {
    static constexpr bool PERM = false;
    float* x_lat; unsigned char* ws; int l;
    __device__ __forceinline__ void operator()(const f32x4 (&acc)[2][2][4][2], const pg8::Unit& u, int wr, int wc, int fr, int fq) const {
        const int* list = (const int*)(ws + WS_LIST); float* x_ctx = (float*)(ws + WS_CTX); const float* mod = (const float*)(ws + WS_MOD) + (size_t)l * 9 * 6144;
        const int row0 = u.pm * 256 + wr * 64 + fr, col0 = u.pn * 256 + wc * 32 + 4 * fq;
#pragma unroll
        for (int ai = 0; ai < 2; ++ai)
#pragma unroll
            for (int m = 0; m < 4; ++m) { const int tok = list[row0 + ai * 128 + m * 16];
                if (tok >= 0) { const int b = tok / TB, p = tok % TB;
                    float* xr = p < TC ? x_ctx + ((size_t)b * TC + p) * D : x_lat + ((size_t)b * TL + (p - TC)) * D;
                    const float* mrow = mod + (size_t)(p < TC ? 8 : b) * 6144 + 5 * D;
#pragma unroll
                    for (int bj = 0; bj < 2; ++bj)
#pragma unroll
                        for (int n = 0; n < 2; ++n) { const int c = col0 + bj * 128 + n * 16; const f32x4 gv = *(const f32x4*)(mrow + c);
                            *(f32x4*)(xr + c) = *(const f32x4*)(xr + c) + gv * acc[ai][bj][m][n]; } }
                asm volatile("" ::: "memory"); }
    }
};

constexpr int LD64 = 72;
__device__ __forceinline__ f32x4 mma16g(f32x4 acc, const LAS bf16* A, int lda, const bf16* Btg, int ldb, int lane) {
    const int r = lane & 15, kq = (lane >> 4) * 8;
    const bf16x8 a = *(const LAS bf16x8*)(A + r * lda + kq);
    const bf16x8 b = *(const bf16x8*)(Btg + (size_t)r * ldb + kq);
    return __builtin_amdgcn_mfma_f32_16x16x32_bf16(a, b, acc, 0, 0, 0);
}
__device__ __forceinline__ void phase_conv(const Frame& F0) {
    PH_ENTER(F0);
    const AS4 Args* KA = kargs();
    const bf16* UXBC = (const bf16*)(F.ws + WS_UXBC); bf16* XBCA = (bf16*)(F.ws + WS_XBCA);
    const float* cw = LP(22, 9 * 768); const float* cb = LP(23, 768);
    const int cg = F.tid % 96, sub = F.tid / 96;
    if (sub >= 5) return;
    const int ch0 = cg * 8;
    float wgt0[9][8], bias[8];
#pragma unroll
    for (int k = 0; k < 9; ++k) { const f32x4 wa = *(const f32x4*)(cw + k * 768 + ch0), wb = *(const f32x4*)(cw + k * 768 + ch0 + 4);
        wgt0[k][0] = wa.x; wgt0[k][1] = wa.y; wgt0[k][2] = wa.z; wgt0[k][3] = wa.w; wgt0[k][4] = wb.x; wgt0[k][5] = wb.y; wgt0[k][6] = wb.z; wgt0[k][7] = wb.w; }
    { const f32x4 b0 = *(const f32x4*)(cb + ch0), b1 = *(const f32x4*)(cb + ch0 + 4); bias[0] = b0.x; bias[1] = b0.y; bias[2] = b0.z; bias[3] = b0.w; bias[4] = b1.x; bias[5] = b1.y; bias[6] = b1.z; bias[7] = b1.w; }
    for (int it = F.bid * 5 + sub; it < NUNIT64 * 4; it += F.G * 5) {
        const int u = it >> 2, run = it & 3, b = u / NTILE64, tl = u % NTILE64, p0 = tl * 64; const size_t rowbase = (size_t)b * TB;
        const bool lat = p0 >= TC; const int gr = (p0 - TC) >> 6;
        const int xhi = lat ? 64 : TC, x0 = (lat ? 0 : p0) + run * 16;
        const bf16* rp0; const bf16* rp1; const bf16* rp2; bool rv0, rv2;
        { const int y0 = gr - 1, y2 = gr + 1; rv0 = lat && y0 >= 0; rv2 = lat && y2 < 128;
            rp1 = UXBC + (rowbase + (lat ? TC + gr * 64 : 0)) * 768 + ch0; rp0 = rv0 ? rp1 - 64 * 768 : rp1; rp2 = rv2 ? rp1 + 64 * 768 : rp1; }
        const float m0 = rv0 ? 1.f : 0.f, m2 = rv2 ? 1.f : 0.f;
        u32x4 w00, w01, w02, w10, w11, w12;
        { const int xa = x0 - 1; const bool va = xa >= 0; const size_t oa = (size_t)(va ? xa : 0) * 768; const u32x4 z4 = {0u, 0u, 0u, 0u};
            w00 = va ? *(const u32x4*)(rp0 + oa) : z4; w01 = va ? *(const u32x4*)(rp1 + oa) : z4; w02 = va ? *(const u32x4*)(rp2 + oa) : z4;
            const size_t ob = (size_t)x0 * 768; w10 = *(const u32x4*)(rp0 + ob); w11 = *(const u32x4*)(rp1 + ob); w12 = *(const u32x4*)(rp2 + ob); }
#pragma unroll 4
        for (int k = 0; k < 16; ++k) { const int x = x0 + k, xn = x + 1; const bool vn = xn < xhi; const size_t on = (size_t)(vn ? xn : x) * 768; const u32x4 z4 = {0u, 0u, 0u, 0u};
            u32x4 w20 = *(const u32x4*)(rp0 + on), w21 = *(const u32x4*)(rp1 + on), w22 = *(const u32x4*)(rp2 + on);
            if (!vn) { w20 = z4; w21 = z4; w22 = z4; }
            float acc[8], t0[8], t2[8];
#pragma unroll
            for (int i = 0; i < 8; ++i) { acc[i] = bias[i]; t0[i] = 0.f; t2[i] = 0.f; }
            float v[8];
#define CONV_TAP(W, K, DST) unpack8(W, v); _Pragma("unroll") for (int i = 0; i < 8; ++i) DST[i] += v[i] * wgt0[K][i];
            CONV_TAP(w00, 0, t0) CONV_TAP(w10, 1, t0) CONV_TAP(w20, 2, t0) CONV_TAP(w01, 3, acc) CONV_TAP(w11, 4, acc) CONV_TAP(w21, 5, acc) CONV_TAP(w02, 6, t2) CONV_TAP(w12, 7, t2) CONV_TAP(w22, 8, t2)
#undef CONV_TAP
#pragma unroll
            for (int i = 0; i < 8; ++i) acc[i] = siluf(acc[i] + m0 * t0[i] + m2 * t2[i]);
            *(u32x4*)(XBCA + (rowbase + (lat ? TC + gr * 64 + x : x)) * 768 + ch0) = pack8(acc);
            w00 = w10; w01 = w11; w02 = w12; w10 = w20; w11 = w21; w12 = w22;
        }
    }
}
__device__ __forceinline__ void phase_prep(const Frame& F0) {
    PH_ENTER(F0);
    const AS4 Args* KA = kargs();
    const int tid = F.tid, lane = F.lane, wave = F.wave;
    const bf16* URW = (const bf16*)(F.ws + WS_URW); const bf16* UXBC = (const bf16*)(F.ws + WS_UXBC);
    bf16* XBCA = (bf16*)(F.ws + WS_XBCA);
    h16* RECS = (h16*)(F.ws + WS_RECS); h16* RECD = (h16*)(F.ws + WS_RECD); h16* BONUS = (h16*)(F.ws + WS_BONUS); h16* GATE = (h16*)(F.ws + WS_GATE);
    const bf16* LW = (const bf16*)(F.ws + WS_LOWR);
    const float* mup = LP(10, 1024); const float* mun = LP(11, 1024);
    const float* w0 = LP(12, 512); const float* a0 = LP(14, 512);
    const float* k_k = LP(17, 256); const float* r_k = LP(19, 256);
    const float* cw = LP(22, 9 * 768); const float* cb = LP(23, 768);
    constexpr int LDR = 776, LDG = 136;
    LAS h16* RKV = (LAS h16*)F.lds;
    LAS bf16* WLi = (LAS bf16*)(F.lds + 99328);
    LAS bf16* ALi = (LAS bf16*)(F.lds + 108544);
    LAS bf16* GSi = (LAS bf16*)(F.lds + 117760);
    bf16x8 Bf[5][2][4];
    { const int c0 = wave * 32, r = lane & 15, kq = (lane >> 4) * 8;
#pragma unroll
        for (int mm = 0; mm < 4; ++mm) { const bf16* Bt = mm < 2 ? LW + (size_t)mm * 16384 : (mm < 4 ? LW + 32768 + (size_t)(mm - 2) * 16384 : LW + 65536); const int ldb = mm < 4 ? 64 : 128;
#pragma unroll
            for (int nt = 0; nt < 2; ++nt)
#pragma unroll
                for (int ks = 0; ks < 4; ++ks) if (ks < (mm < 4 ? 2 : 4)) Bf[mm][nt][ks] = *(const bf16x8*)(Bt + (size_t)(c0 + nt * 16 + r) * ldb + ks * 32 + kq); } }
    for (int u = F.bid; u < NUNIT64; u += F.G) {
        const int b = u / NTILE64, tl = u % NTILE64, p0 = tl * 64;
        const int seg_lo = p0 < TC ? 0 : TC, seg_hi = p0 < TC ? TC : TB;
        const size_t rowbase = (size_t)b * TB;
        LDS_BARRIER();
        SUBREP(1) { const int t = tid >> 3, part = tid & 7, p = p0 + t; const bf16* ur = URW + (rowbase + p) * 1024;
            const bool hp = p - 1 >= seg_lo, hn = p + 1 < seg_hi;
#pragma unroll 4
            for (int j = 0; j < 16; ++j) { const int c0 = (j * 8 + part) * 8;
                float uc[8], up[8], un[8];
                unpack8(*(const u32x4*)(ur + c0), uc);
                if (hp) unpack8(*(const u32x4*)(ur - 1024 + c0), up); else {
#pragma unroll
                    for (int i = 0; i < 8; ++i) up[i] = 0.f; }
                if (hn) unpack8(*(const u32x4*)(ur + 1024 + c0), un); else {
#pragma unroll
                    for (int i = 0; i < 8; ++i) un[i] = 0.f; }
                const f32x4 mp0 = *(const f32x4*)(mup + c0), mp1 = *(const f32x4*)(mup + c0 + 4), mn0 = *(const f32x4*)(mun + c0), mn1 = *(const f32x4*)(mun + c0 + 4);
                float sv[8];
#pragma unroll
                for (int i = 0; i < 4; ++i) { sv[i] = uc[i] + mp0[i] * (up[i] - uc[i]) + mn0[i] * (un[i] - uc[i]); sv[4 + i] = uc[4 + i] + mp1[i] * (up[4 + i] - uc[4 + i]) + mn1[i] * (un[4 + i] - uc[4 + i]); }
                if (c0 < 768) { h16x8 hv;
#pragma unroll
                    for (int i = 0; i < 8; ++i) hv[i] = (h16)sv[i];
                    *(LAS h16x8*)(RKV + t * LDR + c0) = hv; }
                else if (c0 < 832) {
#pragma unroll
                    for (int i = 0; i < 8; ++i) sv[i] = tanhf(sv[i]);
                    *(LAS u32x4*)(WLi + t * LD64 + (c0 - 768)) = pack8(sv); }
                else if (c0 < 896) *(LAS u32x4*)(ALi + t * LD64 + (c0 - 832)) = pack8(sv);
                else {
#pragma unroll
                    for (int i = 0; i < 8; ++i) sv[i] = sigm(sv[i]);
                    *(LAS u32x4*)(GSi + t * LDG + (c0 - 896)) = pack8(sv); }
            } }
        LDS_BARRIER();
        SUBREP(2) { const int t = tid >> 3, hq = tid & 7, h = hq >> 1, c0 = h * 64 + (hq & 1) * 32, p = p0 + t;
            float ss = 0.f, bs = 0.f;
#pragma unroll
            for (int j = 0; j < 4; ++j) { const h16x8 rv = *(const LAS h16x8*)(RKV + t * LDR + c0 + 8 * j), kv = *(const LAS h16x8*)(RKV + t * LDR + 256 + c0 + 8 * j);
                const f32x4 kk0 = *(const f32x4*)(k_k + c0 + 8 * j), kk1 = *(const f32x4*)(k_k + c0 + 8 * j + 4), rk0 = *(const f32x4*)(r_k + c0 + 8 * j), rk1 = *(const f32x4*)(r_k + c0 + 8 * j + 4);
#pragma unroll
                for (int i = 0; i < 8; ++i) { const float kf = (float)kv[i], rf = (float)rv[i], kc = i < 4 ? kk0[i & 3] : kk1[i & 3], rc = i < 4 ? rk0[i & 3] : rk1[i & 3];
                    const float kr = kf * kc; ss += kr * kr; bs += rf * kf * rc; } }
            ss += dpp_mov<0xB1>(ss); bs += dpp_mov<0xB1>(bs);
            const float rs = rsqrtf(ss + 1e-12f);
            h16* rec = RECS + (((size_t)b * 4 + h) * TB + p) * 256 + (hq & 1) * 32;
            h16* bon = BONUS + (rowbase + p) * 256 + c0;
#pragma unroll
            for (int j = 0; j < 4; ++j) { const h16x8 rv = *(const LAS h16x8*)(RKV + t * LDR + c0 + 8 * j), kv = *(const LAS h16x8*)(RKV + t * LDR + 256 + c0 + 8 * j), vv = *(const LAS h16x8*)(RKV + t * LDR + 512 + c0 + 8 * j);
                const f32x4 kk0 = *(const f32x4*)(k_k + c0 + 8 * j), kk1 = *(const f32x4*)(k_k + c0 + 8 * j + 4);
                h16x8 kkv, bv;
#pragma unroll
                for (int i = 0; i < 8; ++i) { kkv[i] = (h16)((float)kv[i] * (i < 4 ? kk0[i & 3] : kk1[i & 3]) * rs); bv[i] = (h16)(bs * (float)vv[i]); }
                *(h16x8*)(rec + 8 * j) = rv; *(h16x8*)(rec + 64 + 8 * j) = vv; *(h16x8*)(rec + 128 + 8 * j) = kkv; *(h16x8*)(rec + 192 + 8 * j) = kv;
                *(h16x8*)(bon + 8 * j) = bv; asm volatile("" ::: "memory"); } }
        LDS_BARRIER();
        SUBREP(3) { const int c0 = wave * 32, h = wave >> 1, lr = (lane >> 4) * 4, lc = lane & 15;
#pragma unroll
            for (int nt = 0; nt < 2; ++nt)
#pragma unroll
                for (int ks = 0; ks < 4; ++ks) Bf[4][nt][ks] = *(const bf16x8*)(LW + 65536 + (size_t)(c0 + nt * 16 + (lane & 15)) * 128 + ks * 32 + (lane >> 4) * 8);
#pragma unroll
            for (int mm = 0; mm < 5; ++mm) {
                const LAS bf16* Ai = mm < 2 ? WLi : (mm < 4 ? ALi : GSi); const int lda = mm < 4 ? LD64 : LDG, nks = mm < 4 ? 2 : 4;
                f32x4 acc[4][2];
#pragma unroll
                for (int tt = 0; tt < 4; ++tt)
#pragma unroll
                    for (int nt = 0; nt < 2; ++nt) acc[tt][nt] = (f32x4){0.f, 0.f, 0.f, 0.f};
#pragma unroll
                for (int ks = 0; ks < 4; ++ks) if (ks < nks)
#pragma unroll
                    for (int tt = 0; tt < 4; ++tt) { const bf16x8 af = *(const LAS bf16x8*)(Ai + (tt * 16 + (lane & 15)) * lda + ks * 32 + (lane >> 4) * 8);
#pragma unroll
                        for (int nt = 0; nt < 2; ++nt) acc[tt][nt] = __builtin_amdgcn_mfma_f32_16x16x32_bf16(af, Bf[mm][nt][ks], acc[tt][nt], 0, 0, 0); }
                LAS h16* STG = (LAS h16*)F.lds + (mm & 1) * (64 * 264);
#pragma unroll
                for (int nt = 0; nt < 2; ++nt) { const int c = c0 + nt * 16 + lc;
                    const float bias = mm < 2 ? w0[mm * 256 + c] : (mm < 4 ? a0[(mm - 2) * 256 + c] : 0.f);
#pragma unroll
                    for (int tt = 0; tt < 4; ++tt)
#pragma unroll
                        for (int i = 0; i < 4; ++i) { const float x = acc[tt][nt][i] + bias; const float sg = sigm(x);
                            const float o = mm < 2 ? 1.f - __expf(-0.60653066f * sg) : (mm < 4 ? sg : x);
                            STG[(tt * 16 + lr + i) * 264 + c] = (h16)o; } }
                LDS_BARRIER();
#pragma unroll
                for (int i = 0; i < 4; ++i) { const int id = tid + 512 * i, t = id >> 5, ch = id & 31, hh = ch >> 3;
                    const h16x8 v = *(const LAS h16x8*)(STG + t * 264 + ch * 8);
                    h16* dst = mm < 2 ? RECD + ((((size_t)b * 4 + hh) * 2 + mm) * TB + p0 + t) * 128 + (ch & 7) * 8
                             : (mm < 4 ? RECD + ((((size_t)b * 4 + hh) * 2 + (mm - 2)) * TB + p0 + t) * 128 + 64 + (ch & 7) * 8 : GATE + (rowbase + p0 + t) * 256 + ch * 8);
                    *(h16x8*)dst = v; }
            } }
    }
}

__device__ __forceinline__ f32x4 mma16(f32x4 acc, const LAS bf16* A, int lda, const LAS bf16* Bt, int ldb, int lane) {
    const int r = lane & 15, kq = (lane >> 4) * 8;
    const bf16x8 a = *(const LAS bf16x8*)(A + r * lda + kq);
    const bf16x8 b = *(const LAS bf16x8*)(Bt + r * ldb + kq);
    return __builtin_amdgcn_mfma_f32_16x16x32_bf16(a, b, acc, 0, 0, 0);
}
typedef short v4i16 __attribute__((ext_vector_type(4)));
__device__ __forceinline__ bf16x8 frag_tr(const LAS bf16* T, int ld, int k0, int c0, int lane) {
    const int g = lane >> 4, q = (lane & 15) >> 2, p = lane & 3;
    const LAS bf16* a = T + (k0 + 8 * g + q) * ld + c0 + 4 * p;
    const v4i16 lo = __builtin_amdgcn_ds_read_tr16_b64_v4i16((LAS v4i16*)a);
    const v4i16 hi = __builtin_amdgcn_ds_read_tr16_b64_v4i16((LAS v4i16*)(a + 4 * ld));
    return (bf16x8){lo[0], lo[1], lo[2], lo[3], hi[0], hi[1], hi[2], hi[3]};
}
__device__ __forceinline__ bf16x8 frag_row(const LAS bf16* A, int lda, int lane) { return *(const LAS bf16x8*)(A + (lane & 15) * lda + (lane >> 4) * 8); }
__device__ __forceinline__ float scan_incl(float v, int lane, bool rev) {
#pragma unroll
    for (int o = 1; o < 64; o <<= 1) { const float t = rev ? __shfl_down(v, o) : __shfl_up(v, o); if (rev ? (lane + o < 64) : (lane >= o)) v += t; }
    return v;
}


__device__ __forceinline__ void gla_bcs(const Frame& F, const AS4 Args* KA, size_t row0, LAS float* LG, LAS float* GLT) {
    const int tid = F.tid;
    const float* UM = (const float*)(F.ws + WS_UMISC); const float* ga2 = LP(28, 2 * 16 * 128); const float* gb = LP(29, 256);
    LDS_BARRIER();
    if (tid < 256) { const int s = tid >> 2, j4 = (tid & 3) * 4; *(LAS f32x4*)(GLT + s * 16 + j4) = *(const f32x4*)(UM + (row0 + s) * 32 + 8 + j4); }
    LDS_BARRIER();
    { const int ch2 = tid & 255, d = ch2 >> 7, ch = ch2 & 127, sh = tid >> 8;
        float w[16];
#pragma unroll
        for (int j = 0; j < 16; ++j) w[j] = ga2[(size_t)(d * 16 + j) * 128 + ch];
        const float bias = gb[d * 128 + ch];
#pragma unroll 4
        for (int t = 0; t < 32; ++t) { const int s = sh * 32 + t; float z = bias;
#pragma unroll
            for (int j4 = 0; j4 < 4; ++j4) { const f32x4 g4 = *(const LAS f32x4*)(GLT + s * 16 + j4 * 4); z += g4.x * w[j4 * 4] + g4.y * w[j4 * 4 + 1] + g4.z * w[j4 * 4 + 2] + g4.w * w[j4 * 4 + 3]; }
            LG[(d * 64 + s) * 128 + ch] = -softplusf_(-z) * (1.f / 16.f); } }
    LDS_BARRIER();
    if (tid < 256) { const int d = tid >> 7, ch = tid & 127; float a = 0.f;
#pragma unroll 8
        for (int t = 0; t < 64; ++t) { const int s = d ? 63 - t : t; a += LG[(d * 64 + s) * 128 + ch]; LG[(d * 64 + s) * 128 + ch] = a; } }
    LDS_BARRIER();
}
__device__ __forceinline__ void phase_combine_gla(const Frame& F0) {
    PH_ENTER(F0);
    const int gid = F.bid * 512 + F.tid;
    if (gid >= 64 * 1024) return;
    const int chain = gid >> 10, e0 = (gid & 1023) * 2, d = chain & 1, bh = chain >> 1, b = bh >> 2, h = bh & 3;
    bf16* GS = (bf16*)(F.ws + WS_GS) + (size_t)chain * NTILE64 * 2048 + e0; const float* GDEC = (const float*)(F.ws + WS_GDEC) + (size_t)b * NTILE64 * 256 + d * 128 + h * 32 + (e0 & 31);
    float S0 = 0.f, S1 = 0.f;
#pragma unroll 4
    for (int it = 0; it < NTILE64; ++it) {
        const int c = d == 0 ? it : (it < 4 ? 3 - it : 131 - (it - 4));
        unsigned* p = (unsigned*)(GS + (size_t)c * 2048); const unsigned st = *p; const f32x2 dec = *(const f32x2*)(GDEC + (size_t)c * 256);
        *p = pk2(S0, S1);
        S0 = S0 * dec.x + __uint_as_float(st << 16); S1 = S1 * dec.y + __uint_as_float(st & 0xffff0000u);
    }
}
__device__ __forceinline__ void phase_finish_gla(const Frame& F0) {
    PH_ENTER(F0);
    const AS4 Args* KA = kargs();
    const int tid = F.tid, lane = F.lane, wave = F.wave;
    const bf16* UG = (const bf16*)(F.ws + WS_UGLA); const bf16* GS = (const bf16*)(F.ws + WS_GS); bf16* MIX = (bf16*)(F.ws + WS_ACT);
    const float* gln = LP(30, 256);
    constexpr int LD32 = 40;
    LAS float* LG = (LAS float*)F.lds;
    LAS bf16* QE = (LAS bf16*)(F.lds + 65536);
    LAS bf16* KE = (LAS bf16*)(F.lds + 86016);
    LAS bf16* VT = (LAS bf16*)(F.lds + 96256);
    LAS bf16* ST = (LAS bf16*)(F.lds + 105472);
    LAS bf16* ATT = (LAS bf16*)(F.lds + 115712);
    LAS bf16* OB = (LAS bf16*)(F.lds + 124928);
    LAS float* RSQ = (LAS float*)(F.lds + 134144);
    LAS float* GLT = (LAS float*)(F.lds + 134656);
    LAS bf16* RT = (LAS bf16*)(F.lds + 138752);
    const int lt = wave & 3, cth = wave >> 2, lr = (lane >> 4) * 4, lc = lane & 15;
    const bool skipctx = F.l == 1;
    for (int j_ = F.G - 1 - F.bid; j_ < n_units(skipctx); j_ += F.G) {
        const int u = unit_of(skipctx, j_);
        const int b = u / NTILE64, c = u % NTILE64; const size_t row0 = (size_t)b * TB + (size_t)c * 64;
        u32x2 pq, pk; u32x4 pv, pst, prt;
        { const int l = tid >> 3, g4 = (tid & 7) * 4; const bf16* ur = UG + (row0 + l) * 768;
            pq = *(const u32x2*)(ur + g4); pk = *(const u32x2*)(ur + 128 + g4);
            pv = *(const u32x4*)(UG + (row0 + (tid & 63)) * 768 + 256 + (tid >> 6) * 8);
            { const int d = tid >> 8, r = (tid & 255) >> 2, ch = tid & 3; pst = *(const u32x4*)(GS + ((((size_t)b * 4) * 2 + d) * NTILE64 + c) * 2048 + r * 32 + ch * 8); }
            prt = *(const u32x4*)(UG + (row0 + (tid >> 3)) * 768 + 512 + (tid & 7) * 8); }
        gla_bcs(F, KA, row0, LG, GLT);
#pragma unroll 1
        for (int h = 0; h < 4; ++h) {
            { const int l = tid >> 3, g4 = (tid & 7) * 4, ch = h * 32 + g4;
                const u32x2 qr = pq, kr = pk;
                const float q[4] = { bf2f(qr.x & 0xffff) * 0.17677669529663687f, bf2f(qr.x >> 16) * 0.17677669529663687f, bf2f(qr.y & 0xffff) * 0.17677669529663687f, bf2f(qr.y >> 16) * 0.17677669529663687f };
                const float k[4] = { bf2f(kr.x & 0xffff), bf2f(kr.x >> 16), bf2f(kr.y & 0xffff), bf2f(kr.y >> 16) };
#pragma unroll
                for (int d = 0; d < 2; ++d) { const f32x4 bc = *(const LAS f32x4*)(LG + (d * 64 + l) * 128 + ch), rf = *(const LAS f32x4*)(LG + (d * 64 + 32) * 128 + ch);
                    float qe[4], ke[4], qb[4];
#pragma unroll
                    for (int i = 0; i < 4; ++i) { qe[i] = q[i] * __expf(bc[i] - rf[i]); ke[i] = k[i] * __expf(rf[i] - bc[i]); qb[i] = q[i] * __expf(bc[i]); }
                    u32x2 w; w.x = pk2(qe[0], qe[1]); w.y = pk2(qe[2], qe[3]); *(LAS u32x2*)(QE + (d * 64 + l) * LD32 + g4) = w;
                    w.x = pk2(qb[0], qb[1]); w.y = pk2(qb[2], qb[3]); *(LAS u32x2*)(QE + ((2 + d) * 64 + l) * LD32 + g4) = w;
                    w.x = pk2(ke[0], ke[1]); w.y = pk2(ke[2], ke[3]); *(LAS u32x2*)(KE + (d * 64 + l) * LD32 + g4) = w; } }
            { const int s = tid & 63, g8 = tid >> 6; const unsigned w[4] = {pv.x, pv.y, pv.z, pv.w};
#pragma unroll
                for (int i = 0; i < 8; ++i) VT[(g8 * 8 + i) * LD64 + s] = (bf16)(i & 1 ? w[i >> 1] >> 16 : w[i >> 1] & 0xffffu); }
            { const int d = tid >> 8, r = (tid & 255) >> 2, ch = tid & 3; *(LAS u32x4*)(ST + (d * 64 + r) * LD32 + ch * 8) = pst; }
            *(LAS u32x4*)(RT + (tid >> 3) * LD64 + (tid & 7) * 8) = prt;
            { const int hn = h < 3 ? h + 1 : 3; const int l = tid >> 3, g4 = (tid & 7) * 4; const bf16* ur = UG + (row0 + l) * 768;
                pq = *(const u32x2*)(ur + hn * 32 + g4); pk = *(const u32x2*)(ur + 128 + hn * 32 + g4);
                pv = *(const u32x4*)(UG + (row0 + (tid & 63)) * 768 + 256 + hn * 64 + (tid >> 6) * 8);
                { const int d = tid >> 8, r = (tid & 255) >> 2, ch = tid & 3; pst = *(const u32x4*)(GS + ((((size_t)b * 4 + hn) * 2 + d) * NTILE64 + c) * 2048 + r * 32 + ch * 8); }
                prt = *(const u32x4*)(UG + (row0 + (tid >> 3)) * 768 + 512 + hn * 64 + (tid & 7) * 8); }
            LDS_BARRIER();
#pragma unroll
            for (int j = 0; j < 2; ++j) { const int st = 2 * cth + j; const f32x4 z4 = {0.f, 0.f, 0.f, 0.f};
                const f32x4 af = mma16(z4, QE + (lt * 16) * LD32, LD32, KE + (st * 16) * LD32, LD32, lane);
                const f32x4 ab = mma16(z4, QE + (64 + lt * 16) * LD32, LD32, KE + (64 + st * 16) * LD32, LD32, lane);
                const int s = st * 16 + lc;
#pragma unroll
                for (int i = 0; i < 4; ++i) { const int l = lt * 16 + lr + i; ATT[l * LD64 + s] = (bf16)f2bf((s <= l ? af[i] : 0.f) + (s >= l ? ab[i] : 0.f)); } }
            LDS_BARRIER();
            f32x4 o[2];
#pragma unroll
            for (int j = 0; j < 2; ++j) { const int vt = 2 * cth + j; f32x4 acc = {0.f, 0.f, 0.f, 0.f};
#pragma unroll
                for (int ks = 0; ks < 2; ++ks) acc = mma16(acc, ATT + lt * 16 * LD64 + ks * 32, LD64, VT + vt * 16 * LD64 + ks * 32, LD64, lane);
                acc = mma16(acc, QE + (128 + lt * 16) * LD32, LD32, ST + (vt * 16) * LD32, LD32, lane);
                acc = mma16(acc, QE + (192 + lt * 16) * LD32, LD32, ST + (64 + vt * 16) * LD32, LD32, lane);
                o[j] = acc; }
#pragma unroll
            for (int i = 0; i < 4; ++i) { const float t = sum16(o[0][i] * o[0][i] + o[1][i] * o[1][i]); if (lc == 0) RSQ[cth * 64 + lt * 16 + lr + i] = t; }
            LDS_BARRIER();
#pragma unroll
            for (int j = 0; j < 2; ++j) { const int dv = (2 * cth + j) * 16 + lc; const float gn = gln[h * 64 + dv];
#pragma unroll
                for (int i = 0; i < 4; ++i) { const int l = lt * 16 + lr + i; const float scl = rsqrtf((RSQ[l] + RSQ[64 + l]) * (1.f / 64.f) + 1e-6f);
                    const float r = bf2f(RT[l * LD64 + dv]);
                    OB[l * LD64 + dv] = (bf16)f2bf(o[j][i] * scl * gn * siluf(r)); } }
            LDS_BARRIER();
            { const int r = tid >> 3, ch = tid & 7; *(u32x4*)(MIX + (row0 + r) * D + 768 + h * 64 + ch * 8) = *(const LAS u32x4*)(OB + r * LD64 + ch * 8); }
        }
    }
}

__device__ __forceinline__ void phase_states(const Frame& F0) {
    PH_ENTER(F0);
    const AS4 Args* KA = kargs();
    const int tid = F.tid, lane = F.lane, wave = F.wave;
    const bf16* XBCA = (const bf16*)(F.ws + WS_XBCA); const float* UM = (const float*)(F.ws + WS_UMISC);
    bf16* SS = (bf16*)(F.ws + WS_SS); float* SDEC = (float*)(F.ws + WS_SDEC);
    const float* dtb = LP(24, 16); const float* alog = LP(25, 16);
    LAS bf16* CT = (LAS bf16*)F.lds;
    LAS bf16* XTW = (LAS bf16*)(F.lds + 99328);
    LAS bf16* BT = (LAS bf16*)(F.lds + 117760);
    LAS float* WTS = (LAS float*)(F.lds + 136192);
    const bf16* UG = (const bf16*)(F.ws + WS_UGLA); bf16* GS = (bf16*)(F.ws + WS_GS); float* GDEC = (float*)(F.ws + WS_GDEC);
    LAS float* LG = (LAS float*)F.lds;
    LAS bf16* VT4 = (LAS bf16*)(F.lds + 65536);
    LAS bf16* KTE = (LAS bf16*)(F.lds + 102400);
    LAS float* GLT = (LAS float*)(F.lds + 139264);
    for (int u = F.G - 1 - F.bid; u < NUNIT64; u += F.G) {
        const int b = u / NTILE64, c = u % NTILE64; const size_t row0 = (size_t)b * TB + (size_t)c * 64;
        LDS_BARRIER();
#pragma unroll
        for (int i = 0; i < 12; ++i) { const int id = tid + 512 * i, r = id / 96, ch = id % 96;
            *(LAS u32x4*)(CT + r * 776 + ch * 8) = *(const u32x4*)(XBCA + (row0 + r) * 768 + ch * 8); }
#pragma unroll
        for (int j = 0; j < 2; ++j) { const int q = wave * 2 + j, h = q >> 1, d = q & 1;
            const float dtp = softplusf_(UM[(row0 + lane) * 32 + h] + dtb[d * 8 + h]);
            const float dA = -__expf(alog[d * 8 + h]) * dtp;
            const float cs = scan_incl(dA, lane, d == 1);
            const float ce = __shfl(cs, d == 0 ? 63 : 0);
            WTS[q * 64 + lane] = __expf(ce - cs) * dtp;
            if (lane == 0) SDEC[((size_t)b * NTILE64 + c) * 16 + q] = __expf(ce); }
        LDS_BARRIER();
#pragma unroll 1
        for (int hp = 0; hp < 4; ++hp) {
            { const int sr = tid >> 3, ch = tid & 7, g = hp >> 1; float bv[8]; unpack8(*(const LAS u32x4*)(CT + sr * 776 + 512 + g * 64 + ch * 8), bv);
#pragma unroll
                for (int q = 0; q < 4; ++q) { const float w = WTS[(hp * 4 + q) * 64 + sr]; float o[8];
#pragma unroll
                    for (int i = 0; i < 8; ++i) o[i] = bv[i] * w;
                    *(LAS u32x4*)(XTW + (q * 64 + sr) * LD64 + ch * 8) = pack8(o); } }
            LDS_BARRIER();
            { const int d = wave >> 2, mt = wave & 3;
#pragma unroll
                for (int hh = 0; hh < 2; ++hh) { const int h = hp * 2 + hh;
                    bf16* dst = SS + ((((size_t)b * 8 + h) * 2 + d) * NTILE64 + c) * 4096;
                    bf16x8 af[2];
#pragma unroll
                    for (int ks = 0; ks < 2; ++ks) af[ks] = frag_tr(CT, 776, ks * 32, h * 64 + mt * 16, lane);
#pragma unroll
                    for (int nt = 0; nt < 4; ++nt) { f32x4 acc = {0.f, 0.f, 0.f, 0.f};
#pragma unroll
                        for (int ks = 0; ks < 2; ++ks) acc = __builtin_amdgcn_mfma_f32_16x16x32_bf16(af[ks], frag_tr(XTW + (hh * 2 + d) * 64 * LD64, LD64, ks * 32, nt * 16, lane), acc, 0, 0, 0);
#pragma unroll
                        for (int i = 0; i < 4; ++i) dst[(mt * 16 + (lane >> 4) * 4 + i) * 64 + nt * 16 + (lane & 15)] = (bf16)f2bf(acc[i]); } } }
            LDS_BARRIER();
        }
        gla_bcs(F, KA, row0, LG, GLT);
        if (tid < 256) GDEC[((size_t)b * NTILE64 + c) * 256 + tid] = __expf(LG[((tid >> 7) * 64 + ((tid >> 7) ? 0 : 63)) * 128 + (tid & 127)]);
        { const int sr = tid >> 3, q8 = tid & 7; const bf16* ur = UG + (row0 + sr) * 768;
#pragma unroll
            for (int i = 0; i < 4; ++i) { const int col = (q8 * 4 + i) * 8; *(LAS u32x4*)(VT4 + sr * 264 + col) = *(const u32x4*)(ur + 256 + col); }
#pragma unroll
            for (int i = 0; i < 2; ++i) { const int col = (q8 * 2 + i) * 8; float kv[8]; unpack8(*(const u32x4*)(ur + 128 + col), kv);
#pragma unroll
                for (int d = 0; d < 2; ++d) { const LAS float* be = LG + (d * 64 + (d ? 0 : 63)) * 128 + col; const LAS float* bc = LG + (d * 64 + sr) * 128 + col; float o[8];
#pragma unroll
                    for (int k = 0; k < 8; ++k) o[k] = kv[k] * __expf(be[k] - bc[k]);
                    *(LAS u32x4*)(KTE + (d * 64 + sr) * 136 + col) = pack8(o); } } }
        LDS_BARRIER();
        { const int d = wave >> 2, mt = wave & 3;
#pragma unroll
            for (int h = 0; h < 4; ++h) { bf16* dst = GS + ((((size_t)b * 4 + h) * 2 + d) * NTILE64 + c) * 2048;
                bf16x8 af[2];
#pragma unroll
                for (int ks = 0; ks < 2; ++ks) af[ks] = frag_tr(VT4, 264, ks * 32, h * 64 + mt * 16, lane);
#pragma unroll
                for (int nt = 0; nt < 2; ++nt) { f32x4 acc = {0.f, 0.f, 0.f, 0.f};
#pragma unroll
                    for (int ks = 0; ks < 2; ++ks) acc = __builtin_amdgcn_mfma_f32_16x16x32_bf16(af[ks], frag_tr(KTE + d * 64 * 136, 136, ks * 32, h * 32 + nt * 16, lane), acc, 0, 0, 0);
#pragma unroll
                    for (int i = 0; i < 4; ++i) dst[(mt * 16 + (lane >> 4) * 4 + i) * 32 + nt * 16 + (lane & 15)] = (bf16)f2bf(acc[i]); } } }
    }
}
__device__ __forceinline__ void phase_combine_ssd(const Frame& F0) {
    PH_ENTER(F0);
    const int gid = F.bid * 512 + F.tid;
    if (gid >= 128 * 1024) return;
    const int chain = gid >> 10, e0 = (gid & 1023) * 4, d = chain & 1, bh = chain >> 1, b = bh >> 3, h = bh & 7;
    bf16* SS = (bf16*)(F.ws + WS_SS) + (size_t)chain * NTILE64 * 4096 + e0; const float* SDEC = (const float*)(F.ws + WS_SDEC) + (size_t)b * NTILE64 * 16 + h * 2 + d;
    float S0 = 0.f, S1 = 0.f, S2 = 0.f, S3 = 0.f;
#pragma unroll 4
    for (int it = 0; it < NTILE64; ++it) {
        const int c = d == 0 ? it : (it < 4 ? 3 - it : 131 - (it - 4));
        u32x2* p = (u32x2*)(SS + (size_t)c * 4096); const u32x2 st = *p; const float dec = SDEC[c * 16];
        u32x2 o; o.x = pk2(S0, S1); o.y = pk2(S2, S3); *p = o;
        S0 = S0 * dec + __uint_as_float(st.x << 16); S1 = S1 * dec + __uint_as_float(st.x & 0xffff0000u); S2 = S2 * dec + __uint_as_float(st.y << 16); S3 = S3 * dec + __uint_as_float(st.y & 0xffff0000u);
    }
}
__device__ __forceinline__ void phase_finish_ssd(const Frame& F0) {
    PH_ENTER(F0);
    const AS4 Args* KA = kargs();
    const int tid = F.tid, lane = F.lane, wave = F.wave;
    const bf16* XBCA = (const bf16*)(F.ws + WS_XBCA); const float* UM = (const float*)(F.ws + WS_UMISC); const bf16* UZ = (const bf16*)(F.ws + WS_UZ);
    const bf16* SS = (const bf16*)(F.ws + WS_SS); bf16* MIX = (bf16*)(F.ws + WS_ACT);
    const float* dtb = LP(24, 16); const float* alog = LP(25, 16); const float* dsk = LP(26, 8); const float* sng = LP(27, 512);
    LAS bf16* CB = (LAS bf16*)F.lds;
    LAS bf16* BI = (LAS bf16*)(F.lds + 18432);
    LAS bf16* XT = (LAS bf16*)(F.lds + 18432);
    LAS bf16* MI = (LAS bf16*)(F.lds + 27648);
    LAS bf16* SFB = (LAS bf16*)(F.lds + 36864);
    LAS float* ACS = (LAS float*)(F.lds + 55296);
    LAS float* RSQ = (LAS float*)(F.lds + 63488);
    LAS bf16* GB = (LAS bf16*)(F.lds + 64000);
    LAS bf16* ZT = (LAS bf16*)(F.lds + 129536);
    const int lt = wave & 3, cth = wave >> 2, lr = (lane >> 4) * 4, lc = lane & 15;
    const bool skipctx = F.l == 1;
    for (int j_ = F.bid; j_ < n_units(skipctx); j_ += F.G) {
        const int u = unit_of(skipctx, j_);
        const int b = u / NTILE64, c = u % NTILE64; const size_t row0 = (size_t)b * TB + (size_t)c * 64;
        u32x4 pxt, psf, psb, pzt;
        { const int s_ = tid & 63, pg = tid >> 6, r = tid >> 3, ch = tid & 7;
            pxt = *(const u32x4*)(XBCA + (row0 + r) * 768 + ch * 8);
            psf = *(const u32x4*)(SS + ((((size_t)b * 8) * 2 + 0) * NTILE64 + c) * 4096 + r * 64 + ch * 8); psb = *(const u32x4*)(SS + ((((size_t)b * 8) * 2 + 1) * NTILE64 + c) * 4096 + r * 64 + ch * 8);
            pzt = *(const u32x4*)(UZ + (row0 + r) * 512 + ch * 8); }
        LDS_BARRIER();
#pragma unroll
        for (int i = 0; i < 4; ++i) { const int id = tid + 512 * i, r = id >> 5, ch = id & 31;
            const int which = ch >> 3;
            LAS bf16* dst = (which < 2 ? BI + (which * 64 + r) * LD64 : CB + ((which - 2) * 64 + r) * LD64) + (ch & 7) * 8;
            *(LAS u32x4*)dst = *(const u32x4*)(XBCA + (row0 + r) * 768 + 512 + ch * 8); }
        { const int h = wave;
#pragma unroll
            for (int d = 0; d < 2; ++d) { const float dtp = softplusf_(UM[(row0 + lane) * 32 + h] + dtb[d * 8 + h]);
                const float cs = scan_incl(-__expf(alog[d * 8 + h]) * dtp, lane, d == 1);
                ACS[(d * 8 + h) * 64 + lane] = cs; ACS[((2 + d) * 8 + h) * 64 + lane] = dtp; } }
        LDS_BARRIER();
        f32x4 G00 = {0.f, 0.f, 0.f, 0.f}, G01 = G00, G10 = G00, G11 = G00;
#pragma unroll
        for (int ks = 0; ks < 2; ++ks) {
            G00 = mma16(G00, CB + (lt * 16) * LD64 + ks * 32, LD64, BI + ((2 * cth) * 16) * LD64 + ks * 32, LD64, lane);
            G01 = mma16(G01, CB + (lt * 16) * LD64 + ks * 32, LD64, BI + ((2 * cth + 1) * 16) * LD64 + ks * 32, LD64, lane);
            G10 = mma16(G10, CB + (64 + lt * 16) * LD64 + ks * 32, LD64, BI + (64 + (2 * cth) * 16) * LD64 + ks * 32, LD64, lane);
            G11 = mma16(G11, CB + (64 + lt * 16) * LD64 + ks * 32, LD64, BI + (64 + (2 * cth + 1) * 16) * LD64 + ks * 32, LD64, lane); }
        LDS_BARRIER();
        f32x4 rsq = {0.f, 0.f, 0.f, 0.f};
#pragma unroll 1
        for (int h = 0; h < 8; ++h) {
            const int g = h >> 2;
            { const int r = tid >> 3, ch = tid & 7;
                *(LAS u32x4*)(XT + r * LD64 + ch * 8) = pxt;
                *(LAS u32x4*)(SFB + r * LD64 + ch * 8) = psf; *(LAS u32x4*)(SFB + (64 + r) * LD64 + ch * 8) = psb; *(LAS u32x4*)(ZT + r * LD64 + ch * 8) = pzt;
                const int hn = h < 7 ? h + 1 : 7;
                pxt = *(const u32x4*)(XBCA + (row0 + r) * 768 + hn * 64 + ch * 8);
                psf = *(const u32x4*)(SS + ((((size_t)b * 8 + hn) * 2 + 0) * NTILE64 + c) * 4096 + r * 64 + ch * 8); psb = *(const u32x4*)(SS + ((((size_t)b * 8 + hn) * 2 + 1) * NTILE64 + c) * 4096 + r * 64 + ch * 8);
                pzt = *(const u32x4*)(UZ + (row0 + r) * 512 + hn * 64 + ch * 8); }
            const LAS float* af = ACS + h * 64; const LAS float* ab = ACS + (8 + h) * 64; const LAS float* pf = ACS + (16 + h) * 64; const LAS float* pb = ACS + (24 + h) * 64;
#pragma unroll
            for (int j = 0; j < 2; ++j) { const int s = (2 * cth + j) * 16 + lc; const float afs = af[s], abs_ = ab[s], pfs = pf[s], pbs = pb[s];
                const f32x4 gt = g ? (j ? G11 : G10) : (j ? G01 : G00);
#pragma unroll
                for (int i = 0; i < 4; ++i) { const int l = lt * 16 + lr + i;
                    const float wf = s <= l ? __expf(af[l] - afs) * pfs : 0.f, wb = s >= l ? __expf(ab[l] - abs_) * pbs : 0.f;
                    MI[l * LD64 + s] = (bf16)f2bf(gt[i] * (wf + wb)); } }
            LDS_BARRIER();
#pragma unroll
            for (int j = 0; j < 2; ++j) { const int pt = 2 * cth + j; f32x4 acc = {0.f, 0.f, 0.f, 0.f}, tf = {0.f, 0.f, 0.f, 0.f}, tb = {0.f, 0.f, 0.f, 0.f};
#pragma unroll
                for (int ks = 0; ks < 2; ++ks) { acc = __builtin_amdgcn_mfma_f32_16x16x32_bf16(frag_row(MI + lt * 16 * LD64 + ks * 32, LD64, lane), frag_tr(XT, LD64, ks * 32, pt * 16, lane), acc, 0, 0, 0);
                    tf = mma16(tf, CB + (g * 64 + lt * 16) * LD64 + ks * 32, LD64, SFB + pt * 16 * LD64 + ks * 32, LD64, lane);
                    tb = mma16(tb, CB + (g * 64 + lt * 16) * LD64 + ks * 32, LD64, SFB + (64 + pt * 16) * LD64 + ks * 32, LD64, lane); }
                const int p = pt * 16 + lc; const float ds = dsk[h];
#pragma unroll
                for (int i = 0; i < 4; ++i) { const int l = lt * 16 + lr + i;
                    const float y = acc[i] + __expf(af[l]) * tf[i] + __expf(ab[l]) * tb[i];
                    const float xs = bf2f(XT[l * LD64 + p]), z = bf2f(ZT[l * LD64 + p]);
                    const float gv = (y + ds * xs) * siluf(z); GB[l * 512 + h * 64 + p] = (bf16)f2bf(gv); rsq[i] += gv * gv; } }
            LDS_BARRIER();
        }
#pragma unroll
        for (int i = 0; i < 4; ++i) { const float t = sum16(rsq[i]); if (lc == 0) RSQ[cth * 64 + lt * 16 + lr + i] = t; }
        LDS_BARRIER();
#pragma unroll
        for (int i = 0; i < 8; ++i) { const int id = tid + 512 * i, r = id >> 6, ch = id & 63;
            const float scl = rsqrtf((RSQ[r] + RSQ[64 + r]) * (1.f / 512.f) + 1e-6f);
            float v[8]; unpack8(*(const LAS u32x4*)(GB + r * 512 + ch * 8), v);
            const f32x4 n0 = *(const f32x4*)(sng + ch * 8), n1 = *(const f32x4*)(sng + ch * 8 + 4);
#pragma unroll
            for (int k = 0; k < 4; ++k) { v[k] *= scl * n0[k]; v[4 + k] *= scl * n1[k]; }
            *(u32x4*)(MIX + (row0 + r) * D + 256 + ch * 8) = pack8(v); }
    }
}


__device__ __forceinline__ bf16* rw_out(unsigned char* ws, int b, int h, int d, int c, int which) {
    h16* RECS = (h16*)(ws + WS_RECS); h16* RECD = (h16*)(ws + WS_RECD); const size_t p0 = (size_t)c * 64;
    if (d == 0) return (bf16*)(RECS + (((size_t)b * 4 + h) * TB + p0) * 256) + which * 4096;
    return (bf16*)(RECD + ((((size_t)b * 4 + h) * 2 + (which >> 1)) * TB + p0) * 128) + (which & 1) * 4096;
}
__device__ __forceinline__ void phase_rwkv_local(const Frame& F0) {
    PH_ENTER(F0);
    const AS4 Args* KA = kargs();
    const int tid0 = F.tid, wave = F.wave;
#define RL_STEP const int tid = launder_i(tid0); const int lane = tid & 63; const int lr = (lane >> 4) * 4, lc = lane & 15;
    const h16* RECS = (const h16*)(F.ws + WS_RECS); const h16* RECD = (const h16*)(F.ws + WS_RECD);
    float* RPL = (float*)(F.ws + WS_RPL);
    const float* k_a = LP(18, 256);
    constexpr int LDS_S = 264, LDS_D = 136, LDF = 68;
    LAS h16* STS = (LAS h16*)F.lds;
    LAS h16* STD = (LAS h16*)(F.lds + 33792);
    LAS float* AABF = (LAS float*)(F.lds + 33792);
    LAS bf16* ULT = (LAS bf16*)(F.lds + 33792);
    LAS float* TF = (LAS float*)(F.lds + 51200);
    LAS bf16* AVT = (LAS bf16*)(F.lds + 51200); LAS bf16* W0T = (LAS bf16*)(F.lds + 60416);
    LAS bf16* NAT = (LAS bf16*)(F.lds + 69632);
    LAS bf16* TRN = (LAS bf16*)(F.lds + 106496);
    LAS bf16* R0I = (LAS bf16*)(F.lds + 143360);
    LAS float* M1 = (LAS float*)(F.lds + 152576);
    LAS float* GSUM = (LAS float*)(F.lds + 157184);
    h16x8 ps[4], pd[2];
#define RL_LOAD_S(uu) do { const int h_ = (uu) & 3, bc_ = (uu) >> 2, b_ = bc_ / NTILE64, c_ = bc_ % NTILE64; const h16* src = RECS + (((size_t)b_ * 4 + h_) * TB + (size_t)c_ * 64) * 256; \
        _Pragma("unroll") for (int i = 0; i < 4; ++i) { const int id = launder_i(tid0) + 512 * i, r = id >> 5, ch = id & 31; ps[i] = *(const h16x8*)(src + (size_t)r * 256 + ch * 8); } } while (0)
#define RL_LOAD_D(uu, dd) do { const int h_ = (uu) & 3, bc_ = (uu) >> 2, b_ = bc_ / NTILE64, c_ = bc_ % NTILE64; const h16* src = RECD + ((((size_t)b_ * 4 + h_) * 2 + (dd)) * TB + (size_t)c_ * 64) * 128; \
        _Pragma("unroll") for (int i = 0; i < 2; ++i) { const int id = launder_i(tid0) + 512 * i, r = id >> 4, ch = id & 15; pd[i] = *(const h16x8*)(src + (size_t)r * 128 + ch * 8); } } while (0)
    if (F.bid < NUNIT64 * 4) { RL_LOAD_S(F.bid); RL_LOAD_D(F.bid, 0); }
    for (int u = F.bid; u < NUNIT64 * 4; u += F.G) {
        const int h = u & 3, bc = u >> 2, b = bc / NTILE64, c = bc % NTILE64;
        LDS_BARRIER();
        { RL_STEP
#pragma unroll
            for (int i = 0; i < 4; ++i) { const int id = tid + 512 * i, r = id >> 5, ch = id & 31; *(LAS h16x8*)(STS + r * LDS_S + ch * 8) = ps[i]; } }
#pragma unroll 1
        for (int d = 0; d < 2; ++d) {
            LDS_BARRIER();
            { RL_STEP
#pragma unroll
                for (int i = 0; i < 2; ++i) { const int id = tid + 512 * i, r = id >> 4, ch = id & 15; *(LAS h16x8*)(STD + r * LDS_D + ch * 8) = pd[i]; } }
            if (d == 0) RL_LOAD_D(u, 1); else if (u + F.G < NUNIT64 * 4) { RL_LOAD_S(u + F.G); RL_LOAD_D(u + F.G, 0); }
            LDS_BARRIER();
            SUBREP(8) { RL_STEP const int kp = tid & 31, tg = tid >> 5, k = 2 * kp;
                f32x2 wv[4], li[4]; f32x2 run = {1.f, 1.f};
#pragma unroll
                for (int i = 0; i < 4; ++i) { const int t = tg * 4 + i, srow = d ? 63 - t : t; const unsigned raw = *(const LAS unsigned*)(STD + srow * LDS_D + k);
                    const h16 o0 = __builtin_bit_cast(h16, (unsigned short)(raw & 0xffff)), o1 = __builtin_bit_cast(h16, (unsigned short)(raw >> 16));
                    wv[i] = (f32x2){1.f - (float)o0, 1.f - (float)o1}; run = run * wv[i]; li[i] = run; }
                *(LAS f32x2*)(GSUM + tg * 64 + k) = run;
                for (int i = tid; i < 64 * LDF; i += 512) TF[i] = 0.f;
                LDS_BARRIER();
                f32x2 off = {1.f, 1.f}, pref = {1.f, 1.f}, pend = {1.f, 1.f};
#pragma unroll
                for (int g = 0; g < 16; ++g) { const f32x2 gs = *(const LAS f32x2*)(GSUM + g * 64 + k); if (g < tg) off = off * gs; if (g < 8) pref = pref * gs; pend = pend * gs; }
                const f32x2 kac = *(const f32x2*)(k_a + h * 64 + k);
                const f32x2 ipref = {1.f / pref.x, 1.f / pref.y};
                f32x2 pexcl = off;
                unsigned vt[4], a0t[4], bht[4], kht[4];
#pragma unroll
                for (int i = 0; i < 4; ++i) { const int t = tg * 4 + i, srow = d ? 63 - t : t;
                    const f32x2 pin = off * li[i];
                    const unsigned rr = *(const LAS unsigned*)(STS + srow * LDS_S + k), vr = *(const LAS unsigned*)(STS + srow * LDS_S + 64 + k), kkr = *(const LAS unsigned*)(STS + srow * LDS_S + 128 + k), kxr = *(const LAS unsigned*)(STS + srow * LDS_S + 192 + k);
                    const unsigned ar_ = *(const LAS unsigned*)(STD + srow * LDS_D + 64 + k);
#define H2F(x, hi) ((float)__builtin_bit_cast(h16, (unsigned short)((hi) ? ((x) >> 16) : ((x) & 0xffff))))
                    const f32x2 r = {H2F(rr, 0), H2F(rr, 1)}, vv = {H2F(vr, 0), H2F(vr, 1)}, kk = {H2F(kkr, 0), H2F(kkr, 1)}, kx = {H2F(kxr, 0), H2F(kxr, 1)}, av = {H2F(ar_, 0), H2F(ar_, 1)};
#undef H2F
                    const f32x2 kmod = kx * ((av - 1.f) * kac + 1.f), bb = kk * av;
                    const f32x2 ipin = {1.f / pin.x, 1.f / pin.y};
                    const f32x2 e1 = pexcl * ipref, e2 = pin * ipref, e3 = pref * ipin, eL = pend * ipin;
                    const f32x2 at = -kk * e1, rt = r * e2, bt = bb * e3, kt = kmod * e3, r0 = r * pin, a0 = -kk * pexcl, bh = bb * eL, kh = kmod * eL;
                    *(LAS unsigned*)(NAT + (0 * 64 + t) * LD64 + k) = pk2(at.x, at.y); *(LAS unsigned*)(NAT + (1 * 64 + t) * LD64 + k) = pk2(rt.x, rt.y);
                    *(LAS unsigned*)(NAT + (2 * 64 + t) * LD64 + k) = pk2(bt.x, bt.y); *(LAS unsigned*)(NAT + (3 * 64 + t) * LD64 + k) = pk2(kt.x, kt.y);
                    *(LAS unsigned*)(R0I + t * LD64 + k) = pk2(r0.x, r0.y);
                    vt[i] = pk2(vv.x, vv.y); a0t[i] = pk2(a0.x, a0.y); bht[i] = pk2(bh.x, bh.y); kht[i] = pk2(kh.x, kh.y);
                    pexcl = pin; }
#define TR_WR(SLOT, ARR) do { u32x2 lo, hi; lo.x = (ARR[0] & 0xffffu) | (ARR[1] << 16); lo.y = (ARR[2] & 0xffffu) | (ARR[3] << 16); hi.x = (ARR[0] >> 16) | (ARR[1] & 0xffff0000u); hi.y = (ARR[2] >> 16) | (ARR[3] & 0xffff0000u); \
                    *(LAS u32x2*)(TRN + ((SLOT) * 64 + k) * LD64 + tg * 4) = lo; *(LAS u32x2*)(TRN + ((SLOT) * 64 + k + 1) * LD64 + tg * 4) = hi; } while (0)
                TR_WR(0, vt); TR_WR(1, a0t); TR_WR(2, bht); TR_WR(3, kht);
#undef TR_WR
                if (tg == 15) *(f32x2*)(RPL + (((((size_t)b * 4 + h) * 2 + d) * NTILE64) + c) * 64 + k) = pend; }
            LDS_BARRIER();
            { RL_STEP const int pr = wave >> 1, rh = wave & 1; f32x4 acc[2][4];
#pragma unroll
                for (int mi = 0; mi < 2; ++mi)
#pragma unroll
                    for (int nt = 0; nt < 4; ++nt) { f32x4 a4 = {0.f, 0.f, 0.f, 0.f};
#pragma unroll
                        for (int ks = 0; ks < 2; ++ks) a4 = mma16(a4, NAT + ((pr >> 1) * 64 + (2 * rh + mi) * 16) * LD64 + ks * 32, LD64, NAT + ((2 + (pr & 1)) * 64 + nt * 16) * LD64 + ks * 32, LD64, lane);
                        acc[mi][nt] = a4; }
                LDS_BARRIER();
#pragma unroll
                for (int mi = 0; mi < 2; ++mi)
#pragma unroll
                    for (int nt = 0; nt < 4; ++nt)
#pragma unroll
                        for (int i = 0; i < 4; ++i) { const int t = (2 * rh + mi) * 16 + lr + i, ii = nt * 16 + lc;
                            const float v = (pr < 2 ? ii < t : ii <= t) ? acc[mi][nt][i] : 0.f;
                            if (pr == 0) AABF[t * LDF + ii] = v; else NAT[((pr - 1) * 64 + t) * LD64 + ii] = (bf16)f2bf(v); } }
            LDS_BARRIER();
            SUBREP(9) if (wave == 0) { RL_STEP const int blk = lane >> 4, j = lane & 15; float Tr[16]; const LAS float* ab = AABF + (blk * 16) * LDF + blk * 16;
#pragma unroll
                for (int t = 0; t < 16; ++t) { float a0 = (j == t) ? 1.f : 0.f, a1 = 0.f;
#pragma unroll
                    for (int i4 = 0; i4 < t; i4 += 4) { const f32x4 av = *(const LAS f32x4*)(ab + t * LDF + i4);
                        a0 += av.x * Tr[i4]; if (i4 + 1 < t) a1 += av.y * Tr[i4 + 1]; if (i4 + 2 < t) a0 += av.z * Tr[i4 + 2]; if (i4 + 3 < t) a1 += av.w * Tr[i4 + 3]; }
                    Tr[t] = a0 + a1; TF[(blk * 16 + t) * LDF + blk * 16 + j] = Tr[t]; } }
            LDS_BARRIER();
            SUBREP(10) {
#define RL_LEVEL(M, ACTIVE, PP, TT, J0) do { \
                { RL_STEP if (ACTIVE) { const int pp = (PP), t = (TT), j0 = (J0), rb = pp * 2 * (M) + (M), cb = pp * 2 * (M); f32x2 mm = {0.f, 0.f}; \
                    _Pragma("unroll") for (int i = 0; i < (M); i += 4) { const f32x4 av = *(const LAS f32x4*)(AABF + (rb + t) * LDF + cb + i); \
                        mm += av.x * *(const LAS f32x2*)(TF + (cb + i) * LDF + cb + j0) + av.y * *(const LAS f32x2*)(TF + (cb + i + 1) * LDF + cb + j0) + av.z * *(const LAS f32x2*)(TF + (cb + i + 2) * LDF + cb + j0) + av.w * *(const LAS f32x2*)(TF + (cb + i + 3) * LDF + cb + j0); } \
                    *(LAS f32x2*)(M1 + pp * 576 + t * 36 + j0) = mm; } } \
                LDS_BARRIER(); \
                { RL_STEP if (ACTIVE) { const int pp = (PP), t = (TT), j0 = (J0), rb = pp * 2 * (M) + (M), cb = pp * 2 * (M); f32x2 xx = {0.f, 0.f}; \
                    _Pragma("unroll") for (int q = 0; q < (M); q += 4) { const f32x4 tv = *(const LAS f32x4*)(TF + (rb + t) * LDF + rb + q); \
                        xx += tv.x * *(const LAS f32x2*)(M1 + pp * 576 + q * 36 + j0) + tv.y * *(const LAS f32x2*)(M1 + pp * 576 + (q + 1) * 36 + j0) + tv.z * *(const LAS f32x2*)(M1 + pp * 576 + (q + 2) * 36 + j0) + tv.w * *(const LAS f32x2*)(M1 + pp * 576 + (q + 3) * 36 + j0); } \
                    *(LAS f32x2*)(TF + (rb + t) * LDF + cb + j0) = xx; } } \
                LDS_BARRIER(); } while (0)
                RL_LEVEL(16, tid < 256, tid >> 7, (tid >> 3) & 15, (tid & 7) * 2);
                RL_LEVEL(32, true, 0, tid >> 4, (tid & 15) * 2);
#undef RL_LEVEL
            }
            { RL_STEP const int t = tid >> 3, i0 = (tid & 7) * 8; float v[8];
#pragma unroll
                for (int i = 0; i < 8; ++i) v[i] = TF[t * LDF + i0 + i];
                *(LAS u32x4*)(NAT + (3 * 64 + t) * LD64 + i0) = pack8(v); }
            LDS_BARRIER();
            SUBREP(11) { RL_STEP const int pr = wave >> 2, mt = wave & 3; f32x4 acc[4];
#pragma unroll
                for (int nt = 0; nt < 4; ++nt) { f32x4 a4 = {0.f, 0.f, 0.f, 0.f};
#pragma unroll
                    for (int ks = 0; ks < 2; ++ks) a4 = mma16(a4, TRN + (pr * 64 + mt * 16) * LD64 + ks * 32, LD64, NAT + ((pr ? 3 : 0) * 64 + nt * 16) * LD64 + ks * 32, LD64, lane);
                    acc[nt] = a4; }
                LAS bf16* dst = pr ? W0T : AVT;
#pragma unroll
                for (int nt = 0; nt < 4; ++nt)
#pragma unroll
                    for (int i = 0; i < 4; ++i) dst[(mt * 16 + lr + i) * LD64 + nt * 16 + lc] = (bf16)f2bf(acc[nt][i]); }
            LDS_BARRIER();
            SUBREP(11) { RL_STEP const int mt = wave & 3, nh = wave >> 2;
#pragma unroll
                for (int nn = 0; nn < 2; ++nn) { const int nt = 2 * nh + nn; f32x4 a4 = {0.f, 0.f, 0.f, 0.f};
#pragma unroll
                    for (int ks = 0; ks < 2; ++ks) a4 = mma16(a4, AVT + (mt * 16) * LD64 + ks * 32, LD64, NAT + (3 * 64 + nt * 16) * LD64 + ks * 32, LD64, lane);
#pragma unroll
                    for (int i = 0; i < 4; ++i) ULT[(mt * 16 + lr + i) * LD64 + nt * 16 + lc] = (bf16)f2bf(a4[i]); } }
            LDS_BARRIER();
            { RL_STEP const int o = wave >> 1, rh = wave & 1;
                const LAS bf16* A1 = o == 0 ? TRN + 2 * 64 * LD64 : (o == 1 ? ULT : NAT + 1 * 64 * LD64);
                const LAS bf16* B1 = o == 0 ? W0T : (o == 1 ? TRN + 2 * 64 * LD64 : (o == 2 ? W0T : ULT));
                const LAS bf16* A2 = o == 1 ? TRN : NAT + 2 * 64 * LD64;
                const LAS bf16* B2 = o == 1 ? TRN + 3 * 64 * LD64 : TRN;
                f32x4 res[2][4];
#pragma unroll
                for (int mi = 0; mi < 2; ++mi)
#pragma unroll
                    for (int nt = 0; nt < 4; ++nt) { const int mt = 2 * rh + mi; f32x4 a4 = {0.f, 0.f, 0.f, 0.f};
#pragma unroll
                        for (int ks = 0; ks < 2; ++ks) { a4 = mma16(a4, A1 + (mt * 16) * LD64 + ks * 32, LD64, B1 + (nt * 16) * LD64 + ks * 32, LD64, lane);
                            if (o == 1 || o == 3) a4 = mma16(a4, A2 + (mt * 16) * LD64 + ks * 32, LD64, B2 + (nt * 16) * LD64 + ks * 32, LD64, lane); }
#pragma unroll
                        for (int i = 0; i < 4; ++i) { const int rr = mt * 16 + lr + i, cc = nt * 16 + lc; if (o == 2) a4[i] += bf2f(R0I[rr * LD64 + cc]); }
                        res[mi][nt] = a4; }
                LDS_BARRIER();
#pragma unroll
                for (int mi = 0; mi < 2; ++mi)
#pragma unroll
                    for (int nt = 0; nt < 4; ++nt)
#pragma unroll
                        for (int i = 0; i < 4; ++i) NAT[o * 4096 + ((2 * rh + mi) * 16 + lr + i) * 64 + nt * 16 + lc] = (bf16)f2bf(res[mi][nt][i]);
                LDS_BARRIER();
#pragma unroll
                for (int i = 0; i < 4; ++i) { const int id = tid + 512 * i, oo = id >> 9, ch = id & 511; *(u32x4*)(rw_out(F.ws, b, h, d, c, oo) + ch * 8) = *(const LAS u32x4*)(NAT + oo * 4096 + ch * 8); } }
        }
    }
#undef RL_STEP
#undef RL_LOAD_S
#undef RL_LOAD_D
}
__device__ __forceinline__ void phase_rwkv_combine(const Frame& F0) {
    PH_ENTER(F0);
    const int lane = F.lane;
    if (F.wave != 0 || F.bid >= 256) return;
    const int chain = F.bid >> 2, q = F.bid & 3, d = chain & 1, bh = chain >> 1, b = bh >> 2, h = bh & 3;
    LAS bf16* SA = (LAS bf16*)F.lds;
    const float* RPL = (const float*)(F.ws + WS_RPL) + (size_t)chain * NTILE64 * 64;
    const int lr = (lane >> 4) * 4, lc = lane & 15, ar = lane & 15, akq = (lane >> 4) * 8;
    f32x4 S[4];
#pragma unroll
    for (int nt = 0; nt < 4; ++nt) S[nt] = (f32x4){0.f, 0.f, 0.f, 0.f};
    bf16x8 bfr[4][4][2]; unsigned short psi[4][4][4]; float pl[4][4];
#define RWC_CIDX(k) (d == 0 ? (k) : ((k) < 4 ? 3 - (k) : 131 - ((k) - 4)))
#define RWC_PRE(SET, k) do { const int c_ = RWC_CIDX(k); const bf16* phit = rw_out(F.ws, b, h, d, c_, 0); const bf16* psip = rw_out(F.ws, b, h, d, c_, 1) + (size_t)q * 16 * 64; \
        _Pragma("unroll") for (int nt = 0; nt < 4; ++nt) { \
            _Pragma("unroll") for (int ks = 0; ks < 2; ++ks) bfr[SET][nt][ks] = *(const bf16x8*)(phit + (nt * 16 + ar) * 64 + ks * 32 + akq); \
            _Pragma("unroll") for (int i = 0; i < 4; ++i) psi[SET][nt][i] = psip[(lr + i) * 64 + nt * 16 + lc]; \
            pl[SET][nt] = RPL[(size_t)c_ * 64 + nt * 16 + lc]; } } while (0)
    RWC_PRE(0, 0); RWC_PRE(1, 1); RWC_PRE(2, 2);
#pragma unroll 1
    for (int k4 = 0; k4 < NTILE64; k4 += 4) {
#pragma unroll
        for (int j = 0; j < 4; ++j) {
            const int k = k4 + j, c = RWC_CIDX(k);
            f32x4 init[4];
#pragma unroll
            for (int nt = 0; nt < 4; ++nt)
#pragma unroll
                for (int i = 0; i < 4; ++i) { init[nt][i] = S[nt][i] * pl[j][nt] + bf2f(psi[j][nt][i]); SA[(lr + i) * LD64 + nt * 16 + lc] = (bf16)f2bf(S[nt][i]); }
            asm volatile("" : "+v"(init[0]), "+v"(init[1]), "+v"(init[2]), "+v"(init[3]) :: "memory");
            if (k + 3 < NTILE64) RWC_PRE((j + 3) & 3, k + 3);
            LDS_WAIT();
            const bf16x8 a0 = *(const LAS bf16x8*)(SA + ar * LD64 + akq), a1 = *(const LAS bf16x8*)(SA + ar * LD64 + 32 + akq);
            { bf16* s0p = rw_out(F.ws, b, h, d, c, 1) + (size_t)q * 16 * 64;
#pragma unroll
                for (int i = 0; i < 2; ++i) { const int id = lane + 64 * i, r = id >> 3, ch = id & 7; *(u32x4*)(s0p + r * 64 + ch * 8) = *(const LAS u32x4*)(SA + r * LD64 + ch * 8); } }
#pragma unroll
            for (int nt = 0; nt < 4; ++nt) { f32x4 a4 = init[nt];
                a4 = __builtin_amdgcn_mfma_f32_16x16x32_bf16(a0, bfr[j][nt][0], a4, 0, 0, 0); a4 = __builtin_amdgcn_mfma_f32_16x16x32_bf16(a1, bfr[j][nt][1], a4, 0, 0, 0); S[nt] = a4; }
            LDS_WAIT();
        }
    }
#undef RWC_PRE
#undef RWC_CIDX
}
__device__ __forceinline__ void phase_combine_side(const Frame& F0) {
    PH_ENTER(F0);
    if (F.wave < 4 || F.G != 256) return;
    const int lgid = F.bid * 256 + (F.tid - 256);
    const int sch = lgid >> 9, sd = sch & 1, sbh = sch >> 1; bf16* SSp = (bf16*)(F.ws + WS_SS) + (size_t)sch * NTILE64 * 4096 + (lgid & 511) * 8;
    const float* SDp = (const float*)(F.ws + WS_SDEC) + (size_t)(sbh >> 3) * NTILE64 * 16 + (sbh & 7) * 2 + sd;
    const int gch = lgid >> 10, gd = gch & 1, gbh = gch >> 1, ge0 = (lgid & 1023) * 2; bf16* GSp = (bf16*)(F.ws + WS_GS) + (size_t)gch * NTILE64 * 2048 + ge0;
    const float* GDp = (const float*)(F.ws + WS_GDEC) + (size_t)(gbh >> 2) * NTILE64 * 256 + gd * 128 + (gbh & 3) * 32 + (ge0 & 31);
    float cS[8] = {0.f, 0.f, 0.f, 0.f, 0.f, 0.f, 0.f, 0.f}, cG0 = 0.f, cG1 = 0.f;
    u32x4 pS[4]; float pSd[4]; unsigned pG[4]; f32x2 pGd[4];
#define CS_CIDX(k, dd) ((dd) == 0 ? (k) : ((k) < 4 ? 3 - (k) : 131 - ((k) - 4)))
#define CS_LOAD(SET, k) do { const int cs_ = CS_CIDX(k, sd), cg_ = CS_CIDX(k, gd); pS[SET] = *(const u32x4*)(SSp + (size_t)cs_ * 4096); pSd[SET] = SDp[cs_ * 16]; \
        pG[SET] = *(const unsigned*)(GSp + (size_t)cg_ * 2048); pGd[SET] = *(const f32x2*)(GDp + (size_t)cg_ * 256); } while (0)
    CS_LOAD(0, 0); CS_LOAD(1, 1); CS_LOAD(2, 2);
#pragma unroll 1
    for (int k4 = 0; k4 < NTILE64; k4 += 4) {
#pragma unroll
        for (int j = 0; j < 4; ++j) { const int k = k4 + j, cs = CS_CIDX(k, sd), cg = CS_CIDX(k, gd);
            float f[8]; unpack8(pS[j], f); const float dec = pSd[j]; const unsigned gt = pG[j]; const f32x2 gdec = pGd[j];
            asm volatile("" : "+v"(f[0]), "+v"(f[7]) : "v"(dec), "v"(gt), "v"(gdec.x), "v"(gdec.y) : "memory");
            if (k + 3 < NTILE64) CS_LOAD((j + 3) & 3, k + 3);
            u32x4 o; o.x = pk2(cS[0], cS[1]); o.y = pk2(cS[2], cS[3]); o.z = pk2(cS[4], cS[5]); o.w = pk2(cS[6], cS[7]); *(u32x4*)(SSp + (size_t)cs * 4096) = o;
#pragma unroll
            for (int i = 0; i < 8; ++i) cS[i] = cS[i] * dec + f[i];
            *(unsigned*)(GSp + (size_t)cg * 2048) = pk2(cG0, cG1);
            cG0 = cG0 * gdec.x + __uint_as_float(gt << 16); cG1 = cG1 * gdec.y + __uint_as_float(gt & 0xffff0000u); }
    }
#undef CS_LOAD
#undef CS_CIDX
}
__device__ __forceinline__ void phase_finish_rwkv(const Frame& F0) {
    PH_ENTER(F0);
    const AS4 Args* KA = kargs();
    const int lane = F.lane, wave = F.wave;
    const h16* BONUS = (const h16*)(F.ws + WS_BONUS); const h16* GATE = (const h16*)(F.ws + WS_GATE);
    bf16* YO = (bf16*)(F.ws + WS_YRW);
    const float* gng = LP(20, 256); const float* gnb = LP(21, 256);
    const int h = wave >> 1, rh = wave & 1, lr = (lane >> 4) * 4, lc = lane & 15, ar = lane & 15, akq = (lane >> 4) * 8;
    const bool skipctx = F.l == 1;
    for (int j_ = F.bid; j_ < n_units(skipctx); j_ += F.G) {
        const int u = unit_of(skipctx, j_);
        const int b = u / NTILE64, c = u % NTILE64; const size_t row0 = (size_t)b * TB + (size_t)c * 64;
        f32x4 acc[2][4];
#pragma unroll
        for (int mi = 0; mi < 2; ++mi)
#pragma unroll
            for (int nt = 0; nt < 4; ++nt) acc[mi][nt] = (f32x4){0.f, 0.f, 0.f, 0.f};
#pragma unroll
        for (int d = 0; d < 2; ++d) { const bf16* om = rw_out(F.ws, b, h, d, c, 2); const bf16* s0 = rw_out(F.ws, b, h, d, c, 1); const bf16* yl = rw_out(F.ws, b, h, d, c, 3);
#pragma unroll
            for (int mi = 0; mi < 2; ++mi) { const int srow = (2 * rh + mi) * 16 + ar, trow = d ? 63 - srow : srow;
                const bf16x8 a0 = *(const bf16x8*)(om + trow * 64 + akq), a1 = *(const bf16x8*)(om + trow * 64 + 32 + akq);
#pragma unroll
                for (int nt = 0; nt < 4; ++nt) { const bf16x8 b0 = *(const bf16x8*)(s0 + (nt * 16 + ar) * 64 + akq), b1 = *(const bf16x8*)(s0 + (nt * 16 + ar) * 64 + 32 + akq);
                    f32x4 a4 = acc[mi][nt];
                    a4 = __builtin_amdgcn_mfma_f32_16x16x32_bf16(a0, b0, a4, 0, 0, 0); a4 = __builtin_amdgcn_mfma_f32_16x16x32_bf16(a1, b1, a4, 0, 0, 0);
#pragma unroll
                    for (int i = 0; i < 4; ++i) { const int s = (2 * rh + mi) * 16 + lr + i, t = d ? 63 - s : s; a4[i] += bf2f(yl[t * 64 + nt * 16 + lc]); }
                    acc[mi][nt] = a4; } } }
#pragma unroll
        for (int mi = 0; mi < 2; ++mi)
#pragma unroll
            for (int i = 0; i < 4; ++i) { const int s = (2 * rh + mi) * 16 + lr + i; const size_t r = row0 + s;
                float y0 = acc[mi][0][i], y1 = acc[mi][1][i], y2 = acc[mi][2][i], y3 = acc[mi][3][i];
                const float mu = sum16((y0 + y1) + (y2 + y3)) * (1.f / 64.f);
                y0 -= mu; y1 -= mu; y2 -= mu; y3 -= mu;
                const float rs = rsqrtf(sum16((y0 * y0 + y1 * y1) + (y2 * y2 + y3 * y3)) * (1.f / 64.f) + 64e-5f);
                const float yy[4] = {y0, y1, y2, y3};
#pragma unroll
                for (int nt = 0; nt < 4; ++nt) { const int cc = h * 64 + nt * 16 + lc;
                    const float o = (yy[nt] * rs * gng[cc] + gnb[cc] + (float)BONUS[r * 256 + cc]) * (float)GATE[r * 256 + cc];
                    YO[r * 256 + cc] = (bf16)f2bf(o); } }
    }
}
__device__ __forceinline__ void phase_copy_yrw(const Frame& F0) {
    PH_ENTER(F0);
    const bf16* YO = (const bf16*)(F.ws + WS_YRW); bf16* MIX = (bf16*)(F.ws + WS_ACT);
    const bool skipctx = F.l == 1; const int NR = skipctx ? NB * TL : T;
    for (int i = F.bid * 512 + F.tid; i < NR * 32; i += F.G * 512) { const int row_ = i >> 5, ch = i & 31; const int row = skipctx ? (row_ / TL) * TB + TC + row_ % TL : row_;
        *(u32x4*)(MIX + (size_t)row * D + ch * 8) = *(const u32x4*)(YO + (size_t)row * 256 + ch * 8); }
}
__device__ __forceinline__ void phase_router(const Frame& F0) {
    PH_ENTER(F0);
    const AS4 Args* KA = kargs();
    const int tid = F.tid, lane = F.lane, wave = F.wave;
    LAS float* RW = (LAS float*)F.lds;
    LAS int* lcnt = (LAS int*)(F.lds + 81920);
    const float* rgw = LP(31, D * 4); const float* rew = LP(33, D * 16); const float* rgb = LP(32, 4); const float* reb = LP(34, 16);
    for (int i = tid; i < 20 * D; i += 512) { const int e = i / D, k = i % D; RW[i] = e < 4 ? rgw[k * 4 + e] : rew[k * 16 + (e - 4)]; }
    if (tid < NCLS) lcnt[tid] = 0;
    LDS_BARRIER();
    const float* g = LP(7, D);
    const float* mod = (const float*)(F.ws + WS_MOD) + (size_t)F.l * 9 * 6144;
    bf16* TOK = (bf16*)(F.ws + WS_ACT);
    int4* TI = (int4*)(F.ws + WS_TOKINFO);
    int* CNT = (int*)(F.ws + WS_CNT);
    const bool skipctx = F.l == 1;
    if (skipctx && F.bid < 32 && tid < NCLS) CNT[((F.bid >> 2) * NTILE64 + (F.bid & 3)) * NCLS + tid] = 0;
    for (int j_ = F.bid; j_ < n_units(skipctx); j_ += F.G) {
        const int u = unit_of(skipctx, j_);
        f32x4 A[4], B[4], nv[4];
        { const float* mrow = mod + (size_t)mod_index(u * 64) * 6144;
#pragma unroll
            for (int j = 0; j < 4; ++j) { const int c = 4 * lane + 256 * j; A[j] = *(const f32x4*)(g + c) * (*(const f32x4*)(mrow + 4 * D + c) + 1.f); B[j] = *(const f32x4*)(mrow + 3 * D + c); }
            const f32x4* xr = (const f32x4*)xcur_row(F, u * 64 + wave * 8) + lane;
#pragma unroll
            for (int j = 0; j < 4; ++j) nv[j] = xr[64 * j]; }
        for (int rr = 0; rr < 8; ++rr) {
            const int row = u * 64 + wave * 8 + rr;
            f32x4 v[4]; float s = 0.f;
#pragma unroll
            for (int j = 0; j < 4; ++j) { v[j] = nv[j]; s += (v[j].x * v[j].x + v[j].y * v[j].y) + (v[j].z * v[j].z + v[j].w * v[j].w); }
            if (rr + 1 < 8) { const f32x4* xn = (const f32x4*)xcur_row(F, row + 1) + lane;
#pragma unroll
                for (int j = 0; j < 4; ++j) nv[j] = xn[64 * j]; }
            const float rs = rsqrtf(wave_sum(s) * (1.f / D) + 1e-6f);
            u32x2* o8 = (u32x2*)(TOK + (size_t)row * D) + lane;
#pragma unroll
            for (int j = 0; j < 4; ++j) { v[j] = v[j] * rs * A[j] + B[j];
                u32x2 w; w.x = pk2(v[j].x, v[j].y); w.y = pk2(v[j].z, v[j].w); o8[64 * j] = w; }
            float lg[20];
#pragma unroll
            for (int e = 0; e < 20; ++e) { float a = 0.f;
#pragma unroll
                for (int j = 0; j < 4; ++j) { const f32x4 w = *(const LAS f32x4*)(RW + e * D + 4 * lane + 256 * j); a += (v[j].x * w.x + v[j].y * w.y) + (v[j].z * w.z + v[j].w * w.w); }
                lg[e] = wave_sum(a); }
            float gl0 = lg[0] + rgb[0], gl1 = lg[1] + rgb[1], gl2 = lg[2] + rgb[2], gl3 = lg[3] + rgb[3];
            int gs = 0; float gm = gl0;
            if (gl1 > gm) { gm = gl1; gs = 1; } if (gl2 > gm) { gm = gl2; gs = 2; } if (gl3 > gm) { gm = gl3; gs = 3; }
            const float pg = 1.f / (__expf(gl0 - gm) + __expf(gl1 - gm) + __expf(gl2 - gm) + __expf(gl3 - gm));
            float e0, e1, e2, e3;
            e0 = gs == 0 ? lg[4] : (gs == 1 ? lg[8] : (gs == 2 ? lg[12] : lg[16])); e1 = gs == 0 ? lg[5] : (gs == 1 ? lg[9] : (gs == 2 ? lg[13] : lg[17]));
            e2 = gs == 0 ? lg[6] : (gs == 1 ? lg[10] : (gs == 2 ? lg[14] : lg[18])); e3 = gs == 0 ? lg[7] : (gs == 1 ? lg[11] : (gs == 2 ? lg[15] : lg[19]));
            e0 += reb[gs * 4 + 0]; e1 += reb[gs * 4 + 1]; e2 += reb[gs * 4 + 2]; e3 += reb[gs * 4 + 3];
            int i1 = 0; float m1 = e0;
            if (e1 > m1) { m1 = e1; i1 = 1; } if (e2 > m1) { m1 = e2; i1 = 2; } if (e3 > m1) { m1 = e3; i1 = 3; }
            int i2 = -1; float m2 = -3.0e38f;
            if (i1 != 0 && e0 > m2) { m2 = e0; i2 = 0; } if (i1 != 1 && e1 > m2) { m2 = e1; i2 = 1; } if (i1 != 2 && e2 > m2) { m2 = e2; i2 = 2; } if (i1 != 3 && e3 > m2) { m2 = e3; i2 = 3; }
            const float p1 = 1.f, p2 = __expf(m2 - m1);
            const float w1 = pg * p1 / (p1 + p2), w2 = pg * p2 / (p1 + p2);
            const int lo = i1 < i2 ? i1 : i2, hi = i1 < i2 ? i2 : i1;
            const int pr = lo == 0 ? hi - 1 : (lo == 1 ? hi + 1 : 5);
            const int cls = gs * 6 + pr;
            const float wa = i1 < i2 ? w1 : w2, wb = i1 < i2 ? w2 : w1;
            if (lane == 0) { const int rank = atomicAdd((int*)(lcnt + cls), 1);
                TI[row] = make_int4(cls, __float_as_int(wa), __float_as_int(wb), rank); }
        }
        LDS_BARRIER();
        if (tid < NCLS) { CNT[u * NCLS + tid] = lcnt[tid]; lcnt[tid] = 0; }
        LDS_BARRIER();
    }
}

__device__ __forceinline__ void phase_scatter(const Frame& F0) {
    PH_ENTER(F0);
    const int tid = F.tid, lane = F.lane, wave = F.wave;
    LAS int* C = (LAS int*)F.lds;
    LAS int* tot = (LAS int*)(F.lds + 102400);
    LAS int* cs = (LAS int*)(F.lds + 102400 + 128);
    LAS int* base = (LAS int*)(F.lds + 102400 + 256);
    const int* CNT = (const int*)(F.ws + WS_CNT);
    int* MI = (int*)(F.ws + WS_CNT) + NUNIT64 * NCLS;
    for (int i = tid; i < NUNIT64 * NCLS; i += 512) C[i] = CNT[i];
    LDS_BARRIER();
    if (tid < NCLS * 16) { const int c = tid >> 4, s16 = tid & 15; int part = 0; for (int uu = s16; uu < NUNIT64; uu += 16) part += C[uu * NCLS + c];
        const float pf = sum16((float)part); if (s16 == 0) tot[c] = (int)pf; }
    LDS_BARRIER();
    if (tid == 0) { int s = 0; for (int c = 0; c < NCLS; ++c) { cs[c] = s; s += (tot[c] + 255) & ~255; } cs[NCLS] = s; }
    LDS_BARRIER();
    if (F.bid == 0 && tid <= NCLS) MI[tid] = cs[tid];
    const int4* TI = (const int4*)(F.ws + WS_TOKINFO);
    int* LIST = (int*)(F.ws + WS_LIST); f32x2* WSL = (f32x2*)(F.ws + WS_WSLOT);
    for (int c = F.bid; c < NCLS; c += F.G) {
        const int s0 = cs[c] + tot[c], s1 = cs[c + 1];
        for (int s = s0 + tid; s < s1; s += 512) { LIST[s] = -1; WSL[s] = (f32x2){0.f, 0.f}; }
    }
    const bool skipctx = F.l == 1;
    for (int j_ = F.bid; j_ < n_units(skipctx); j_ += F.G) {
        const int u = unit_of(skipctx, j_);
        LDS_BARRIER();
        if (tid < NCLS * 16) { const int c = tid >> 4, s = tid & 15; int part = 0; for (int uu = s; uu < u; uu += 16) part += C[uu * NCLS + c];
            float pf = sum16((float)part);
            if (s == 0) base[c] = cs[c] + (int)pf; }
        LDS_BARRIER();
        {
#pragma unroll
            for (int rr = 0; rr < 8; ++rr) { const int row = u * 64 + wave * 8 + rr;
                if (lane == 0) { const int4 ti = TI[row]; const int slot = base[ti.x] + ti.w; LIST[slot] = row; WSL[slot] = (f32x2){__int_as_float(ti.y), __int_as_float(ti.z)}; } } }
    }
}

__device__ __forceinline__ void phase_final(const Frame& F0) {
    PH_ENTER(F0);
    const AS4 Args* KA = kargs();
    const int gw = F.bid * 8 + F.wave, NGW = F.G * 8, lane = F.lane;
    const float* g = INP(38);
    constexpr int NR = NB * TL; const int R = (NR + NGW - 1) / NGW, r0 = gw * R, r1 = min(NR, r0 + R);
    f32x4 G4[4], nv[4];
#pragma unroll
    for (int j = 0; j < 4; ++j) G4[j] = *(const f32x4*)(g + 4 * lane + 256 * j);
    if (r0 < r1) { const f32x4* xr = (const f32x4*)(F.out + (size_t)r0 * D) + lane;
#pragma unroll
        for (int j = 0; j < 4; ++j) nv[j] = xr[64 * j]; }
    for (int row = r0; row < r1; ++row) {
        f32x4 v[4];
#pragma unroll
        for (int j = 0; j < 4; ++j) v[j] = nv[j];
        if (row + 1 < r1) { const f32x4* xn = (const f32x4*)(F.out + (size_t)(row + 1) * D) + lane;
#pragma unroll
            for (int j = 0; j < 4; ++j) nv[j] = xn[64 * j]; }
        float s = 0.f;
#pragma unroll
        for (int j = 0; j < 4; ++j) s += (v[j].x * v[j].x + v[j].y * v[j].y) + (v[j].z * v[j].z + v[j].w * v[j].w);
        const float rs = rsqrtf(wave_sum(s) * (1.f / D) + 1e-6f);
        f32x4* xr = (f32x4*)(F.out + (size_t)row * D) + lane;
#pragma unroll
        for (int j = 0; j < 4; ++j) xr[64 * j] = v[j] * rs * G4[j];
    }
}

constexpr int PH_PER_LAYER = 12, PH_FINAL = 1 + 2 * PH_PER_LAYER, PH_END = PH_FINAL + 1;
template <int L> __device__ __forceinline__ void run_layer(Frame& F0, const XcdBarrier& bar, const int lo, const int hi) {
    constexpr int l = L;
#define IN(k) (lo <= (k) && (k) < hi)
#define SEAM(k) do { if (IN(k) && IN((k) + 1)) { XcdBarrier bb = bar; GAS unsigned* _b = (GAS unsigned*)bb.bar; asm volatile("" : "+s"(_b)); bb.bar = (unsigned*)_b; xcd_barrier(bb); } } while (0)
        F0.l = l;
        const int pb = 1 + PH_PER_LAYER * l;
        if (HAS(1) && IN(pb + 1)) { for (int rep = 0; rep < REP(1); ++rep) phase_norm1(F0); if (l == 1 && HAS(0)) phase_convert(F0); } SEAM(pb + 1);
        if (HAS(2) && IN(pb + 2)) {
            PH_ENTER(F0);
            SchedStatic S; S.nM = T / 256; S.nN = IN_PAD / 256; S.nwg = S.nM * S.nN; S.G = F.G; S.c = F.bid; S.ws = F.ws; S.offA = WS_ACT; S.offB = WS_WIN; S.skipctx = 0;
            EpiU E{F.ws};
            for (int rep = 0; rep < REP(2); ++rep) pg8::gemm_phase<EpiU, SchedStatic, true, false, 1024>(F.lds, F.tid, S, E);
        } SEAM(pb + 2);
        if (HAS(3) && IN(pb + 3)) { phase_conv(F0); for (int rep = 0; rep < REP(3); ++rep) phase_prep(F0); } SEAM(pb + 3);
#define GBAR() do { if (hi - lo > 1) { XcdBarrier bb = bar; GAS unsigned* _b = (GAS unsigned*)bb.bar; asm volatile("" : "+s"(_b)); bb.bar = (unsigned*)_b; xcd_barrier(bb); } } while (0)
        if (HAS(4) && IN(pb + 5)) {
            if (MK_PROBE_RW >= 1) { phase_rwkv_local(F0); GBAR(); if (MK_PROBE_RW >= 2) { phase_rwkv_combine(F0); GBAR(); } phase_prep(F0); GBAR(); }
            if (MK_PROBE_RW == 0) { for (int rep = 0; rep < REP(4); ++rep) phase_states(F0); } phase_rwkv_local(F0); if (MK_PROBE_RW) { GBAR(); phase_states(F0); GBAR(); } if (F0.G != 256) { phase_combine_ssd(F0); phase_combine_gla(F0); } GBAR(); phase_rwkv_combine(F0); phase_combine_side(F0); } SEAM(pb + 5);
        if (HAS(6) && IN(pb + 6)) { phase_finish_rwkv(F0); GBAR(); phase_finish_ssd(F0); phase_finish_gla(F0); phase_copy_yrw(F0); } SEAM(pb + 6);
#undef GBAR
        if (HAS(7) && IN(pb + 7)) {
            PH_ENTER(F0);
            const AS4 Args* KA = kargs();
            SchedStatic S; S.skipctx = (F.l == 1); S.nM = S.skipctx ? NB * TL / 256 : T / 256; S.nN = D / 256; S.nwg = S.nM * S.nN; S.G = F.G; S.c = F.bid; S.ws = F.ws; S.offA = WS_ACT; S.offB = WS_WOUT;
            EpiRes E{F.l == 0 ? INP(0) : (const float*)F.out, F.l == 0 ? INP(2) : (const float*)(F.ws + WS_CTX), F.out, F.ws, F.l};
            pg8::gemm_phase<EpiRes, SchedStatic, true, false, 1024>(F.lds, F.tid, S, E);
        } SEAM(pb + 7);
        if (HAS(8) && IN(pb + 8)) { for (int rep = 0; rep < REP(8); ++rep) phase_router(F0); } SEAM(pb + 8);
        if (HAS(9) && IN(pb + 9)) { for (int rep = 0; rep < REP(9); ++rep) phase_scatter(F0); } SEAM(pb + 9);
        if (IN(pb + 10) || IN(pb + 11)) {
            PH_ENTER(F0);
            LAS int* cs = (LAS int*)(F.lds + CSTAB_OFF);
            const int* MI = (const int*)(F.ws + WS_CNT) + NUNIT64 * NCLS;
            __syncthreads();
            if (F.tid <= NCLS) cs[F.tid] = MI[F.tid];
            __syncthreads();
        }
        if (HAS(10) && IN(pb + 10)) {
            PH_ENTER(F0);
            LAS int* cs = (LAS int*)(F.lds + CSTAB_OFF);
            SchedMoE<8> S; S.ntiles = cs[NCLS] / 256; S.G = F.G; S.c = F.bid; S.cs = cs; S.ws = F.ws;
            EpiSwiGLU E{F.ws};
            for (int rep = 0; rep < REP(10); ++rep) pg8::gemm_phase<EpiSwiGLU, SchedMoE<8>, true, false, 1024, true>(F.lds, F.tid, S, E);
        } SEAM(pb + 10);
        if (HAS(11) && IN(pb + 11)) {
            PH_ENTER(F0);
            LAS int* cs = (LAS int*)(F.lds + CSTAB_OFF);
            SchedMoE<4> S; S.ntiles = cs[NCLS] / 256; S.G = F.G; S.c = F.bid; S.cs = cs; S.ws = F.ws;
            EpiScatter E{F.out, F.ws, F.l};
            pg8::gemm_phase<EpiScatter, SchedMoE<4>, true, true, 512>(F.lds, F.tid, S, E);
        } SEAM(pb + 11);
    }
#undef IN
#undef SEAM
__global__ void __launch_bounds__(512, 2) mk_fwd(Args args) {
    extern __shared__ __attribute__((aligned(16))) unsigned char lds_raw[];
    Frame F0;
    F0.lds = (LAS unsigned char*)lds_raw;
    F0.tid = threadIdx.x; F0.lane = F0.tid & 63; F0.wave = __builtin_amdgcn_readfirstlane(F0.tid >> 6);
    F0.G = gridDim.x; F0.bid = blockIdx.x; F0.out = args.out; F0.ws = args.ws; F0.l = 0;
    for (int u = F0.tid; u < (LDS_BYTES - LDSCTL_OFF) / 4; u += 512) ((LAS unsigned*)(F0.lds + LDSCTL_OFF))[u] = 0u;
    __syncthreads();
    const int lo = args.ph_lo, hi = args.ph_hi;
    const bool use_bar = (hi - lo) > 1;
    XcdBarrier bar; bar.bar = (unsigned*)(F0.ws + WS_CTL) + CW_BAR; bar.x = 0; bar.st = nullptr;
    if (use_bar) bar = xcd_barrier_post((unsigned*)(F0.ws + WS_CTL) + CW_BAR, (volatile LAS unsigned*)(F0.lds + MISC_OFF) + 8);
#define IN(k) (lo <= (k) && (k) < hi)
#define SEAM(k) do { if (IN(k) && IN((k) + 1)) { XcdBarrier bb = bar; GAS unsigned* _b = (GAS unsigned*)bb.bar; asm volatile("" : "+s"(_b)); bb.bar = (unsigned*)_b; xcd_barrier(bb); } } while (0)
    if (HAS(12) && IN(0)) { phase_mods(F0); } if (HAS(0) && IN(0)) { F0.l = 0; phase_convert(F0); } SEAM(0);
    run_layer<0>(F0, bar, lo, hi);
    run_layer<1>(F0, bar, lo, hi);
    if (HAS(13) && IN(PH_FINAL)) { phase_final(F0); }
#undef IN
#undef SEAM
}

extern "C" void kernel_launch(void* const* d_in, const int* in_sizes, int n_in, void* d_out, int out_size, void* d_ws, size_t ws_size, hipStream_t stream) {
    static int grid = 0;
    if (grid == 0) {
        if (n_in != 39 || ws_size < WS_END) { fprintf(stderr, "kernel_launch: unexpected n_in %d / ws %zu\n", n_in, ws_size); grid = -1; return; }
        int dev = 0, cus = 0;
        if (hipGetDevice(&dev) != hipSuccess || hipDeviceGetAttribute(&cus, hipDeviceAttributeMultiprocessorCount, dev) != hipSuccess) { grid = -1; return; }
        if (hipFuncSetAttribute((const void*)mk_fwd, hipFuncAttributeMaxDynamicSharedMemorySize, LDS_BYTES) != hipSuccess) { fprintf(stderr, "kernel_launch: hipFuncSetAttribute failed\n"); grid = -1; return; }
        int per_cu = 0;
        (void)hipOccupancyMaxActiveBlocksPerMultiprocessor(&per_cu, (const void*)mk_fwd, 512, LDS_BYTES);
        (void)hipGetLastError();
        grid = cus;
    }
    if (grid < 0) return;
    (void)hipMemsetAsync((char*)d_ws + WS_CTL, 0, CTL_ZERO_BYTES, stream);
    Args a{};
    for (int i = 0; i < 39; ++i) a.in[i] = (const float*)d_in[i];
    a.out = (float*)d_out; a.ws = (unsigned char*)d_ws;
#if MK_ONE_LAUNCH
    a.ph_lo = 0; a.ph_hi = PH_END;
    hipLaunchKernelGGL(mk_fwd, dim3(grid), dim3(512), LDS_BYTES, stream, a);
#else
    for (int ph = 0; ph < PH_END; ++ph) { a.ph_lo = ph; a.ph_hi = ph + 1; hipLaunchKernelGGL(mk_fwd, dim3(grid), dim3(512), LDS_BYTES, stream, a); }
#endif
}
```

```cpp
#include <hip/hip_runtime.h>
#include <cstdio>
#include <cstdint>

#define GAS __attribute__((address_space(1)))
#define LAS __attribute__((address_space(3)))
typedef unsigned short bf16;
typedef short bf16x8 __attribute__((ext_vector_type(8)));
typedef float f32x4 __attribute__((ext_vector_type(4)));
typedef float f32x2 __attribute__((ext_vector_type(2)));
typedef unsigned u32x4 __attribute__((ext_vector_type(4)));
typedef unsigned u32x2 __attribute__((ext_vector_type(2)));
typedef _Float16 h16;
typedef _Float16 h16x8 __attribute__((ext_vector_type(8)));
typedef _Float16 h16x4 __attribute__((ext_vector_type(4)));

#ifndef MK_ONE_LAUNCH
#define MK_ONE_LAUNCH 1
#endif
#ifndef MK_PHMASK
#define MK_PHMASK 0xffffffffu
#endif
#define HAS(k) ((MK_PHMASK >> (k)) & 1u)
#ifndef MK_REP
#define MK_REP 0u
#endif
#define REP(k) (((MK_REP >> (k)) & 1u) ? 2 : 1)
#ifndef MK_SUB
#define MK_SUB 0u
#endif
#ifndef MK_PROBE_RW
#define MK_PROBE_RW 0
#endif
#define SUBREP(k) for (int _r = 0; _r < ((((MK_SUB) >> (k)) & 1u) ? 2 : 1); ++_r)

constexpr int D = 1024, NB = 8, TL = 8192, TC = 256, TB = TL + TC, T = NB * TB;
constexpr int NTILE64 = TB / 64;
constexpr int IN_COLS = 3096, IN_PAD = 3328;
constexpr int NCLS = 24, MAXSLOT = T + NCLS * 256;
constexpr int NUNIT64 = NB * NTILE64;

constexpr size_t MiB = 1u << 20;
constexpr size_t WS_CTL = 0, CTL_ZERO_BYTES = 1 * MiB;
constexpr size_t WS_MOD = 1 * MiB;
constexpr size_t WS_CNT = 2 * MiB;
constexpr size_t WS_TOKINFO = 3 * MiB;
constexpr size_t WS_LIST = 5 * MiB;
constexpr size_t WS_WSLOT = 6 * MiB;
constexpr size_t WS_CTX = 8 * MiB;
constexpr size_t WS_WIN = 16 * MiB;
constexpr size_t WS_WOUT = 23 * MiB;
constexpr size_t WS_W13 = 25 * MiB;
constexpr size_t WS_W2T = 57 * MiB;
constexpr size_t WS_ACT = 74 * MiB;
constexpr size_t WS_REC = 74 * MiB;
constexpr size_t WS_RECS = WS_REC, WS_RECD = WS_REC + (size_t)T * 4 * 256 * 2;
constexpr size_t WS_LOWR = 73 * MiB;
constexpr size_t WS_TOKS = 206 * MiB;
constexpr size_t WS_URW = 371 * MiB;
constexpr size_t WS_SS = 371 * MiB;
constexpr size_t WS_GS = 503 * MiB;
constexpr size_t WS_YRW = 536 * MiB;
constexpr size_t WS_SDEC = 7 * MiB;
constexpr size_t WS_H1 = 371 * MiB;
constexpr size_t WS_UXBC = 503 * MiB;
constexpr size_t WS_UZ = 602 * MiB;
constexpr size_t WS_UGLA = 668 * MiB;
constexpr size_t WS_UMISC = 767 * MiB;
constexpr size_t WS_XBCA = 776 * MiB;
constexpr size_t WS_BONUS = 875 * MiB;
constexpr size_t WS_GATE = 908 * MiB;
constexpr size_t WS_GDEC = 941 * MiB;
constexpr size_t WS_RPL = 943 * MiB;
constexpr size_t WS_END = 946 * MiB;
static_assert(WS_RECD + (size_t)T * 8 * 128 * 2 <= WS_URW, "records fit");
static_assert(WS_SS + (size_t)128 * 132 * 4096 * 2 <= WS_GS && WS_GS + (size_t)64 * 132 * 2048 * 2 <= WS_YRW && WS_YRW + (size_t)2 * T * 256 * 2 <= WS_UZ, "state buffers fit");
static_assert(WS_TOKS + (size_t)MAXSLOT * 1024 * 2 <= WS_H1, "toks fits");
static_assert(WS_H1 + (size_t)MAXSLOT * 1024 * 2 <= WS_UMISC, "h1 fits");

constexpr int CW_BAR = 4096;

constexpr int RING_BYTES = 131072;
constexpr int LDS_BYTES = 163840;
constexpr int LDSCTL_OFF = LDS_BYTES - 2048, MISC_OFF = LDSCTL_OFF + 320, CSTAB_OFF = LDSCTL_OFF + 1024;

#define RLX_AGENT __ATOMIC_RELAXED, __HIP_MEMORY_SCOPE_AGENT
#define LDS_WAIT() asm volatile("s_waitcnt lgkmcnt(0)" ::: "memory")
#define LDS_BARRIER() asm volatile("s_waitcnt lgkmcnt(0)\n\ts_barrier" ::: "memory")
#define VM_WAIT() asm volatile("s_waitcnt vmcnt(0)" ::: "memory")
__device__ __forceinline__ float bf2f(unsigned short h) { return __uint_as_float(((unsigned)h) << 16); }
typedef __bf16 hwbf16x2 __attribute__((ext_vector_type(2)));
__device__ __forceinline__ unsigned pk2(float lo, float hi) { const f32x2 v = {lo, hi}; const hwbf16x2 b = __builtin_convertvector(v, hwbf16x2); return __builtin_bit_cast(unsigned, b); }
__device__ __forceinline__ unsigned f2bf(float f) { return pk2(f, 0.f) & 0xffffu; }
__device__ __forceinline__ float sigm(float x) { return 1.f / (1.f + __expf(-x)); }
__device__ __forceinline__ float siluf(float x) { return x / (1.f + __expf(-x)); }
__device__ __forceinline__ float softplusf_(float x) { return x > 20.f ? x : log1pf(__expf(x)); }
__device__ __forceinline__ void unpack8(u32x4 v, float* o) {
    o[0] = __uint_as_float(v.x << 16); o[1] = __uint_as_float(v.x & 0xffff0000u); o[2] = __uint_as_float(v.y << 16); o[3] = __uint_as_float(v.y & 0xffff0000u);
    o[4] = __uint_as_float(v.z << 16); o[5] = __uint_as_float(v.z & 0xffff0000u); o[6] = __uint_as_float(v.w << 16); o[7] = __uint_as_float(v.w & 0xffff0000u);
}
__device__ __forceinline__ u32x4 pack8(const float* o) { u32x4 v; v.x = pk2(o[0], o[1]); v.y = pk2(o[2], o[3]); v.z = pk2(o[4], o[5]); v.w = pk2(o[6], o[7]); return v; }
__device__ __forceinline__ int launder_i(int v) { asm volatile("" : "+v"(v)); return v; }
template <int CTRL> __device__ __forceinline__ float dpp_mov(float v) { return __int_as_float(__builtin_amdgcn_update_dpp(0, __float_as_int(v), CTRL, 0xf, 0xf, false)); }
__device__ __forceinline__ float sum8(float v) { v += dpp_mov<0xB1>(v); v += dpp_mov<0x4E>(v); v += dpp_mov<0x141>(v); return v; }
__device__ __forceinline__ float sum16(float v) { v = sum8(v); v += dpp_mov<0x140>(v); return v; }
__device__ __forceinline__ float wave_sum(float v) {
    v = sum16(v);
    v += __int_as_float(__builtin_amdgcn_update_dpp(0, __float_as_int(v), 0x142, 0xa, 0xf, false));
    v += __int_as_float(__builtin_amdgcn_update_dpp(0, __float_as_int(v), 0x143, 0xc, 0xf, false));
    return __int_as_float(__builtin_amdgcn_readlane(__float_as_int(v), 63));
}

namespace pg8 {
constexpr int BM = 256, BK = 64, HALF = 128, HTB = HALF * BK * 2, STAGE_BYTES = 8 * HTB, NXCD = 8, WGM = 8;
__host__ __device__ __forceinline__ int lds_byte(int r, int c) { const int st = (r >> 4) * 2 + (c >> 5), rr = r & 15, cc = c & 31, ob = rr * 64 + cc * 2; return st * 1024 + (ob ^ (((ob >> 9) & 1) << 5)); }
__host__ __device__ __forceinline__ void stage_rc(int b, int& R, int& C) { const int st = b / 1024, sb = b % 1024, swz = sb ^ (((sb >> 9) & 1) << 5); R = (st >> 1) * 16 + swz / 64; C = (st & 1) * 32 + (swz % 64) / 2; }
__host__ __device__ __forceinline__ int perm32(int rho) { const int n = rho >> 4, i = rho & 15; return 8 * (i >> 2) + 4 * n + (i & 3); }
struct Unit { int pm, pn, aux; };
__device__ __forceinline__ const GAS char* uni_ptr(const char* p) { const unsigned long long v = (unsigned long long)p;
    const unsigned lo = __builtin_amdgcn_readfirstlane((unsigned)v), hi = __builtin_amdgcn_readfirstlane((unsigned)(v >> 32)); return (const GAS char*)(((unsigned long long)hi << 32) | lo); }
__device__ __forceinline__ unsigned cvt_pk_bf16(float lo, float hi) { unsigned r; asm volatile("v_cvt_pk_bf16_f32 %0, %1, %2" : "=v"(r) : "v"(lo), "v"(hi)); return r; }

template <class Epi, class Sched, bool ALIGN_EPI, bool KSPLIT, int LDB, bool GATHER = false>
__device__ __forceinline__ void gemm_phase(LAS unsigned char* lds, const int tid, const Sched& S, const Epi& E) {
    constexpr int K = 1024, nt = K / BK, ntb = KSPLIT ? nt / 2 : nt;
    const int wid = __builtin_amdgcn_readfirstlane(tid >> 6), lane = tid & 63, wr = wid >> 2, wc = wid & 3, fr = lane & 15, fq = lane >> 4;
    unsigned voffA[2], voffB[2];
#pragma unroll
    for (int i = 0; i < 2; ++i) { int R, C; stage_rc(tid * 16 + i * 8192, R, C); const int Rb = Epi::PERM ? ((R & ~31) + perm32(R & 31)) : R;
        voffA[i] = (unsigned)(R * K + C) * 2u; voffB[i] = (unsigned)(Rb * LDB + C) * 2u; }
    unsigned cvA[2][2], nvA[2][2]; int arow[2][2];
#pragma unroll
    for (int i = 0; i < 2; ++i) { int R, C; stage_rc(tid * 16 + i * 8192, R, C); arow[0][i] = R; arow[1][i] = C * 2; }
    constexpr size_t kstep = (size_t)(BK * 2);
    constexpr size_t hstepA = (size_t)HALF * K * 2, hstepB = (size_t)HALF * LDB * 2;
    const unsigned ldsw = (unsigned)wid * 1024u;
    const int aoff = lds_byte(wr * 64 + fr, fq * 8), boff = lds_byte(wc * 32 + fr, fq * 8);
#define PG8_SA(b, h) (((b) * 2 + (h)) * HTB)
#define PG8_SB(b, h) ((4 + (b) * 2 + (h)) * HTB)
#define PG8_STAGE(bufoff, gbase, voff) do { const GAS char* _gb = (const GAS char*)(gbase); _Pragma("unroll") for (int _i = 0; _i < 2; ++_i) \
        __builtin_amdgcn_global_load_lds((const GAS unsigned*)(_gb + (voff)[_i]), (LAS unsigned*)(lds + (bufoff) + ldsw + _i * 8192), 16, 0, 0); } while (0)
#define PG8_LDA(dst, b, h) do { _Pragma("unroll") for (int m = 0; m < 4; ++m) _Pragma("unroll") for (int k = 0; k < 2; ++k) dst[m][k] = *(const LAS bf16x8*)(lds + PG8_SA(b, h) + aoff + m * 2048 + k * 1024); } while (0)
#define PG8_LDB(dst, b, h) do { _Pragma("unroll") for (int n = 0; n < 2; ++n) _Pragma("unroll") for (int k = 0; k < 2; ++k) dst[n][k] = *(const LAS bf16x8*)(lds + PG8_SB(b, h) + boff + n * 2048 + k * 1024); } while (0)
#define PG8_MMA(ai, bj, At, Bt) do { __builtin_amdgcn_s_setprio(1); _Pragma("unroll") for (int m = 0; m < 4; ++m) _Pragma("unroll") for (int n = 0; n < 2; ++n) _Pragma("unroll") for (int k = 0; k < 2; ++k) \
        acc[ai][bj][m][n] = __builtin_amdgcn_mfma_f32_16x16x32_bf16(Bt[n][k], At[m][k], acc[ai][bj][m][n], 0, 0, 0); __builtin_amdgcn_s_setprio(0); } while (0)
#define PG8_WAIT_V(n) asm volatile("s_waitcnt vmcnt(" #n ")" ::: "memory")
#define PG8_WAIT_L(n) asm volatile("s_waitcnt lgkmcnt(" #n ")" ::: "memory")
#define PG8_BAR __builtin_amdgcn_s_barrier()
#define PG8_SCHED __builtin_amdgcn_sched_barrier(0)
    Unit cur, nxt; int ui = 0;
    if (!S.next(0, cur)) return;
    f32x4 acc[2][2][4][2];
#pragma unroll
    for (int a = 0; a < 2; ++a)
#pragma unroll
        for (int b = 0; b < 2; ++b)
#pragma unroll
            for (int m = 0; m < 4; ++m)
#pragma unroll
                for (int n = 0; n < 2; ++n) acc[a][b][m][n] = (f32x4){0.f, 0.f, 0.f, 0.f};
    bf16x8 At[4][2], B0[2][2], B1[2][2];
    const char* cA = (const char*)uni_ptr(S.aptr(cur)); const char* cB = (const char*)uni_ptr(S.bptr(cur));
#define PG8_LOADROWS(dst, u) do { if constexpr (GATHER) { const int* rl_ = S.rowlist(u); _Pragma("unroll") for (int hh = 0; hh < 2; ++hh) _Pragma("unroll") for (int i = 0; i < 2; ++i) { \
        const int r_ = rl_[hh * HALF + arow[0][i]]; dst[hh][i] = (unsigned)(r_ < 0 ? 0 : r_) * (unsigned)(K * 2) + (unsigned)arow[1][i]; } } } while (0)
    PG8_LOADROWS(cvA, cur);
#define PG8_STAGE_A(bufoff, gbase, half, next) do { if constexpr (GATHER) { PG8_STAGE(bufoff, gbase, (next) ? nvA[half] : cvA[half]); } else { PG8_STAGE(bufoff, (gbase) + (half) * hstepA, voffA); } } while (0)
    {
        PG8_STAGE(PG8_SB(0, 0), cB, voffB); PG8_STAGE(PG8_SB(0, 1), cB + hstepB, voffB); PG8_STAGE_A(PG8_SA(0, 0), cA, 0, false); PG8_STAGE_A(PG8_SA(0, 1), cA, 1, false);
        if (wr == 1) PG8_BAR;
        PG8_WAIT_V(2); PG8_BAR;
        PG8_STAGE(PG8_SB(1, 0), cB + kstep, voffB); PG8_STAGE_A(PG8_SA(1, 0), cA + kstep, 0, false); PG8_STAGE(PG8_SB(1, 1), cB + hstepB + kstep, voffB);
        PG8_WAIT_V(6); PG8_BAR;
    }
    for (;;) {
        const bool has_next = S.next(ui + 1, nxt);
        if (has_next) PG8_LOADROWS(nvA, nxt); else { _Pragma("unroll") for (int hh = 0; hh < 2; ++hh) _Pragma("unroll") for (int i = 0; i < 2; ++i) nvA[hh][i] = cvA[hh][i]; }
#pragma unroll 1
        for (int t = 0; t < nt; t += 2) {
            const bool last = (t == nt - 2);
            const char* a1 = cA + (size_t)(t + 1) * kstep;
            const char* a2; const char* b2;
            if (last) { a2 = has_next ? S.aptr(nxt) : cA; b2 = has_next ? S.bptr(nxt) : cB; }
            else { a2 = cA + (size_t)(t + 2) * kstep; if (KSPLIT && t + 2 >= ntb) b2 = S.bptr2(cur) + (size_t)(t + 2 - ntb) * kstep; else b2 = cB + (size_t)(t + 2) * kstep; }
            a2 = (const char*)uni_ptr(a2); b2 = (const char*)uni_ptr(b2);
            const char* a3 = a2 + kstep; const char* b3 = b2 + kstep;
            PG8_LDB(B0, 0, 0); PG8_LDB(B1, 0, 1); PG8_SCHED; PG8_LDA(At, 0, 0); PG8_STAGE_A(PG8_SA(1, 1), a1, 1, false);
            PG8_WAIT_V(8); PG8_WAIT_L(0); PG8_BAR; PG8_MMA(0, 0, At, B0); PG8_MMA(0, 1, At, B1); PG8_BAR; PG8_SCHED;
            PG8_LDA(At, 0, 1); PG8_STAGE(PG8_SB(0, 0), b2, voffB); PG8_STAGE(PG8_SB(0, 1), b2 + hstepB, voffB); PG8_STAGE_A(PG8_SA(0, 0), a2, 0, last);
            PG8_WAIT_V(8); PG8_WAIT_L(0); PG8_BAR; PG8_MMA(1, 0, At, B0); PG8_MMA(1, 1, At, B1); PG8_BAR; PG8_SCHED;
            PG8_LDB(B0, 1, 0); PG8_LDB(B1, 1, 1); PG8_SCHED; PG8_LDA(At, 1, 0); PG8_STAGE_A(PG8_SA(0, 1), a2, 1, last);
            PG8_WAIT_V(8); PG8_WAIT_L(0); PG8_BAR; PG8_MMA(0, 0, At, B0); PG8_MMA(0, 1, At, B1); PG8_BAR; PG8_SCHED;
            PG8_LDA(At, 1, 1); PG8_STAGE(PG8_SB(1, 0), b3, voffB); PG8_STAGE(PG8_SB(1, 1), b3 + hstepB, voffB); PG8_STAGE_A(PG8_SA(1, 0), a3, 0, last);
            PG8_WAIT_V(8); PG8_WAIT_L(0); PG8_BAR; PG8_MMA(1, 0, At, B0); PG8_MMA(1, 1, At, B1); PG8_BAR; PG8_SCHED;
        }
        if constexpr (ALIGN_EPI) { if (wr == 0) PG8_BAR; }
        E(acc, cur, wr, wc, fr, fq);
        if (!has_next) break;
#pragma unroll
        for (int a = 0; a < 2; ++a)
#pragma unroll
            for (int b = 0; b < 2; ++b)
#pragma unroll
                for (int m = 0; m < 4; ++m)
#pragma unroll
                    for (int n = 0; n < 2; ++n) acc[a][b][m][n] = (f32x4){0.f, 0.f, 0.f, 0.f};
        cur = nxt; cA = (const char*)uni_ptr(S.aptr(cur)); cB = (const char*)uni_ptr(S.bptr(cur)); ++ui;
        if constexpr (GATHER) { _Pragma("unroll") for (int hh = 0; hh < 2; ++hh) _Pragma("unroll") for (int i = 0; i < 2; ++i) cvA[hh][i] = nvA[hh][i]; }
        if constexpr (ALIGN_EPI) { if (wr == 1) PG8_BAR; }
    }
    PG8_WAIT_V(0);
    if constexpr (!ALIGN_EPI) { if (wr == 0) PG8_BAR; }
    PG8_BAR;
#undef PG8_SA
#undef PG8_LOADROWS
#undef PG8_STAGE_A
#undef PG8_SB
#undef PG8_STAGE
#undef PG8_LDA
#undef PG8_LDB
#undef PG8_MMA
#undef PG8_WAIT_V
#undef PG8_WAIT_L
#undef PG8_BAR
#undef PG8_SCHED
}
}

#define XB_TMO      128
#define XB_XCNT(j)  (256  + 64 * (j))
#define XB_XSUB(j)  (1280 + 64 * (j))
#define XB_XGEN(j)  (2304 + 64 * (j))
#define XB_TOP      3328
#define XB_TOPGEN   3392
#define XCD_BAR_WORDS 3456
#define XB_SPIN_CAP (1u << 25)
__device__ __forceinline__ unsigned xb_ld(unsigned* p)              { return __hip_atomic_load(p, __ATOMIC_RELAXED, __HIP_MEMORY_SCOPE_AGENT); }
__device__ __forceinline__ unsigned xb_add(unsigned* p, unsigned v) { return __hip_atomic_fetch_add(p, v, __ATOMIC_RELAXED, __HIP_MEMORY_SCOPE_AGENT); }
__device__ __forceinline__ unsigned xb_xcc_id() { return (unsigned)__builtin_amdgcn_s_getreg((3 << 11) | 20) & 0xFu; }
#define XB_SPIN(cond, bar) do { unsigned _sp = 0; while (cond) { __builtin_amdgcn_s_sleep(1); \
    if ((++_sp & 255u) == 0u) { if (xb_ld(&(bar)[XB_TMO])) break; if (_sp > XB_SPIN_CAP) { atomicAdd(&(bar)[XB_TMO], 1u); break; } } } } while (0)
struct XcdBarrier { unsigned* bar; unsigned x; volatile LAS unsigned* st; };
__device__ __forceinline__ XcdBarrier xcd_barrier_post(unsigned* bar, volatile LAS unsigned* st) {
    XcdBarrier b; b.bar = bar; b.x = xb_xcc_id(); b.st = st;
    if (threadIdx.x == 0) (void)xb_add(&bar[XB_XCNT(b.x)], 1u);
    return b;
}
__device__ __forceinline__ void xcd_barrier_complete(unsigned* bar, unsigned x, unsigned& nloc, unsigned& nx) {
    const unsigned G = gridDim.x * gridDim.y * gridDim.z;
    unsigned sum, cnt, mine, sp = 0u;
    for (;;) {
        sum = 0u; cnt = 0u; mine = 0u;
#pragma unroll 1
        for (unsigned j = 0; j < 16; ++j) { const unsigned c = xb_ld(&bar[XB_XCNT(j)]); sum += c; cnt += (c > 0u) ? 1u : 0u; mine = (j == x) ? c : mine; }
        if (sum == G) break;
        __builtin_amdgcn_s_sleep(1);
        if ((++sp & 255u) == 0u) { if (xb_ld(&bar[XB_TMO])) break; if (sp > XB_SPIN_CAP) { atomicAdd(&bar[XB_TMO], 1u); break; } }
    }
    nloc = mine > 0u ? mine : 1u; nx = cnt > 0u ? cnt : 1u;
}
__device__ __forceinline__ void xcd_barrier(const XcdBarrier& b) {
    asm volatile("s_waitcnt vmcnt(0)" ::: "memory");
    __syncthreads();
    if (threadIdx.x == 0) {
        unsigned* bar = b.bar;
        __builtin_amdgcn_s_waitcnt(0);
        unsigned nloc = b.st[0], nx = b.st[1];
        if (nloc == 0u) { xcd_barrier_complete(bar, b.x, nloc, nx); b.st[0] = nloc; b.st[1] = nx; }
        const unsigned old = xb_add(&bar[XB_XSUB(b.x)], 1u);
        const unsigned gen = old / nloc;
        if (old + 1u == (gen + 1u) * nloc) {
            __builtin_amdgcn_fence(__ATOMIC_RELEASE, "agent");
            asm volatile("s_waitcnt vmcnt(0)" ::: "memory");
            const unsigned og = xb_add(&bar[XB_TOP], 1u);
            const unsigned tg = og / nx;
            if (og + 1u == (tg + 1u) * nx) xb_add(&bar[XB_TOPGEN], 1u);
            else XB_SPIN(xb_ld(&bar[XB_TOPGEN]) == tg, bar);
            __builtin_amdgcn_fence(__ATOMIC_ACQUIRE, "agent");
            xb_add(&bar[XB_XGEN(b.x)], 1u);
            asm volatile("s_waitcnt vmcnt(0)" ::: "memory");
        } else {
            XB_SPIN(xb_ld(&bar[XB_XGEN(b.x)]) == gen, bar);
            __builtin_amdgcn_fence(__ATOMIC_ACQUIRE, "agent");
            asm volatile("s_waitcnt vmcnt(0)" ::: "memory");
        }
    }
    __syncthreads();
}

struct Args { const float* in[39]; float* out; unsigned char* ws; int ph_lo, ph_hi; };
struct Frame {
    LAS unsigned char* lds;
    int tid, lane, wave, G, bid;
    float* out; unsigned char* ws;
    int l;
};
#define AS4 __attribute__((address_space(4)))
#define PH_ENTER(F0) Frame F = (F0); { GAS unsigned char* _w = (GAS unsigned char*)F.ws; GAS float* _o = (GAS float*)F.out; \
    asm volatile("" : "+s"(_w), "+s"(_o), "+v"(F.tid), "+s"(F.wave), "+s"(F.bid), "+s"(F.G), "+s"(F.l)); F.ws = (unsigned char*)_w; F.out = (float*)_o; } F.lane = F.tid & 63
__device__ __forceinline__ const AS4 Args* kargs() { const AS4 Args* p = (const AS4 Args*)__builtin_amdgcn_kernarg_segment_ptr(); asm volatile("" : "+s"(p)); return p; }
#define INP(i) ((const float*)(GAS const float*)(KA->in[i]))
#define LP(i, stride) (INP(i) + (size_t)F.l * (stride))

__device__ __forceinline__ const float* xin_row(const float* xl, const float* xc, int row) {
    const int b = row / TB, p = row % TB;
    if (p < TC) return xc + ((size_t)b * TC + p) * D;
    return xl + ((size_t)b * TL + (p - TC)) * D;
}
__device__ __forceinline__ float* xcur_row(const Frame& F, int row) {
    const int b = row / TB, p = row % TB;
    if (p < TC) return (float*)(F.ws + WS_CTX) + ((size_t)b * TC + p) * D;
    return F.out + ((size_t)b * TL + (p - TC)) * D;
}
__device__ __forceinline__ int n_units(bool skipctx) { return skipctx ? NB * 128 : NUNIT64; }
__device__ __forceinline__ int unit_of(bool skipctx, int j) { return skipctx ? (j >> 7) * NTILE64 + 4 + (j & 127) : j; }
__device__ __forceinline__ int mod_index(int row) { const int b = row / TB, p = row % TB; return p < TC ? 8 : b; }

__device__ __forceinline__ int in_colmap(int n) {
    if (n < 2304) return n;
    if (n < 2816) return n + 8;
    if (n < 3072) return n + 24;
    if (n < 3080) return n - 768;
    if (n < 3096) return n - 256;
    return -1;
}
__device__ __forceinline__ void tr_item(const float* src, int ldsrc, int scol, bf16* dst, int K, int n0, int k0, LAS float* scr, int lane) {
#pragma unroll 8
    for (int i = 0; i < 32; ++i) { const int kk = 2 * i + (lane >> 5); scr[kk * 33 + (lane & 31)] = scol >= 0 ? src[(size_t)(k0 + kk) * ldsrc + scol] : 0.f; }
    LDS_WAIT(); asm volatile("" ::: "memory");
    const int c = lane & 7;
#pragma unroll
    for (int j = 0; j < 4; ++j) { const int n = (lane >> 3) + 8 * j; const LAS float* s = scr + (8 * c) * 33 + n;
        u32x4 o; o.x = pk2(s[0 * 33], s[1 * 33]); o.y = pk2(s[2 * 33], s[3 * 33]); o.z = pk2(s[4 * 33], s[5 * 33]); o.w = pk2(s[6 * 33], s[7 * 33]);
        *(GAS u32x4*)(dst + (size_t)(n0 + n) * K + k0 + 8 * c) = o; }
    LDS_WAIT(); asm volatile("" ::: "memory");
}
__device__ __forceinline__ void phase_convert(const Frame& F0) {
    PH_ENTER(F0);
    const AS4 Args* KA = kargs();
    LAS float* scr = (LAS float*)(F.lds + F.wave * 16384);
    const int gw = F.bid * 8 + F.wave, NGW = F.G * 8, l = F.l, lane = F.lane;
    constexpr int I_A = 16 * 104, I_B = 16 * 32, I_C = 16 * 16 * 32, I_D = 16 * 8 * 32, I_E = 48;
    for (int it = gw; it < I_A + I_B + I_C + I_D + I_E; it += NGW) {
        int r = it;
        if (r < I_A) { const int kb = r / 104, nb = r % 104; tr_item(INP(8) + (size_t)l * D * IN_COLS, IN_COLS, in_colmap(nb * 32 + (lane & 31)), (bf16*)(F.ws + WS_WIN), D, nb * 32, kb * 64, scr, lane); continue; }
        r -= I_A;
        if (r < I_B) { const int kb = r / 32, nb = r % 32; tr_item(INP(9) + (size_t)l * D * D, D, nb * 32 + (lane & 31), (bf16*)(F.ws + WS_WOUT), D, nb * 32, kb * 64, scr, lane); continue; }
        r -= I_B;
        if (r < I_C) { const int e = r / 512, rr = r % 512, kb = rr / 32, nb = rr % 32; const int n0 = nb * 32, j = n0 >> 8, wi = n0 & 255;
            const float* src = (wi < 128 ? INP(35) : INP(36)) + (size_t)(l * 16 + e) * D * 512;
            tr_item(src, 512, 128 * j + (wi & 127) + (lane & 31), (bf16*)(F.ws + WS_W13) + (size_t)e * D * D, D, n0, kb * 64, scr, lane); continue; }
        r -= I_C;
        if (r < I_D) { const int e = r / 256, rr = r % 256, kb = rr / 32, nb = rr % 32;
            tr_item(INP(37) + (size_t)(l * 16 + e) * 512 * D, D, nb * 32 + (lane & 31), (bf16*)(F.ws + WS_W2T) + (size_t)e * D * 512, 512, nb * 32, kb * 64, scr, lane); continue; }
        r -= I_D;
        { bf16* LW = (bf16*)(F.ws + WS_LOWR);
            if (r < 16) { const int d = r >> 3, nb = r & 7; tr_item(INP(13) + (size_t)(l * 2 + d) * 64 * 256, 256, nb * 32 + (lane & 31), LW + (size_t)d * 256 * 64, 64, nb * 32, 0, scr, lane); }
            else if (r < 32) { const int d = (r - 16) >> 3, nb = r & 7; tr_item(INP(15) + (size_t)(l * 2 + d) * 64 * 256, 256, nb * 32 + (lane & 31), LW + 32768 + (size_t)d * 256 * 64, 64, nb * 32, 0, scr, lane); }
            else { const int kb = (r - 32) >> 3, nb = r & 7; tr_item(INP(16) + (size_t)l * 128 * 256, 256, nb * 32 + (lane & 31), LW + 65536, 128, nb * 32, kb * 64, scr, lane); } }
    }
}
__device__ __forceinline__ void phase_mods(const Frame& F0) {
    PH_ENTER(F0);
    const AS4 Args* KA = kargs();
    LAS float* cond = (LAS float*)F.lds;
    LAS float* red = (LAS float*)(F.lds + 40960);
    for (int i = F.tid; i < 9 * D; i += 512) { const float v = i < 8 * D ? INP(1)[i] : INP(3)[i - 8 * D]; cond[i] = siluf(v); }
    LDS_BARRIER();
    float* mod = (float*)(F.ws + WS_MOD);
    for (int u = F.bid; u < 2 * 96; u += F.G) {
        const int l = u / 96, cb = u % 96, col = cb * 64 + F.lane;
        const float* W = INP(4) + (size_t)l * D * 6144;
        float acc[9];
#pragma unroll
        for (int i = 0; i < 9; ++i) acc[i] = 0.f;
#pragma unroll 1
        for (int k0 = F.wave * 128; k0 < F.wave * 128 + 128; k0 += 16) { float w[16];
#pragma unroll
            for (int kk = 0; kk < 16; ++kk) w[kk] = W[(size_t)(k0 + kk) * 6144 + col];
#pragma unroll
            for (int kk = 0; kk < 16; kk += 4)
#pragma unroll
                for (int i = 0; i < 9; ++i) { const f32x4 c4 = *(const LAS f32x4*)(cond + i * D + k0 + kk); acc[i] += c4.x * w[kk] + c4.y * w[kk + 1] + c4.z * w[kk + 2] + c4.w * w[kk + 3]; } }
#pragma unroll
        for (int i = 0; i < 9; ++i) red[(F.wave * 9 + i) * 64 + F.lane] = acc[i];
        LDS_BARRIER();
        for (int o = F.tid; o < 9 * 64; o += 512) { const int i = o / 64, ln = o % 64; float s = 0.f;
#pragma unroll
            for (int w = 0; w < 8; ++w) s += red[(w * 9 + i) * 64 + ln];
            mod[((size_t)l * 9 + i) * 6144 + cb * 64 + ln] = s + INP(5)[(size_t)l * 6144 + cb * 64 + ln]; }
        LDS_BARRIER();
    }
}

__device__ __forceinline__ void phase_norm1(const Frame& F0) {
    PH_ENTER(F0);
    const AS4 Args* KA = kargs();
    const float* xl = F.l == 0 ? INP(0) : (const float*)F.out; const float* xc = F.l == 0 ? INP(2) : (const float*)(F.ws + WS_CTX);
    const int gw = F.bid * 8 + F.wave, NGW = F.G * 8, lane = F.lane;
    const float* g = LP(6, D);
    const float* mod = (const float*)(F.ws + WS_MOD) + (size_t)F.l * 9 * 6144;
    bf16* H = (bf16*)(F.ws + WS_ACT);
    const int R = (T + NGW - 1) / NGW, r0 = gw * R, r1 = min(T, r0 + R);
    f32x4 A[4], B[4], nv[4]; int curmi = -1;
    if (r0 < r1) { const f32x4* xr = (const f32x4*)xin_row(xl, xc, r0) + lane;
#pragma unroll
        for (int j = 0; j < 4; ++j) nv[j] = xr[64 * j]; }
    for (int row = r0; row < r1; ++row) {
        f32x4 v[4];
#pragma unroll
        for (int j = 0; j < 4; ++j) v[j] = nv[j];
        if (row + 1 < r1) { const f32x4* xr = (const f32x4*)xin_row(xl, xc, row + 1) + lane;
#pragma unroll
            for (int j = 0; j < 4; ++j) nv[j] = xr[64 * j]; }
        const int mi = mod_index(row);
        if (mi != curmi) { curmi = mi; const float* mrow = mod + (size_t)mi * 6144;
#pragma unroll
            for (int j = 0; j < 4; ++j) { const int c = 4 * lane + 256 * j; A[j] = *(const f32x4*)(g + c) * (*(const f32x4*)(mrow + D + c) + 1.f); B[j] = *(const f32x4*)(mrow + c); } }
        float s = 0.f;
#pragma unroll
        for (int j = 0; j < 4; ++j) s += (v[j].x * v[j].x + v[j].y * v[j].y) + (v[j].z * v[j].z + v[j].w * v[j].w);
        const float rs = rsqrtf(wave_sum(s) * (1.f / D) + 1e-6f);
        u32x2* o8 = (u32x2*)(H + (size_t)row * D) + lane;
#pragma unroll
        for (int j = 0; j < 4; ++j) { const f32x4 h = v[j] * rs * A[j] + B[j]; u32x2 w; w.x = pk2(h.x, h.y); w.y = pk2(h.z, h.w); o8[64 * j] = w; }
    }
}

struct SchedStatic {
    int nM, nN, nwg, G, c; const unsigned char* ws; size_t offA, offB; int skipctx;
    __device__ __forceinline__ bool next(int i, pg8::Unit& u) const {
        const long L = (long)i * G + c; if (L >= nwg) return false;
        int wgid = (int)L; { const int q = nwg / 8, r = nwg % 8, xcd = wgid % 8, off = wgid / 8; wgid = (xcd < r ? xcd * (q + 1) : r * (q + 1) + (xcd - r) * q) + off; }
        const int nig = 8 * nN, gid = wgid / nig, fm = gid * 8, gsz = (nM - fm) < 8 ? (nM - fm) : 8;
        u.pm = fm + ((wgid % nig) % gsz); u.pn = (wgid % nig) / gsz; u.aux = 0;
        if (skipctx) u.pm = (u.pm >> 5) * 33 + 1 + (u.pm & 31);
        return true;
    }
    __device__ __forceinline__ const char* aptr(const pg8::Unit& u) const { return (const char*)ws + offA + (size_t)u.pm * (256 * 1024 * 2); }
    __device__ __forceinline__ const char* bptr(const pg8::Unit& u) const { return (const char*)ws + offB + (size_t)u.pn * (256 * 1024 * 2); }
    __device__ __forceinline__ const char* bptr2(const pg8::Unit& u) const { return bptr(u); }
    __device__ __forceinline__ const int* rowlist(const pg8::Unit&) const { return nullptr; }
};
struct EpiU {
    static constexpr bool PERM = true;
    unsigned char* ws;
    __device__ __forceinline__ void operator()(const f32x4 (&acc)[2][2][4][2], const pg8::Unit& u, int wr, int wc, int fr, int fq) const {
        const int row0 = u.pm * 256 + wr * 64 + fr, pn = u.pn;
        float* u_misc = (float*)(ws + WS_UMISC);
        if (pn < 12) {
            bf16* base; int ld, c0;
            if (pn < 4) { base = (bf16*)(ws + WS_URW); ld = 1024; c0 = pn * 256; } else if (pn < 6) { base = (bf16*)(ws + WS_UZ); ld = 512; c0 = (pn - 4) * 256; }
            else if (pn < 9) { base = (bf16*)(ws + WS_UXBC); ld = 768; c0 = (pn - 6) * 256; } else { base = (bf16*)(ws + WS_UGLA); ld = 768; c0 = (pn - 9) * 256; }
            const int col0 = c0 + wc * 32 + 8 * fq;
#pragma unroll
            for (int ai = 0; ai < 2; ++ai)
#pragma unroll
                for (int m = 0; m < 4; ++m) { bf16* rowp = base + (size_t)(row0 + ai * 128 + m * 16) * ld + col0;
#pragma unroll
                    for (int bj = 0; bj < 2; ++bj) { const f32x4 v0 = acc[ai][bj][m][0], v1 = acc[ai][bj][m][1];
                        u32x4 w; w.x = pg8::cvt_pk_bf16(v0[0], v0[1]); w.y = pg8::cvt_pk_bf16(v0[2], v0[3]); w.z = pg8::cvt_pk_bf16(v1[0], v1[1]); w.w = pg8::cvt_pk_bf16(v1[2], v1[3]);
                        *(u32x4*)(rowp + bj * 128) = w; } }
        } else if (wc == 0) {
#pragma unroll
            for (int ai = 0; ai < 2; ++ai)
#pragma unroll
                for (int m = 0; m < 4; ++m) { float* rp = u_misc + (size_t)(row0 + ai * 128 + m * 16) * 32 + 8 * fq;
                    *(f32x4*)rp = acc[ai][0][m][0]; *(f32x4*)(rp + 4) = acc[ai][0][m][1]; }
        }
    }
};
struct EpiRes {
    static constexpr bool PERM = false;
    const float* xin_lat; const float* xin_ctx; float* out; unsigned char* ws; int l;
    __device__ __forceinline__ void operator()(const f32x4 (&acc)[2][2][4][2], const pg8::Unit& u, int wr, int wc, int fr, int fq) const {
        const int b = u.pm / 33, tb = u.pm % 33;
        const float* mod = (const float*)(ws + WS_MOD) + (size_t)l * 9 * 6144;
        const float* xi; float* xo; const float* mrow;
        if (tb == 0) { xi = xin_ctx + (size_t)b * TC * D; xo = (float*)(ws + WS_CTX) + (size_t)b * TC * D; mrow = mod + (size_t)8 * 6144 + 2 * D; }
        else { const size_t o = ((size_t)b * TL + (size_t)(tb - 1) * 256) * D; xi = xin_lat + o; xo = out + o; mrow = mod + (size_t)b * 6144 + 2 * D; }
        const int r0 = wr * 64 + fr, col0 = u.pn * 256 + wc * 32 + 4 * fq;
#pragma unroll
        for (int ai = 0; ai < 2; ++ai)
#pragma unroll
            for (int m = 0; m < 4; ++m) { const size_t off = (size_t)(r0 + ai * 128 + m * 16) * D + col0;
#pragma unroll
                for (int bj = 0; bj < 2; ++bj)
#pragma unroll
                    for (int n = 0; n < 2; ++n) { const f32x4 xv = *(const f32x4*)(xi + off + bj * 128 + n * 16); const f32x4 gv = *(const f32x4*)(mrow + col0 + bj * 128 + n * 16);
                        *(f32x4*)(xo + off + bj * 128 + n * 16) = xv + gv * acc[ai][bj][m][n]; }
                asm volatile("" ::: "memory"); }
    }
};
__device__ __forceinline__ void cls_experts(int cls, int& ea, int& eb) {
    const int g = cls / 6, pr = cls % 6;
    const int pa = pr < 3 ? 0 : (pr < 5 ? 1 : 2);
    const int pb = pr == 0 ? 1 : (pr == 1 ? 2 : (pr == 2 ? 3 : (pr == 3 ? 2 : 3)));
    ea = g * 4 + pa; eb = g * 4 + pb;
}
template <int NJ> struct SchedMoE {
    int ntiles, G, c; const LAS int* cs; const unsigned char* ws;
    __device__ __forceinline__ bool next(int i, pg8::Unit& u) const {
        const long L = (long)i * G + c; if (L >= (long)ntiles * NJ) return false;
        const int tile = (int)(L / NJ), j = (int)(L % NJ), slot0 = tile * 256;
        int cls = 0;
#pragma unroll 1
        for (int k = 1; k < NCLS; ++k) cls = (slot0 >= cs[k]) ? k : cls;
        u.pm = tile; u.pn = j; u.aux = cls; return true;
    }
    __device__ __forceinline__ const char* aptr(const pg8::Unit& u) const { return NJ == 8 ? (const char*)ws + WS_ACT : (const char*)ws + WS_H1 + (size_t)u.pm * (256 * 1024 * 2); }
    __device__ __forceinline__ const int* rowlist(const pg8::Unit& u) const { return (const int*)(ws + WS_LIST) + u.pm * 256; }
    __device__ __forceinline__ const char* bptr(const pg8::Unit& u) const { int ea, eb; cls_experts(u.aux, ea, eb);
        if (NJ == 8) { const int e = u.pn < 4 ? ea : eb; return (const char*)ws + WS_W13 + ((size_t)e * D + (size_t)(u.pn & 3) * 256) * D * 2; }
        return (const char*)ws + WS_W2T + ((size_t)ea * D + (size_t)u.pn * 256) * 512 * 2; }
    __device__ __forceinline__ const char* bptr2(const pg8::Unit& u) const { int ea, eb; cls_experts(u.aux, ea, eb);
        return (const char*)ws + WS_W2T + ((size_t)eb * D + (size_t)u.pn * 256) * 512 * 2; }
};
struct EpiSwiGLU {
    static constexpr bool PERM = true;
    unsigned char* ws;
    __device__ __forceinline__ void operator()(const f32x4 (&acc)[2][2][4][2], const pg8::Unit& u, int wr, int wc, int fr, int fq) const {
        bf16* H1 = (bf16*)(ws + WS_H1); const f32x2* wslot = (const f32x2*)(ws + WS_WSLOT);
        const int row0 = u.pm * 256 + wr * 64 + fr, j = u.pn;
        const int col0 = (j >> 2) * 512 + (j & 3) * 128 + wc * 32 + 8 * fq;
#pragma unroll
        for (int ai = 0; ai < 2; ++ai)
#pragma unroll
            for (int m = 0; m < 4; ++m) { const int row = row0 + ai * 128 + m * 16; const f32x2 wv = wslot[row]; const float w = j < 4 ? wv.x : wv.y;
                float o[8];
#pragma unroll
                for (int n = 0; n < 2; ++n)
#pragma unroll
                    for (int i = 0; i < 4; ++i) { const float gt = acc[ai][0][m][n][i], up = acc[ai][1][m][n][i]; o[n * 4 + i] = siluf(gt) * up * w; }
                u32x4 wv4; wv4.x = pg8::cvt_pk_bf16(o[0], o[1]); wv4.y = pg8::cvt_pk_bf16(o[2], o[3]); wv4.z = pg8::cvt_pk_bf16(o[4], o[5]); wv4.w = pg8::cvt_pk_bf16(o[6], o[7]);
                *(u32x4*)(H1 + (size_t)row * D + col0) = wv4; }
    }
};
struct EpiScatter {
    static constexpr bool PERM = false;
    float* x_lat; unsigned char* ws; int l;
    __device__ __forceinline__ void operator()(const f32x4 (&acc)[2][2][4][2], const pg8::Unit& u, int wr, int wc, int fr, int fq) const {
        const int* list = (const int*)(ws + WS_LIST); float* x_ctx = (float*)(ws + WS_CTX); const float* mod = (const float*)(ws + WS_MOD) + (size_t)l * 9 * 6144;
        const int row0 = u.pm * 256 + wr * 64 + fr, col0 = u.pn * 256 + wc * 32 + 4 * fq;
#pragma unroll
        for (int ai = 0; ai < 2; ++ai)
#pragma unroll
            for (int m = 0; m < 4; ++m) { const int tok = list[row0 + ai * 128 + m * 16];
                if (tok >= 0) { const int b = tok / TB, p = tok % TB;
                    float* xr = p < TC ? x_ctx + ((size_t)b * TC + p) * D : x_lat + ((size_t)b * TL + (p - TC)) * D;
                    const float* mrow = mod + (size_t)(p < TC ? 8 : b) * 6144 + 5 * D;
#pragma unroll
                    for (int bj = 0; bj < 2; ++bj)
#pragma unroll
                        for (int n = 0; n < 2; ++n) { const int c = col0 + bj * 128 + n * 16; const f32x4 gv = *(const f32x4*)(mrow + c);
                            *(f32x4*)(xr + c) = *(const f32x4*)(xr + c) + gv * acc[ai][bj][m][n]; } }
                asm volatile("" ::: "memory"); }
    }
};

constexpr int LD64 = 72;
__device__ __forceinline__ f32x4 mma16g(f32x4 acc, const LAS bf16* A, int lda, const bf16* Btg, int ldb, int lane) {
    const int r = lane & 15, kq = (lane >> 4) * 8;
    const bf16x8 a = *(const LAS bf16x8*)(A + r * lda + kq);
    const bf16x8 b = *(const bf16x8*)(Btg + (size_t)r * ldb + kq);
    return __builtin_amdgcn_mfma_f32_16x16x32_bf16(a, b, acc, 0, 0, 0);
}
__device__ __forceinline__ void phase_conv(const Frame& F0) {
    PH_ENTER(F0);
    const AS4 Args* KA = kargs();
    const bf16* UXBC = (const bf16*)(F.ws + WS_UXBC); bf16* XBCA = (bf16*)(F.ws + WS_XBCA);
    const float* cw = LP(22, 9 * 768); const float* cb = LP(23, 768);
    const int cg = F.tid % 96, sub = F.tid / 96;
    if (sub >= 5) return;
    const int ch0 = cg * 8;
    float wgt0[9][8], bias[8];
#pragma unroll
    for (int k = 0; k < 9; ++k) { const f32x4 wa = *(const f32x4*)(cw + k * 768 + ch0), wb = *(const f32x4*)(cw + k * 768 + ch0 + 4);
        wgt0[k][0] = wa.x; wgt0[k][1] = wa.y; wgt0[k][2] = wa.z; wgt0[k][3] = wa.w; wgt0[k][4] = wb.x; wgt0[k][5] = wb.y; wgt0[k][6] = wb.z; wgt0[k][7] = wb.w; }
    { const f32x4 b0 = *(const f32x4*)(cb + ch0), b1 = *(const f32x4*)(cb + ch0 + 4); bias[0] = b0.x; bias[1] = b0.y; bias[2] = b0.z; bias[3] = b0.w; bias[4] = b1.x; bias[5] = b1.y; bias[6] = b1.z; bias[7] = b1.w; }
    for (int it = F.bid * 5 + sub; it < NUNIT64 * 4; it += F.G * 5) {
        const int u = it >> 2, run = it & 3, b = u / NTILE64, tl = u % NTILE64, p0 = tl * 64; const size_t rowbase = (size_t)b * TB;
        const bool lat = p0 >= TC; const int gr = (p0 - TC) >> 6;
        const int xhi = lat ? 64 : TC, x0 = (lat ? 0 : p0) + run * 16;
        const bf16* rp0; const bf16* rp1; const bf16* rp2; bool rv0, rv2;
        { const int y0 = gr - 1, y2 = gr + 1; rv0 = lat && y0 >= 0; rv2 = lat && y2 < 128;
            rp1 = UXBC + (rowbase + (lat ? TC + gr * 64 : 0)) * 768 + ch0; rp0 = rv0 ? rp1 - 64 * 768 : rp1; rp2 = rv2 ? rp1 + 64 * 768 : rp1; }
        const float m0 = rv0 ? 1.f : 0.f, m2 = rv2 ? 1.f : 0.f;
        u32x4 w00, w01, w02, w10, w11, w12;
        { const int xa = x0 - 1; const bool va = xa >= 0; const size_t oa = (size_t)(va ? xa : 0) * 768; const u32x4 z4 = {0u, 0u, 0u, 0u};
            w00 = va ? *(const u32x4*)(rp0 + oa) : z4; w01 = va ? *(const u32x4*)(rp1 + oa) : z4; w02 = va ? *(const u32x4*)(rp2 + oa) : z4;
            const size_t ob = (size_t)x0 * 768; w10 = *(const u32x4*)(rp0 + ob); w11 = *(const u32x4*)(rp1 + ob); w12 = *(const u32x4*)(rp2 + ob); }
#pragma unroll 4
        for (int k = 0; k < 16; ++k) { const int x = x0 + k, xn = x + 1; const bool vn = xn < xhi; const size_t on = (size_t)(vn ? xn : x) * 768; const u32x4 z4 = {0u, 0u, 0u, 0u};
            u32x4 w20 = *(const u32x4*)(rp0 + on), w21 = *(const u32x4*)(rp1 + on), w22 = *(const u32x4*)(rp2 + on);
            if (!vn) { w20 = z4; w21 = z4; w22 = z4; }
            float acc[8], t0[8], t2[8];
#pragma unroll
            for (int i = 0; i < 8; ++i) { acc[i] = bias[i]; t0[i] = 0.f; t2[i] = 0.f; }
            float v[8];
#define CONV_TAP(W, K, DST) unpack8(W, v); _Pragma("unroll") for (int i = 0; i < 8; ++i) DST[i] += v[i] * wgt0[K][i];
            CONV_TAP(w00, 0, t0) CONV_TAP(w10, 1, t0) CONV_TAP(w20, 2, t0) CONV_TAP(w01, 3, acc) CONV_TAP(w11, 4, acc) CONV_TAP(w21, 5, acc) CONV_TAP(w02, 6, t2) CONV_TAP(w12, 7, t2) CONV_TAP(w22, 8, t2)
#undef CONV_TAP
#pragma unroll
            for (int i = 0; i < 8; ++i) acc[i] = siluf(acc[i] + m0 * t0[i] + m2 * t2[i]);
            *(u32x4*)(XBCA + (rowbase + (lat ? TC + gr * 64 + x : x)) * 768 + ch0) = pack8(acc);
            w00 = w10; w01 = w11; w02 = w12; w10 = w20; w11 = w21; w12 = w22;
        }
    }
}
__device__ __forceinline__ void phase_prep(const Frame& F0) {
    PH_ENTER(F0);
    const AS4 Args* KA = kargs();
    const int tid = F.tid, lane = F.lane, wave = F.wave;
    const bf16* URW = (const bf16*)(F.ws + WS_URW); const bf16* UXBC = (const bf16*)(F.ws + WS_UXBC);
    bf16* XBCA = (bf16*)(F.ws + WS_XBCA);
    h16* RECS = (h16*)(F.ws + WS_RECS); h16* RECD = (h16*)(F.ws + WS_RECD); h16* BONUS = (h16*)(F.ws + WS_BONUS); h16* GATE = (h16*)(F.ws + WS_GATE);
    const bf16* LW = (const bf16*)(F.ws + WS_LOWR);
    const float* mup = LP(10, 1024); const float* mun = LP(11, 1024);
    const float* w0 = LP(12, 512); const float* a0 = LP(14, 512);
    const float* k_k = LP(17, 256); const float* r_k = LP(19, 256);
    const float* cw = LP(22, 9 * 768); const float* cb = LP(23, 768);
    constexpr int LDR = 776, LDG = 136;
    LAS h16* RKV = (LAS h16*)F.lds;
    LAS bf16* WLi = (LAS bf16*)(F.lds + 99328);
    LAS bf16* ALi = (LAS bf16*)(F.lds + 108544);
    LAS bf16* GSi = (LAS bf16*)(F.lds + 117760);
    bf16x8 Bf[5][2][4];
    { const int c0 = wave * 32, r = lane & 15, kq = (lane >> 4) * 8;
#pragma unroll
        for (int mm = 0; mm < 4; ++mm) { const bf16* Bt = mm < 2 ? LW + (size_t)mm * 16384 : (mm < 4 ? LW + 32768 + (size_t)(mm - 2) * 16384 : LW + 65536); const int ldb = mm < 4 ? 64 : 128;
#pragma unroll
            for (int nt = 0; nt < 2; ++nt)
#pragma unroll
                for (int ks = 0; ks < 4; ++ks) if (ks < (mm < 4 ? 2 : 4)) Bf[mm][nt][ks] = *(const bf16x8*)(Bt + (size_t)(c0 + nt * 16 + r) * ldb + ks * 32 + kq); } }
    for (int u = F.bid; u < NUNIT64; u += F.G) {
        const int b = u / NTILE64, tl = u % NTILE64, p0 = tl * 64;
        const int seg_lo = p0 < TC ? 0 : TC, seg_hi = p0 < TC ? TC : TB;
        const size_t rowbase = (size_t)b * TB;
        LDS_BARRIER();
        SUBREP(1) { const int t = tid >> 3, part = tid & 7, p = p0 + t; const bf16* ur = URW + (rowbase + p) * 1024;
            const bool hp = p - 1 >= seg_lo, hn = p + 1 < seg_hi;
#pragma unroll 4
            for (int j = 0; j < 16; ++j) { const int c0 = (j * 8 + part) * 8;
                float uc[8], up[8], un[8];
                unpack8(*(const u32x4*)(ur + c0), uc);
                if (hp) unpack8(*(const u32x4*)(ur - 1024 + c0), up); else {
#pragma unroll
                    for (int i = 0; i < 8; ++i) up[i] = 0.f; }
                if (hn) unpack8(*(const u32x4*)(ur + 1024 + c0), un); else {
#pragma unroll
                    for (int i = 0; i < 8; ++i) un[i] = 0.f; }
                const f32x4 mp0 = *(const f32x4*)(mup + c0), mp1 = *(const f32x4*)(mup + c0 + 4), mn0 = *(const f32x4*)(mun + c0), mn1 = *(const f32x4*)(mun + c0 + 4);
                float sv[8];
#pragma unroll
                for (int i = 0; i < 4; ++i) { sv[i] = uc[i] + mp0[i] * (up[i] - uc[i]) + mn0[i] * (un[i] - uc[i]); sv[4 + i] = uc[4 + i] + mp1[i] * (up[4 + i] - uc[4 + i]) + mn1[i] * (un[4 + i] - uc[4 + i]); }
                if (c0 < 768) { h16x8 hv;
#pragma unroll
                    for (int i = 0; i < 8; ++i) hv[i] = (h16)sv[i];
                    *(LAS h16x8*)(RKV + t * LDR + c0) = hv; }
                else if (c0 < 832) {
#pragma unroll
                    for (int i = 0; i < 8; ++i) sv[i] = tanhf(sv[i]);
                    *(LAS u32x4*)(WLi + t * LD64 + (c0 - 768)) = pack8(sv); }
                else if (c0 < 896) *(LAS u32x4*)(ALi + t * LD64 + (c0 - 832)) = pack8(sv);
                else {
#pragma unroll
                    for (int i = 0; i < 8; ++i) sv[i] = sigm(sv[i]);
                    *(LAS u32x4*)(GSi + t * LDG + (c0 - 896)) = pack8(sv); }
            } }
        LDS_BARRIER();
        SUBREP(2) { const int t = tid >> 3, hq = tid & 7, h = hq >> 1, c0 = h * 64 + (hq & 1) * 32, p = p0 + t;
            float ss = 0.f, bs = 0.f;
#pragma unroll
            for (int j = 0; j < 4; ++j) { const h16x8 rv = *(const LAS h16x8*)(RKV + t * LDR + c0 + 8 * j), kv = *(const LAS h16x8*)(RKV + t * LDR + 256 + c0 + 8 * j);
                const f32x4 kk0 = *(const f32x4*)(k_k + c0 + 8 * j), kk1 = *(const f32x4*)(k_k + c0 + 8 * j + 4), rk0 = *(const f32x4*)(r_k + c0 + 8 * j), rk1 = *(const f32x4*)(r_k + c0 + 8 * j + 4);
#pragma unroll
                for (int i = 0; i < 8; ++i) { const float kf = (float)kv[i], rf = (float)rv[i], kc = i < 4 ? kk0[i & 3] : kk1[i & 3], rc = i < 4 ? rk0[i & 3] : rk1[i & 3];
                    const float kr = kf * kc; ss += kr * kr; bs += rf * kf * rc; } }
            ss += dpp_mov<0xB1>(ss); bs += dpp_mov<0xB1>(bs);
            const float rs = rsqrtf(ss + 1e-12f);
            h16* rec = RECS + (((size_t)b * 4 + h) * TB + p) * 256 + (hq & 1) * 32;
            h16* bon = BONUS + (rowbase + p) * 256 + c0;
#pragma unroll
            for (int j = 0; j < 4; ++j) { const h16x8 rv = *(const LAS h16x8*)(RKV + t * LDR + c0 + 8 * j), kv = *(const LAS h16x8*)(RKV + t * LDR + 256 + c0 + 8 * j), vv = *(const LAS h16x8*)(RKV + t * LDR + 512 + c0 + 8 * j);
                const f32x4 kk0 = *(const f32x4*)(k_k + c0 + 8 * j), kk1 = *(const f32x4*)(k_k + c0 + 8 * j + 4);
                h16x8 kkv, bv;
#pragma unroll
                for (int i = 0; i < 8; ++i) { kkv[i] = (h16)((float)kv[i] * (i < 4 ? kk0[i & 3] : kk1[i & 3]) * rs); bv[i] = (h16)(bs * (float)vv[i]); }
                *(h16x8*)(rec + 8 * j) = rv; *(h16x8*)(rec + 64 + 8 * j) = vv; *(h16x8*)(rec + 128 + 8 * j) = kkv; *(h16x8*)(rec + 192 + 8 * j) = kv;
                *(h16x8*)(bon + 8 * j) = bv; asm volatile("" ::: "memory"); } }
        LDS_BARRIER();
        SUBREP(3) { const int c0 = wave * 32, h = wave >> 1, lr = (lane >> 4) * 4, lc = lane & 15;
#pragma unroll
            for (int nt = 0; nt < 2; ++nt)
#pragma unroll
                for (int ks = 0; ks < 4; ++ks) Bf[4][nt][ks] = *(const bf16x8*)(LW + 65536 + (size_t)(c0 + nt * 16 + (lane & 15)) * 128 + ks * 32 + (lane >> 4) * 8);
#pragma unroll
            for (int mm = 0; mm < 5; ++mm) {
                const LAS bf16* Ai = mm < 2 ? WLi : (mm < 4 ? ALi : GSi); const int lda = mm < 4 ? LD64 : LDG, nks = mm < 4 ? 2 : 4;
                f32x4 acc[4][2];
#pragma unroll
                for (int tt = 0; tt < 4; ++tt)
#pragma unroll
                    for (int nt = 0; nt < 2; ++nt) acc[tt][nt] = (f32x4){0.f, 0.f, 0.f, 0.f};
#pragma unroll
                for (int ks = 0; ks < 4; ++ks) if (ks < nks)
#pragma unroll
                    for (int tt = 0; tt < 4; ++tt) { const bf16x8 af = *(const LAS bf16x8*)(Ai + (tt * 16 + (lane & 15)) * lda + ks * 32 + (lane >> 4) * 8);
#pragma unroll
                        for (int nt = 0; nt < 2; ++nt) acc[tt][nt] = __builtin_amdgcn_mfma_f32_16x16x32_bf16(af, Bf[mm][nt][ks], acc[tt][nt], 0, 0, 0); }
                LAS h16* STG = (LAS h16*)F.lds + (mm & 1) * (64 * 264);
#pragma unroll
                for (int nt = 0; nt < 2; ++nt) { const int c = c0 + nt * 16 + lc;
                    const float bias = mm < 2 ? w0[mm * 256 + c] : (mm < 4 ? a0[(mm - 2) * 256 + c] : 0.f);
#pragma unroll
                    for (int tt = 0; tt < 4; ++tt)
#pragma unroll
                        for (int i = 0; i < 4; ++i) { const float x = acc[tt][nt][i] + bias; const float sg = sigm(x);
                            const float o = mm < 2 ? 1.f - __expf(-0.60653066f * sg) : (mm < 4 ? sg : x);
                            STG[(tt * 16 + lr + i) * 264 + c] = (h16)o; } }
                LDS_BARRIER();
#pragma unroll
                for (int i = 0; i < 4; ++i) { const int id = tid + 512 * i, t = id >> 5, ch = id & 31, hh = ch >> 3;
                    const h16x8 v = *(const LAS h16x8*)(STG + t * 264 + ch * 8);
                    h16* dst = mm < 2 ? RECD + ((((size_t)b * 4 + hh) * 2 + mm) * TB + p0 + t) * 128 + (ch & 7) * 8
                             : (mm < 4 ? RECD + ((((size_t)b * 4 + hh) * 2 + (mm - 2)) * TB + p0 + t) * 128 + 64 + (ch & 7) * 8 : GATE + (rowbase + p0 + t) * 256 + ch * 8);
                    *(h16x8*)dst = v; }
            } }
    }
}

__device__ __forceinline__ f32x4 mma16(f32x4 acc, const LAS bf16* A, int lda, const LAS bf16* Bt, int ldb, int lane) {
    const int r = lane & 15, kq = (lane >> 4) * 8;
    const bf16x8 a = *(const LAS bf16x8*)(A + r * lda + kq);
    const bf16x8 b = *(const LAS bf16x8*)(Bt + r * ldb + kq);
    return __builtin_amdgcn_mfma_f32_16x16x32_bf16(a, b, acc, 0, 0, 0);
}
typedef short v4i16 __attribute__((ext_vector_type(4)));
__device__ __forceinline__ bf16x8 frag_tr(const LAS bf16* T, int ld, int k0, int c0, int lane) {
    const int g = lane >> 4, q = (lane & 15) >> 2, p = lane & 3;
    const LAS bf16* a = T + (k0 + 8 * g + q) * ld + c0 + 4 * p;
    const v4i16 lo = __builtin_amdgcn_ds_read_tr16_b64_v4i16((LAS v4i16*)a);
    const v4i16 hi = __builtin_amdgcn_ds_read_tr16_b64_v4i16((LAS v4i16*)(a + 4 * ld));
    return (bf16x8){lo[0], lo[1], lo[2], lo[3], hi[0], hi[1], hi[2], hi[3]};
}
__device__ __forceinline__ bf16x8 frag_row(const LAS bf16* A, int lda, int lane) { return *(const LAS bf16x8*)(A + (lane & 15) * lda + (lane >> 4) * 8); }
template <int MT, int NT, int KS> __device__ __forceinline__ void mm_block(f32x4 (&acc)[MT][NT], const LAS bf16* A, int lda, const LAS bf16* Bt, int ldb, int lane) {
    bf16x8 af[MT][KS], bfr[NT][KS];
#pragma unroll
    for (int mi = 0; mi < MT; ++mi)
#pragma unroll
        for (int ks = 0; ks < KS; ++ks) af[mi][ks] = frag_row(A + mi * 16 * lda + ks * 32, lda, lane);
#pragma unroll
    for (int nt = 0; nt < NT; ++nt)
#pragma unroll
        for (int ks = 0; ks < KS; ++ks) bfr[nt][ks] = frag_row(Bt + nt * 16 * ldb + ks * 32, ldb, lane);
#pragma unroll
    for (int mi = 0; mi < MT; ++mi)
#pragma unroll
        for (int nt = 0; nt < NT; ++nt)
#pragma unroll
            for (int ks = 0; ks < KS; ++ks) acc[mi][nt] = __builtin_amdgcn_mfma_f32_16x16x32_bf16(af[mi][ks], bfr[nt][ks], acc[mi][nt], 0, 0, 0);
}
__device__ __forceinline__ float scan_incl(float v, int lane, bool rev) {
#pragma unroll
    for (int o = 1; o < 64; o <<= 1) { const float t = rev ? __shfl_down(v, o) : __shfl_up(v, o); if (rev ? (lane + o < 64) : (lane >= o)) v += t; }
    return v;
}


__device__ __forceinline__ void gla_bcs(const Frame& F, const AS4 Args* KA, size_t row0, LAS float* LG, LAS float* GLT) {
    const int tid = F.tid;
    const float* UM = (const float*)(F.ws + WS_UMISC); const float* ga2 = LP(28, 2 * 16 * 128); const float* gb = LP(29, 256);
    LDS_BARRIER();
    if (tid < 256) { const int s = tid >> 2, j4 = (tid & 3) * 4; *(LAS f32x4*)(GLT + s * 16 + j4) = *(const f32x4*)(UM + (row0 + s) * 32 + 8 + j4); }
    LDS_BARRIER();
    { const int ch2 = tid & 255, d = ch2 >> 7, ch = ch2 & 127, sh = tid >> 8;
        float w[16];
#pragma unroll
        for (int j = 0; j < 16; ++j) w[j] = ga2[(size_t)(d * 16 + j) * 128 + ch];
        const float bias = gb[d * 128 + ch];
#pragma unroll 4
        for (int t = 0; t < 32; ++t) { const int s = sh * 32 + t; float z = bias;
#pragma unroll
            for (int j4 = 0; j4 < 4; ++j4) { const f32x4 g4 = *(const LAS f32x4*)(GLT + s * 16 + j4 * 4); z += g4.x * w[j4 * 4] + g4.y * w[j4 * 4 + 1] + g4.z * w[j4 * 4 + 2] + g4.w * w[j4 * 4 + 3]; }
            LG[(d * 64 + s) * 128 + ch] = -softplusf_(-z) * (1.f / 16.f); } }
    LDS_BARRIER();
    if (tid < 256) { const int d = tid >> 7, ch = tid & 127; float a = 0.f;
#pragma unroll 8
        for (int t = 0; t < 64; ++t) { const int s = d ? 63 - t : t; a += LG[(d * 64 + s) * 128 + ch]; LG[(d * 64 + s) * 128 + ch] = a; } }
    LDS_BARRIER();
}
__device__ __forceinline__ void phase_combine_gla(const Frame& F0) {
    PH_ENTER(F0);
    const int gid = F.bid * 512 + F.tid;
    if (gid >= 64 * 1024) return;
    const int chain = gid >> 10, e0 = (gid & 1023) * 2, d = chain & 1, bh = chain >> 1, b = bh >> 2, h = bh & 3;
    bf16* GS = (bf16*)(F.ws + WS_GS) + (size_t)chain * NTILE64 * 2048 + e0; const float* GDEC = (const float*)(F.ws + WS_GDEC) + (size_t)b * NTILE64 * 256 + d * 128 + h * 32 + (e0 & 31);
    float S0 = 0.f, S1 = 0.f;
#pragma unroll 4
    for (int it = 0; it < NTILE64; ++it) {
        const int c = d == 0 ? it : (it < 4 ? 3 - it : 131 - (it - 4));
        unsigned* p = (unsigned*)(GS + (size_t)c * 2048); const unsigned st = *p; const f32x2 dec = *(const f32x2*)(GDEC + (size_t)c * 256);
        *p = pk2(S0, S1);
        S0 = S0 * dec.x + __uint_as_float(st << 16); S1 = S1 * dec.y + __uint_as_float(st & 0xffff0000u);
    }
}
__device__ __forceinline__ void phase_finish_gla(const Frame& F0) {
    PH_ENTER(F0);
    const AS4 Args* KA = kargs();
    const int tid = F.tid, lane = F.lane, wave = F.wave;
    const bf16* UG = (const bf16*)(F.ws + WS_UGLA); const bf16* GS = (const bf16*)(F.ws + WS_GS); bf16* MIX = (bf16*)(F.ws + WS_ACT);
    const float* gln = LP(30, 256);
    constexpr int LD32 = 40;
    LAS float* LG = (LAS float*)F.lds;
    LAS bf16* QE = (LAS bf16*)(F.lds + 65536);
    LAS bf16* KE = (LAS bf16*)(F.lds + 86016);
    LAS bf16* VT = (LAS bf16*)(F.lds + 96256);
    LAS bf16* ST = (LAS bf16*)(F.lds + 105472);
    LAS bf16* ATT = (LAS bf16*)(F.lds + 115712);
    LAS bf16* OB = (LAS bf16*)(F.lds + 124928);
    LAS float* RSQ = (LAS float*)(F.lds + 134144);
    LAS float* GLT = (LAS float*)(F.lds + 134656);
    LAS bf16* RT = (LAS bf16*)(F.lds + 138752);
    const int lt = wave & 3, cth = wave >> 2, lr = (lane >> 4) * 4, lc = lane & 15;
    const bool skipctx = F.l == 1;
    for (int j_ = F.G - 1 - F.bid; j_ < n_units(skipctx); j_ += F.G) {
        const int u = unit_of(skipctx, j_);
        const int b = u / NTILE64, c = u % NTILE64; const size_t row0 = (size_t)b * TB + (size_t)c * 64;
        u32x2 pq, pk; u32x4 pv, pst, prt;
        { const int l = tid >> 3, g4 = (tid & 7) * 4; const bf16* ur = UG + (row0 + l) * 768;
            pq = *(const u32x2*)(ur + g4); pk = *(const u32x2*)(ur + 128 + g4);
            pv = *(const u32x4*)(UG + (row0 + (tid & 63)) * 768 + 256 + (tid >> 6) * 8);
            { const int d = tid >> 8, r = (tid & 255) >> 2, ch = tid & 3; pst = *(const u32x4*)(GS + ((((size_t)b * 4) * 2 + d) * NTILE64 + c) * 2048 + r * 32 + ch * 8); }
            prt = *(const u32x4*)(UG + (row0 + (tid >> 3)) * 768 + 512 + (tid & 7) * 8); }
        gla_bcs(F, KA, row0, LG, GLT);
#pragma unroll 1
        for (int h = 0; h < 4; ++h) {
            { const int l = tid >> 3, g4 = (tid & 7) * 4, ch = h * 32 + g4;
                const u32x2 qr = pq, kr = pk;
                const float q[4] = { bf2f(qr.x & 0xffff) * 0.17677669529663687f, bf2f(qr.x >> 16) * 0.17677669529663687f, bf2f(qr.y & 0xffff) * 0.17677669529663687f, bf2f(qr.y >> 16) * 0.17677669529663687f };
                const float k[4] = { bf2f(kr.x & 0xffff), bf2f(kr.x >> 16), bf2f(kr.y & 0xffff), bf2f(kr.y >> 16) };
#pragma unroll
                for (int d = 0; d < 2; ++d) { const f32x4 bc = *(const LAS f32x4*)(LG + (d * 64 + l) * 128 + ch), rf = *(const LAS f32x4*)(LG + (d * 64 + 32) * 128 + ch);
                    float qe[4], ke[4], qb[4];
#pragma unroll
                    for (int i = 0; i < 4; ++i) { qe[i] = q[i] * __expf(bc[i] - rf[i]); ke[i] = k[i] * __expf(rf[i] - bc[i]); qb[i] = q[i] * __expf(bc[i]); }
                    u32x2 w; w.x = pk2(qe[0], qe[1]); w.y = pk2(qe[2], qe[3]); *(LAS u32x2*)(QE + (d * 64 + l) * LD32 + g4) = w;
                    w.x = pk2(qb[0], qb[1]); w.y = pk2(qb[2], qb[3]); *(LAS u32x2*)(QE + ((2 + d) * 64 + l) * LD32 + g4) = w;
                    w.x = pk2(ke[0], ke[1]); w.y = pk2(ke[2], ke[3]); *(LAS u32x2*)(KE + (d * 64 + l) * LD32 + g4) = w; } }
            { const int s = tid & 63, g8 = tid >> 6; const unsigned w[4] = {pv.x, pv.y, pv.z, pv.w};
#pragma unroll
                for (int i = 0; i < 8; ++i) VT[(g8 * 8 + i) * LD64 + s] = (bf16)(i & 1 ? w[i >> 1] >> 16 : w[i >> 1] & 0xffffu); }
            { const int d = tid >> 8, r = (tid & 255) >> 2, ch = tid & 3; *(LAS u32x4*)(ST + (d * 64 + r) * LD32 + ch * 8) = pst; }
            *(LAS u32x4*)(RT + (tid >> 3) * LD64 + (tid & 7) * 8) = prt;
            { const int hn = h < 3 ? h + 1 : 3; const int l = tid >> 3, g4 = (tid & 7) * 4; const bf16* ur = UG + (row0 + l) * 768;
                pq = *(const u32x2*)(ur + hn * 32 + g4); pk = *(const u32x2*)(ur + 128 + hn * 32 + g4);
                pv = *(const u32x4*)(UG + (row0 + (tid & 63)) * 768 + 256 + hn * 64 + (tid >> 6) * 8);
                { const int d = tid >> 8, r = (tid & 255) >> 2, ch = tid & 3; pst = *(const u32x4*)(GS + ((((size_t)b * 4 + hn) * 2 + d) * NTILE64 + c) * 2048 + r * 32 + ch * 8); }
                prt = *(const u32x4*)(UG + (row0 + (tid >> 3)) * 768 + 512 + hn * 64 + (tid & 7) * 8); }
            LDS_BARRIER();
#pragma unroll
            for (int j = 0; j < 2; ++j) { const int st = 2 * cth + j; const f32x4 z4 = {0.f, 0.f, 0.f, 0.f};
                const f32x4 af = mma16(z4, QE + (lt * 16) * LD32, LD32, KE + (st * 16) * LD32, LD32, lane);
                const f32x4 ab = mma16(z4, QE + (64 + lt * 16) * LD32, LD32, KE + (64 + st * 16) * LD32, LD32, lane);
                const int s = st * 16 + lc;
#pragma unroll
                for (int i = 0; i < 4; ++i) { const int l = lt * 16 + lr + i; ATT[l * LD64 + s] = (bf16)f2bf((s <= l ? af[i] : 0.f) + (s >= l ? ab[i] : 0.f)); } }
            LDS_BARRIER();
            f32x4 o[2];
#pragma unroll
            for (int j = 0; j < 2; ++j) { const int vt = 2 * cth + j; f32x4 acc = {0.f, 0.f, 0.f, 0.f};
#pragma unroll
                for (int ks = 0; ks < 2; ++ks) acc = mma16(acc, ATT + lt * 16 * LD64 + ks * 32, LD64, VT + vt * 16 * LD64 + ks * 32, LD64, lane);
                acc = mma16(acc, QE + (128 + lt * 16) * LD32, LD32, ST + (vt * 16) * LD32, LD32, lane);
                acc = mma16(acc, QE + (192 + lt * 16) * LD32, LD32, ST + (64 + vt * 16) * LD32, LD32, lane);
                o[j] = acc; }
#pragma unroll
            for (int i = 0; i < 4; ++i) { const float t = sum16(o[0][i] * o[0][i] + o[1][i] * o[1][i]); if (lc == 0) RSQ[cth * 64 + lt * 16 + lr + i] = t; }
            LDS_BARRIER();
#pragma unroll
            for (int j = 0; j < 2; ++j) { const int dv = (2 * cth + j) * 16 + lc; const float gn = gln[h * 64 + dv];
#pragma unroll
                for (int i = 0; i < 4; ++i) { const int l = lt * 16 + lr + i; const float scl = rsqrtf((RSQ[l] + RSQ[64 + l]) * (1.f / 64.f) + 1e-6f);
                    const float r = bf2f(RT[l * LD64 + dv]);
                    OB[l * LD64 + dv] = (bf16)f2bf(o[j][i] * scl * gn * siluf(r)); } }
            LDS_BARRIER();
            { const int r = tid >> 3, ch = tid & 7; *(u32x4*)(MIX + (row0 + r) * D + 768 + h * 64 + ch * 8) = *(const LAS u32x4*)(OB + r * LD64 + ch * 8); }
        }
    }
}

__device__ __forceinline__ void phase_states(const Frame& F0) {
    PH_ENTER(F0);
    const AS4 Args* KA = kargs();
    const int tid = F.tid, lane = F.lane, wave = F.wave;
    const bf16* XBCA = (const bf16*)(F.ws + WS_XBCA); const float* UM = (const float*)(F.ws + WS_UMISC);
    bf16* SS = (bf16*)(F.ws + WS_SS); float* SDEC = (float*)(F.ws + WS_SDEC);
    const float* dtb = LP(24, 16); const float* alog = LP(25, 16);
    LAS bf16* CT = (LAS bf16*)F.lds;
    LAS bf16* XTW = (LAS bf16*)(F.lds + 99328);
    LAS bf16* BT = (LAS bf16*)(F.lds + 117760);
    LAS float* WTS = (LAS float*)(F.lds + 136192);
    const bf16* UG = (const bf16*)(F.ws + WS_UGLA); bf16* GS = (bf16*)(F.ws + WS_GS); float* GDEC = (float*)(F.ws + WS_GDEC);
    LAS float* LG = (LAS float*)F.lds;
    LAS bf16* VT4 = (LAS bf16*)(F.lds + 65536);
    LAS bf16* KTE = (LAS bf16*)(F.lds + 102400);
    LAS float* GLT = (LAS float*)(F.lds + 139264);
    for (int u = F.G - 1 - F.bid; u < NUNIT64; u += F.G) {
        const int b = u / NTILE64, c = u % NTILE64; const size_t row0 = (size_t)b * TB + (size_t)c * 64;
        LDS_BARRIER();
#pragma unroll
        for (int i = 0; i < 12; ++i) { const int id = tid + 512 * i, r = id / 96, ch = id % 96;
            *(LAS u32x4*)(CT + r * 776 + ch * 8) = *(const u32x4*)(XBCA + (row0 + r) * 768 + ch * 8); }
#pragma unroll
        for (int j = 0; j < 2; ++j) { const int q = wave * 2 + j, h = q >> 1, d = q & 1;
            const float dtp = softplusf_(UM[(row0 + lane) * 32 + h] + dtb[d * 8 + h]);
            const float dA = -__expf(alog[d * 8 + h]) * dtp;
            const float cs = scan_incl(dA, lane, d == 1);
            const float ce = __shfl(cs, d == 0 ? 63 : 0);
            WTS[q * 64 + lane] = __expf(ce - cs) * dtp;
            if (lane == 0) SDEC[((size_t)b * NTILE64 + c) * 16 + q] = __expf(ce); }
        LDS_BARRIER();
#pragma unroll 1
        for (int hp = 0; hp < 4; ++hp) {
            { const int sr = tid >> 3, ch = tid & 7, g = hp >> 1; float bv[8]; unpack8(*(const LAS u32x4*)(CT + sr * 776 + 512 + g * 64 + ch * 8), bv);
#pragma unroll
                for (int q = 0; q < 4; ++q) { const float w = WTS[(hp * 4 + q) * 64 + sr]; float o[8];
#pragma unroll
                    for (int i = 0; i < 8; ++i) o[i] = bv[i] * w;
                    *(LAS u32x4*)(XTW + (q * 64 + sr) * LD64 + ch * 8) = pack8(o); } }
            LDS_BARRIER();
            { const int d = wave >> 2, mt = wave & 3;
#pragma unroll
                for (int hh = 0; hh < 2; ++hh) { const int h = hp * 2 + hh;
                    bf16* dst = SS + ((((size_t)b * 8 + h) * 2 + d) * NTILE64 + c) * 4096;
                    bf16x8 af[2];
#pragma unroll
                    for (int ks = 0; ks < 2; ++ks) af[ks] = frag_tr(CT, 776, ks * 32, h * 64 + mt * 16, lane);
#pragma unroll
                    for (int nt = 0; nt < 4; ++nt) { f32x4 acc = {0.f, 0.f, 0.f, 0.f};
#pragma unroll
                        for (int ks = 0; ks < 2; ++ks) acc = __builtin_amdgcn_mfma_f32_16x16x32_bf16(af[ks], frag_tr(XTW + (hh * 2 + d) * 64 * LD64, LD64, ks * 32, nt * 16, lane), acc, 0, 0, 0);
#pragma unroll
                        for (int i = 0; i < 4; ++i) dst[(mt * 16 + (lane >> 4) * 4 + i) * 64 + nt * 16 + (lane & 15)] = (bf16)f2bf(acc[i]); } } }
            LDS_BARRIER();
        }
        gla_bcs(F, KA, row0, LG, GLT);
        if (tid < 256) GDEC[((size_t)b * NTILE64 + c) * 256 + tid] = __expf(LG[((tid >> 7) * 64 + ((tid >> 7) ? 0 : 63)) * 128 + (tid & 127)]);
        { const int sr = tid >> 3, q8 = tid & 7; const bf16* ur = UG + (row0 + sr) * 768;
#pragma unroll
            for (int i = 0; i < 4; ++i) { const int col = (q8 * 4 + i) * 8; *(LAS u32x4*)(VT4 + sr * 264 + col) = *(const u32x4*)(ur + 256 + col); }
#pragma unroll
            for (int i = 0; i < 2; ++i) { const int col = (q8 * 2 + i) * 8; float kv[8]; unpack8(*(const u32x4*)(ur + 128 + col), kv);
#pragma unroll
                for (int d = 0; d < 2; ++d) { const LAS float* be = LG + (d * 64 + (d ? 0 : 63)) * 128 + col; const LAS float* bc = LG + (d * 64 + sr) * 128 + col; float o[8];
#pragma unroll
                    for (int k = 0; k < 8; ++k) o[k] = kv[k] * __expf(be[k] - bc[k]);
                    *(LAS u32x4*)(KTE + (d * 64 + sr) * 136 + col) = pack8(o); } } }
        LDS_BARRIER();
        { const int d = wave >> 2, mt = wave & 3;
#pragma unroll
            for (int h = 0; h < 4; ++h) { bf16* dst = GS + ((((size_t)b * 4 + h) * 2 + d) * NTILE64 + c) * 2048;
                bf16x8 af[2];
#pragma unroll
                for (int ks = 0; ks < 2; ++ks) af[ks] = frag_tr(VT4, 264, ks * 32, h * 64 + mt * 16, lane);
#pragma unroll
                for (int nt = 0; nt < 2; ++nt) { f32x4 acc = {0.f, 0.f, 0.f, 0.f};
#pragma unroll
                    for (int ks = 0; ks < 2; ++ks) acc = __builtin_amdgcn_mfma_f32_16x16x32_bf16(af[ks], frag_tr(KTE + d * 64 * 136, 136, ks * 32, h * 32 + nt * 16, lane), acc, 0, 0, 0);
#pragma unroll
                    for (int i = 0; i < 4; ++i) dst[(mt * 16 + (lane >> 4) * 4 + i) * 32 + nt * 16 + (lane & 15)] = (bf16)f2bf(acc[i]); } } }
    }
}
__device__ __forceinline__ void phase_combine_ssd(const Frame& F0) {
    PH_ENTER(F0);
    const int gid = F.bid * 512 + F.tid;
    if (gid >= 128 * 1024) return;
    const int chain = gid >> 10, e0 = (gid & 1023) * 4, d = chain & 1, bh = chain >> 1, b = bh >> 3, h = bh & 7;
    bf16* SS = (bf16*)(F.ws + WS_SS) + (size_t)chain * NTILE64 * 4096 + e0; const float* SDEC = (const float*)(F.ws + WS_SDEC) + (size_t)b * NTILE64 * 16 + h * 2 + d;
    float S0 = 0.f, S1 = 0.f, S2 = 0.f, S3 = 0.f;
#pragma unroll 4
    for (int it = 0; it < NTILE64; ++it) {
        const int c = d == 0 ? it : (it < 4 ? 3 - it : 131 - (it - 4));
        u32x2* p = (u32x2*)(SS + (size_t)c * 4096); const u32x2 st = *p; const float dec = SDEC[c * 16];
        u32x2 o; o.x = pk2(S0, S1); o.y = pk2(S2, S3); *p = o;
        S0 = S0 * dec + __uint_as_float(st.x << 16); S1 = S1 * dec + __uint_as_float(st.x & 0xffff0000u); S2 = S2 * dec + __uint_as_float(st.y << 16); S3 = S3 * dec + __uint_as_float(st.y & 0xffff0000u);
    }
}
__device__ __forceinline__ void phase_finish_ssd(const Frame& F0) {
    PH_ENTER(F0);
    const AS4 Args* KA = kargs();
    const int tid = F.tid, lane = F.lane, wave = F.wave;
    const bf16* XBCA = (const bf16*)(F.ws + WS_XBCA); const float* UM = (const float*)(F.ws + WS_UMISC); const bf16* UZ = (const bf16*)(F.ws + WS_UZ);
    const bf16* SS = (const bf16*)(F.ws + WS_SS); bf16* MIX = (bf16*)(F.ws + WS_ACT);
    const float* dtb = LP(24, 16); const float* alog = LP(25, 16); const float* dsk = LP(26, 8); const float* sng = LP(27, 512);
    LAS bf16* CB = (LAS bf16*)F.lds;
    LAS bf16* BI = (LAS bf16*)(F.lds + 18432);
    LAS bf16* XT = (LAS bf16*)(F.lds + 18432);
    LAS bf16* MI = (LAS bf16*)(F.lds + 27648);
    LAS bf16* SFB = (LAS bf16*)(F.lds + 36864);
    LAS float* ACS = (LAS float*)(F.lds + 55296);
    LAS float* RSQ = (LAS float*)(F.lds + 63488);
    LAS bf16* GB = (LAS bf16*)(F.lds + 64000);
    LAS bf16* ZT = (LAS bf16*)(F.lds + 129536);
    const int lt = wave & 3, cth = wave >> 2, lr = (lane >> 4) * 4, lc = lane & 15;
    const bool skipctx = F.l == 1;
    for (int j_ = F.bid; j_ < n_units(skipctx); j_ += F.G) {
        const int u = unit_of(skipctx, j_);
        const int b = u / NTILE64, c = u % NTILE64; const size_t row0 = (size_t)b * TB + (size_t)c * 64;
        u32x4 pxt, psf, psb, pzt;
        { const int s_ = tid & 63, pg = tid >> 6, r = tid >> 3, ch = tid & 7;
            pxt = *(const u32x4*)(XBCA + (row0 + r) * 768 + ch * 8);
            psf = *(const u32x4*)(SS + ((((size_t)b * 8) * 2 + 0) * NTILE64 + c) * 4096 + r * 64 + ch * 8); psb = *(const u32x4*)(SS + ((((size_t)b * 8) * 2 + 1) * NTILE64 + c) * 4096 + r * 64 + ch * 8);
            pzt = *(const u32x4*)(UZ + (row0 + r) * 512 + ch * 8); }
        LDS_BARRIER();
#pragma unroll
        for (int i = 0; i < 4; ++i) { const int id = tid + 512 * i, r = id >> 5, ch = id & 31;
            const int which = ch >> 3;
            LAS bf16* dst = (which < 2 ? BI + (which * 64 + r) * LD64 : CB + ((which - 2) * 64 + r) * LD64) + (ch & 7) * 8;
            *(LAS u32x4*)dst = *(const u32x4*)(XBCA + (row0 + r) * 768 + 512 + ch * 8); }
        { const int h = wave;
#pragma unroll
            for (int d = 0; d < 2; ++d) { const float dtp = softplusf_(UM[(row0 + lane) * 32 + h] + dtb[d * 8 + h]);
                const float cs = scan_incl(-__expf(alog[d * 8 + h]) * dtp, lane, d == 1);
                ACS[(d * 8 + h) * 64 + lane] = cs; ACS[((2 + d) * 8 + h) * 64 + lane] = dtp; } }
        LDS_BARRIER();
        f32x4 G00 = {0.f, 0.f, 0.f, 0.f}, G01 = G00, G10 = G00, G11 = G00;
#pragma unroll
        for (int ks = 0; ks < 2; ++ks) {
            G00 = mma16(G00, CB + (lt * 16) * LD64 + ks * 32, LD64, BI + ((2 * cth) * 16) * LD64 + ks * 32, LD64, lane);
            G01 = mma16(G01, CB + (lt * 16) * LD64 + ks * 32, LD64, BI + ((2 * cth + 1) * 16) * LD64 + ks * 32, LD64, lane);
            G10 = mma16(G10, CB + (64 + lt * 16) * LD64 + ks * 32, LD64, BI + (64 + (2 * cth) * 16) * LD64 + ks * 32, LD64, lane);
            G11 = mma16(G11, CB + (64 + lt * 16) * LD64 + ks * 32, LD64, BI + (64 + (2 * cth + 1) * 16) * LD64 + ks * 32, LD64, lane); }
        LDS_BARRIER();
        f32x4 rsq = {0.f, 0.f, 0.f, 0.f};
#pragma unroll 1
        for (int h = 0; h < 8; ++h) {
            const int g = h >> 2;
            { const int r = tid >> 3, ch = tid & 7;
                *(LAS u32x4*)(XT + r * LD64 + ch * 8) = pxt;
                *(LAS u32x4*)(SFB + r * LD64 + ch * 8) = psf; *(LAS u32x4*)(SFB + (64 + r) * LD64 + ch * 8) = psb; *(LAS u32x4*)(ZT + r * LD64 + ch * 8) = pzt;
                const int hn = h < 7 ? h + 1 : 7;
                pxt = *(const u32x4*)(XBCA + (row0 + r) * 768 + hn * 64 + ch * 8);
                psf = *(const u32x4*)(SS + ((((size_t)b * 8 + hn) * 2 + 0) * NTILE64 + c) * 4096 + r * 64 + ch * 8); psb = *(const u32x4*)(SS + ((((size_t)b * 8 + hn) * 2 + 1) * NTILE64 + c) * 4096 + r * 64 + ch * 8);
                pzt = *(const u32x4*)(UZ + (row0 + r) * 512 + hn * 64 + ch * 8); }
            const LAS float* af = ACS + h * 64; const LAS float* ab = ACS + (8 + h) * 64; const LAS float* pf = ACS + (16 + h) * 64; const LAS float* pb = ACS + (24 + h) * 64;
#pragma unroll
            for (int j = 0; j < 2; ++j) { const int s = (2 * cth + j) * 16 + lc; const float afs = af[s], abs_ = ab[s], pfs = pf[s], pbs = pb[s];
                const f32x4 gt = g ? (j ? G11 : G10) : (j ? G01 : G00);
#pragma unroll
                for (int i = 0; i < 4; ++i) { const int l = lt * 16 + lr + i;
                    const float wf = s <= l ? __expf(af[l] - afs) * pfs : 0.f, wb = s >= l ? __expf(ab[l] - abs_) * pbs : 0.f;
                    MI[l * LD64 + s] = (bf16)f2bf(gt[i] * (wf + wb)); } }
            LDS_BARRIER();
#pragma unroll
            for (int j = 0; j < 2; ++j) { const int pt = 2 * cth + j; f32x4 acc = {0.f, 0.f, 0.f, 0.f}, tf = {0.f, 0.f, 0.f, 0.f}, tb = {0.f, 0.f, 0.f, 0.f};
#pragma unroll
                for (int ks = 0; ks < 2; ++ks) { acc = __builtin_amdgcn_mfma_f32_16x16x32_bf16(frag_row(MI + lt * 16 * LD64 + ks * 32, LD64, lane), frag_tr(XT, LD64, ks * 32, pt * 16, lane), acc, 0, 0, 0);
                    tf = mma16(tf, CB + (g * 64 + lt * 16) * LD64 + ks * 32, LD64, SFB + pt * 16 * LD64 + ks * 32, LD64, lane);
                    tb = mma16(tb, CB + (g * 64 + lt * 16) * LD64 + ks * 32, LD64, SFB + (64 + pt * 16) * LD64 + ks * 32, LD64, lane); }
                const int p = pt * 16 + lc; const float ds = dsk[h];
#pragma unroll
                for (int i = 0; i < 4; ++i) { const int l = lt * 16 + lr + i;
                    const float y = acc[i] + __expf(af[l]) * tf[i] + __expf(ab[l]) * tb[i];
                    const float xs = bf2f(XT[l * LD64 + p]), z = bf2f(ZT[l * LD64 + p]);
                    const float gv = (y + ds * xs) * siluf(z); GB[l * 512 + h * 64 + p] = (bf16)f2bf(gv); rsq[i] += gv * gv; } }
            LDS_BARRIER();
        }
#pragma unroll
        for (int i = 0; i < 4; ++i) { const float t = sum16(rsq[i]); if (lc == 0) RSQ[cth * 64 + lt * 16 + lr + i] = t; }
        LDS_BARRIER();
#pragma unroll
        for (int i = 0; i < 8; ++i) { const int id = tid + 512 * i, r = id >> 6, ch = id & 63;
            const float scl = rsqrtf((RSQ[r] + RSQ[64 + r]) * (1.f / 512.f) + 1e-6f);
            float v[8]; unpack8(*(const LAS u32x4*)(GB + r * 512 + ch * 8), v);
            const f32x4 n0 = *(const f32x4*)(sng + ch * 8), n1 = *(const f32x4*)(sng + ch * 8 + 4);
#pragma unroll
            for (int k = 0; k < 4; ++k) { v[k] *= scl * n0[k]; v[4 + k] *= scl * n1[k]; }
            *(u32x4*)(MIX + (row0 + r) * D + 256 + ch * 8) = pack8(v); }
    }
}


__device__ __forceinline__ bf16* rw_out(unsigned char* ws, int b, int h, int d, int c, int which) {
    h16* RECS = (h16*)(ws + WS_RECS); h16* RECD = (h16*)(ws + WS_RECD); const size_t p0 = (size_t)c * 64;
    if (d == 0) return (bf16*)(RECS + (((size_t)b * 4 + h) * TB + p0) * 256) + which * 4096;
    return (bf16*)(RECD + ((((size_t)b * 4 + h) * 2 + (which >> 1)) * TB + p0) * 128) + (which & 1) * 4096;
}
__device__ __forceinline__ void phase_rwkv_local(const Frame& F0) {
    PH_ENTER(F0);
    const AS4 Args* KA = kargs();
    const int tid0 = F.tid, wave = F.wave;
#define RL_STEP const int tid = launder_i(tid0); const int lane = tid & 63; const int lr = (lane >> 4) * 4, lc = lane & 15;
    const h16* RECS = (const h16*)(F.ws + WS_RECS); const h16* RECD = (const h16*)(F.ws + WS_RECD);
    float* RPL = (float*)(F.ws + WS_RPL);
    const float* k_a = LP(18, 256);
    constexpr int LDS_S = 264, LDS_D = 136, LDF = 68;
    LAS h16* STS = (LAS h16*)F.lds;
    LAS h16* STD = (LAS h16*)(F.lds + 33792);
    LAS float* AABF = (LAS float*)(F.lds + 33792);
    LAS bf16* ULT = (LAS bf16*)(F.lds + 33792);
    LAS float* TF = (LAS float*)(F.lds + 51200);
    LAS bf16* AVT = (LAS bf16*)(F.lds + 51200); LAS bf16* W0T = (LAS bf16*)(F.lds + 60416);
    LAS bf16* NAT = (LAS bf16*)(F.lds + 69632);
    LAS bf16* TRN = (LAS bf16*)(F.lds + 106496);
    LAS bf16* R0I = (LAS bf16*)(F.lds + 143360);
    LAS float* M1 = (LAS float*)(F.lds + 152576);
    LAS float* GSUM = (LAS float*)(F.lds + 157184);
    h16x8 ps[4], pd[2];
#define RL_LOAD_S(uu) do { const int h_ = (uu) & 3, bc_ = (uu) >> 2, b_ = bc_ / NTILE64, c_ = bc_ % NTILE64; const h16* src = RECS + (((size_t)b_ * 4 + h_) * TB + (size_t)c_ * 64) * 256; \
        _Pragma("unroll") for (int i = 0; i < 4; ++i) { const int id = launder_i(tid0) + 512 * i, r = id >> 5, ch = id & 31; ps[i] = *(const h16x8*)(src + (size_t)r * 256 + ch * 8); } } while (0)
#define RL_LOAD_D(uu, dd) do { const int h_ = (uu) & 3, bc_ = (uu) >> 2, b_ = bc_ / NTILE64, c_ = bc_ % NTILE64; const h16* src = RECD + ((((size_t)b_ * 4 + h_) * 2 + (dd)) * TB + (size_t)c_ * 64) * 128; \
        _Pragma("unroll") for (int i = 0; i < 2; ++i) { const int id = launder_i(tid0) + 512 * i, r = id >> 4, ch = id & 15; pd[i] = *(const h16x8*)(src + (size_t)r * 128 + ch * 8); } } while (0)
    if (F.bid < NUNIT64 * 4) { RL_LOAD_S(F.bid); RL_LOAD_D(F.bid, 0); }
    for (int u = F.bid; u < NUNIT64 * 4; u += F.G) {
        const int h = u & 3, bc = u >> 2, b = bc / NTILE64, c = bc % NTILE64;
        LDS_BARRIER();
        { RL_STEP
#pragma unroll
            for (int i = 0; i < 4; ++i) { const int id = tid + 512 * i, r = id >> 5, ch = id & 31; *(LAS h16x8*)(STS + r * LDS_S + ch * 8) = ps[i]; } }
#pragma unroll 1
        for (int d = 0; d < 2; ++d) {
            LDS_BARRIER();
            { RL_STEP
#pragma unroll
                for (int i = 0; i < 2; ++i) { const int id = tid + 512 * i, r = id >> 4, ch = id & 15; *(LAS h16x8*)(STD + r * LDS_D + ch * 8) = pd[i]; } }
            if (d == 0) RL_LOAD_D(u, 1); else if (u + F.G < NUNIT64 * 4) { RL_LOAD_S(u + F.G); RL_LOAD_D(u + F.G, 0); }
            LDS_BARRIER();
            SUBREP(8) { RL_STEP const int kp = tid & 31, tg = tid >> 5, k = 2 * kp;
                f32x2 wv[4], li[4]; f32x2 run = {1.f, 1.f};
#pragma unroll
                for (int i = 0; i < 4; ++i) { const int t = tg * 4 + i, srow = d ? 63 - t : t; const unsigned raw = *(const LAS unsigned*)(STD + srow * LDS_D + k);
                    const h16 o0 = __builtin_bit_cast(h16, (unsigned short)(raw & 0xffff)), o1 = __builtin_bit_cast(h16, (unsigned short)(raw >> 16));
                    wv[i] = (f32x2){1.f - (float)o0, 1.f - (float)o1}; run = run * wv[i]; li[i] = run; }
                *(LAS f32x2*)(GSUM + tg * 64 + k) = run;
                for (int i = tid; i < 64 * LDF; i += 512) TF[i] = 0.f;
                LDS_BARRIER();
                f32x2 off = {1.f, 1.f}, pref = {1.f, 1.f}, pend = {1.f, 1.f};
#pragma unroll
                for (int g = 0; g < 16; ++g) { const f32x2 gs = *(const LAS f32x2*)(GSUM + g * 64 + k); if (g < tg) off = off * gs; if (g < 8) pref = pref * gs; pend = pend * gs; }
                const f32x2 kac = *(const f32x2*)(k_a + h * 64 + k);
                const f32x2 ipref = {1.f / pref.x, 1.f / pref.y};
                f32x2 pexcl = off;
                unsigned vt[4], a0t[4], bht[4], kht[4];
#pragma unroll
                for (int i = 0; i < 4; ++i) { const int t = tg * 4 + i, srow = d ? 63 - t : t;
                    const f32x2 pin = off * li[i];
                    const unsigned rr = *(const LAS unsigned*)(STS + srow * LDS_S + k), vr = *(const LAS unsigned*)(STS + srow * LDS_S + 64 + k), kkr = *(const LAS unsigned*)(STS + srow * LDS_S + 128 + k), kxr = *(const LAS unsigned*)(STS + srow * LDS_S + 192 + k);
                    const unsigned ar_ = *(const LAS unsigned*)(STD + srow * LDS_D + 64 + k);
#define H2F(x, hi) ((float)__builtin_bit_cast(h16, (unsigned short)((hi) ? ((x) >> 16) : ((x) & 0xffff))))
                    const f32x2 r = {H2F(rr, 0), H2F(rr, 1)}, vv = {H2F(vr, 0), H2F(vr, 1)}, kk = {H2F(kkr, 0), H2F(kkr, 1)}, kx = {H2F(kxr, 0), H2F(kxr, 1)}, av = {H2F(ar_, 0), H2F(ar_, 1)};
#undef H2F
                    const f32x2 kmod = kx * ((av - 1.f) * kac + 1.f), bb = kk * av;
                    const f32x2 ipin = {1.f / pin.x, 1.f / pin.y};
                    const f32x2 e1 = pexcl * ipref, e2 = pin * ipref, e3 = pref * ipin, eL = pend * ipin;
                    const f32x2 at = -kk * e1, rt = r * e2, bt = bb * e3, kt = kmod * e3, r0 = r * pin, a0 = -kk * pexcl, bh = bb * eL, kh = kmod * eL;
                    *(LAS unsigned*)(NAT + (0 * 64 + t) * LD64 + k) = pk2(at.x, at.y); *(LAS unsigned*)(NAT + (1 * 64 + t) * LD64 + k) = pk2(rt.x, rt.y);
                    *(LAS unsigned*)(NAT + (2 * 64 + t) * LD64 + k) = pk2(bt.x, bt.y); *(LAS unsigned*)(NAT + (3 * 64 + t) * LD64 + k) = pk2(kt.x, kt.y);
                    *(LAS unsigned*)(R0I + t * LD64 + k) = pk2(r0.x, r0.y);
                    vt[i] = pk2(vv.x, vv.y); a0t[i] = pk2(a0.x, a0.y); bht[i] = pk2(bh.x, bh.y); kht[i] = pk2(kh.x, kh.y);
                    pexcl = pin; }
#define TR_WR(SLOT, ARR) do { u32x2 lo, hi; lo.x = (ARR[0] & 0xffffu) | (ARR[1] << 16); lo.y = (ARR[2] & 0xffffu) | (ARR[3] << 16); hi.x = (ARR[0] >> 16) | (ARR[1] & 0xffff0000u); hi.y = (ARR[2] >> 16) | (ARR[3] & 0xffff0000u); \
                    *(LAS u32x2*)(TRN + ((SLOT) * 64 + k) * LD64 + tg * 4) = lo; *(LAS u32x2*)(TRN + ((SLOT) * 64 + k + 1) * LD64 + tg * 4) = hi; } while (0)
                TR_WR(0, vt); TR_WR(1, a0t); TR_WR(2, bht); TR_WR(3, kht);
#undef TR_WR
                if (tg == 15) *(f32x2*)(RPL + (((((size_t)b * 4 + h) * 2 + d) * NTILE64) + c) * 64 + k) = pend; }
            LDS_BARRIER();
            { RL_STEP const int pr = wave >> 1, rh = wave & 1; f32x4 acc[2][4];
#pragma unroll
                for (int mi = 0; mi < 2; ++mi)
#pragma unroll
                    for (int nt = 0; nt < 4; ++nt) acc[mi][nt] = (f32x4){0.f, 0.f, 0.f, 0.f};
                mm_block<2, 4, 2>(acc, NAT + ((pr >> 1) * 64 + (2 * rh) * 16) * LD64, LD64, NAT + ((2 + (pr & 1)) * 64) * LD64, LD64, lane);
                LDS_BARRIER();
#pragma unroll
                for (int mi = 0; mi < 2; ++mi)
#pragma unroll
                    for (int nt = 0; nt < 4; ++nt)
#pragma unroll
                        for (int i = 0; i < 4; ++i) { const int t = (2 * rh + mi) * 16 + lr + i, ii = nt * 16 + lc;
                            const float v = (pr < 2 ? ii < t : ii <= t) ? acc[mi][nt][i] : 0.f;
                            if (pr == 0) AABF[t * LDF + ii] = v; else NAT[((pr - 1) * 64 + t) * LD64 + ii] = (bf16)f2bf(v); } }
            LDS_BARRIER();
            SUBREP(9) if (wave == 0) { RL_STEP const int blk = lane >> 4, j = lane & 15; float Tr[16]; const LAS float* ab = AABF + (blk * 16) * LDF + blk * 16;
#pragma unroll
                for (int t = 0; t < 16; ++t) { float a0 = (j == t) ? 1.f : 0.f, a1 = 0.f;
#pragma unroll
                    for (int i4 = 0; i4 < t; i4 += 4) { const f32x4 av = *(const LAS f32x4*)(ab + t * LDF + i4);
                        a0 += av.x * Tr[i4]; if (i4 + 1 < t) a1 += av.y * Tr[i4 + 1]; if (i4 + 2 < t) a0 += av.z * Tr[i4 + 2]; if (i4 + 3 < t) a1 += av.w * Tr[i4 + 3]; }
                    Tr[t] = a0 + a1; TF[(blk * 16 + t) * LDF + blk * 16 + j] = Tr[t]; } }
            LDS_BARRIER();
            SUBREP(10) {
#define RL_LEVEL(M, ACTIVE, PP, TT, J0) do { \
                { RL_STEP if (ACTIVE) { const int pp = (PP), t = (TT), j0 = (J0), rb = pp * 2 * (M) + (M), cb = pp * 2 * (M); f32x2 mm = {0.f, 0.f}; \
                    _Pragma("unroll") for (int i = 0; i < (M); i += 4) { const f32x4 av = *(const LAS f32x4*)(AABF + (rb + t) * LDF + cb + i); \
                        mm += av.x * *(const LAS f32x2*)(TF + (cb + i) * LDF + cb + j0) + av.y * *(const LAS f32x2*)(TF + (cb + i + 1) * LDF + cb + j0) + av.z * *(const LAS f32x2*)(TF + (cb + i + 2) * LDF + cb + j0) + av.w * *(const LAS f32x2*)(TF + (cb + i + 3) * LDF + cb + j0); } \
                    *(LAS f32x2*)(M1 + pp * 576 + t * 36 + j0) = mm; } } \
                LDS_BARRIER(); \
                { RL_STEP if (ACTIVE) { const int pp = (PP), t = (TT), j0 = (J0), rb = pp * 2 * (M) + (M), cb = pp * 2 * (M); f32x2 xx = {0.f, 0.f}; \
                    _Pragma("unroll") for (int q = 0; q < (M); q += 4) { const f32x4 tv = *(const LAS f32x4*)(TF + (rb + t) * LDF + rb + q); \
                        xx += tv.x * *(const LAS f32x2*)(M1 + pp * 576 + q * 36 + j0) + tv.y * *(const LAS f32x2*)(M1 + pp * 576 + (q + 1) * 36 + j0) + tv.z * *(const LAS f32x2*)(M1 + pp * 576 + (q + 2) * 36 + j0) + tv.w * *(const LAS f32x2*)(M1 + pp * 576 + (q + 3) * 36 + j0); } \
                    *(LAS f32x2*)(TF + (rb + t) * LDF + cb + j0) = xx; } } \
                LDS_BARRIER(); } while (0)
                RL_LEVEL(16, tid < 256, tid >> 7, (tid >> 3) & 15, (tid & 7) * 2);
                RL_LEVEL(32, true, 0, tid >> 4, (tid & 15) * 2);
#undef RL_LEVEL
            }
            { RL_STEP const int t = tid >> 3, i0 = (tid & 7) * 8; float v[8];
#pragma unroll
                for (int i = 0; i < 8; ++i) v[i] = TF[t * LDF + i0 + i];
                *(LAS u32x4*)(NAT + (3 * 64 + t) * LD64 + i0) = pack8(v); }
            LDS_BARRIER();
            SUBREP(11) { RL_STEP const int pr = wave >> 2, mt = wave & 3; f32x4 acc[4];
#pragma unroll
                for (int nt = 0; nt < 4; ++nt) acc[nt] = (f32x4){0.f, 0.f, 0.f, 0.f};
                { f32x4 (&a2)[1][4] = *reinterpret_cast<f32x4 (*)[1][4]>(&acc); mm_block<1, 4, 2>(a2, TRN + (pr * 64 + mt * 16) * LD64, LD64, NAT + ((pr ? 3 : 0) * 64) * LD64, LD64, lane); }
                LAS bf16* dst = pr ? W0T : AVT;
#pragma unroll
                for (int nt = 0; nt < 4; ++nt)
#pragma unroll
                    for (int i = 0; i < 4; ++i) dst[(mt * 16 + lr + i) * LD64 + nt * 16 + lc] = (bf16)f2bf(acc[nt][i]); }
            LDS_BARRIER();
            SUBREP(11) { RL_STEP const int mt = wave & 3, nh = wave >> 2;
#pragma unroll
                for (int nn = 0; nn < 2; ++nn) { const int nt = 2 * nh + nn; f32x4 a4 = {0.f, 0.f, 0.f, 0.f};
#pragma unroll
                    for (int ks = 0; ks < 2; ++ks) a4 = mma16(a4, AVT + (mt * 16) * LD64 + ks * 32, LD64, NAT + (3 * 64 + nt * 16) * LD64 + ks * 32, LD64, lane);
#pragma unroll
                    for (int i = 0; i < 4; ++i) ULT[(mt * 16 + lr + i) * LD64 + nt * 16 + lc] = (bf16)f2bf(a4[i]); } }
            LDS_BARRIER();
            { RL_STEP const int o = wave >> 1, rh = wave & 1;
                const LAS bf16* A1 = o == 0 ? TRN + 2 * 64 * LD64 : (o == 1 ? ULT : NAT + 1 * 64 * LD64);
                const LAS bf16* B1 = o == 0 ? W0T : (o == 1 ? TRN + 2 * 64 * LD64 : (o == 2 ? W0T : ULT));
                const LAS bf16* A2 = o == 1 ? TRN : NAT + 2 * 64 * LD64;
                const LAS bf16* B2 = o == 1 ? TRN + 3 * 64 * LD64 : TRN;
                f32x4 res[2][4];
#pragma unroll
                for (int mi = 0; mi < 2; ++mi)
#pragma unroll
                    for (int nt = 0; nt < 4; ++nt) res[mi][nt] = (f32x4){0.f, 0.f, 0.f, 0.f};
                mm_block<2, 4, 2>(res, A1 + (2 * rh * 16) * LD64, LD64, B1, LD64, lane);
                if (o == 1 || o == 3) mm_block<2, 4, 2>(res, A2 + (2 * rh * 16) * LD64, LD64, B2, LD64, lane);
                if (o == 2) {
#pragma unroll
                    for (int mi = 0; mi < 2; ++mi)
#pragma unroll
                        for (int nt = 0; nt < 4; ++nt)
#pragma unroll
                            for (int i = 0; i < 4; ++i) { const int rr = (2 * rh + mi) * 16 + lr + i, cc = nt * 16 + lc; res[mi][nt][i] += bf2f(R0I[rr * LD64 + cc]); } }
                LDS_BARRIER();
#pragma unroll
                for (int mi = 0; mi < 2; ++mi)
#pragma unroll
                    for (int nt = 0; nt < 4; ++nt)
#pragma unroll
                        for (int i = 0; i < 4; ++i) NAT[o * 4096 + ((2 * rh + mi) * 16 + lr + i) * 64 + nt * 16 + lc] = (bf16)f2bf(res[mi][nt][i]);
                LDS_BARRIER();
#pragma unroll
                for (int i = 0; i < 4; ++i) { const int id = tid + 512 * i, oo = id >> 9, ch = id & 511; *(u32x4*)(rw_out(F.ws, b, h, d, c, oo) + ch * 8) = *(const LAS u32x4*)(NAT + oo * 4096 + ch * 8); } }
        }
    }
#undef RL_STEP
#undef RL_LOAD_S
#undef RL_LOAD_D
}
__device__ __forceinline__ void phase_rwkv_combine(const Frame& F0) {
    PH_ENTER(F0);
    const int lane = F.lane;
    if (F.wave != 0 || F.bid >= 256) return;
    const int chain = F.bid >> 2, q = F.bid & 3, d = chain & 1, bh = chain >> 1, b = bh >> 2, h = bh & 3;
    LAS bf16* SA = (LAS bf16*)F.lds;
    const float* RPL = (const float*)(F.ws + WS_RPL) + (size_t)chain * NTILE64 * 64;
    const int lr = (lane >> 4) * 4, lc = lane & 15, ar = lane & 15, akq = (lane >> 4) * 8;
    f32x4 S[4];
#pragma unroll
    for (int nt = 0; nt < 4; ++nt) S[nt] = (f32x4){0.f, 0.f, 0.f, 0.f};
    bf16x8 bfr[4][4][2]; unsigned short psi[4][4][4]; float pl[4][4];
#define RWC_CIDX(k) (d == 0 ? (k) : ((k) < 4 ? 3 - (k) : 131 - ((k) - 4)))
#define RWC_PRE(SET, k) do { const int c_ = RWC_CIDX(k); const bf16* phit = rw_out(F.ws, b, h, d, c_, 0); const bf16* psip = rw_out(F.ws, b, h, d, c_, 1) + (size_t)q * 16 * 64; \
        _Pragma("unroll") for (int nt = 0; nt < 4; ++nt) { \
            _Pragma("unroll") for (int ks = 0; ks < 2; ++ks) bfr[SET][nt][ks] = *(const bf16x8*)(phit + (nt * 16 + ar) * 64 + ks * 32 + akq); \
            _Pragma("unroll") for (int i = 0; i < 4; ++i) psi[SET][nt][i] = psip[(lr + i) * 64 + nt * 16 + lc]; \
            pl[SET][nt] = RPL[(size_t)c_ * 64 + nt * 16 + lc]; } } while (0)
    RWC_PRE(0, 0); RWC_PRE(1, 1); RWC_PRE(2, 2);
#pragma unroll 1
    for (int k4 = 0; k4 < NTILE64; k4 += 4) {
#pragma unroll
        for (int j = 0; j < 4; ++j) {
            const int k = k4 + j, c = RWC_CIDX(k);
            f32x4 init[4];
#pragma unroll
            for (int nt = 0; nt < 4; ++nt)
#pragma unroll
                for (int i = 0; i < 4; ++i) { init[nt][i] = S[nt][i] * pl[j][nt] + bf2f(psi[j][nt][i]); SA[(lr + i) * LD64 + nt * 16 + lc] = (bf16)f2bf(S[nt][i]); }
            asm volatile("" : "+v"(init[0]), "+v"(init[1]), "+v"(init[2]), "+v"(init[3]) :: "memory");
            if (k + 3 < NTILE64) RWC_PRE((j + 3) & 3, k + 3);
            LDS_WAIT();
            const bf16x8 a0 = *(const LAS bf16x8*)(SA + ar * LD64 + akq), a1 = *(const LAS bf16x8*)(SA + ar * LD64 + 32 + akq);
            { bf16* s0p = rw_out(F.ws, b, h, d, c, 1) + (size_t)q * 16 * 64;
#pragma unroll
                for (int i = 0; i < 2; ++i) { const int id = lane + 64 * i, r = id >> 3, ch = id & 7; *(u32x4*)(s0p + r * 64 + ch * 8) = *(const LAS u32x4*)(SA + r * LD64 + ch * 8); } }
#pragma unroll
            for (int nt = 0; nt < 4; ++nt) { f32x4 a4 = init[nt];
                a4 = __builtin_amdgcn_mfma_f32_16x16x32_bf16(a0, bfr[j][nt][0], a4, 0, 0, 0); a4 = __builtin_amdgcn_mfma_f32_16x16x32_bf16(a1, bfr[j][nt][1], a4, 0, 0, 0); S[nt] = a4; }
            LDS_WAIT();
        }
    }
#undef RWC_PRE
#undef RWC_CIDX
}
__device__ __forceinline__ void phase_combine_side(const Frame& F0) {
    PH_ENTER(F0);
    if (F.wave < 4 || F.G != 256) return;
    const int lgid = F.bid * 256 + (F.tid - 256);
    const int sch = lgid >> 9, sd = sch & 1, sbh = sch >> 1; bf16* SSp = (bf16*)(F.ws + WS_SS) + (size_t)sch * NTILE64 * 4096 + (lgid & 511) * 8;
    const float* SDp = (const float*)(F.ws + WS_SDEC) + (size_t)(sbh >> 3) * NTILE64 * 16 + (sbh & 7) * 2 + sd;
    const int gch = lgid >> 10, gd = gch & 1, gbh = gch >> 1, ge0 = (lgid & 1023) * 2; bf16* GSp = (bf16*)(F.ws + WS_GS) + (size_t)gch * NTILE64 * 2048 + ge0;
    const float* GDp = (const float*)(F.ws + WS_GDEC) + (size_t)(gbh >> 2) * NTILE64 * 256 + gd * 128 + (gbh & 3) * 32 + (ge0 & 31);
    float cS[8] = {0.f, 0.f, 0.f, 0.f, 0.f, 0.f, 0.f, 0.f}, cG0 = 0.f, cG1 = 0.f;
    u32x4 pS[4]; float pSd[4]; unsigned pG[4]; f32x2 pGd[4];
#define CS_CIDX(k, dd) ((dd) == 0 ? (k) : ((k) < 4 ? 3 - (k) : 131 - ((k) - 4)))
#define CS_LOAD(SET, k) do { const int cs_ = CS_CIDX(k, sd), cg_ = CS_CIDX(k, gd); pS[SET] = *(const u32x4*)(SSp + (size_t)cs_ * 4096); pSd[SET] = SDp[cs_ * 16]; \
        pG[SET] = *(const unsigned*)(GSp + (size_t)cg_ * 2048); pGd[SET] = *(const f32x2*)(GDp + (size_t)cg_ * 256); } while (0)
    CS_LOAD(0, 0); CS_LOAD(1, 1); CS_LOAD(2, 2);
#pragma unroll 1
    for (int k4 = 0; k4 < NTILE64; k4 += 4) {
#pragma unroll
        for (int j = 0; j < 4; ++j) { const int k = k4 + j, cs = CS_CIDX(k, sd), cg = CS_CIDX(k, gd);
            float f[8]; unpack8(pS[j], f); const float dec = pSd[j]; const unsigned gt = pG[j]; const f32x2 gdec = pGd[j];
            asm volatile("" : "+v"(f[0]), "+v"(f[7]) : "v"(dec), "v"(gt), "v"(gdec.x), "v"(gdec.y) : "memory");
            if (k + 3 < NTILE64) CS_LOAD((j + 3) & 3, k + 3);
            u32x4 o; o.x = pk2(cS[0], cS[1]); o.y = pk2(cS[2], cS[3]); o.z = pk2(cS[4], cS[5]); o.w = pk2(cS[6], cS[7]); *(u32x4*)(SSp + (size_t)cs * 4096) = o;
#pragma unroll
            for (int i = 0; i < 8; ++i) cS[i] = cS[i] * dec + f[i];
            *(unsigned*)(GSp + (size_t)cg * 2048) = pk2(cG0, cG1);
            cG0 = cG0 * gdec.x + __uint_as_float(gt << 16); cG1 = cG1 * gdec.y + __uint_as_float(gt & 0xffff0000u); }
    }
#undef CS_LOAD
#undef CS_CIDX
}
__device__ __forceinline__ void phase_finish_rwkv(const Frame& F0) {
    PH_ENTER(F0);
    const AS4 Args* KA = kargs();
    const int lane = F.lane, wave = F.wave;
    const h16* BONUS = (const h16*)(F.ws + WS_BONUS); const h16* GATE = (const h16*)(F.ws + WS_GATE);
    bf16* YO = (bf16*)(F.ws + WS_YRW);
    const float* gng = LP(20, 256); const float* gnb = LP(21, 256);
    const int h = wave >> 1, rh = wave & 1, lr = (lane >> 4) * 4, lc = lane & 15, ar = lane & 15, akq = (lane >> 4) * 8;
    const bool skipctx = F.l == 1;
    for (int j_ = F.bid; j_ < n_units(skipctx); j_ += F.G) {
        const int u = unit_of(skipctx, j_);
        const int b = u / NTILE64, c = u % NTILE64; const size_t row0 = (size_t)b * TB + (size_t)c * 64;
        f32x4 acc[2][4];
#pragma unroll
        for (int mi = 0; mi < 2; ++mi)
#pragma unroll
            for (int nt = 0; nt < 4; ++nt) acc[mi][nt] = (f32x4){0.f, 0.f, 0.f, 0.f};
#pragma unroll
        for (int d = 0; d < 2; ++d) { const bf16* om = rw_out(F.ws, b, h, d, c, 2); const bf16* s0 = rw_out(F.ws, b, h, d, c, 1); const bf16* yl = rw_out(F.ws, b, h, d, c, 3);
#pragma unroll
            for (int mi = 0; mi < 2; ++mi) { const int srow = (2 * rh + mi) * 16 + ar, trow = d ? 63 - srow : srow;
                const bf16x8 a0 = *(const bf16x8*)(om + trow * 64 + akq), a1 = *(const bf16x8*)(om + trow * 64 + 32 + akq);
#pragma unroll
                for (int nt = 0; nt < 4; ++nt) { const bf16x8 b0 = *(const bf16x8*)(s0 + (nt * 16 + ar) * 64 + akq), b1 = *(const bf16x8*)(s0 + (nt * 16 + ar) * 64 + 32 + akq);
                    f32x4 a4 = acc[mi][nt];
                    a4 = __builtin_amdgcn_mfma_f32_16x16x32_bf16(a0, b0, a4, 0, 0, 0); a4 = __builtin_amdgcn_mfma_f32_16x16x32_bf16(a1, b1, a4, 0, 0, 0);
#pragma unroll
                    for (int i = 0; i < 4; ++i) { const int s = (2 * rh + mi) * 16 + lr + i, t = d ? 63 - s : s; a4[i] += bf2f(yl[t * 64 + nt * 16 + lc]); }
                    acc[mi][nt] = a4; } } }
#pragma unroll
        for (int mi = 0; mi < 2; ++mi)
#pragma unroll
            for (int i = 0; i < 4; ++i) { const int s = (2 * rh + mi) * 16 + lr + i; const size_t r = row0 + s;
                float y0 = acc[mi][0][i], y1 = acc[mi][1][i], y2 = acc[mi][2][i], y3 = acc[mi][3][i];
                const float mu = sum16((y0 + y1) + (y2 + y3)) * (1.f / 64.f);
                y0 -= mu; y1 -= mu; y2 -= mu; y3 -= mu;
                const float rs = rsqrtf(sum16((y0 * y0 + y1 * y1) + (y2 * y2 + y3 * y3)) * (1.f / 64.f) + 64e-5f);
                const float yy[4] = {y0, y1, y2, y3};
#pragma unroll
                for (int nt = 0; nt < 4; ++nt) { const int cc = h * 64 + nt * 16 + lc;
                    const float o = (yy[nt] * rs * gng[cc] + gnb[cc] + (float)BONUS[r * 256 + cc]) * (float)GATE[r * 256 + cc];
                    YO[r * 256 + cc] = (bf16)f2bf(o); } }
    }
}
__device__ __forceinline__ void phase_copy_yrw(const Frame& F0) {
    PH_ENTER(F0);
    const bf16* YO = (const bf16*)(F.ws + WS_YRW); bf16* MIX = (bf16*)(F.ws + WS_ACT);
    const bool skipctx = F.l == 1; const int NR = skipctx ? NB * TL : T;
    for (int i = F.bid * 512 + F.tid; i < NR * 32; i += F.G * 512) { const int row_ = i >> 5, ch = i & 31; const int row = skipctx ? (row_ / TL) * TB + TC + row_ % TL : row_;
        *(u32x4*)(MIX + (size_t)row * D + ch * 8) = *(const u32x4*)(YO + (size_t)row * 256 + ch * 8); }
}
__device__ __forceinline__ void phase_router(const Frame& F0) {
    PH_ENTER(F0);
    const AS4 Args* KA = kargs();
    const int tid = F.tid, lane = F.lane, wave = F.wave;
    LAS float* RW = (LAS float*)F.lds;
    LAS int* lcnt = (LAS int*)(F.lds + 81920);
    const float* rgw = LP(31, D * 4); const float* rew = LP(33, D * 16); const float* rgb = LP(32, 4); const float* reb = LP(34, 16);
    for (int i = tid; i < 20 * D; i += 512) { const int e = i / D, k = i % D; RW[i] = e < 4 ? rgw[k * 4 + e] : rew[k * 16 + (e - 4)]; }
    if (tid < NCLS) lcnt[tid] = 0;
    LDS_BARRIER();
    const float* g = LP(7, D);
    const float* mod = (const float*)(F.ws + WS_MOD) + (size_t)F.l * 9 * 6144;
    bf16* TOK = (bf16*)(F.ws + WS_ACT);
    int4* TI = (int4*)(F.ws + WS_TOKINFO);
    int* CNT = (int*)(F.ws + WS_CNT);
    const bool skipctx = F.l == 1;
    if (skipctx && F.bid < 32 && tid < NCLS) CNT[((F.bid >> 2) * NTILE64 + (F.bid & 3)) * NCLS + tid] = 0;
    for (int j_ = F.bid; j_ < n_units(skipctx); j_ += F.G) {
        const int u = unit_of(skipctx, j_);
        f32x4 A[4], B[4], nv[4];
        { const float* mrow = mod + (size_t)mod_index(u * 64) * 6144;
#pragma unroll
            for (int j = 0; j < 4; ++j) { const int c = 4 * lane + 256 * j; A[j] = *(const f32x4*)(g + c) * (*(const f32x4*)(mrow + 4 * D + c) + 1.f); B[j] = *(const f32x4*)(mrow + 3 * D + c); }
            const f32x4* xr = (const f32x4*)xcur_row(F, u * 64 + wave * 8) + lane;
#pragma unroll
            for (int j = 0; j < 4; ++j) nv[j] = xr[64 * j]; }
        for (int rr = 0; rr < 8; ++rr) {
            const int row = u * 64 + wave * 8 + rr;
            f32x4 v[4]; float s = 0.f;
#pragma unroll
            for (int j = 0; j < 4; ++j) { v[j] = nv[j]; s += (v[j].x * v[j].x + v[j].y * v[j].y) + (v[j].z * v[j].z + v[j].w * v[j].w); }
            if (rr + 1 < 8) { const f32x4* xn = (const f32x4*)xcur_row(F, row + 1) + lane;
#pragma unroll
                for (int j = 0; j < 4; ++j) nv[j] = xn[64 * j]; }
            const float rs = rsqrtf(wave_sum(s) * (1.f / D) + 1e-6f);
            u32x2* o8 = (u32x2*)(TOK + (size_t)row * D) + lane;
#pragma unroll
            for (int j = 0; j < 4; ++j) { v[j] = v[j] * rs * A[j] + B[j];
                u32x2 w; w.x = pk2(v[j].x, v[j].y); w.y = pk2(v[j].z, v[j].w); o8[64 * j] = w; }
            float lg[20];
#pragma unroll
            for (int e = 0; e < 20; ++e) { float a = 0.f;
#pragma unroll
                for (int j = 0; j < 4; ++j) { const f32x4 w = *(const LAS f32x4*)(RW + e * D + 4 * lane + 256 * j); a += (v[j].x * w.x + v[j].y * w.y) + (v[j].z * w.z + v[j].w * w.w); }
                lg[e] = wave_sum(a); }
            float gl0 = lg[0] + rgb[0], gl1 = lg[1] + rgb[1], gl2 = lg[2] + rgb[2], gl3 = lg[3] + rgb[3];
            int gs = 0; float gm = gl0;
            if (gl1 > gm) { gm = gl1; gs = 1; } if (gl2 > gm) { gm = gl2; gs = 2; } if (gl3 > gm) { gm = gl3; gs = 3; }
            const float pg = 1.f / (__expf(gl0 - gm) + __expf(gl1 - gm) + __expf(gl2 - gm) + __expf(gl3 - gm));
            float e0, e1, e2, e3;
            e0 = gs == 0 ? lg[4] : (gs == 1 ? lg[8] : (gs == 2 ? lg[12] : lg[16])); e1 = gs == 0 ? lg[5] : (gs == 1 ? lg[9] : (gs == 2 ? lg[13] : lg[17]));
            e2 = gs == 0 ? lg[6] : (gs == 1 ? lg[10] : (gs == 2 ? lg[14] : lg[18])); e3 = gs == 0 ? lg[7] : (gs == 1 ? lg[11] : (gs == 2 ? lg[15] : lg[19]));
            e0 += reb[gs * 4 + 0]; e1 += reb[gs * 4 + 1]; e2 += reb[gs * 4 + 2]; e3 += reb[gs * 4 + 3];
            int i1 = 0; float m1 = e0;
            if (e1 > m1) { m1 = e1; i1 = 1; } if (e2 > m1) { m1 = e2; i1 = 2; } if (e3 > m1) { m1 = e3; i1 = 3; }
            int i2 = -1; float m2 = -3.0e38f;
            if (i1 != 0 && e0 > m2) { m2 = e0; i2 = 0; } if (i1 != 1 && e1 > m2) { m2 = e1; i2 = 1; } if (i1 != 2 && e2 > m2) { m2 = e2; i2 = 2; } if (i1 != 3 && e3 > m2) { m2 = e3; i2 = 3; }
            const float p1 = 1.f, p2 = __expf(m2 - m1);
            const float w1 = pg * p1 / (p1 + p2), w2 = pg * p2 / (p1 + p2);
            const int lo = i1 < i2 ? i1 : i2, hi = i1 < i2 ? i2 : i1;
            const int pr = lo == 0 ? hi - 1 : (lo == 1 ? hi + 1 : 5);
            const int cls = gs * 6 + pr;
            const float wa = i1 < i2 ? w1 : w2, wb = i1 < i2 ? w2 : w1;
            if (lane == 0) { const int rank = atomicAdd((int*)(lcnt + cls), 1);
                TI[row] = make_int4(cls, __float_as_int(wa), __float_as_int(wb), rank); }
        }
        LDS_BARRIER();
        if (tid < NCLS) { CNT[u * NCLS + tid] = lcnt[tid]; lcnt[tid] = 0; }
        LDS_BARRIER();
    }
}

__device__ __forceinline__ void phase_scatter(const Frame& F0) {
    PH_ENTER(F0);
    const int tid = F.tid, lane = F.lane, wave = F.wave;
    LAS int* C = (LAS int*)F.lds;
    LAS int* tot = (LAS int*)(F.lds + 102400);
    LAS int* cs = (LAS int*)(F.lds + 102400 + 128);
    LAS int* base = (LAS int*)(F.lds + 102400 + 256);
    const int* CNT = (const int*)(F.ws + WS_CNT);
    int* MI = (int*)(F.ws + WS_CNT) + NUNIT64 * NCLS;
    for (int i = tid; i < NUNIT64 * NCLS; i += 512) C[i] = CNT[i];
    LDS_BARRIER();
    if (tid < NCLS * 16) { const int c = tid >> 4, s16 = tid & 15; int part = 0; for (int uu = s16; uu < NUNIT64; uu += 16) part += C[uu * NCLS + c];
        const float pf = sum16((float)part); if (s16 == 0) tot[c] = (int)pf; }
    LDS_BARRIER();
    if (tid == 0) { int s = 0; for (int c = 0; c < NCLS; ++c) { cs[c] = s; s += (tot[c] + 255) & ~255; } cs[NCLS] = s; }
    LDS_BARRIER();
    if (F.bid == 0 && tid <= NCLS) MI[tid] = cs[tid];
    const int4* TI = (const int4*)(F.ws + WS_TOKINFO);
    int* LIST = (int*)(F.ws + WS_LIST); f32x2* WSL = (f32x2*)(F.ws + WS_WSLOT);
    for (int c = F.bid; c < NCLS; c += F.G) {
        const int s0 = cs[c] + tot[c], s1 = cs[c + 1];
        for (int s = s0 + tid; s < s1; s += 512) { LIST[s] = -1; WSL[s] = (f32x2){0.f, 0.f}; }
    }
    const bool skipctx = F.l == 1;
    for (int j_ = F.bid; j_ < n_units(skipctx); j_ += F.G) {
        const int u = unit_of(skipctx, j_);
        LDS_BARRIER();
        if (tid < NCLS * 16) { const int c = tid >> 4, s = tid & 15; int part = 0; for (int uu = s; uu < u; uu += 16) part += C[uu * NCLS + c];
            float pf = sum16((float)part);
            if (s == 0) base[c] = cs[c] + (int)pf; }
        LDS_BARRIER();
        {
#pragma unroll
            for (int rr = 0; rr < 8; ++rr) { const int row = u * 64 + wave * 8 + rr;
                if (lane == 0) { const int4 ti = TI[row]; const int slot = base[ti.x] + ti.w; LIST[slot] = row; WSL[slot] = (f32x2){__int_as_float(ti.y), __int_as_float(ti.z)}; } } }
    }
}

__device__ __forceinline__ void phase_final(const Frame& F0) {
    PH_ENTER(F0);
    const AS4 Args* KA = kargs();
    const int gw = F.bid * 8 + F.wave, NGW = F.G * 8, lane = F.lane;
    const float* g = INP(38);
    constexpr int NR = NB * TL; const int R = (NR + NGW - 1) / NGW, r0 = gw * R, r1 = min(NR, r0 + R);
    f32x4 G4[4], nv[4];
#pragma unroll
    for (int j = 0; j < 4; ++j) G4[j] = *(const f32x4*)(g + 4 * lane + 256 * j);
    if (r0 < r1) { const f32x4* xr = (const f32x4*)(F.out + (size_t)r0 * D) + lane;
#pragma unroll
        for (int j = 0; j < 4; ++j) nv[j] = xr[64 * j]; }
    for (int row = r0; row < r1; ++row) {
        f32x4 v[4];
#pragma unroll
        for (int j = 0; j < 4; ++j) v[j] = nv[j];
        if (row + 1 < r1) { const f32x4* xn = (const f32x4*)(F.out + (size_t)(row + 1) * D) + lane;
#pragma unroll
            for (int j = 0; j < 4; ++j) nv[j] = xn[64 * j]; }
        float s = 0.f;
#pragma unroll
        for (int j = 0; j < 4; ++j) s += (v[j].x * v[j].x + v[j].y * v[j].y) + (v[j].z * v[j].z + v[j].w * v[j].w);
        const float rs = rsqrtf(wave_sum(s) * (1.f / D) + 1e-6f);
        f32x4* xr = (f32x4*)(F.out + (size_t)row * D) + lane;
#pragma unroll
        for (int j = 0; j < 4; ++j) xr[64 * j] = v[j] * rs * G4[j];
    }
}

constexpr int PH_PER_LAYER = 12, PH_FINAL = 1 + 2 * PH_PER_LAYER, PH_END = PH_FINAL + 1;
template <int L> __device__ __forceinline__ void run_layer(Frame& F0, const XcdBarrier& bar, const int lo, const int hi) {
    constexpr int l = L;
#define IN(k) (lo <= (k) && (k) < hi)
#define SEAM(k) do { if (IN(k) && IN((k) + 1)) { XcdBarrier bb = bar; GAS unsigned* _b = (GAS unsigned*)bb.bar; asm volatile("" : "+s"(_b)); bb.bar = (unsigned*)_b; xcd_barrier(bb); } } while (0)
        F0.l = l;
        const int pb = 1 + PH_PER_LAYER * l;
        if (HAS(1) && IN(pb + 1)) { for (int rep = 0; rep < REP(1); ++rep) phase_norm1(F0); if (l == 1 && HAS(0)) phase_convert(F0); } SEAM(pb + 1);
        if (HAS(2) && IN(pb + 2)) {
            PH_ENTER(F0);
            SchedStatic S; S.nM = T / 256; S.nN = IN_PAD / 256; S.nwg = S.nM * S.nN; S.G = F.G; S.c = F.bid; S.ws = F.ws; S.offA = WS_ACT; S.offB = WS_WIN; S.skipctx = 0;
            EpiU E{F.ws};
            for (int rep = 0; rep < REP(2); ++rep) pg8::gemm_phase<EpiU, SchedStatic, true, false, 1024>(F.lds, F.tid, S, E);
        } SEAM(pb + 2);
        if (HAS(3) && IN(pb + 3)) { phase_conv(F0); for (int rep = 0; rep < REP(3); ++rep) phase_prep(F0); } SEAM(pb + 3);
#define GBAR() do { if (hi - lo > 1) { XcdBarrier bb = bar; GAS unsigned* _b = (GAS unsigned*)bb.bar; asm volatile("" : "+s"(_b)); bb.bar = (unsigned*)_b; xcd_barrier(bb); } } while (0)
        if (HAS(4) && IN(pb + 5)) {
            if (MK_PROBE_RW >= 1) { phase_rwkv_local(F0); GBAR(); if (MK_PROBE_RW >= 2) { phase_rwkv_combine(F0); GBAR(); } phase_prep(F0); GBAR(); }
            if (MK_PROBE_RW == 0) { for (int rep = 0; rep < REP(4); ++rep) phase_states(F0); } phase_rwkv_local(F0); if (MK_PROBE_RW) { GBAR(); phase_states(F0); GBAR(); } if (F0.G != 256) { phase_combine_ssd(F0); phase_combine_gla(F0); } GBAR(); phase_rwkv_combine(F0); phase_combine_side(F0); } SEAM(pb + 5);
        if (HAS(6) && IN(pb + 6)) { phase_finish_rwkv(F0); GBAR(); phase_finish_ssd(F0); phase_finish_gla(F0); phase_copy_yrw(F0); } SEAM(pb + 6);
#undef GBAR
        if (HAS(7) && IN(pb + 7)) {
            PH_ENTER(F0);
            const AS4 Args* KA = kargs();
            SchedStatic S; S.skipctx = (F.l == 1); S.nM = S.skipctx ? NB * TL / 256 : T / 256; S.nN = D / 256; S.nwg = S.nM * S.nN; S.G = F.G; S.c = F.bid; S.ws = F.ws; S.offA = WS_ACT; S.offB = WS_WOUT;
            EpiRes E{F.l == 0 ? INP(0) : (const float*)F.out, F.l == 0 ? INP(2) : (const float*)(F.ws + WS_CTX), F.out, F.ws, F.l};
            pg8::gemm_phase<EpiRes, SchedStatic, true, false, 1024>(F.lds, F.tid, S, E);
        } SEAM(pb + 7);
        if (HAS(8) && IN(pb + 8)) { for (int rep = 0; rep < REP(8); ++rep) phase_router(F0); } SEAM(pb + 8);
        if (HAS(9) && IN(pb + 9)) { for (int rep = 0; rep < REP(9); ++rep) phase_scatter(F0); } SEAM(pb + 9);
        if (IN(pb + 10) || IN(pb + 11)) {
            PH_ENTER(F0);
            LAS int* cs = (LAS int*)(F.lds + CSTAB_OFF);
            const int* MI = (const int*)(F.ws + WS_CNT) + NUNIT64 * NCLS;
            __syncthreads();
            if (F.tid <= NCLS) cs[F.tid] = MI[F.tid];
            __syncthreads();
        }
        if (HAS(10) && IN(pb + 10)) {
            PH_ENTER(F0);
            LAS int* cs = (LAS int*)(F.lds + CSTAB_OFF);
            SchedMoE<8> S; S.ntiles = cs[NCLS] / 256; S.G = F.G; S.c = F.bid; S.cs = cs; S.ws = F.ws;
            EpiSwiGLU E{F.ws};
            for (int rep = 0; rep < REP(10); ++rep) pg8::gemm_phase<EpiSwiGLU, SchedMoE<8>, true, false, 1024, true>(F.lds, F.tid, S, E);
        } SEAM(pb + 10);
        if (HAS(11) && IN(pb + 11)) {
            PH_ENTER(F0);
            LAS int* cs = (LAS int*)(F.lds + CSTAB_OFF);
            SchedMoE<4> S; S.ntiles = cs[NCLS] / 256; S.G = F.G; S.c = F.bid; S.cs = cs; S.ws = F.ws;
            EpiScatter E{F.out, F.ws, F.l};
            pg8::gemm_phase<EpiScatter, SchedMoE<4>, true, true, 512>(F.lds, F.tid, S, E);
        } SEAM(pb + 11);
    }
#undef IN
#undef SEAM
__global__ void __launch_bounds__(512, 2) mk_fwd(Args args) {
    extern __shared__ __attribute__((aligned(16))) unsigned char lds_raw[];
    Frame F0;
    F0.lds = (LAS unsigned char*)lds_raw;
    F0.tid = threadIdx.x; F0.lane = F0.tid & 63; F0.wave = __builtin_amdgcn_readfirstlane(F0.tid >> 6);
    F0.G = gridDim.x; F0.bid = blockIdx.x; F0.out = args.out; F0.ws = args.ws; F0.l = 0;
    for (int u = F0.tid; u < (LDS_BYTES - LDSCTL_OFF) / 4; u += 512) ((LAS unsigned*)(F0.lds + LDSCTL_OFF))[u] = 0u;
    __syncthreads();
    const int lo = args.ph_lo, hi = args.ph_hi;
    const bool use_bar = (hi - lo) > 1;
    XcdBarrier bar; bar.bar = (unsigned*)(F0.ws + WS_CTL) + CW_BAR; bar.x = 0; bar.st = nullptr;
    if (use_bar) bar = xcd_barrier_post((unsigned*)(F0.ws + WS_CTL) + CW_BAR, (volatile LAS unsigned*)(F0.lds + MISC_OFF) + 8);
#define IN(k) (lo <= (k) && (k) < hi)
#define SEAM(k) do { if (IN(k) && IN((k) + 1)) { XcdBarrier bb = bar; GAS unsigned* _b = (GAS unsigned*)bb.bar; asm volatile("" : "+s"(_b)); bb.bar = (unsigned*)_b; xcd_barrier(bb); } } while (0)
    if (HAS(12) && IN(0)) { phase_mods(F0); } if (HAS(0) && IN(0)) { F0.l = 0; phase_convert(F0); } SEAM(0);
    run_layer<0>(F0, bar, lo, hi);
    run_layer<1>(F0, bar, lo, hi);
    if (HAS(13) && IN(PH_FINAL)) { phase_final(F0); }
#undef IN
#undef SEAM
}

extern "C" void kernel_launch(void* const* d_in, const int* in_sizes, int n_in, void* d_out, int out_size, void* d_ws, size_t ws_size, hipStream_t stream) {
    static int grid = 0;
    if (grid == 0) {
        if (n_in != 39 || ws_size < WS_END) { fprintf(stderr, "kernel_launch: unexpected n_in %d / ws %zu\n", n_in, ws_size); grid = -1; return; }
        int dev = 0, cus = 0;
        if (hipGetDevice(&dev) != hipSuccess || hipDeviceGetAttribute(&cus, hipDeviceAttributeMultiprocessorCount, dev) != hipSuccess) { grid = -1; return; }
        if (hipFuncSetAttribute((const void*)mk_fwd, hipFuncAttributeMaxDynamicSharedMemorySize, LDS_BYTES) != hipSuccess) { fprintf(stderr, "kernel_launch: hipFuncSetAttribute failed\n"); grid = -1; return; }
        int per_cu = 0;
        (void)hipOccupancyMaxActiveBlocksPerMultiprocessor(&per_cu, (const void*)mk_fwd, 512, LDS_BYTES);
        (void)hipGetLastError();
        grid = cus;
    }
    if (grid < 0) return;
    (void)hipMemsetAsync((char*)d_ws + WS_CTL, 0, CTL_ZERO_BYTES, stream);
    Args a{};
    for (int i = 0; i < 39; ++i) a.in[i] = (const float*)d_in[i];
    a.out = (float*)d_out; a.ws = (unsigned char*)d_ws;
#if MK_ONE_LAUNCH
    a.ph_lo = 0; a.ph_hi = PH_END;
    hipLaunchKernelGGL(mk_fwd, dim3(grid), dim3(512), LDS_BYTES, stream, a);
#else
    for (int ph = 0; ph < PH_END; ++ph) { a.ph_lo = ph; a.ph_hi = ph + 1; hipLaunchKernelGGL(mk_fwd, dim3(grid), dim3(512), LDS_BYTES, stream, a); }
#endif
}
```

```cpp
#include <hip/hip_runtime.h>
#include <cstdio>
#include <cstdint>

#define GAS __attribute__((address_space(1)))
#define LAS __attribute__((address_space(3)))
typedef unsigned short bf16;
typedef short bf16x8 __attribute__((ext_vector_type(8)));
typedef float f32x4 __attribute__((ext_vector_type(4)));
typedef float f32x2 __attribute__((ext_vector_type(2)));
typedef unsigned u32x4 __attribute__((ext_vector_type(4)));
typedef unsigned u32x2 __attribute__((ext_vector_type(2)));
typedef _Float16 h16;
typedef _Float16 h16x8 __attribute__((ext_vector_type(8)));
typedef _Float16 h16x4 __attribute__((ext_vector_type(4)));

#ifndef MK_ONE_LAUNCH
#define MK_ONE_LAUNCH 1
#endif
#ifndef MK_PHMASK
#define MK_PHMASK 0xffffffffu
#endif
#define HAS(k) ((MK_PHMASK >> (k)) & 1u)
#ifndef MK_REP
#define MK_REP 0u
#endif
#define REP(k) (((MK_REP >> (k)) & 1u) ? 2 : 1)
#ifndef MK_SUB
#define MK_SUB 0u
#endif
#ifndef MK_PROBE_RW
#define MK_PROBE_RW 0
#endif
#define SUBREP(k) for (int _r = 0; _r < ((((MK_SUB) >> (k)) & 1u) ? 2 : 1); ++_r)

constexpr int D = 1024, NB = 8, TL = 8192, TC = 256, TB = TL + TC, T = NB * TB;
constexpr int NTILE64 = TB / 64;
constexpr int IN_COLS = 3096, IN_PAD = 3328;
constexpr int NCLS = 24, MAXSLOT = T + NCLS * 256;
constexpr int NUNIT64 = NB * NTILE64;

constexpr size_t MiB = 1u << 20;
constexpr size_t WS_CTL = 0, CTL_ZERO_BYTES = 1 * MiB;
constexpr size_t WS_MOD = 1 * MiB;
constexpr size_t WS_CNT = 2 * MiB;
constexpr size_t WS_TOKINFO = 3 * MiB;
constexpr size_t WS_LIST = 5 * MiB;
constexpr size_t WS_WSLOT = 6 * MiB;
constexpr size_t WS_WIN = 16 * MiB;
constexpr size_t WS_WOUT = 23 * MiB;
constexpr size_t WS_W13 = 25 * MiB;
constexpr size_t WS_W2T = 57 * MiB;
constexpr size_t WS_ACT = 74 * MiB;
constexpr size_t WS_REC = 74 * MiB;
constexpr size_t WS_RECS = WS_REC, WS_RECD = WS_REC + (size_t)T * 4 * 256 * 2;
constexpr size_t WS_LOWR = 73 * MiB;
constexpr size_t WS_TOKS = 206 * MiB;
constexpr size_t WS_URW = 371 * MiB;
constexpr size_t WS_SS = 371 * MiB;
constexpr size_t WS_GS = 503 * MiB;
constexpr size_t WS_YRW = 536 * MiB;
constexpr size_t WS_SDEC = 7 * MiB;
constexpr size_t WS_H1 = 371 * MiB;
constexpr size_t WS_UXBC = 503 * MiB;
constexpr size_t WS_UZ = 602 * MiB;
constexpr size_t WS_UGLA = 668 * MiB;
constexpr size_t WS_UMISC = 767 * MiB;
constexpr size_t WS_XB = 776 * MiB;
constexpr size_t OUT_XBCA = 0;
constexpr size_t OUT_BONUS = 99 * MiB;
constexpr size_t WS_GATE = 908 * MiB;
constexpr size_t WS_GDEC = 941 * MiB;
constexpr size_t WS_RPL = 943 * MiB;
constexpr size_t WS_END = 946 * MiB;
static_assert(WS_RECD + (size_t)T * 8 * 128 * 2 <= WS_URW, "records fit");
static_assert(WS_SS + (size_t)128 * 132 * 4096 * 2 <= WS_GS && WS_GS + (size_t)64 * 132 * 2048 * 2 <= WS_YRW && WS_YRW + (size_t)2 * T * 256 * 2 <= WS_UZ, "state buffers fit");
static_assert(WS_TOKS + (size_t)MAXSLOT * 1024 * 2 <= WS_H1, "toks fits");
static_assert(WS_XB + (size_t)T * 1024 * 2 <= WS_GATE && OUT_XBCA + (size_t)T * 768 * 2 <= OUT_BONUS && OUT_BONUS + (size_t)T * 256 * 2 <= (size_t)NB * TL * D * 4, "stream / d_out scratch fit");
static_assert(WS_H1 + (size_t)MAXSLOT * 1024 * 2 <= WS_UMISC, "h1 fits");

constexpr int CW_BAR = 4096;

constexpr int RING_BYTES = 131072;
constexpr int LDS_BYTES = 163840;
constexpr int LDSCTL_OFF = LDS_BYTES - 2048, MISC_OFF = LDSCTL_OFF + 320, CSTAB_OFF = LDSCTL_OFF + 1024;

#define RLX_AGENT __ATOMIC_RELAXED, __HIP_MEMORY_SCOPE_AGENT
#define LDS_WAIT() asm volatile("s_waitcnt lgkmcnt(0)" ::: "memory")
#define LDS_BARRIER() asm volatile("s_waitcnt lgkmcnt(0)\n\ts_barrier" ::: "memory")
#define VM_WAIT() asm volatile("s_waitcnt vmcnt(0)" ::: "memory")
__device__ __forceinline__ float bf2f(unsigned short h) { return __uint_as_float(((unsigned)h) << 16); }
typedef __bf16 hwbf16x2 __attribute__((ext_vector_type(2)));
__device__ __forceinline__ unsigned pk2(float lo, float hi) { const f32x2 v = {lo, hi}; const hwbf16x2 b = __builtin_convertvector(v, hwbf16x2); return __builtin_bit_cast(unsigned, b); }
__device__ __forceinline__ unsigned f2bf(float f) { return pk2(f, 0.f) & 0xffffu; }
__device__ __forceinline__ float sigm(float x) { return 1.f / (1.f + __expf(-x)); }
__device__ __forceinline__ float siluf(float x) { return x / (1.f + __expf(-x)); }
__device__ __forceinline__ float softplusf_(float x) { return x > 20.f ? x : log1pf(__expf(x)); }
__device__ __forceinline__ void unpack8(u32x4 v, float* o) {
    o[0] = __uint_as_float(v.x << 16); o[1] = __uint_as_float(v.x & 0xffff0000u); o[2] = __uint_as_float(v.y << 16); o[3] = __uint_as_float(v.y & 0xffff0000u);
    o[4] = __uint_as_float(v.z << 16); o[5] = __uint_as_float(v.z & 0xffff0000u); o[6] = __uint_as_float(v.w << 16); o[7] = __uint_as_float(v.w & 0xffff0000u);
}
__device__ __forceinline__ f32x4 bf4(u32x2 w) { return (f32x4){__uint_as_float(w.x << 16), __uint_as_float(w.x & 0xffff0000u), __uint_as_float(w.y << 16), __uint_as_float(w.y & 0xffff0000u)}; }
__device__ __forceinline__ u32x4 pack8(const float* o) { u32x4 v; v.x = pk2(o[0], o[1]); v.y = pk2(o[2], o[3]); v.z = pk2(o[4], o[5]); v.w = pk2(o[6], o[7]); return v; }
__device__ __forceinline__ int launder_i(int v) { asm volatile("" : "+v"(v)); return v; }
template <int CTRL> __device__ __forceinline__ float dpp_mov(float v) { return __int_as_float(__builtin_amdgcn_update_dpp(0, __float_as_int(v), CTRL, 0xf, 0xf, false)); }
__device__ __forceinline__ float sum8(float v) { v += dpp_mov<0xB1>(v); v += dpp_mov<0x4E>(v); v += dpp_mov<0x141>(v); return v; }
__device__ __forceinline__ float sum16(float v) { v = sum8(v); v += dpp_mov<0x140>(v); return v; }
__device__ __forceinline__ float wave_sum(float v) {
    v = sum16(v);
    v += __int_as_float(__builtin_amdgcn_update_dpp(0, __float_as_int(v), 0x142, 0xa, 0xf, false));
    v += __int_as_float(__builtin_amdgcn_update_dpp(0, __float_as_int(v), 0x143, 0xc, 0xf, false));
    return __int_as_float(__builtin_amdgcn_readlane(__float_as_int(v), 63));
}

namespace pg8 {
constexpr int BM = 256, BK = 64, HALF = 128, HTB = HALF * BK * 2, STAGE_BYTES = 8 * HTB, NXCD = 8, WGM = 8;
__host__ __device__ __forceinline__ int lds_byte(int r, int c) { const int st = (r >> 4) * 2 + (c >> 5), rr = r & 15, cc = c & 31, ob = rr * 64 + cc * 2; return st * 1024 + (ob ^ (((ob >> 9) & 1) << 5)); }
__host__ __device__ __forceinline__ void stage_rc(int b, int& R, int& C) { const int st = b / 1024, sb = b % 1024, swz = sb ^ (((sb >> 9) & 1) << 5); R = (st >> 1) * 16 + swz / 64; C = (st & 1) * 32 + (swz % 64) / 2; }
__host__ __device__ __forceinline__ int perm32(int rho) { const int n = rho >> 4, i = rho & 15; return 8 * (i >> 2) + 4 * n + (i & 3); }
struct Unit { int pm, pn, aux; };
__device__ __forceinline__ const GAS char* uni_ptr(const char* p) { const unsigned long long v = (unsigned long long)p;
    const unsigned lo = __builtin_amdgcn_readfirstlane((unsigned)v), hi = __builtin_amdgcn_readfirstlane((unsigned)(v >> 32)); return (const GAS char*)(((unsigned long long)hi << 32) | lo); }
__device__ __forceinline__ unsigned cvt_pk_bf16(float lo, float hi) { unsigned r; asm volatile("v_cvt_pk_bf16_f32 %0, %1, %2" : "=v"(r) : "v"(lo), "v"(hi)); return r; }

template <class Epi, class Sched, bool ALIGN_EPI, bool KSPLIT, int LDB, bool GATHER = false>
__device__ __forceinline__ void gemm_phase(LAS unsigned char* lds, const int tid, const Sched& S, const Epi& E) {
    constexpr int K = 1024, nt = K / BK, ntb = KSPLIT ? nt / 2 : nt;
    const int wid = __builtin_amdgcn_readfirstlane(tid >> 6), lane = tid & 63, wr = wid >> 2, wc = wid & 3, fr = lane & 15, fq = lane >> 4;
    unsigned voffA[2], voffB[2];
#pragma unroll
    for (int i = 0; i < 2; ++i) { int R, C; stage_rc(tid * 16 + i * 8192, R, C); const int Rb = Epi::PERM ? ((R & ~31) + perm32(R & 31)) : R;
        voffA[i] = (unsigned)(R * K + C) * 2u; voffB[i] = (unsigned)(Rb * LDB + C) * 2u; }
    unsigned cvA[2][2], nvA[2][2]; int arow[2][2];
#pragma unroll
    for (int i = 0; i < 2; ++i) { int R, C; stage_rc(tid * 16 + i * 8192, R, C); arow[0][i] = R; arow[1][i] = C * 2; }
    constexpr size_t kstep = (size_t)(BK * 2);
    constexpr size_t hstepA = (size_t)HALF * K * 2, hstepB = (size_t)HALF * LDB * 2;
    const unsigned ldsw = (unsigned)wid * 1024u;
    const int aoff = lds_byte(wr * 64 + fr, fq * 8), boff = lds_byte(wc * 32 + fr, fq * 8);
#define PG8_SA(b, h) (((b) * 2 + (h)) * HTB)
#define PG8_SB(b, h) ((4 + (b) * 2 + (h)) * HTB)
#define PG8_STAGE(bufoff, gbase, voff) do { const GAS char* _gb = (const GAS char*)(gbase); _Pragma("unroll") for (int _i = 0; _i < 2; ++_i) \
        __builtin_amdgcn_global_load_lds((const GAS unsigned*)(_gb + (voff)[_i]), (LAS unsigned*)(lds + (bufoff) + ldsw + _i * 8192), 16, 0, 0); } while (0)
#define PG8_LDA(dst, b, h) do { _Pragma("unroll") for (int m = 0; m < 4; ++m) _Pragma("unroll") for (int k = 0; k < 2; ++k) dst[m][k] = *(const LAS bf16x8*)(lds + PG8_SA(b, h) + aoff + m * 2048 + k * 1024); } while (0)
#define PG8_LDB(dst, b, h) do { _Pragma("unroll") for (int n = 0; n < 2; ++n) _Pragma("unroll") for (int k = 0; k < 2; ++k) dst[n][k] = *(const LAS bf16x8*)(lds + PG8_SB(b, h) + boff + n * 2048 + k * 1024); } while (0)
#define PG8_MMA(ai, bj, At, Bt) do { __builtin_amdgcn_s_setprio(1); _Pragma("unroll") for (int m = 0; m < 4; ++m) _Pragma("unroll") for (int n = 0; n < 2; ++n) _Pragma("unroll") for (int k = 0; k < 2; ++k) \
        acc[ai][bj][m][n] = __builtin_amdgcn_mfma_f32_16x16x32_bf16(Bt[n][k], At[m][k], acc[ai][bj][m][n], 0, 0, 0); __builtin_amdgcn_s_setprio(0); } while (0)
#define PG8_WAIT_V(n) asm volatile("s_waitcnt vmcnt(" #n ")" ::: "memory")
#define PG8_WAIT_L(n) asm volatile("s_waitcnt lgkmcnt(" #n ")" ::: "memory")
#define PG8_BAR __builtin_amdgcn_s_barrier()
#define PG8_SCHED __builtin_amdgcn_sched_barrier(0)
    Unit cur, nxt; int ui = 0;
    if (!S.next(0, cur)) return;
    f32x4 acc[2][2][4][2];
#pragma unroll
    for (int a = 0; a < 2; ++a)
#pragma unroll
        for (int b = 0; b < 2; ++b)
#pragma unroll
            for (int m = 0; m < 4; ++m)
#pragma unroll
                for (int n = 0; n < 2; ++n) acc[a][b][m][n] = (f32x4){0.f, 0.f, 0.f, 0.f};
    bf16x8 At[4][2], B0[2][2], B1[2][2];
    const char* cA = (const char*)uni_ptr(S.aptr(cur)); const char* cB = (const char*)uni_ptr(S.bptr(cur));
#define PG8_LOADROWS(dst, u) do { if constexpr (GATHER) { const int* rl_ = S.rowlist(u); _Pragma("unroll") for (int hh = 0; hh < 2; ++hh) _Pragma("unroll") for (int i = 0; i < 2; ++i) { \
        const int r_ = rl_[hh * HALF + arow[0][i]]; dst[hh][i] = (unsigned)(r_ < 0 ? 0 : r_) * (unsigned)(K * 2) + (unsigned)arow[1][i]; } } } while (0)
    PG8_LOADROWS(cvA, cur);
#define PG8_STAGE_A(bufoff, gbase, half, next) do { if constexpr (GATHER) { PG8_STAGE(bufoff, gbase, (next) ? nvA[half] : cvA[half]); } else { PG8_STAGE(bufoff, (gbase) + (half) * hstepA, voffA); } } while (0)
    {
        PG8_STAGE(PG8_SB(0, 0), cB, voffB); PG8_STAGE(PG8_SB(0, 1), cB + hstepB, voffB); PG8_STAGE_A(PG8_SA(0, 0), cA, 0, false); PG8_STAGE_A(PG8_SA(0, 1), cA, 1, false);
        if (wr == 1) PG8_BAR;
        PG8_WAIT_V(2); PG8_BAR;
        PG8_STAGE(PG8_SB(1, 0), cB + kstep, voffB); PG8_STAGE_A(PG8_SA(1, 0), cA + kstep, 0, false); PG8_STAGE(PG8_SB(1, 1), cB + hstepB + kstep, voffB);
        PG8_WAIT_V(6); PG8_BAR;
    }
    for (;;) {
        const bool has_next = S.next(ui + 1, nxt);
        if (has_next) PG8_LOADROWS(nvA, nxt); else { _Pragma("unroll") for (int hh = 0; hh < 2; ++hh) _Pragma("unroll") for (int i = 0; i < 2; ++i) nvA[hh][i] = cvA[hh][i]; }
#pragma unroll 1
        for (int t = 0; t < nt; t += 2) {
            const bool last = (t == nt - 2);
            const char* a1 = cA + (size_t)(t + 1) * kstep;
            const char* a2; const char* b2;
            if (last) { a2 = has_next ? S.aptr(nxt) : cA; b2 = has_next ? S.bptr(nxt) : cB; }
            else { a2 = cA + (size_t)(t + 2) * kstep; if (KSPLIT && t + 2 >= ntb) b2 = S.bptr2(cur) + (size_t)(t + 2 - ntb) * kstep; else b2 = cB + (size_t)(t + 2) * kstep; }
            a2 = (const char*)uni_ptr(a2); b2 = (const char*)uni_ptr(b2);
            const char* a3 = a2 + kstep; const char* b3 = b2 + kstep;
            PG8_LDB(B0, 0, 0); PG8_LDB(B1, 0, 1); PG8_SCHED; PG8_LDA(At, 0, 0); PG8_STAGE_A(PG8_SA(1, 1), a1, 1, false);
            PG8_WAIT_V(8); PG8_WAIT_L(0); PG8_BAR; PG8_MMA(0, 0, At, B0); PG8_MMA(0, 1, At, B1); PG8_BAR; PG8_SCHED;
            PG8_LDA(At, 0, 1); PG8_STAGE(PG8_SB(0, 0), b2, voffB); PG8_STAGE(PG8_SB(0, 1), b2 + hstepB, voffB); PG8_STAGE_A(PG8_SA(0, 0), a2, 0, last);
            PG8_WAIT_V(8); PG8_WAIT_L(0); PG8_BAR; PG8_MMA(1, 0, At, B0); PG8_MMA(1, 1, At, B1); PG8_BAR; PG8_SCHED;
            PG8_LDB(B0, 1, 0); PG8_LDB(B1, 1, 1); PG8_SCHED; PG8_LDA(At, 1, 0); PG8_STAGE_A(PG8_SA(0, 1), a2, 1, last);
            PG8_WAIT_V(8); PG8_WAIT_L(0); PG8_BAR; PG8_MMA(0, 0, At, B0); PG8_MMA(0, 1, At, B1); PG8_BAR; PG8_SCHED;
            PG8_LDA(At, 1, 1); PG8_STAGE(PG8_SB(1, 0), b3, voffB); PG8_STAGE(PG8_SB(1, 1), b3 + hstepB, voffB); PG8_STAGE_A(PG8_SA(1, 0), a3, 0, last);
            PG8_WAIT_V(8); PG8_WAIT_L(0); PG8_BAR; PG8_MMA(1, 0, At, B0); PG8_MMA(1, 1, At, B1); PG8_BAR; PG8_SCHED;
        }
        if constexpr (ALIGN_EPI) { if (wr == 0) PG8_BAR; }
        E(acc, cur, wr, wc, fr, fq);
        if (!has_next) break;
#pragma unroll
        for (int a = 0; a < 2; ++a)
#pragma unroll
            for (int b = 0; b < 2; ++b)
#pragma unroll
                for (int m = 0; m < 4; ++m)
#pragma unroll
                    for (int n = 0; n < 2; ++n) acc[a][b][m][n] = (f32x4){0.f, 0.f, 0.f, 0.f};
        cur = nxt; cA = (const char*)uni_ptr(S.aptr(cur)); cB = (const char*)uni_ptr(S.bptr(cur)); ++ui;
        if constexpr (GATHER) { _Pragma("unroll") for (int hh = 0; hh < 2; ++hh) _Pragma("unroll") for (int i = 0; i < 2; ++i) cvA[hh][i] = nvA[hh][i]; }
        if constexpr (ALIGN_EPI) { if (wr == 1) PG8_BAR; }
    }
    PG8_WAIT_V(0);
    if constexpr (!ALIGN_EPI) { if (wr == 0) PG8_BAR; }
    PG8_BAR;
#undef PG8_SA
#undef PG8_LOADROWS
#undef PG8_STAGE_A
#undef PG8_SB
#undef PG8_STAGE
#undef PG8_LDA
#undef PG8_LDB
#undef PG8_MMA
#undef PG8_WAIT_V
#undef PG8_WAIT_L
#undef PG8_BAR
#undef PG8_SCHED
}
}

#define XB_TMO      128
#define XB_XCNT(j)  (256  + 64 * (j))
#define XB_XSUB(j)  (1280 + 64 * (j))
#define XB_XGEN(j)  (2304 + 64 * (j))
#define XB_TOP      3328
#define XB_TOPGEN   3392
#define XCD_BAR_WORDS 3456
#define XB_SPIN_CAP (1u << 25)
__device__ __forceinline__ unsigned xb_ld(unsigned* p)              { return __hip_atomic_load(p, __ATOMIC_RELAXED, __HIP_MEMORY_SCOPE_AGENT); }
__device__ __forceinline__ unsigned xb_add(unsigned* p, unsigned v) { return __hip_atomic_fetch_add(p, v, __ATOMIC_RELAXED, __HIP_MEMORY_SCOPE_AGENT); }
__device__ __forceinline__ unsigned xb_xcc_id() { return (unsigned)__builtin_amdgcn_s_getreg((3 << 11) | 20) & 0xFu; }
#define XB_SPIN(cond, bar) do { unsigned _sp = 0; while (cond) { __builtin_amdgcn_s_sleep(1); \
    if ((++_sp & 255u) == 0u) { if (xb_ld(&(bar)[XB_TMO])) break; if (_sp > XB_SPIN_CAP) { atomicAdd(&(bar)[XB_TMO], 1u); break; } } } } while (0)
struct XcdBarrier { unsigned* bar; unsigned x; volatile LAS unsigned* st; };
__device__ __forceinline__ XcdBarrier xcd_barrier_post(unsigned* bar, volatile LAS unsigned* st) {
    XcdBarrier b; b.bar = bar; b.x = xb_xcc_id(); b.st = st;
    if (threadIdx.x == 0) (void)xb_add(&bar[XB_XCNT(b.x)], 1u);
    return b;
}
__device__ __forceinline__ void xcd_barrier_complete(unsigned* bar, unsigned x, unsigned& nloc, unsigned& nx) {
    const unsigned G = gridDim.x * gridDim.y * gridDim.z;
    unsigned sum, cnt, mine, sp = 0u;
    for (;;) {
        sum = 0u; cnt = 0u; mine = 0u;
#pragma unroll 1
        for (unsigned j = 0; j < 16; ++j) { const unsigned c = xb_ld(&bar[XB_XCNT(j)]); sum += c; cnt += (c > 0u) ? 1u : 0u; mine = (j == x) ? c : mine; }
        if (sum == G) break;
        __builtin_amdgcn_s_sleep(1);
        if ((++sp & 255u) == 0u) { if (xb_ld(&bar[XB_TMO])) break; if (sp > XB_SPIN_CAP) { atomicAdd(&bar[XB_TMO], 1u); break; } }
    }
    nloc = mine > 0u ? mine : 1u; nx = cnt > 0u ? cnt : 1u;
}
__device__ __forceinline__ void xcd_barrier(const XcdBarrier& b) {
    asm volatile("s_waitcnt vmcnt(0)" ::: "memory");
    __syncthreads();
    if (threadIdx.x == 0) {
        unsigned* bar = b.bar;
        __builtin_amdgcn_s_waitcnt(0);
        unsigned nloc = b.st[0], nx = b.st[1];
        if (nloc == 0u) { xcd_barrier_complete(bar, b.x, nloc, nx); b.st[0] = nloc; b.st[1] = nx; }
        const unsigned old = xb_add(&bar[XB_XSUB(b.x)], 1u);
        const unsigned gen = old / nloc;
        if (old + 1u == (gen + 1u) * nloc) {
            __builtin_amdgcn_fence(__ATOMIC_RELEASE, "agent");
            asm volatile("s_waitcnt vmcnt(0)" ::: "memory");
            const unsigned og = xb_add(&bar[XB_TOP], 1u);
            const unsigned tg = og / nx;
            if (og + 1u == (tg + 1u) * nx) xb_add(&bar[XB_TOPGEN], 1u);
            else XB_SPIN(xb_ld(&bar[XB_TOPGEN]) == tg, bar);
            __builtin_amdgcn_fence(__ATOMIC_ACQUIRE, "agent");
            xb_add(&bar[XB_XGEN(b.x)], 1u);
            asm volatile("s_waitcnt vmcnt(0)" ::: "memory");
        } else {
            XB_SPIN(xb_ld(&bar[XB_XGEN(b.x)]) == gen, bar);
            __builtin_amdgcn_fence(__ATOMIC_ACQUIRE, "agent");
            asm volatile("s_waitcnt vmcnt(0)" ::: "memory");
        }
    }
    __syncthreads();
}

struct Args { const float* in[39]; float* out; unsigned char* ws; int ph_lo, ph_hi; };
struct Frame {
    LAS unsigned char* lds;
    int tid, lane, wave, G, bid;
    float* out; unsigned char* ws;
    int l;
};
#define AS4 __attribute__((address_space(4)))
#define PH_ENTER(F0) Frame F = (F0); { GAS unsigned char* _w = (GAS unsigned char*)F.ws; GAS float* _o = (GAS float*)F.out; \
    asm volatile("" : "+s"(_w), "+s"(_o), "+v"(F.tid), "+s"(F.wave), "+s"(F.bid), "+s"(F.G), "+s"(F.l)); F.ws = (unsigned char*)_w; F.out = (float*)_o; } F.lane = F.tid & 63
__device__ __forceinline__ const AS4 Args* kargs() { const AS4 Args* p = (const AS4 Args*)__builtin_amdgcn_kernarg_segment_ptr(); asm volatile("" : "+s"(p)); return p; }
#define INP(i) ((const float*)(GAS const float*)(KA->in[i]))
#define LP(i, stride) (INP(i) + (size_t)F.l * (stride))

__device__ __forceinline__ const float* xin_row(const float* xl, const float* xc, int row) {
    const int b = row / TB, p = row % TB;
    if (p < TC) return xc + ((size_t)b * TC + p) * D;
    return xl + ((size_t)b * TL + (p - TC)) * D;
}
__device__ __forceinline__ int n_units(bool skipctx) { return skipctx ? NB * 128 : NUNIT64; }
__device__ __forceinline__ int unit_of(bool skipctx, int j) { return skipctx ? (j >> 7) * NTILE64 + 4 + (j & 127) : j; }
__device__ __forceinline__ int mod_index(int row) { const int b = row / TB, p = row % TB; return p < TC ? 8 : b; }

__device__ __forceinline__ int in_colmap(int n) {
    if (n < 2304) return n;
    if (n < 2816) return n + 8;
    if (n < 3072) return n + 24;
    if (n < 3080) return n - 768;
    if (n < 3096) return n - 256;
    return -1;
}
__device__ __forceinline__ void tr_item(const float* src, int ldsrc, int scol, bf16* dst, int K, int n0, int k0, LAS float* scr, int lane) {
#pragma unroll 8
    for (int i = 0; i < 32; ++i) { const int kk = 2 * i + (lane >> 5); scr[kk * 33 + (lane & 31)] = scol >= 0 ? src[(size_t)(k0 + kk) * ldsrc + scol] : 0.f; }
    LDS_WAIT(); asm volatile("" ::: "memory");
    const int c = lane & 7;
#pragma unroll
    for (int j = 0; j < 4; ++j) { const int n = (lane >> 3) + 8 * j; const LAS float* s = scr + (8 * c) * 33 + n;
        u32x4 o; o.x = pk2(s[0 * 33], s[1 * 33]); o.y = pk2(s[2 * 33], s[3 * 33]); o.z = pk2(s[4 * 33], s[5 * 33]); o.w = pk2(s[6 * 33], s[7 * 33]);
        *(GAS u32x4*)(dst + (size_t)(n0 + n) * K + k0 + 8 * c) = o; }
    LDS_WAIT(); asm volatile("" ::: "memory");
}
__device__ __forceinline__ void phase_convert(const Frame& F0) {
    PH_ENTER(F0);
    const AS4 Args* KA = kargs();
    LAS float* scr = (LAS float*)(F.lds + F.wave * 16384);
    const int gw = F.bid * 8 + F.wave, NGW = F.G * 8, l = F.l, lane = F.lane;
    constexpr int I_A = 16 * 104, I_B = 16 * 32, I_C = 16 * 16 * 32, I_D = 16 * 8 * 32, I_E = 48;
    for (int it = gw; it < I_A + I_B + I_C + I_D + I_E; it += NGW) {
        int r = it;
        if (r < I_A) { const int kb = r / 104, nb = r % 104; tr_item(INP(8) + (size_t)l * D * IN_COLS, IN_COLS, in_colmap(nb * 32 + (lane & 31)), (bf16*)(F.ws + WS_WIN), D, nb * 32, kb * 64, scr, lane); continue; }
        r -= I_A;
        if (r < I_B) { const int kb = r / 32, nb = r % 32; tr_item(INP(9) + (size_t)l * D * D, D, nb * 32 + (lane & 31), (bf16*)(F.ws + WS_WOUT), D, nb * 32, kb * 64, scr, lane); continue; }
        r -= I_B;
        if (r < I_C) { const int e = r / 512, rr = r % 512, kb = rr / 32, nb = rr % 32; const int n0 = nb * 32, j = n0 >> 8, wi = n0 & 255;
            const float* src = (wi < 128 ? INP(35) : INP(36)) + (size_t)(l * 16 + e) * D * 512;
            tr_item(src, 512, 128 * j + (wi & 127) + (lane & 31), (bf16*)(F.ws + WS_W13) + (size_t)e * D * D, D, n0, kb * 64, scr, lane); continue; }
        r -= I_C;
        if (r < I_D) { const int e = r / 256, rr = r % 256, kb = rr / 32, nb = rr % 32;
            tr_item(INP(37) + (size_t)(l * 16 + e) * 512 * D, D, nb * 32 + (lane & 31), (bf16*)(F.ws + WS_W2T) + (size_t)e * D * 512, 512, nb * 32, kb * 64, scr, lane); continue; }
        r -= I_D;
        { bf16* LW = (bf16*)(F.ws + WS_LOWR);
            if (r < 16) { const int d = r >> 3, nb = r & 7; tr_item(INP(13) + (size_t)(l * 2 + d) * 64 * 256, 256, nb * 32 + (lane & 31), LW + (size_t)d * 256 * 64, 64, nb * 32, 0, scr, lane); }
            else if (r < 32) { const int d = (r - 16) >> 3, nb = r & 7; tr_item(INP(15) + (size_t)(l * 2 + d) * 64 * 256, 256, nb * 32 + (lane & 31), LW + 32768 + (size_t)d * 256 * 64, 64, nb * 32, 0, scr, lane); }
            else { const int kb = (r - 32) >> 3, nb = r & 7; tr_item(INP(16) + (size_t)l * 128 * 256, 256, nb * 32 + (lane & 31), LW + 65536, 128, nb * 32, kb * 64, scr, lane); } }
    }
}
__device__ __forceinline__ void phase_mods(const Frame& F0) {
    PH_ENTER(F0);
    const AS4 Args* KA = kargs();
    LAS float* cond = (LAS float*)F.lds;
    LAS float* red = (LAS float*)(F.lds + 40960);
    for (int i = F.tid; i < 9 * D; i += 512) { const float v = i < 8 * D ? INP(1)[i] : INP(3)[i - 8 * D]; cond[i] = siluf(v); }
    LDS_BARRIER();
    float* mod = (float*)(F.ws + WS_MOD);
    for (int u = F.bid; u < 2 * 96; u += F.G) {
        const int l = u / 96, cb = u % 96, col = cb * 64 + F.lane;
        const float* W = INP(4) + (size_t)l * D * 6144;
        float acc[9];
#pragma unroll
        for (int i = 0; i < 9; ++i) acc[i] = 0.f;
#pragma unroll 1
        for (int k0 = F.wave * 128; k0 < F.wave * 128 + 128; k0 += 16) { float w[16];
#pragma unroll
            for (int kk = 0; kk < 16; ++kk) w[kk] = W[(size_t)(k0 + kk) * 6144 + col];
#pragma unroll
            for (int kk = 0; kk < 16; kk += 4)
#pragma unroll
                for (int i = 0; i < 9; ++i) { const f32x4 c4 = *(const LAS f32x4*)(cond + i * D + k0 + kk); acc[i] += c4.x * w[kk] + c4.y * w[kk + 1] + c4.z * w[kk + 2] + c4.w * w[kk + 3]; } }
#pragma unroll
        for (int i = 0; i < 9; ++i) red[(F.wave * 9 + i) * 64 + F.lane] = acc[i];
        LDS_BARRIER();
        for (int o = F.tid; o < 9 * 64; o += 512) { const int i = o / 64, ln = o % 64; float s = 0.f;
#pragma unroll
            for (int w = 0; w < 8; ++w) s += red[(w * 9 + i) * 64 + ln];
            mod[((size_t)l * 9 + i) * 6144 + cb * 64 + ln] = s + INP(5)[(size_t)l * 6144 + cb * 64 + ln]; }
        LDS_BARRIER();
    }
}

__device__ __forceinline__ void phase_norm1(const Frame& F0) {
    PH_ENTER(F0);
    const AS4 Args* KA = kargs();
    const float* xl = INP(0); const float* xc = INP(2); const bf16* XB = (const bf16*)(F.ws + WS_XB); const bool first = F.l == 0;
    const int gw = F.bid * 8 + F.wave, NGW = F.G * 8, lane = F.lane;
    const float* g = LP(6, D);
    const float* mod = (const float*)(F.ws + WS_MOD) + (size_t)F.l * 9 * 6144;
    bf16* H = (bf16*)(F.ws + WS_ACT);
    const int R = (T + NGW - 1) / NGW, r0 = gw * R, r1 = min(T, r0 + R);
    f32x4 A[4], B[4], nv[4]; u32x2 nb[4]; int curmi = -1;
#define N1_LOAD(row) do { if (first) { const f32x4* xr = (const f32x4*)xin_row(xl, xc, (row)) + lane; _Pragma("unroll") for (int j = 0; j < 4; ++j) nv[j] = xr[64 * j]; } \
        else { const u32x2* xr = (const u32x2*)(XB + (size_t)(row) * D) + lane; _Pragma("unroll") for (int j = 0; j < 4; ++j) nb[j] = xr[64 * j]; } } while (0)
    if (r0 < r1) N1_LOAD(r0);
    for (int row = r0; row < r1; ++row) {
        f32x4 v[4];
        if (first) {
#pragma unroll
            for (int j = 0; j < 4; ++j) v[j] = nv[j];
        } else {
#pragma unroll
            for (int j = 0; j < 4; ++j) v[j] = bf4(nb[j]);
        }
        if (row + 1 < r1) N1_LOAD(row + 1);
        const int mi = mod_index(row);
        if (mi != curmi) { curmi = mi; const float* mrow = mod + (size_t)mi * 6144;
#pragma unroll
            for (int j = 0; j < 4; ++j) { const int c = 4 * lane + 256 * j; A[j] = *(const f32x4*)(g + c) * (*(const f32x4*)(mrow + D + c) + 1.f); B[j] = *(const f32x4*)(mrow + c); } }
        float s = 0.f;
#pragma unroll
        for (int j = 0; j < 4; ++j) s += (v[j].x * v[j].x + v[j].y * v[j].y) + (v[j].z * v[j].z + v[j].w * v[j].w);
        const float rs = rsqrtf(wave_sum(s) * (1.f / D) + 1e-6f);
        u32x2* o8 = (u32x2*)(H + (size_t)row * D) + lane;
#pragma unroll
        for (int j = 0; j < 4; ++j) { const f32x4 h = v[j] * rs * A[j] + B[j]; u32x2 w; w.x = pk2(h.x, h.y); w.y = pk2(h.z, h.w); o8[64 * j] = w; }
    }
#undef N1_LOAD
}

struct SchedStatic {
    int nM, nN, nwg, G, c; const unsigned char* ws; size_t offA, offB; int skipctx;
    __device__ __forceinline__ bool next(int i, pg8::Unit& u) const {
        const long L = (long)i * G + c; if (L >= nwg) return false;
        int wgid = (int)L; { const int q = nwg / 8, r = nwg % 8, xcd = wgid % 8, off = wgid / 8; wgid = (xcd < r ? xcd * (q + 1) : r * (q + 1) + (xcd - r) * q) + off; }
        const int nig = 8 * nN, gid = wgid / nig, fm = gid * 8, gsz = (nM - fm) < 8 ? (nM - fm) : 8;
        u.pm = fm + ((wgid % nig) % gsz); u.pn = (wgid % nig) / gsz; u.aux = 0;
        if (skipctx) u.pm = (u.pm >> 5) * 33 + 1 + (u.pm & 31);
        return true;
    }
    __device__ __forceinline__ const char* aptr(const pg8::Unit& u) const { return (const char*)ws + offA + (size_t)u.pm * (256 * 1024 * 2); }
    __device__ __forceinline__ const char* bptr(const pg8::Unit& u) const { return (const char*)ws + offB + (size_t)u.pn * (256 * 1024 * 2); }
    __device__ __forceinline__ const char* bptr2(const pg8::Unit& u) const { return bptr(u); }
    __device__ __forceinline__ const int* rowlist(const pg8::Unit&) const { return nullptr; }
};
struct EpiU {
    static constexpr bool PERM = true;
    unsigned char* ws;
    __device__ __forceinline__ void operator()(const f32x4 (&acc)[2][2][4][2], const pg8::Unit& u, int wr, int wc, int fr, int fq) const {
        const int row0 = u.pm * 256 + wr * 64 + fr, pn = u.pn;
        float* u_misc = (float*)(ws + WS_UMISC);
        if (pn < 12) {
            bf16* base; int ld, c0;
            if (pn < 4) { base = (bf16*)(ws + WS_URW); ld = 1024; c0 = pn * 256; } else if (pn < 6) { base = (bf16*)(ws + WS_UZ); ld = 512; c0 = (pn - 4) * 256; }
            else if (pn < 9) { base = (bf16*)(ws + WS_UXBC); ld = 768; c0 = (pn - 6) * 256; } else { base = (bf16*)(ws + WS_UGLA); ld = 768; c0 = (pn - 9) * 256; }
            const int col0 = c0 + wc * 32 + 8 * fq;
#pragma unroll
            for (int ai = 0; ai < 2; ++ai)
#pragma unroll
                for (int m = 0; m < 4; ++m) { bf16* rowp = base + (size_t)(row0 + ai * 128 + m * 16) * ld + col0;
#pragma unroll
                    for (int bj = 0; bj < 2; ++bj) { const f32x4 v0 = acc[ai][bj][m][0], v1 = acc[ai][bj][m][1];
                        u32x4 w; w.x = pg8::cvt_pk_bf16(v0[0], v0[1]); w.y = pg8::cvt_pk_bf16(v0[2], v0[3]); w.z = pg8::cvt_pk_bf16(v1[0], v1[1]); w.w = pg8::cvt_pk_bf16(v1[2], v1[3]);
                        *(u32x4*)(rowp + bj * 128) = w; } }
        } else if (wc == 0) {
#pragma unroll
            for (int ai = 0; ai < 2; ++ai)
#pragma unroll
                for (int m = 0; m < 4; ++m) { float* rp = u_misc + (size_t)(row0 + ai * 128 + m * 16) * 32 + 8 * fq;
                    *(f32x4*)rp = acc[ai][0][m][0]; *(f32x4*)(rp + 4) = acc[ai][0][m][1]; }
        }
    }
};
struct EpiRes {
    static constexpr bool PERM = true;
    const float* xin_lat; const float* xin_ctx; unsigned char* ws; int l;
    __device__ __forceinline__ void operator()(const f32x4 (&acc)[2][2][4][2], const pg8::Unit& u, int wr, int wc, int fr, int fq) const {
        const int b = u.pm / 33, tb = u.pm % 33;
        const float* mrow = (const float*)(ws + WS_MOD) + (size_t)l * 9 * 6144 + (size_t)(tb == 0 ? 8 : b) * 6144 + 2 * D;
        const float* xi = tb == 0 ? xin_ctx + (size_t)b * TC * D : xin_lat + ((size_t)b * TL + (size_t)(tb - 1) * 256) * D;
        bf16* xo = (bf16*)(ws + WS_XB) + (size_t)u.pm * 256 * D;
        const int r0 = wr * 64 + fr, col0 = u.pn * 256 + wc * 32 + 8 * fq;
        const bool first = l == 0;
#pragma unroll
        for (int ai = 0; ai < 2; ++ai)
#pragma unroll
            for (int m = 0; m < 4; ++m) { const size_t off = (size_t)(r0 + ai * 128 + m * 16) * D + col0;
#pragma unroll
                for (int bj = 0; bj < 2; ++bj) { const f32x4 g0 = *(const f32x4*)(mrow + col0 + bj * 128), g1 = *(const f32x4*)(mrow + col0 + bj * 128 + 4);
                    f32x4 x0, x1;
                    if (first) { x0 = *(const f32x4*)(xi + off + bj * 128); x1 = *(const f32x4*)(xi + off + bj * 128 + 4); }
                    else { const u32x4 w = *(const u32x4*)(xo + off + bj * 128); x0 = bf4((u32x2){w.x, w.y}); x1 = bf4((u32x2){w.z, w.w}); }
                    x0 = x0 + g0 * acc[ai][bj][m][0]; x1 = x1 + g1 * acc[ai][bj][m][1];
                    u32x4 o; o.x = pg8::cvt_pk_bf16(x0[0], x0[1]); o.y = pg8::cvt_pk_bf16(x0[2], x0[3]); o.z = pg8::cvt_pk_bf16(x1[0], x1[1]); o.w = pg8::cvt_pk_bf16(x1[2], x1[3]);
                    *(u32x4*)(xo + off + bj * 128) = o; }
                asm volatile("" ::: "memory"); }
    }
};
__device__ __forceinline__ void cls_experts(int cls, int& ea, int& eb) {
    const int g = cls / 6, pr = cls % 6;
    const int pa = pr < 3 ? 0 : (pr < 5 ? 1 : 2);
    const int pb = pr == 0 ? 1 : (pr == 1 ? 2 : (pr == 2 ? 3 : (pr == 3 ? 2 : 3)));
    ea = g * 4 + pa; eb = g * 4 + pb;
}
template <int NJ> struct SchedMoE {
    int ntiles, G, c; const LAS int* cs; const unsigned char* ws;
    __device__ __forceinline__ bool next(int i, pg8::Unit& u) const {
        const long L = (long)i * G + c; if (L >= (long)ntiles * NJ) return false;
        const int tile = (int)(L / NJ), j = (int)(L % NJ), slot0 = tile * 256;
        int cls = 0;
#pragma unroll 1
        for (int k = 1; k < NCLS; ++k) cls = (slot0 >= cs[k]) ? k : cls;
        u.pm = tile; u.pn = j; u.aux = cls; return true;
    }
    __device__ __forceinline__ const char* aptr(const pg8::Unit& u) const { return NJ == 8 ? (const char*)ws + WS_ACT : (const char*)ws + WS_H1 + (size_t)u.pm * (256 * 1024 * 2); }
    __device__ __forceinline__ const int* rowlist(const pg8::Unit& u) const { return (const int*)(ws + WS_LIST) + u.pm * 256; }
    __device__ __forceinline__ const char* bptr(const pg8::Unit& u) const { int ea, eb; cls_experts(u.aux, ea, eb);
        if (NJ == 8) { const int e = u.pn < 4 ? ea : eb; return (const char*)ws + WS_W13 + ((size_t)e * D + (size_t)(u.pn & 3) * 256) * D * 2; }
        return (const char*)ws + WS_W2T + ((size_t)ea * D + (size_t)u.pn * 256) * 512 * 2; }
    __device__ __forceinline__ const char* bptr2(const pg8::Unit& u) const { int ea, eb; cls_experts(u.aux, ea, eb);
        return (const char*)ws + WS_W2T + ((size_t)eb * D + (size_t)u.pn * 256) * 512 * 2; }
};
struct EpiSwiGLU {
    static constexpr bool PERM = true;
    unsigned char* ws;
    __device__ __forceinline__ void operator()(const f32x4 (&acc)[2][2][4][2], const pg8::Unit& u, int wr, int wc, int fr, int fq) const {
        bf16* H1 = (bf16*)(ws + WS_H1); const f32x2* wslot = (const f32x2*)(ws + WS_WSLOT);
        const int row0 = u.pm * 256 + wr * 64 + fr, j = u.pn;
        const int col0 = (j >> 2) * 512 + (j & 3) * 128 + wc * 32 + 8 * fq;
#pragma unroll
        for (int ai = 0; ai < 2; ++ai)
#pragma unroll
            for (int m = 0; m < 4; ++m) { const int row = row0 + ai * 128 + m * 16; const f32x2 wv = wslot[row]; const float w = j < 4 ? wv.x : wv.y;
                float o[8];
#pragma unroll
                for (int n = 0; n < 2; ++n)
#pragma unroll
                    for (int i = 0; i < 4; ++i) { const float gt = acc[ai][0][m][n][i], up = acc[ai][1][m][n][i]; o[n * 4 + i] = siluf(gt) * up * w; }
                u32x4 wv4; wv4.x = pg8::cvt_pk_bf16(o[0], o[1]); wv4.y = pg8::cvt_pk_bf16(o[2], o[3]); wv4.z = pg8::cvt_pk_bf16(o[4], o[5]); wv4.w = pg8::cvt_pk_bf16(o[6], o[7]);
                *(u32x4*)(H1 + (size_t)row * D + col0) = wv4; }
    }
};
struct EpiScatter {
    static constexpr bool PERM = true;
    unsigned char* ws; int l;
    __device__ __forceinline__ void operator()(const f32x4 (&acc)[2][2][4][2], const pg8::Unit& u, int wr, int wc, int fr, int fq) const {
        const int* list = (const int*)(ws + WS_LIST); bf16* XB = (bf16*)(ws + WS_XB); const float* mod = (const float*)(ws + WS_MOD) + (size_t)l * 9 * 6144;
        const int row0 = u.pm * 256 + wr * 64 + fr, col0 = u.pn * 256 + wc * 32 + 8 * fq;
#pragma unroll
        for (int ai = 0; ai < 2; ++ai)
#pragma unroll
            for (int m = 0; m < 4; ++m) { const int tok = list[row0 + ai * 128 + m * 16];
                if (tok >= 0) { const int b = tok / TB, p = tok % TB;
                    bf16* xr = XB + (size_t)tok * D + col0;
                    const float* mrow = mod + (size_t)(p < TC ? 8 : b) * 6144 + 5 * D + col0;
#pragma unroll
                    for (int bj = 0; bj < 2; ++bj) { const f32x4 g0 = *(const f32x4*)(mrow + bj * 128), g1 = *(const f32x4*)(mrow + bj * 128 + 4);
                        const u32x4 w = *(const u32x4*)(xr + bj * 128);
                        const f32x4 x0 = bf4((u32x2){w.x, w.y}) + g0 * acc[ai][bj][m][0], x1 = bf4((u32x2){w.z, w.w}) + g1 * acc[ai][bj][m][1];
                        u32x4 o; o.x = pg8::cvt_pk_bf16(x0[0], x0[1]); o.y = pg8::cvt_pk_bf16(x0[2], x0[3]); o.z = pg8::cvt_pk_bf16(x1[0], x1[1]); o.w = pg8::cvt_pk_bf16(x1[2], x1[3]);
                        *(u32x4*)(xr + bj * 128) = o; } }
                asm volatile("" ::: "memory"); }
    }
};

constexpr int LD64 = 72;
__device__ __forceinline__ f32x4 mma16g(f32x4 acc, const LAS bf16* A, int lda, const bf16* Btg, int ldb, int lane) {
    const int r = lane & 15, kq = (lane >> 4) * 8;
    const bf16x8 a = *(const LAS bf16x8*)(A + r * lda + kq);
    const bf16x8 b = *(const bf16x8*)(Btg + (size_t)r * ldb + kq);
    return __builtin_amdgcn_mfma_f32_16x16x32_bf16(a, b, acc, 0, 0, 0);
}
__device__ __forceinline__ void phase_conv(const Frame& F0) {
    PH_ENTER(F0);
    const AS4 Args* KA = kargs();
    const bf16* UXBC = (const bf16*)(F.ws + WS_UXBC); bf16* XBCA = (bf16*)((unsigned char*)F.out + OUT_XBCA);
    const float* cw = LP(22, 9 * 768); const float* cb = LP(23, 768);
    const int cg = F.tid % 96, sub = F.tid / 96;
    if (sub >= 5) return;
    const int ch0 = cg * 8;
    float wgt0[9][8], bias[8];
#pragma unroll
    for (int k = 0; k < 9; ++k) { const f32x4 wa = *(const f32x4*)(cw + k * 768 + ch0), wb = *(const f32x4*)(cw + k * 768 + ch0 + 4);
        wgt0[k][0] = wa.x; wgt0[k][1] = wa.y; wgt0[k][2] = wa.z; wgt0[k][3] = wa.w; wgt0[k][4] = wb.x; wgt0[k][5] = wb.y; wgt0[k][6] = wb.z; wgt0[k][7] = wb.w; }
    { const f32x4 b0 = *(const f32x4*)(cb + ch0), b1 = *(const f32x4*)(cb + ch0 + 4); bias[0] = b0.x; bias[1] = b0.y; bias[2] = b0.z; bias[3] = b0.w; bias[4] = b1.x; bias[5] = b1.y; bias[6] = b1.z; bias[7] = b1.w; }
    for (int it = F.bid * 5 + sub; it < NUNIT64 * 4; it += F.G * 5) {
        const int u = it >> 2, run = it & 3, b = u / NTILE64, tl = u % NTILE64, p0 = tl * 64; const size_t rowbase = (size_t)b * TB;
        const bool lat = p0 >= TC; const int gr = (p0 - TC) >> 6;
        const int xhi = lat ? 64 : TC, x0 = (lat ? 0 : p0) + run * 16;
        const bf16* rp0; const bf16* rp1; const bf16* rp2; bool rv0, rv2;
        { const int y0 = gr - 1, y2 = gr + 1; rv0 = lat && y0 >= 0; rv2 = lat && y2 < 128;
            rp1 = UXBC + (rowbase + (lat ? TC + gr * 64 : 0)) * 768 + ch0; rp0 = rv0 ? rp1 - 64 * 768 : rp1; rp2 = rv2 ? rp1 + 64 * 768 : rp1; }
        const float m0 = rv0 ? 1.f : 0.f, m2 = rv2 ? 1.f : 0.f;
        u32x4 w00, w01, w02, w10, w11, w12;
        { const int xa = x0 - 1; const bool va = xa >= 0; const size_t oa = (size_t)(va ? xa : 0) * 768; const u32x4 z4 = {0u, 0u, 0u, 0u};
            w00 = va ? *(const u32x4*)(rp0 + oa) : z4; w01 = va ? *(const u32x4*)(rp1 + oa) : z4; w02 = va ? *(const u32x4*)(rp2 + oa) : z4;
            const size_t ob = (size_t)x0 * 768; w10 = *(const u32x4*)(rp0 + ob); w11 = *(const u32x4*)(rp1 + ob); w12 = *(const u32x4*)(rp2 + ob); }
#pragma unroll 4
        for (int k = 0; k < 16; ++k) { const int x = x0 + k, xn = x + 1; const bool vn = xn < xhi; const size_t on = (size_t)(vn ? xn : x) * 768; const u32x4 z4 = {0u, 0u, 0u, 0u};
            u32x4 w20 = *(const u32x4*)(rp0 + on), w21 = *(const u32x4*)(rp1 + on), w22 = *(const u32x4*)(rp2 + on);
            if (!vn) { w20 = z4; w21 = z4; w22 = z4; }
            float acc[8], t0[8], t2[8];
#pragma unroll
            for (int i = 0; i < 8; ++i) { acc[i] = bias[i]; t0[i] = 0.f; t2[i] = 0.f; }
            float v[8];
#define CONV_TAP(W, K, DST) unpack8(W, v); _Pragma("unroll") for (int i = 0; i < 8; ++i) DST[i] += v[i] * wgt0[K][i];
            CONV_TAP(w00, 0, t0) CONV_TAP(w10, 1, t0) CONV_TAP(w20, 2, t0) CONV_TAP(w01, 3, acc) CONV_TAP(w11, 4, acc) CONV_TAP(w21, 5, acc) CONV_TAP(w02, 6, t2) CONV_TAP(w12, 7, t2) CONV_TAP(w22, 8, t2)
#undef CONV_TAP
#pragma unroll
            for (int i = 0; i < 8; ++i) acc[i] = siluf(acc[i] + m0 * t0[i] + m2 * t2[i]);
            *(u32x4*)(XBCA + (rowbase + (lat ? TC + gr * 64 + x : x)) * 768 + ch0) = pack8(acc);
            w00 = w10; w01 = w11; w02 = w12; w10 = w20; w11 = w21; w12 = w22;
        }
    }
}
__device__ __forceinline__ void phase_prep(const Frame& F0) {
    PH_ENTER(F0);
    const AS4 Args* KA = kargs();
    const int tid = F.tid, lane = F.lane, wave = F.wave;
    const bf16* URW = (const bf16*)(F.ws + WS_URW); const bf16* UXBC = (const bf16*)(F.ws + WS_UXBC);
    bf16* XBCA = (bf16*)((unsigned char*)F.out + OUT_XBCA);
    h16* RECS = (h16*)(F.ws + WS_RECS); h16* RECD = (h16*)(F.ws + WS_RECD); h16* BONUS = (h16*)((unsigned char*)F.out + OUT_BONUS); h16* GATE = (h16*)(F.ws + WS_GATE);
    const bf16* LW = (const bf16*)(F.ws + WS_LOWR);
    const float* mup = LP(10, 1024); const float* mun = LP(11, 1024);
    const float* w0 = LP(12, 512); const float* a0 = LP(14, 512);
    const float* k_k = LP(17, 256); const float* r_k = LP(19, 256);
    const float* cw = LP(22, 9 * 768); const float* cb = LP(23, 768);
    constexpr int LDR = 776, LDG = 136;
    LAS h16* RKV = (LAS h16*)F.lds;
    LAS bf16* WLi = (LAS bf16*)(F.lds + 99328);
    LAS bf16* ALi = (LAS bf16*)(F.lds + 108544);
    LAS bf16* GSi = (LAS bf16*)(F.lds + 117760);
    bf16x8 Bf[5][2][4];
    { const int c0 = wave * 32, r = lane & 15, kq = (lane >> 4) * 8;
#pragma unroll
        for (int mm = 0; mm < 4; ++mm) { const bf16* Bt = mm < 2 ? LW + (size_t)mm * 16384 : (mm < 4 ? LW + 32768 + (size_t)(mm - 2) * 16384 : LW + 65536); const int ldb = mm < 4 ? 64 : 128;
#pragma unroll
            for (int nt = 0; nt < 2; ++nt)
#pragma unroll
                for (int ks = 0; ks < 4; ++ks) if (ks < (mm < 4 ? 2 : 4)) Bf[mm][nt][ks] = *(const bf16x8*)(Bt + (size_t)(c0 + nt * 16 + r) * ldb + ks * 32 + kq); } }
    for (int u = F.bid; u < NUNIT64; u += F.G) {
        const int b = u / NTILE64, tl = u % NTILE64, p0 = tl * 64;
        const int seg_lo = p0 < TC ? 0 : TC, seg_hi = p0 < TC ? TC : TB;
        const size_t rowbase = (size_t)b * TB;
        LDS_BARRIER();
        SUBREP(1) { const int t = tid >> 3, part = tid & 7, p = p0 + t; const bf16* ur = URW + (rowbase + p) * 1024;
            const bool hp = p - 1 >= seg_lo, hn = p + 1 < seg_hi;
#pragma unroll 4
            for (int j = 0; j < 16; ++j) { const int c0 = (j * 8 + part) * 8;
                float uc[8], up[8], un[8];
                unpack8(*(const u32x4*)(ur + c0), uc);
                if (hp) unpack8(*(const u32x4*)(ur - 1024 + c0), up); else {
#pragma unroll
                    for (int i = 0; i < 8; ++i) up[i] = 0.f; }
                if (hn) unpack8(*(const u32x4*)(ur + 1024 + c0), un); else {
#pragma unroll
                    for (int i = 0; i < 8; ++i) un[i] = 0.f; }
                const f32x4 mp0 = *(const f32x4*)(mup + c0), mp1 = *(const f32x4*)(mup + c0 + 4), mn0 = *(const f32x4*)(mun + c0), mn1 = *(const f32x4*)(mun + c0 + 4);
                float sv[8];
#pragma unroll
                for (int i = 0; i < 4; ++i) { sv[i] = uc[i] + mp0[i] * (up[i] - uc[i]) + mn0[i] * (un[i] - uc[i]); sv[4 + i] = uc[4 + i] + mp1[i] * (up[4 + i] - uc[4 + i]) + mn1[i] * (un[4 + i] - uc[4 + i]); }
                if (c0 < 768) { h16x8 hv;
#pragma unroll
                    for (int i = 0; i < 8; ++i) hv[i] = (h16)sv[i];
                    *(LAS h16x8*)(RKV + t * LDR + c0) = hv; }
                else if (c0 < 832) {
#pragma unroll
                    for (int i = 0; i < 8; ++i) sv[i] = tanhf(sv[i]);
                    *(LAS u32x4*)(WLi + t * LD64 + (c0 - 768)) = pack8(sv); }
                else if (c0 < 896) *(LAS u32x4*)(ALi + t * LD64 + (c0 - 832)) = pack8(sv);
                else {
#pragma unroll
                    for (int i = 0; i < 8; ++i) sv[i] = sigm(sv[i]);
                    *(LAS u32x4*)(GSi + t * LDG + (c0 - 896)) = pack8(sv); }
            } }
        LDS_BARRIER();
        SUBREP(2) { const int t = tid >> 3, hq = tid & 7, h = hq >> 1, c0 = h * 64 + (hq & 1) * 32, p = p0 + t;
            float ss = 0.f, bs = 0.f;
#pragma unroll
            for (int j = 0; j < 4; ++j) { const h16x8 rv = *(const LAS h16x8*)(RKV + t * LDR + c0 + 8 * j), kv = *(const LAS h16x8*)(RKV + t * LDR + 256 + c0 + 8 * j);
                const f32x4 kk0 = *(const f32x4*)(k_k + c0 + 8 * j), kk1 = *(const f32x4*)(k_k + c0 + 8 * j + 4), rk0 = *(const f32x4*)(r_k + c0 + 8 * j), rk1 = *(const f32x4*)(r_k + c0 + 8 * j + 4);
#pragma unroll
                for (int i = 0; i < 8; ++i) { const float kf = (float)kv[i], rf = (float)rv[i], kc = i < 4 ? kk0[i & 3] : kk1[i & 3], rc = i < 4 ? rk0[i & 3] : rk1[i & 3];
                    const float kr = kf * kc; ss += kr * kr; bs += rf * kf * rc; } }
            ss += dpp_mov<0xB1>(ss); bs += dpp_mov<0xB1>(bs);
            const float rs = rsqrtf(ss + 1e-12f);
            h16* rec = RECS + (((size_t)b * 4 + h) * TB + p) * 256 + (hq & 1) * 32;
            h16* bon = BONUS + (rowbase + p) * 256 + c0;
#pragma unroll
            for (int j = 0; j < 4; ++j) { const h16x8 rv = *(const LAS h16x8*)(RKV + t * LDR + c0 + 8 * j), kv = *(const LAS h16x8*)(RKV + t * LDR + 256 + c0 + 8 * j), vv = *(const LAS h16x8*)(RKV + t * LDR + 512 + c0 + 8 * j);
                const f32x4 kk0 = *(const f32x4*)(k_k + c0 + 8 * j), kk1 = *(const f32x4*)(k_k + c0 + 8 * j + 4);
                h16x8 kkv, bv;
#pragma unroll
                for (int i = 0; i < 8; ++i) { kkv[i] = (h16)((float)kv[i] * (i < 4 ? kk0[i & 3] : kk1[i & 3]) * rs); bv[i] = (h16)(bs * (float)vv[i]); }
                *(h16x8*)(rec + 8 * j) = rv; *(h16x8*)(rec + 64 + 8 * j) = vv; *(h16x8*)(rec + 128 + 8 * j) = kkv; *(h16x8*)(rec + 192 + 8 * j) = kv;
                *(h16x8*)(bon + 8 * j) = bv; asm volatile("" ::: "memory"); } }
        LDS_BARRIER();
        SUBREP(3) { const int c0 = wave * 32, h = wave >> 1, lr = (lane >> 4) * 4, lc = lane & 15;
#pragma unroll
            for (int nt = 0; nt < 2; ++nt)
#pragma unroll
                for (int ks = 0; ks < 4; ++ks) Bf[4][nt][ks] = *(const bf16x8*)(LW + 65536 + (size_t)(c0 + nt * 16 + (lane & 15)) * 128 + ks * 32 + (lane >> 4) * 8);
#pragma unroll
            for (int mm = 0; mm < 5; ++mm) {
                const LAS bf16* Ai = mm < 2 ? WLi : (mm < 4 ? ALi : GSi); const int lda = mm < 4 ? LD64 : LDG, nks = mm < 4 ? 2 : 4;
                f32x4 acc[4][2];
#pragma unroll
                for (int tt = 0; tt < 4; ++tt)
#pragma unroll
                    for (int nt = 0; nt < 2; ++nt) acc[tt][nt] = (f32x4){0.f, 0.f, 0.f, 0.f};
#pragma unroll
                for (int ks = 0; ks < 4; ++ks) if (ks < nks)
#pragma unroll
                    for (int tt = 0; tt < 4; ++tt) { const bf16x8 af = *(const LAS bf16x8*)(Ai + (tt * 16 + (lane & 15)) * lda + ks * 32 + (lane >> 4) * 8);
#pragma unroll
                        for (int nt = 0; nt < 2; ++nt) acc[tt][nt] = __builtin_amdgcn_mfma_f32_16x16x32_bf16(af, Bf[mm][nt][ks], acc[tt][nt], 0, 0, 0); }
                LAS h16* STG = (LAS h16*)F.lds + (mm & 1) * (64 * 264);
#pragma unroll
                for (int nt = 0; nt < 2; ++nt) { const int c = c0 + nt * 16 + lc;
                    const float bias = mm < 2 ? w0[mm * 256 + c] : (mm < 4 ? a0[(mm - 2) * 256 + c] : 0.f);
#pragma unroll
                    for (int tt = 0; tt < 4; ++tt)
#pragma unroll
                        for (int i = 0; i < 4; ++i) { const float x = acc[tt][nt][i] + bias; const float sg = sigm(x);
                            const float o = mm < 2 ? 1.f - __expf(-0.60653066f * sg) : (mm < 4 ? sg : x);
                            STG[(tt * 16 + lr + i) * 264 + c] = (h16)o; } }
                LDS_BARRIER();
#pragma unroll
                for (int i = 0; i < 4; ++i) { const int id = tid + 512 * i, t = id >> 5, ch = id & 31, hh = ch >> 3;
                    const h16x8 v = *(const LAS h16x8*)(STG + t * 264 + ch * 8);
                    h16* dst = mm < 2 ? RECD + ((((size_t)b * 4 + hh) * 2 + mm) * TB + p0 + t) * 128 + (ch & 7) * 8
                             : (mm < 4 ? RECD + ((((size_t)b * 4 + hh) * 2 + (mm - 2)) * TB + p0 + t) * 128 + 64 + (ch & 7) * 8 : GATE + (rowbase + p0 + t) * 256 + ch * 8);
                    *(h16x8*)dst = v; }
            } }
    }
}

__device__ __forceinline__ f32x4 mma16(f32x4 acc, const LAS bf16* A, int lda, const LAS bf16* Bt, int ldb, int lane) {
    const int r = lane & 15, kq = (lane >> 4) * 8;
    const bf16x8 a = *(const LAS bf16x8*)(A + r * lda + kq);
    const bf16x8 b = *(const LAS bf16x8*)(Bt + r * ldb + kq);
    return __builtin_amdgcn_mfma_f32_16x16x32_bf16(a, b, acc, 0, 0, 0);
}
typedef short v4i16 __attribute__((ext_vector_type(4)));
__device__ __forceinline__ bf16x8 frag_tr(const LAS bf16* T, int ld, int k0, int c0, int lane) {
    const int g = lane >> 4, q = (lane & 15) >> 2, p = lane & 3;
    const LAS bf16* a = T + (k0 + 8 * g + q) * ld + c0 + 4 * p;
    const v4i16 lo = __builtin_amdgcn_ds_read_tr16_b64_v4i16((LAS v4i16*)a);
    const v4i16 hi = __builtin_amdgcn_ds_read_tr16_b64_v4i16((LAS v4i16*)(a + 4 * ld));
    return (bf16x8){lo[0], lo[1], lo[2], lo[3], hi[0], hi[1], hi[2], hi[3]};
}
__device__ __forceinline__ bf16x8 frag_row(const LAS bf16* A, int lda, int lane) { return *(const LAS bf16x8*)(A + (lane & 15) * lda + (lane >> 4) * 8); }
template <int MT, int NT, int KS> __device__ __forceinline__ void mm_block(f32x4 (&acc)[MT][NT], const LAS bf16* A, int lda, const LAS bf16* Bt, int ldb, int lane) {
    bf16x8 af[MT][KS], bfr[NT][KS];
#pragma unroll
    for (int mi = 0; mi < MT; ++mi)
#pragma unroll
        for (int ks = 0; ks < KS; ++ks) af[mi][ks] = frag_row(A + mi * 16 * lda + ks * 32, lda, lane);
#pragma unroll
    for (int nt = 0; nt < NT; ++nt)
#pragma unroll
        for (int ks = 0; ks < KS; ++ks) bfr[nt][ks] = frag_row(Bt + nt * 16 * ldb + ks * 32, ldb, lane);
#pragma unroll
    for (int mi = 0; mi < MT; ++mi)
#pragma unroll
        for (int nt = 0; nt < NT; ++nt)
#pragma unroll
            for (int ks = 0; ks < KS; ++ks) acc[mi][nt] = __builtin_amdgcn_mfma_f32_16x16x32_bf16(af[mi][ks], bfr[nt][ks], acc[mi][nt], 0, 0, 0);
}
__device__ __forceinline__ float scan_incl(float v, int lane, bool rev) {
#pragma unroll
    for (int o = 1; o < 64; o <<= 1) { const float t = rev ? __shfl_down(v, o) : __shfl_up(v, o); if (rev ? (lane + o < 64) : (lane >= o)) v += t; }
    return v;
}


__device__ __forceinline__ void gla_bcs(const Frame& F, const AS4 Args* KA, size_t row0, LAS float* LG, LAS float* GLT) {
    const int tid = F.tid;
    const float* UM = (const float*)(F.ws + WS_UMISC); const float* ga2 = LP(28, 2 * 16 * 128); const float* gb = LP(29, 256);
    LDS_BARRIER();
    if (tid < 256) { const int s = tid >> 2, j4 = (tid & 3) * 4; *(LAS f32x4*)(GLT + s * 16 + j4) = *(const f32x4*)(UM + (row0 + s) * 32 + 8 + j4); }
    LDS_BARRIER();
    { const int ch2 = tid & 255, d = ch2 >> 7, ch = ch2 & 127, sh = tid >> 8;
        float w[16];
#pragma unroll
        for (int j = 0; j < 16; ++j) w[j] = ga2[(size_t)(d * 16 + j) * 128 + ch];
        const float bias = gb[d * 128 + ch];
#pragma unroll 4
        for (int t = 0; t < 32; ++t) { const int s = sh * 32 + t; float z = bias;
#pragma unroll
            for (int j4 = 0; j4 < 4; ++j4) { const f32x4 g4 = *(const LAS f32x4*)(GLT + s * 16 + j4 * 4); z += g4.x * w[j4 * 4] + g4.y * w[j4 * 4 + 1] + g4.z * w[j4 * 4 + 2] + g4.w * w[j4 * 4 + 3]; }
            LG[(d * 64 + s) * 128 + ch] = -softplusf_(-z) * (1.f / 16.f); } }
    LDS_BARRIER();
    if (tid < 256) { const int d = tid >> 7, ch = tid & 127; float a = 0.f;
#pragma unroll 8
        for (int t = 0; t < 64; ++t) { const int s = d ? 63 - t : t; a += LG[(d * 64 + s) * 128 + ch]; LG[(d * 64 + s) * 128 + ch] = a; } }
    LDS_BARRIER();
}
__device__ __forceinline__ void phase_combine_gla(const Frame& F0) {
    PH_ENTER(F0);
    const int gid = F.bid * 512 + F.tid;
    if (gid >= 64 * 1024) return;
    const int chain = gid >> 10, e0 = (gid & 1023) * 2, d = chain & 1, bh = chain >> 1, b = bh >> 2, h = bh & 3;
    bf16* GS = (bf16*)(F.ws + WS_GS) + (size_t)chain * NTILE64 * 2048 + e0; const float* GDEC = (const float*)(F.ws + WS_GDEC) + (size_t)b * NTILE64 * 256 + d * 128 + h * 32 + (e0 & 31);
    float S0 = 0.f, S1 = 0.f;
#pragma unroll 4
    for (int it = 0; it < NTILE64; ++it) {
        const int c = d == 0 ? it : (it < 4 ? 3 - it : 131 - (it - 4));
        unsigned* p = (unsigned*)(GS + (size_t)c * 2048); const unsigned st = *p; const f32x2 dec = *(const f32x2*)(GDEC + (size_t)c * 256);
        *p = pk2(S0, S1);
        S0 = S0 * dec.x + __uint_as_float(st << 16); S1 = S1 * dec.y + __uint_as_float(st & 0xffff0000u);
    }
}
__device__ __forceinline__ void phase_finish_gla(const Frame& F0) {
    PH_ENTER(F0);
    const AS4 Args* KA = kargs();
    const int tid = F.tid, lane = F.lane, wave = F.wave;
    const bf16* UG = (const bf16*)(F.ws + WS_UGLA); const bf16* GS = (const bf16*)(F.ws + WS_GS); bf16* MIX = (bf16*)(F.ws + WS_ACT);
    const float* gln = LP(30, 256);
    constexpr int LD32 = 40;
    LAS float* LG = (LAS float*)F.lds;
    LAS bf16* QE = (LAS bf16*)(F.lds + 65536);
    LAS bf16* KE = (LAS bf16*)(F.lds + 86016);
    LAS bf16* VT = (LAS bf16*)(F.lds + 96256);
    LAS bf16* ST = (LAS bf16*)(F.lds + 105472);
    LAS bf16* ATT = (LAS bf16*)(F.lds + 115712);
    LAS bf16* OB = (LAS bf16*)(F.lds + 124928);
    LAS float* RSQ = (LAS float*)(F.lds + 134144);
    LAS float* GLT = (LAS float*)(F.lds + 134656);
    LAS bf16* RT = (LAS bf16*)(F.lds + 138752);
    const int lt = wave & 3, cth = wave >> 2, lr = (lane >> 4) * 4, lc = lane & 15;
    const bool skipctx = F.l == 1;
    for (int j_ = F.G - 1 - F.bid; j_ < n_units(skipctx); j_ += F.G) {
        const int u = unit_of(skipctx, j_);
        const int b = u / NTILE64, c = u % NTILE64; const size_t row0 = (size_t)b * TB + (size_t)c * 64;
        u32x2 pq, pk; u32x4 pv, pst, prt;
        { const int l = tid >> 3, g4 = (tid & 7) * 4; const bf16* ur = UG + (row0 + l) * 768;
            pq = *(const u32x2*)(ur + g4); pk = *(const u32x2*)(ur + 128 + g4);
            pv = *(const u32x4*)(UG + (row0 + (tid & 63)) * 768 + 256 + (tid >> 6) * 8);
            { const int d = tid >> 8, r = (tid & 255) >> 2, ch = tid & 3; pst = *(const u32x4*)(GS + ((((size_t)b * 4) * 2 + d) * NTILE64 + c) * 2048 + r * 32 + ch * 8); }
            prt = *(const u32x4*)(UG + (row0 + (tid >> 3)) * 768 + 512 + (tid & 7) * 8); }
        gla_bcs(F, KA, row0, LG, GLT);
#pragma unroll 1
        for (int h = 0; h < 4; ++h) {
            { const int l = tid >> 3, g4 = (tid & 7) * 4, ch = h * 32 + g4;
                const u32x2 qr = pq, kr = pk;
                const float q[4] = { bf2f(qr.x & 0xffff) * 0.17677669529663687f, bf2f(qr.x >> 16) * 0.17677669529663687f, bf2f(qr.y & 0xffff) * 0.17677669529663687f, bf2f(qr.y >> 16) * 0.17677669529663687f };
                const float k[4] = { bf2f(kr.x & 0xffff), bf2f(kr.x >> 16), bf2f(kr.y & 0xffff), bf2f(kr.y >> 16) };
#pragma unroll
                for (int d = 0; d < 2; ++d) { const f32x4 bc = *(const LAS f32x4*)(LG + (d * 64 + l) * 128 + ch), rf = *(const LAS f32x4*)(LG + (d * 64 + 32) * 128 + ch);
                    float qe[4], ke[4], qb[4];
#pragma unroll
                    for (int i = 0; i < 4; ++i) { qe[i] = q[i] * __expf(bc[i] - rf[i]); ke[i] = k[i] * __expf(rf[i] - bc[i]); qb[i] = q[i] * __expf(bc[i]); }
                    u32x2 w; w.x = pk2(qe[0], qe[1]); w.y = pk2(qe[2], qe[3]); *(LAS u32x2*)(QE + (d * 64 + l) * LD32 + g4) = w;
                    w.x = pk2(qb[0], qb[1]); w.y = pk2(qb[2], qb[3]); *(LAS u32x2*)(QE + ((2 + d) * 64 + l) * LD32 + g4) = w;
                    w.x = pk2(ke[0], ke[1]); w.y = pk2(ke[2], ke[3]); *(LAS u32x2*)(KE + (d * 64 + l) * LD32 + g4) = w; } }
            { const int s = tid & 63, g8 = tid >> 6; const unsigned w[4] = {pv.x, pv.y, pv.z, pv.w};
#pragma unroll
                for (int i = 0; i < 8; ++i) VT[(g8 * 8 + i) * LD64 + s] = (bf16)(i & 1 ? w[i >> 1] >> 16 : w[i >> 1] & 0xffffu); }
            { const int d = tid >> 8, r = (tid & 255) >> 2, ch = tid & 3; *(LAS u32x4*)(ST + (d * 64 + r) * LD32 + ch * 8) = pst; }
            *(LAS u32x4*)(RT + (tid >> 3) * LD64 + (tid & 7) * 8) = prt;
            { const int hn = h < 3 ? h + 1 : 3; const int l = tid >> 3, g4 = (tid & 7) * 4; const bf16* ur = UG + (row0 + l) * 768;
                pq = *(const u32x2*)(ur + hn * 32 + g4); pk = *(const u32x2*)(ur + 128 + hn * 32 + g4);
                pv = *(const u32x4*)(UG + (row0 + (tid & 63)) * 768 + 256 + hn * 64 + (tid >> 6) * 8);
                { const int d = tid >> 8, r = (tid & 255) >> 2, ch = tid & 3; pst = *(const u32x4*)(GS + ((((size_t)b * 4 + hn) * 2 + d) * NTILE64 + c) * 2048 + r * 32 + ch * 8); }
                prt = *(const u32x4*)(UG + (row0 + (tid >> 3)) * 768 + 512 + hn * 64 + (tid & 7) * 8); }
            LDS_BARRIER();
#pragma unroll
            for (int j = 0; j < 2; ++j) { const int st = 2 * cth + j; const f32x4 z4 = {0.f, 0.f, 0.f, 0.f};
                const f32x4 af = mma16(z4, QE + (lt * 16) * LD32, LD32, KE + (st * 16) * LD32, LD32, lane);
                const f32x4 ab = mma16(z4, QE + (64 + lt * 16) * LD32, LD32, KE + (64 + st * 16) * LD32, LD32, lane);
                const int s = st * 16 + lc;
#pragma unroll
                for (int i = 0; i < 4; ++i) { const int l = lt * 16 + lr + i; ATT[l * LD64 + s] = (bf16)f2bf((s <= l ? af[i] : 0.f) + (s >= l ? ab[i] : 0.f)); } }
            LDS_BARRIER();
            f32x4 o[2];
#pragma unroll
            for (int j = 0; j < 2; ++j) { const int vt = 2 * cth + j; f32x4 acc = {0.f, 0.f, 0.f, 0.f};
#pragma unroll
                for (int ks = 0; ks < 2; ++ks) acc = mma16(acc, ATT + lt * 16 * LD64 + ks * 32, LD64, VT + vt * 16 * LD64 + ks * 32, LD64, lane);
                acc = mma16(acc, QE + (128 + lt * 16) * LD32, LD32, ST + (vt * 16) * LD32, LD32, lane);
                acc = mma16(acc, QE + (192 + lt * 16) * LD32, LD32, ST + (64 + vt * 16) * LD32, LD32, lane);
                o[j] = acc; }
#pragma unroll
            for (int i = 0; i < 4; ++i) { const float t = sum16(o[0][i] * o[0][i] + o[1][i] * o[1][i]); if (lc == 0) RSQ[cth * 64 + lt * 16 + lr + i] = t; }
            LDS_BARRIER();
#pragma unroll
            for (int j = 0; j < 2; ++j) { const int dv = (2 * cth + j) * 16 + lc; const float gn = gln[h * 64 + dv];
#pragma unroll
                for (int i = 0; i < 4; ++i) { const int l = lt * 16 + lr + i; const float scl = rsqrtf((RSQ[l] + RSQ[64 + l]) * (1.f / 64.f) + 1e-6f);
                    const float r = bf2f(RT[l * LD64 + dv]);
                    OB[l * LD64 + dv] = (bf16)f2bf(o[j][i] * scl * gn * siluf(r)); } }
            LDS_BARRIER();
            { const int r = tid >> 3, ch = tid & 7; *(u32x4*)(MIX + (row0 + r) * D + 768 + h * 64 + ch * 8) = *(const LAS u32x4*)(OB + r * LD64 + ch * 8); }
        }
    }
}

__device__ __forceinline__ void phase_states(const Frame& F0) {
    PH_ENTER(F0);
    const AS4 Args* KA = kargs();
    const int tid = F.tid, lane = F.lane, wave = F.wave;
    const bf16* XBCA = (const bf16*)((const unsigned char*)F.out + OUT_XBCA); const float* UM = (const float*)(F.ws + WS_UMISC);
    bf16* SS = (bf16*)(F.ws + WS_SS); float* SDEC = (float*)(F.ws + WS_SDEC);
    const float* dtb = LP(24, 16); const float* alog = LP(25, 16);
    LAS bf16* CT = (LAS bf16*)F.lds;
    LAS bf16* XTW = (LAS bf16*)(F.lds + 99328);
    LAS bf16* BT = (LAS bf16*)(F.lds + 117760);
    LAS float* WTS = (LAS float*)(F.lds + 136192);
    const bf16* UG = (const bf16*)(F.ws + WS_UGLA); bf16* GS = (bf16*)(F.ws + WS_GS); float* GDEC = (float*)(F.ws + WS_GDEC);
    LAS float* LG = (LAS float*)F.lds;
    LAS bf16* VT4 = (LAS bf16*)(F.lds + 65536);
    LAS bf16* KTE = (LAS bf16*)(F.lds + 102400);
    LAS float* GLT = (LAS float*)(F.lds + 139264);
    for (int u = F.G - 1 - F.bid; u < NUNIT64; u += F.G) {
        const int b = u / NTILE64, c = u % NTILE64; const size_t row0 = (size_t)b * TB + (size_t)c * 64;
        LDS_BARRIER();
#pragma unroll
        for (int i = 0; i < 12; ++i) { const int id = tid + 512 * i, r = id / 96, ch = id % 96;
            *(LAS u32x4*)(CT + r * 776 + ch * 8) = *(const u32x4*)(XBCA + (row0 + r) * 768 + ch * 8); }
#pragma unroll
        for (int j = 0; j < 2; ++j) { const int q = wave * 2 + j, h = q >> 1, d = q & 1;
            const float dtp = softplusf_(UM[(row0 + lane) * 32 + h] + dtb[d * 8 + h]);
            const float dA = -__expf(alog[d * 8 + h]) * dtp;
            const float cs = scan_incl(dA, lane, d == 1);
            const float ce = __shfl(cs, d == 0 ? 63 : 0);
            WTS[q * 64 + lane] = __expf(ce - cs) * dtp;
            if (lane == 0) SDEC[((size_t)b * NTILE64 + c) * 16 + q] = __expf(ce); }
        LDS_BARRIER();
#pragma unroll 1
        for (int hp = 0; hp < 4; ++hp) {
            { const int sr = tid >> 3, ch = tid & 7, g = hp >> 1; float bv[8]; unpack8(*(const LAS u32x4*)(CT + sr * 776 + 512 + g * 64 + ch * 8), bv);
#pragma unroll
                for (int q = 0; q < 4; ++q) { const float w = WTS[(hp * 4 + q) * 64 + sr]; float o[8];
#pragma unroll
                    for (int i = 0; i < 8; ++i) o[i] = bv[i] * w;
                    *(LAS u32x4*)(XTW + (q * 64 + sr) * LD64 + ch * 8) = pack8(o); } }
            LDS_BARRIER();
            { const int d = wave >> 2, mt = wave & 3;
#pragma unroll
                for (int hh = 0; hh < 2; ++hh) { const int h = hp * 2 + hh;
                    bf16* dst = SS + ((((size_t)b * 8 + h) * 2 + d) * NTILE64 + c) * 4096;
                    bf16x8 af[2];
#pragma unroll
                    for (int ks = 0; ks < 2; ++ks) af[ks] = frag_tr(CT, 776, ks * 32, h * 64 + mt * 16, lane);
#pragma unroll
                    for (int nt = 0; nt < 4; ++nt) { f32x4 acc = {0.f, 0.f, 0.f, 0.f};
#pragma unroll
                        for (int ks = 0; ks < 2; ++ks) acc = __builtin_amdgcn_mfma_f32_16x16x32_bf16(af[ks], frag_tr(XTW + (hh * 2 + d) * 64 * LD64, LD64, ks * 32, nt * 16, lane), acc, 0, 0, 0);
#pragma unroll
                        for (int i = 0; i < 4; ++i) dst[(mt * 16 + (lane >> 4) * 4 + i) * 64 + nt * 16 + (lane & 15)] = (bf16)f2bf(acc[i]); } } }
            LDS_BARRIER();
        }
        gla_bcs(F, KA, row0, LG, GLT);
        if (tid < 256) GDEC[((size_t)b * NTILE64 + c) * 256 + tid] = __expf(LG[((tid >> 7) * 64 + ((tid >> 7) ? 0 : 63)) * 128 + (tid & 127)]);
        { const int sr = tid >> 3, q8 = tid & 7; const bf16* ur = UG + (row0 + sr) * 768;
#pragma unroll
            for (int i = 0; i < 4; ++i) { const int col = (q8 * 4 + i) * 8; *(LAS u32x4*)(VT4 + sr * 264 + col) = *(const u32x4*)(ur + 256 + col); }
#pragma unroll
            for (int i = 0; i < 2; ++i) { const int col = (q8 * 2 + i) * 8; float kv[8]; unpack8(*(const u32x4*)(ur + 128 + col), kv);
#pragma unroll
                for (int d = 0; d < 2; ++d) { const LAS float* be = LG + (d * 64 + (d ? 0 : 63)) * 128 + col; const LAS float* bc = LG + (d * 64 + sr) * 128 + col; float o[8];
#pragma unroll
                    for (int k = 0; k < 8; ++k) o[k] = kv[k] * __expf(be[k] - bc[k]);
                    *(LAS u32x4*)(KTE + (d * 64 + sr) * 136 + col) = pack8(o); } } }
        LDS_BARRIER();
        { const int d = wave >> 2, mt = wave & 3;
#pragma unroll
            for (int h = 0; h < 4; ++h) { bf16* dst = GS + ((((size_t)b * 4 + h) * 2 + d) * NTILE64 + c) * 2048;
                bf16x8 af[2];
#pragma unroll
                for (int ks = 0; ks < 2; ++ks) af[ks] = frag_tr(VT4, 264, ks * 32, h * 64 + mt * 16, lane);
#pragma unroll
                for (int nt = 0; nt < 2; ++nt) { f32x4 acc = {0.f, 0.f, 0.f, 0.f};
#pragma unroll
                    for (int ks = 0; ks < 2; ++ks) acc = __builtin_amdgcn_mfma_f32_16x16x32_bf16(af[ks], frag_tr(KTE + d * 64 * 136, 136, ks * 32, h * 32 + nt * 16, lane), acc, 0, 0, 0);
#pragma unroll
                    for (int i = 0; i < 4; ++i) dst[(mt * 16 + (lane >> 4) * 4 + i) * 32 + nt * 16 + (lane & 15)] = (bf16)f2bf(acc[i]); } } }
    }
}
__device__ __forceinline__ void phase_combine_ssd(const Frame& F0) {
    PH_ENTER(F0);
    const int gid = F.bid * 512 + F.tid;
    if (gid >= 128 * 1024) return;
    const int chain = gid >> 10, e0 = (gid & 1023) * 4, d = chain & 1, bh = chain >> 1, b = bh >> 3, h = bh & 7;
    bf16* SS = (bf16*)(F.ws + WS_SS) + (size_t)chain * NTILE64 * 4096 + e0; const float* SDEC = (const float*)(F.ws + WS_SDEC) + (size_t)b * NTILE64 * 16 + h * 2 + d;
    float S0 = 0.f, S1 = 0.f, S2 = 0.f, S3 = 0.f;
#pragma unroll 4
    for (int it = 0; it < NTILE64; ++it) {
        const int c = d == 0 ? it : (it < 4 ? 3 - it : 131 - (it - 4));
        u32x2* p = (u32x2*)(SS + (size_t)c * 4096); const u32x2 st = *p; const float dec = SDEC[c * 16];
        u32x2 o; o.x = pk2(S0, S1); o.y = pk2(S2, S3); *p = o;
        S0 = S0 * dec + __uint_as_float(st.x << 16); S1 = S1 * dec + __uint_as_float(st.x & 0xffff0000u); S2 = S2 * dec + __uint_as_float(st.y << 16); S3 = S3 * dec + __uint_as_float(st.y & 0xffff0000u);
    }
}
__device__ __forceinline__ void phase_finish_ssd(const Frame& F0) {
    PH_ENTER(F0);
    const AS4 Args* KA = kargs();
    const int tid = F.tid, lane = F.lane, wave = F.wave;
    const bf16* XBCA = (const bf16*)((const unsigned char*)F.out + OUT_XBCA); const float* UM = (const float*)(F.ws + WS_UMISC); const bf16* UZ = (const bf16*)(F.ws + WS_UZ);
    const bf16* SS = (const bf16*)(F.ws + WS_SS); bf16* MIX = (bf16*)(F.ws + WS_ACT);
    const float* dtb = LP(24, 16); const float* alog = LP(25, 16); const float* dsk = LP(26, 8); const float* sng = LP(27, 512);
    LAS bf16* CB = (LAS bf16*)F.lds;
    LAS bf16* BI = (LAS bf16*)(F.lds + 18432);
    LAS bf16* XT = (LAS bf16*)(F.lds + 18432);
    LAS bf16* MI = (LAS bf16*)(F.lds + 27648);
    LAS bf16* SFB = (LAS bf16*)(F.lds + 36864);
    LAS float* ACS = (LAS float*)(F.lds + 55296);
    LAS float* RSQ = (LAS float*)(F.lds + 63488);
    LAS bf16* GB = (LAS bf16*)(F.lds + 64000);
    LAS bf16* ZT = (LAS bf16*)(F.lds + 129536);
    const int lt = wave & 3, cth = wave >> 2, lr = (lane >> 4) * 4, lc = lane & 15;
    const bool skipctx = F.l == 1;
    for (int j_ = F.bid; j_ < n_units(skipctx); j_ += F.G) {
        const int u = unit_of(skipctx, j_);
        const int b = u / NTILE64, c = u % NTILE64; const size_t row0 = (size_t)b * TB + (size_t)c * 64;
        u32x4 pxt, psf, psb, pzt;
        { const int s_ = tid & 63, pg = tid >> 6, r = tid >> 3, ch = tid & 7;
            pxt = *(const u32x4*)(XBCA + (row0 + r) * 768 + ch * 8);
            psf = *(const u32x4*)(SS + ((((size_t)b * 8) * 2 + 0) * NTILE64 + c) * 4096 + r * 64 + ch * 8); psb = *(const u32x4*)(SS + ((((size_t)b * 8) * 2 + 1) * NTILE64 + c) * 4096 + r * 64 + ch * 8);
            pzt = *(const u32x4*)(UZ + (row0 + r) * 512 + ch * 8); }
        LDS_BARRIER();
#pragma unroll
        for (int i = 0; i < 4; ++i) { const int id = tid + 512 * i, r = id >> 5, ch = id & 31;
            const int which = ch >> 3;
            LAS bf16* dst = (which < 2 ? BI + (which * 64 + r) * LD64 : CB + ((which - 2) * 64 + r) * LD64) + (ch & 7) * 8;
            *(LAS u32x4*)dst = *(const u32x4*)(XBCA + (row0 + r) * 768 + 512 + ch * 8); }
        { const int h = wave;
#pragma unroll
            for (int d = 0; d < 2; ++d) { const float dtp = softplusf_(UM[(row0 + lane) * 32 + h] + dtb[d * 8 + h]);
                const float cs = scan_incl(-__expf(alog[d * 8 + h]) * dtp, lane, d == 1);
                ACS[(d * 8 + h) * 64 + lane] = cs; ACS[((2 + d) * 8 + h) * 64 + lane] = dtp; } }
        LDS_BARRIER();
        f32x4 G00 = {0.f, 0.f, 0.f, 0.f}, G01 = G00, G10 = G00, G11 = G00;
#pragma unroll
        for (int ks = 0; ks < 2; ++ks) {
            G00 = mma16(G00, CB + (lt * 16) * LD64 + ks * 32, LD64, BI + ((2 * cth) * 16) * LD64 + ks * 32, LD64, lane);
            G01 = mma16(G01, CB + (lt * 16) * LD64 + ks * 32, LD64, BI + ((2 * cth + 1) * 16) * LD64 + ks * 32, LD64, lane);
            G10 = mma16(G10, CB + (64 + lt * 16) * LD64 + ks * 32, LD64, BI + (64 + (2 * cth) * 16) * LD64 + ks * 32, LD64, lane);
            G11 = mma16(G11, CB + (64 + lt * 16) * LD64 + ks * 32, LD64, BI + (64 + (2 * cth + 1) * 16) * LD64 + ks * 32, LD64, lane); }
        LDS_BARRIER();
        f32x4 rsq = {0.f, 0.f, 0.f, 0.f};
#pragma unroll 1
        for (int h = 0; h < 8; ++h) {
            const int g = h >> 2;
            { const int r = tid >> 3, ch = tid & 7;
                *(LAS u32x4*)(XT + r * LD64 + ch * 8) = pxt;
                *(LAS u32x4*)(SFB + r * LD64 + ch * 8) = psf; *(LAS u32x4*)(SFB + (64 + r) * LD64 + ch * 8) = psb; *(LAS u32x4*)(ZT + r * LD64 + ch * 8) = pzt;
                const int hn = h < 7 ? h + 1 : 7;
                pxt = *(const u32x4*)(XBCA + (row0 + r) * 768 + hn * 64 + ch * 8);
                psf = *(const u32x4*)(SS + ((((size_t)b * 8 + hn) * 2 + 0) * NTILE64 + c) * 4096 + r * 64 + ch * 8); psb = *(const u32x4*)(SS + ((((size_t)b * 8 + hn) * 2 + 1) * NTILE64 + c) * 4096 + r * 64 + ch * 8);
                pzt = *(const u32x4*)(UZ + (row0 + r) * 512 + hn * 64 + ch * 8); }
            const LAS float* af = ACS + h * 64; const LAS float* ab = ACS + (8 + h) * 64; const LAS float* pf = ACS + (16 + h) * 64; const LAS float* pb = ACS + (24 + h) * 64;
#pragma unroll
            for (int j = 0; j < 2; ++j) { const int s = (2 * cth + j) * 16 + lc; const float afs = af[s], abs_ = ab[s], pfs = pf[s], pbs = pb[s];
                const f32x4 gt = g ? (j ? G11 : G10) : (j ? G01 : G00);
#pragma unroll
                for (int i = 0; i < 4; ++i) { const int l = lt * 16 + lr + i;
                    const float wf = s <= l ? __expf(af[l] - afs) * pfs : 0.f, wb = s >= l ? __expf(ab[l] - abs_) * pbs : 0.f;
                    MI[l * LD64 + s] = (bf16)f2bf(gt[i] * (wf + wb)); } }
            LDS_BARRIER();
#pragma unroll
            for (int j = 0; j < 2; ++j) { const int pt = 2 * cth + j; f32x4 acc = {0.f, 0.f, 0.f, 0.f}, tf = {0.f, 0.f, 0.f, 0.f}, tb = {0.f, 0.f, 0.f, 0.f};
#pragma unroll
                for (int ks = 0; ks < 2; ++ks) { acc = __builtin_amdgcn_mfma_f32_16x16x32_bf16(frag_row(MI + lt * 16 * LD64 + ks * 32, LD64, lane), frag_tr(XT, LD64, ks * 32, pt * 16, lane), acc, 0, 0, 0);
                    tf = mma16(tf, CB + (g * 64 + lt * 16) * LD64 + ks * 32, LD64, SFB + pt * 16 * LD64 + ks * 32, LD64, lane);
                    tb = mma16(tb, CB + (g * 64 + lt * 16) * LD64 + ks * 32, LD64, SFB + (64 + pt * 16) * LD64 + ks * 32, LD64, lane); }
                const int p = pt * 16 + lc; const float ds = dsk[h];
#pragma unroll
                for (int i = 0; i < 4; ++i) { const int l = lt * 16 + lr + i;
                    const float y = acc[i] + __expf(af[l]) * tf[i] + __expf(ab[l]) * tb[i];
                    const float xs = bf2f(XT[l * LD64 + p]), z = bf2f(ZT[l * LD64 + p]);
                    const float gv = (y + ds * xs) * siluf(z); GB[l * 512 + h * 64 + p] = (bf16)f2bf(gv); rsq[i] += gv * gv; } }
            LDS_BARRIER();
        }
#pragma unroll
        for (int i = 0; i < 4; ++i) { const float t = sum16(rsq[i]); if (lc == 0) RSQ[cth * 64 + lt * 16 + lr + i] = t; }
        LDS_BARRIER();
#pragma unroll
        for (int i = 0; i < 8; ++i) { const int id = tid + 512 * i, r = id >> 6, ch = id & 63;
            const float scl = rsqrtf((RSQ[r] + RSQ[64 + r]) * (1.f / 512.f) + 1e-6f);
            float v[8]; unpack8(*(const LAS u32x4*)(GB + r * 512 + ch * 8), v);
            const f32x4 n0 = *(const f32x4*)(sng + ch * 8), n1 = *(const f32x4*)(sng + ch * 8 + 4);
#pragma unroll
            for (int k = 0; k < 4; ++k) { v[k] *= scl * n0[k]; v[4 + k] *= scl * n1[k]; }
            *(u32x4*)(MIX + (row0 + r) * D + 256 + ch * 8) = pack8(v); }
    }
}


__device__ __forceinline__ bf16* rw_out(unsigned char* ws, int b, int h, int d, int c, int which) {
    h16* RECS = (h16*)(ws + WS_RECS); h16* RECD = (h16*)(ws + WS_RECD); const size_t p0 = (size_t)c * 64;
    if (d == 0) return (bf16*)(RECS + (((size_t)b * 4 + h) * TB + p0) * 256) + which * 4096;
    return (bf16*)(RECD + ((((size_t)b * 4 + h) * 2 + (which >> 1)) * TB + p0) * 128) + (which & 1) * 4096;
}
__device__ __forceinline__ void phase_rwkv_local(const Frame& F0) {
    PH_ENTER(F0);
    const AS4 Args* KA = kargs();
    const int tid0 = F.tid, wave = F.wave;
#define RL_STEP const int tid = launder_i(tid0); const int lane = tid & 63; const int lr = (lane >> 4) * 4, lc = lane & 15;
    const h16* RECS = (const h16*)(F.ws + WS_RECS); const h16* RECD = (const h16*)(F.ws + WS_RECD);
    float* RPL = (float*)(F.ws + WS_RPL);
    const float* k_a = LP(18, 256);
    constexpr int LDS_S = 264, LDS_D = 136, LDF = 68;
    LAS h16* STS = (LAS h16*)F.lds;
    LAS h16* STD = (LAS h16*)(F.lds + 33792);
    LAS float* AABF = (LAS float*)(F.lds + 33792);
    LAS bf16* ULT = (LAS bf16*)(F.lds + 33792);
    LAS float* TF = (LAS float*)(F.lds + 51200);
    LAS bf16* AVT = (LAS bf16*)(F.lds + 51200); LAS bf16* W0T = (LAS bf16*)(F.lds + 60416);
    LAS bf16* NAT = (LAS bf16*)(F.lds + 69632);
    LAS bf16* TRN = (LAS bf16*)(F.lds + 106496);
    LAS bf16* R0I = (LAS bf16*)(F.lds + 143360);
    LAS float* M1 = (LAS float*)(F.lds + 152576);
    LAS float* GSUM = (LAS float*)(F.lds + 157184);
    h16x8 ps[4], pd[2];
#define RL_LOAD_S(uu) do { const int h_ = (uu) & 3, bc_ = (uu) >> 2, b_ = bc_ / NTILE64, c_ = bc_ % NTILE64; const h16* src = RECS + (((size_t)b_ * 4 + h_) * TB + (size_t)c_ * 64) * 256; \
        _Pragma("unroll") for (int i = 0; i < 4; ++i) { const int id = launder_i(tid0) + 512 * i, r = id >> 5, ch = id & 31; ps[i] = *(const h16x8*)(src + (size_t)r * 256 + ch * 8); } } while (0)
#define RL_LOAD_D(uu, dd) do { const int h_ = (uu) & 3, bc_ = (uu) >> 2, b_ = bc_ / NTILE64, c_ = bc_ % NTILE64; const h16* src = RECD + ((((size_t)b_ * 4 + h_) * 2 + (dd)) * TB + (size_t)c_ * 64) * 128; \
        _Pragma("unroll") for (int i = 0; i < 2; ++i) { const int id = launder_i(tid0) + 512 * i, r = id >> 4, ch = id & 15; pd[i] = *(const h16x8*)(src + (size_t)r * 128 + ch * 8); } } while (0)
    if (F.bid < NUNIT64 * 4) { RL_LOAD_S(F.bid); RL_LOAD_D(F.bid, 0); }
    for (int u = F.bid; u < NUNIT64 * 4; u += F.G) {
        const int h = u & 3, bc = u >> 2, b = bc / NTILE64, c = bc % NTILE64;
        LDS_BARRIER();
        { RL_STEP
#pragma unroll
            for (int i = 0; i < 4; ++i) { const int id = tid + 512 * i, r = id >> 5, ch = id & 31; *(LAS h16x8*)(STS + r * LDS_S + ch * 8) = ps[i]; } }
#pragma unroll 1
        for (int d = 0; d < 2; ++d) {
            LDS_BARRIER();
            { RL_STEP
#pragma unroll
                for (int i = 0; i < 2; ++i) { const int id = tid + 512 * i, r = id >> 4, ch = id & 15; *(LAS h16x8*)(STD + r * LDS_D + ch * 8) = pd[i]; } }
            if (d == 0) RL_LOAD_D(u, 1); else if (u + F.G < NUNIT64 * 4) { RL_LOAD_S(u + F.G); RL_LOAD_D(u + F.G, 0); }
            LDS_BARRIER();
            SUBREP(8) { RL_STEP const int kp = tid & 31, tg = tid >> 5, k = 2 * kp;
                f32x2 wv[4], li[4]; f32x2 run = {1.f, 1.f};
#pragma unroll
                for (int i = 0; i < 4; ++i) { const int t = tg * 4 + i, srow = d ? 63 - t : t; const unsigned raw = *(const LAS unsigned*)(STD + srow * LDS_D + k);
                    const h16 o0 = __builtin_bit_cast(h16, (unsigned short)(raw & 0xffff)), o1 = __builtin_bit_cast(h16, (unsigned short)(raw >> 16));
                    wv[i] = (f32x2){1.f - (float)o0, 1.f - (float)o1}; run = run * wv[i]; li[i] = run; }
                *(LAS f32x2*)(GSUM + tg * 64 + k) = run;
                for (int i = tid; i < 64 * LDF; i += 512) TF[i] = 0.f;
                LDS_BARRIER();
                f32x2 off = {1.f, 1.f}, pref = {1.f, 1.f}, pend = {1.f, 1.f};
#pragma unroll
                for (int g = 0; g < 16; ++g) { const f32x2 gs = *(const LAS f32x2*)(GSUM + g * 64 + k); if (g < tg) off = off * gs; if (g < 8) pref = pref * gs; pend = pend * gs; }
                const f32x2 kac = *(const f32x2*)(k_a + h * 64 + k);
                const f32x2 ipref = {1.f / pref.x, 1.f / pref.y};
                f32x2 pexcl = off;
                unsigned vt[4], a0t[4], bht[4], kht[4];
#pragma unroll
                for (int i = 0; i < 4; ++i) { const int t = tg * 4 + i, srow = d ? 63 - t : t;
                    const f32x2 pin = off * li[i];
                    const unsigned rr = *(const LAS unsigned*)(STS + srow * LDS_S + k), vr = *(const LAS unsigned*)(STS + srow * LDS_S + 64 + k), kkr = *(const LAS unsigned*)(STS + srow * LDS_S + 128 + k), kxr = *(const LAS unsigned*)(STS + srow * LDS_S + 192 + k);
                    const unsigned ar_ = *(const LAS unsigned*)(STD + srow * LDS_D + 64 + k);
#define H2F(x, hi) ((float)__builtin_bit_cast(h16, (unsigned short)((hi) ? ((x) >> 16) : ((x) & 0xffff))))
                    const f32x2 r = {H2F(rr, 0), H2F(rr, 1)}, vv = {H2F(vr, 0), H2F(vr, 1)}, kk = {H2F(kkr, 0), H2F(kkr, 1)}, kx = {H2F(kxr, 0), H2F(kxr, 1)}, av = {H2F(ar_, 0), H2F(ar_, 1)};
#undef H2F
                    const f32x2 kmod = kx * ((av - 1.f) * kac + 1.f), bb = kk * av;
                    const f32x2 ipin = {1.f / pin.x, 1.f / pin.y};
                    const f32x2 e1 = pexcl * ipref, e2 = pin * ipref, e3 = pref * ipin, eL = pend * ipin;
                    const f32x2 at = -kk * e1, rt = r * e2, bt = bb * e3, kt = kmod * e3, r0 = r * pin, a0 = -kk * pexcl, bh = bb * eL, kh = kmod * eL;
                    *(LAS unsigned*)(NAT + (0 * 64 + t) * LD64 + k) = pk2(at.x, at.y); *(LAS unsigned*)(NAT + (1 * 64 + t) * LD64 + k) = pk2(rt.x, rt.y);
                    *(LAS unsigned*)(NAT + (2 * 64 + t) * LD64 + k) = pk2(bt.x, bt.y); *(LAS unsigned*)(NAT + (3 * 64 + t) * LD64 + k) = pk2(kt.x, kt.y);
                    *(LAS unsigned*)(R0I + t * LD64 + k) = pk2(r0.x, r0.y);
                    vt[i] = pk2(vv.x, vv.y); a0t[i] = pk2(a0.x, a0.y); bht[i] = pk2(bh.x, bh.y); kht[i] = pk2(kh.x, kh.y);
                    pexcl = pin; }
#define TR_WR(SLOT, ARR) do { u32x2 lo, hi; lo.x = (ARR[0] & 0xffffu) | (ARR[1] << 16); lo.y = (ARR[2] & 0xffffu) | (ARR[3] << 16); hi.x = (ARR[0] >> 16) | (ARR[1] & 0xffff0000u); hi.y = (ARR[2] >> 16) | (ARR[3] & 0xffff0000u); \
                    *(LAS u32x2*)(TRN + ((SLOT) * 64 + k) * LD64 + tg * 4) = lo; *(LAS u32x2*)(TRN + ((SLOT) * 64 + k + 1) * LD64 + tg * 4) = hi; } while (0)
                TR_WR(0, vt); TR_WR(1, a0t); TR_WR(2, bht); TR_WR(3, kht);
#undef TR_WR
                if (tg == 15) *(f32x2*)(RPL + (((((size_t)b * 4 + h) * 2 + d) * NTILE64) + c) * 64 + k) = pend; }
            LDS_BARRIER();
            { RL_STEP const int pr = wave >> 1, rh = wave & 1; f32x4 acc[2][4];
#pragma unroll
                for (int mi = 0; mi < 2; ++mi)
#pragma unroll
                    for (int nt = 0; nt < 4; ++nt) acc[mi][nt] = (f32x4){0.f, 0.f, 0.f, 0.f};
                mm_block<2, 4, 2>(acc, NAT + ((pr >> 1) * 64 + (2 * rh) * 16) * LD64, LD64, NAT + ((2 + (pr & 1)) * 64) * LD64, LD64, lane);
                LDS_BARRIER();
#pragma unroll
                for (int mi = 0; mi < 2; ++mi)
#pragma unroll
                    for (int nt = 0; nt < 4; ++nt)
#pragma unroll
                        for (int i = 0; i < 4; ++i) { const int t = (2 * rh + mi) * 16 + lr + i, ii = nt * 16 + lc;
                            const float v = (pr < 2 ? ii < t : ii <= t) ? acc[mi][nt][i] : 0.f;
                            if (pr == 0) AABF[t * LDF + ii] = v; else NAT[((pr - 1) * 64 + t) * LD64 + ii] = (bf16)f2bf(v); } }
            LDS_BARRIER();
            SUBREP(9) if (wave == 0) { RL_STEP const int blk = lane >> 4, j = lane & 15; float Tr[16]; const LAS float* ab = AABF + (blk * 16) * LDF + blk * 16;
#pragma unroll
                for (int t = 0; t < 16; ++t) { float a0 = (j == t) ? 1.f : 0.f, a1 = 0.f;
#pragma unroll
                    for (int i4 = 0; i4 < t; i4 += 4) { const f32x4 av = *(const LAS f32x4*)(ab + t * LDF + i4);
                        a0 += av.x * Tr[i4]; if (i4 + 1 < t) a1 += av.y * Tr[i4 + 1]; if (i4 + 2 < t) a0 += av.z * Tr[i4 + 2]; if (i4 + 3 < t) a1 += av.w * Tr[i4 + 3]; }
                    Tr[t] = a0 + a1; TF[(blk * 16 + t) * LDF + blk * 16 + j] = Tr[t]; } }
            LDS_BARRIER();
            SUBREP(10) {
#define RL_LEVEL(M, ACTIVE, PP, TT, J0) do { \
                { RL_STEP if (ACTIVE) { const int pp = (PP), t = (TT), j0 = (J0), rb = pp * 2 * (M) + (M), cb = pp * 2 * (M); f32x2 mm = {0.f, 0.f}; \
                    _Pragma("unroll") for (int i = 0; i < (M); i += 4) { const f32x4 av = *(const LAS f32x4*)(AABF + (rb + t) * LDF + cb + i); \
                        mm += av.x * *(const LAS f32x2*)(TF + (cb + i) * LDF + cb + j0) + av.y * *(const LAS f32x2*)(TF + (cb + i + 1) * LDF + cb + j0) + av.z * *(const LAS f32x2*)(TF + (cb + i + 2) * LDF + cb + j0) + av.w * *(const LAS f32x2*)(TF + (cb + i + 3) * LDF + cb + j0); } \
                    *(LAS f32x2*)(M1 + pp * 576 + t * 36 + j0) = mm; } } \
                LDS_BARRIER(); \
                { RL_STEP if (ACTIVE) { const int pp = (PP), t = (TT), j0 = (J0), rb = pp * 2 * (M) + (M), cb = pp * 2 * (M); f32x2 xx = {0.f, 0.f}; \
                    _Pragma("unroll") for (int q = 0; q < (M); q += 4) { const f32x4 tv = *(const LAS f32x4*)(TF + (rb + t) * LDF + rb + q); \
                        xx += tv.x * *(const LAS f32x2*)(M1 + pp * 576 + q * 36 + j0) + tv.y * *(const LAS f32x2*)(M1 + pp * 576 + (q + 1) * 36 + j0) + tv.z * *(const LAS f32x2*)(M1 + pp * 576 + (q + 2) * 36 + j0) + tv.w * *(const LAS f32x2*)(M1 + pp * 576 + (q + 3) * 36 + j0); } \
                    *(LAS f32x2*)(TF + (rb + t) * LDF + cb + j0) = xx; } } \
                LDS_BARRIER(); } while (0)
                RL_LEVEL(16, tid < 256, tid >> 7, (tid >> 3) & 15, (tid & 7) * 2);
                RL_LEVEL(32, true, 0, tid >> 4, (tid & 15) * 2);
#undef RL_LEVEL
            }
            { RL_STEP const int t = tid >> 3, i0 = (tid & 7) * 8; float v[8];
#pragma unroll
                for (int i = 0; i < 8; ++i) v[i] = TF[t * LDF + i0 + i];
                *(LAS u32x4*)(NAT + (3 * 64 + t) * LD64 + i0) = pack8(v); }
            LDS_BARRIER();
            SUBREP(11) { RL_STEP const int pr = wave >> 2, mt = wave & 3; f32x4 acc[4];
#pragma unroll
                for (int nt = 0; nt < 4; ++nt) acc[nt] = (f32x4){0.f, 0.f, 0.f, 0.f};
                { f32x4 (&a2)[1][4] = *reinterpret_cast<f32x4 (*)[1][4]>(&acc); mm_block<1, 4, 2>(a2, TRN + (pr * 64 + mt * 16) * LD64, LD64, NAT + ((pr ? 3 : 0) * 64) * LD64, LD64, lane); }
                LAS bf16* dst = pr ? W0T : AVT;
#pragma unroll
                for (int nt = 0; nt < 4; ++nt)
#pragma unroll
                    for (int i = 0; i < 4; ++i) dst[(mt * 16 + lr + i) * LD64 + nt * 16 + lc] = (bf16)f2bf(acc[nt][i]); }
            LDS_BARRIER();
            SUBREP(11) { RL_STEP const int mt = wave & 3, nh = wave >> 2;
#pragma unroll
                for (int nn = 0; nn < 2; ++nn) { const int nt = 2 * nh + nn; f32x4 a4 = {0.f, 0.f, 0.f, 0.f};
#pragma unroll
                    for (int ks = 0; ks < 2; ++ks) a4 = mma16(a4, AVT + (mt * 16) * LD64 + ks * 32, LD64, NAT + (3 * 64 + nt * 16) * LD64 + ks * 32, LD64, lane);
#pragma unroll
                    for (int i = 0; i < 4; ++i) ULT[(mt * 16 + lr + i) * LD64 + nt * 16 + lc] = (bf16)f2bf(a4[i]); } }
            LDS_BARRIER();
            { RL_STEP const int o = wave >> 1, rh = wave & 1;
                const LAS bf16* A1 = o == 0 ? TRN + 2 * 64 * LD64 : (o == 1 ? ULT : NAT + 1 * 64 * LD64);
                const LAS bf16* B1 = o == 0 ? W0T : (o == 1 ? TRN + 2 * 64 * LD64 : (o == 2 ? W0T : ULT));
                const LAS bf16* A2 = o == 1 ? TRN : NAT + 2 * 64 * LD64;
                const LAS bf16* B2 = o == 1 ? TRN + 3 * 64 * LD64 : TRN;
                f32x4 res[2][4];
#pragma unroll
                for (int mi = 0; mi < 2; ++mi)
#pragma unroll
                    for (int nt = 0; nt < 4; ++nt) res[mi][nt] = (f32x4){0.f, 0.f, 0.f, 0.f};
                mm_block<2, 4, 2>(res, A1 + (2 * rh * 16) * LD64, LD64, B1, LD64, lane);
                if (o == 1 || o == 3) mm_block<2, 4, 2>(res, A2 + (2 * rh * 16) * LD64, LD64, B2, LD64, lane);
                if (o == 2) {
#pragma unroll
                    for (int mi = 0; mi < 2; ++mi)
#pragma unroll
                        for (int nt = 0; nt < 4; ++nt)
#pragma unroll
                            for (int i = 0; i < 4; ++i) { const int rr = (2 * rh + mi) * 16 + lr + i, cc = nt * 16 + lc; res[mi][nt][i] += bf2f(R0I[rr * LD64 + cc]); } }
                LDS_BARRIER();
#pragma unroll
                for (int mi = 0; mi < 2; ++mi)
#pragma unroll
                    for (int nt = 0; nt < 4; ++nt)
#pragma unroll
                        for (int i = 0; i < 4; ++i) NAT[o * 4096 + ((2 * rh + mi) * 16 + lr + i) * 64 + nt * 16 + lc] = (bf16)f2bf(res[mi][nt][i]);
                LDS_BARRIER();
#pragma unroll
                for (int i = 0; i < 4; ++i) { const int id = tid + 512 * i, oo = id >> 9, ch = id & 511; *(u32x4*)(rw_out(F.ws, b, h, d, c, oo) + ch * 8) = *(const LAS u32x4*)(NAT + oo * 4096 + ch * 8); } }
        }
    }
#undef RL_STEP
#undef RL_LOAD_S
#undef RL_LOAD_D
}
__device__ __forceinline__ void phase_rwkv_combine(const Frame& F0) {
    PH_ENTER(F0);
    const int lane = F.lane;
    if (F.wave != 0 || F.bid >= 256) return;
    const int chain = F.bid >> 2, q = F.bid & 3, d = chain & 1, bh = chain >> 1, b = bh >> 2, h = bh & 3;
    LAS bf16* SA = (LAS bf16*)F.lds;
    const float* RPL = (const float*)(F.ws + WS_RPL) + (size_t)chain * NTILE64 * 64;
    const int lr = (lane >> 4) * 4, lc = lane & 15, ar = lane & 15, akq = (lane >> 4) * 8;
    f32x4 S[4];
#pragma unroll
    for (int nt = 0; nt < 4; ++nt) S[nt] = (f32x4){0.f, 0.f, 0.f, 0.f};
    bf16x8 bfr[4][4][2]; unsigned short psi[4][4][4]; float pl[4][4];
#define RWC_CIDX(k) (d == 0 ? (k) : ((k) < 4 ? 3 - (k) : 131 - ((k) - 4)))
#define RWC_PRE(SET, k) do { const int c_ = RWC_CIDX(k); const bf16* phit = rw_out(F.ws, b, h, d, c_, 0); const bf16* psip = rw_out(F.ws, b, h, d, c_, 1) + (size_t)q * 16 * 64; \
        _Pragma("unroll") for (int nt = 0; nt < 4; ++nt) { \
            _Pragma("unroll") for (int ks = 0; ks < 2; ++ks) bfr[SET][nt][ks] = *(const bf16x8*)(phit + (nt * 16 + ar) * 64 + ks * 32 + akq); \
            _Pragma("unroll") for (int i = 0; i < 4; ++i) psi[SET][nt][i] = psip[(lr + i) * 64 + nt * 16 + lc]; \
            pl[SET][nt] = RPL[(size_t)c_ * 64 + nt * 16 + lc]; } } while (0)
    RWC_PRE(0, 0); RWC_PRE(1, 1); RWC_PRE(2, 2);
#pragma unroll 1
    for (int k4 = 0; k4 < NTILE64; k4 += 4) {
#pragma unroll
        for (int j = 0; j < 4; ++j) {
            const int k = k4 + j, c = RWC_CIDX(k);
            f32x4 init[4];
#pragma unroll
            for (int nt = 0; nt < 4; ++nt)
#pragma unroll
                for (int i = 0; i < 4; ++i) { init[nt][i] = S[nt][i] * pl[j][nt] + bf2f(psi[j][nt][i]); SA[(lr + i) * LD64 + nt * 16 + lc] = (bf16)f2bf(S[nt][i]); }
            asm volatile("" : "+v"(init[0]), "+v"(init[1]), "+v"(init[2]), "+v"(init[3]) :: "memory");
            if (k + 3 < NTILE64) RWC_PRE((j + 3) & 3, k + 3);
            LDS_WAIT();
            const bf16x8 a0 = *(const LAS bf16x8*)(SA + ar * LD64 + akq), a1 = *(const LAS bf16x8*)(SA + ar * LD64 + 32 + akq);
            { bf16* s0p = rw_out(F.ws, b, h, d, c, 1) + (size_t)q * 16 * 64;
#pragma unroll
                for (int i = 0; i < 2; ++i) { const int id = lane + 64 * i, r = id >> 3, ch = id & 7; *(u32x4*)(s0p + r * 64 + ch * 8) = *(const LAS u32x4*)(SA + r * LD64 + ch * 8); } }
#pragma unroll
            for (int nt = 0; nt < 4; ++nt) { f32x4 a4 = init[nt];
                a4 = __builtin_amdgcn_mfma_f32_16x16x32_bf16(a0, bfr[j][nt][0], a4, 0, 0, 0); a4 = __builtin_amdgcn_mfma_f32_16x16x32_bf16(a1, bfr[j][nt][1], a4, 0, 0, 0); S[nt] = a4; }
            LDS_WAIT();
        }
    }
#undef RWC_PRE
#undef RWC_CIDX
}
__device__ __forceinline__ void phase_combine_side(const Frame& F0) {
    PH_ENTER(F0);
    if (F.wave < 4 || F.G != 256) return;
    const int lgid = F.bid * 256 + (F.tid - 256);
    const int sch = lgid >> 9, sd = sch & 1, sbh = sch >> 1; bf16* SSp = (bf16*)(F.ws + WS_SS) + (size_t)sch * NTILE64 * 4096 + (lgid & 511) * 8;
    const float* SDp = (const float*)(F.ws + WS_SDEC) + (size_t)(sbh >> 3) * NTILE64 * 16 + (sbh & 7) * 2 + sd;
    const int gch = lgid >> 10, gd = gch & 1, gbh = gch >> 1, ge0 = (lgid & 1023) * 2; bf16* GSp = (bf16*)(F.ws + WS_GS) + (size_t)gch * NTILE64 * 2048 + ge0;
    const float* GDp = (const float*)(F.ws + WS_GDEC) + (size_t)(gbh >> 2) * NTILE64 * 256 + gd * 128 + (gbh & 3) * 32 + (ge0 & 31);
    float cS[8] = {0.f, 0.f, 0.f, 0.f, 0.f, 0.f, 0.f, 0.f}, cG0 = 0.f, cG1 = 0.f;
    u32x4 pS[4]; float pSd[4]; unsigned pG[4]; f32x2 pGd[4];
#define CS_CIDX(k, dd) ((dd) == 0 ? (k) : ((k) < 4 ? 3 - (k) : 131 - ((k) - 4)))
#define CS_LOAD(SET, k) do { const int cs_ = CS_CIDX(k, sd), cg_ = CS_CIDX(k, gd); pS[SET] = *(const u32x4*)(SSp + (size_t)cs_ * 4096); pSd[SET] = SDp[cs_ * 16]; \
        pG[SET] = *(const unsigned*)(GSp + (size_t)cg_ * 2048); pGd[SET] = *(const f32x2*)(GDp + (size_t)cg_ * 256); } while (0)
    CS_LOAD(0, 0); CS_LOAD(1, 1); CS_LOAD(2, 2);
#pragma unroll 1
    for (int k4 = 0; k4 < NTILE64; k4 += 4) {
#pragma unroll
        for (int j = 0; j < 4; ++j) { const int k = k4 + j, cs = CS_CIDX(k, sd), cg = CS_CIDX(k, gd);
            float f[8]; unpack8(pS[j], f); const float dec = pSd[j]; const unsigned gt = pG[j]; const f32x2 gdec = pGd[j];
            asm volatile("" : "+v"(f[0]), "+v"(f[7]) : "v"(dec), "v"(gt), "v"(gdec.x), "v"(gdec.y) : "memory");
            if (k + 3 < NTILE64) CS_LOAD((j + 3) & 3, k + 3);
            u32x4 o; o.x = pk2(cS[0], cS[1]); o.y = pk2(cS[2], cS[3]); o.z = pk2(cS[4], cS[5]); o.w = pk2(cS[6], cS[7]); *(u32x4*)(SSp + (size_t)cs * 4096) = o;
#pragma unroll
            for (int i = 0; i < 8; ++i) cS[i] = cS[i] * dec + f[i];
            *(unsigned*)(GSp + (size_t)cg * 2048) = pk2(cG0, cG1);
            cG0 = cG0 * gdec.x + __uint_as_float(gt << 16); cG1 = cG1 * gdec.y + __uint_as_float(gt & 0xffff0000u); }
    }
#undef CS_LOAD
#undef CS_CIDX
}
__device__ __forceinline__ void phase_finish_rwkv(const Frame& F0) {
    PH_ENTER(F0);
    const AS4 Args* KA = kargs();
    const int lane = F.lane, wave = F.wave;
    const h16* BONUS = (const h16*)((const unsigned char*)F.out + OUT_BONUS); const h16* GATE = (const h16*)(F.ws + WS_GATE);
    bf16* YO = (bf16*)(F.ws + WS_YRW);
    const float* gng = LP(20, 256); const float* gnb = LP(21, 256);
    const int h = wave >> 1, rh = wave & 1, lr = (lane >> 4) * 4, lc = lane & 15, ar = lane & 15, akq = (lane >> 4) * 8;
    const bool skipctx = F.l == 1;
    for (int j_ = F.bid; j_ < n_units(skipctx); j_ += F.G) {
        const int u = unit_of(skipctx, j_);
        const int b = u / NTILE64, c = u % NTILE64; const size_t row0 = (size_t)b * TB + (size_t)c * 64;
        f32x4 acc[2][4];
#pragma unroll
        for (int mi = 0; mi < 2; ++mi)
#pragma unroll
            for (int nt = 0; nt < 4; ++nt) acc[mi][nt] = (f32x4){0.f, 0.f, 0.f, 0.f};
#pragma unroll
        for (int d = 0; d < 2; ++d) { const bf16* om = rw_out(F.ws, b, h, d, c, 2); const bf16* s0 = rw_out(F.ws, b, h, d, c, 1); const bf16* yl = rw_out(F.ws, b, h, d, c, 3);
#pragma unroll
            for (int mi = 0; mi < 2; ++mi) { const int srow = (2 * rh + mi) * 16 + ar, trow = d ? 63 - srow : srow;
                const bf16x8 a0 = *(const bf16x8*)(om + trow * 64 + akq), a1 = *(const bf16x8*)(om + trow * 64 + 32 + akq);
#pragma unroll
                for (int nt = 0; nt < 4; ++nt) { const bf16x8 b0 = *(const bf16x8*)(s0 + (nt * 16 + ar) * 64 + akq), b1 = *(const bf16x8*)(s0 + (nt * 16 + ar) * 64 + 32 + akq);
                    f32x4 a4 = acc[mi][nt];
                    a4 = __builtin_amdgcn_mfma_f32_16x16x32_bf16(a0, b0, a4, 0, 0, 0); a4 = __builtin_amdgcn_mfma_f32_16x16x32_bf16(a1, b1, a4, 0, 0, 0);
#pragma unroll
                    for (int i = 0; i < 4; ++i) { const int s = (2 * rh + mi) * 16 + lr + i, t = d ? 63 - s : s; a4[i] += bf2f(yl[t * 64 + nt * 16 + lc]); }
                    acc[mi][nt] = a4; } } }
#pragma unroll
        for (int mi = 0; mi < 2; ++mi)
#pragma unroll
            for (int i = 0; i < 4; ++i) { const int s = (2 * rh + mi) * 16 + lr + i; const size_t r = row0 + s;
                float y0 = acc[mi][0][i], y1 = acc[mi][1][i], y2 = acc[mi][2][i], y3 = acc[mi][3][i];
                const float mu = sum16((y0 + y1) + (y2 + y3)) * (1.f / 64.f);
                y0 -= mu; y1 -= mu; y2 -= mu; y3 -= mu;
                const float rs = rsqrtf(sum16((y0 * y0 + y1 * y1) + (y2 * y2 + y3 * y3)) * (1.f / 64.f) + 64e-5f);
                const float yy[4] = {y0, y1, y2, y3};
#pragma unroll
                for (int nt = 0; nt < 4; ++nt) { const int cc = h * 64 + nt * 16 + lc;
                    const float o = (yy[nt] * rs * gng[cc] + gnb[cc] + (float)BONUS[r * 256 + cc]) * (float)GATE[r * 256 + cc];
                    YO[r * 256 + cc] = (bf16)f2bf(o); } }
    }
}
__device__ __forceinline__ void phase_copy_yrw(const Frame& F0) {
    PH_ENTER(F0);
    const bf16* YO = (const bf16*)(F.ws + WS_YRW); bf16* MIX = (bf16*)(F.ws + WS_ACT);
    const bool skipctx = F.l == 1; const int NR = skipctx ? NB * TL : T;
    for (int i = F.bid * 512 + F.tid; i < NR * 32; i += F.G * 512) { const int row_ = i >> 5, ch = i & 31; const int row = skipctx ? (row_ / TL) * TB + TC + row_ % TL : row_;
        *(u32x4*)(MIX + (size_t)row * D + ch * 8) = *(const u32x4*)(YO + (size_t)row * 256 + ch * 8); }
}
__device__ __forceinline__ void phase_router(const Frame& F0) {
    PH_ENTER(F0);
    const AS4 Args* KA = kargs();
    const int tid = F.tid, lane = F.lane, wave = F.wave;
    LAS float* RW = (LAS float*)F.lds;
    LAS int* lcnt = (LAS int*)(F.lds + 81920);
    const float* rgw = LP(31, D * 4); const float* rew = LP(33, D * 16); const float* rgb = LP(32, 4); const float* reb = LP(34, 16);
    for (int i = tid; i < 20 * D; i += 512) { const int e = i / D, k = i % D; RW[i] = e < 4 ? rgw[k * 4 + e] : rew[k * 16 + (e - 4)]; }
    if (tid < NCLS) lcnt[tid] = 0;
    LDS_BARRIER();
    const float* g = LP(7, D);
    const float* mod = (const float*)(F.ws + WS_MOD) + (size_t)F.l * 9 * 6144;
    bf16* TOK = (bf16*)(F.ws + WS_ACT); const bf16* XB = (const bf16*)(F.ws + WS_XB);
    int4* TI = (int4*)(F.ws + WS_TOKINFO);
    int* CNT = (int*)(F.ws + WS_CNT);
    const bool skipctx = F.l == 1;
    if (skipctx && F.bid < 32 && tid < NCLS) CNT[((F.bid >> 2) * NTILE64 + (F.bid & 3)) * NCLS + tid] = 0;
    for (int j_ = F.bid; j_ < n_units(skipctx); j_ += F.G) {
        const int u = unit_of(skipctx, j_);
        f32x4 A[4], B[4]; u32x2 nv[4];
        { const float* mrow = mod + (size_t)mod_index(u * 64) * 6144;
#pragma unroll
            for (int j = 0; j < 4; ++j) { const int c = 4 * lane + 256 * j; A[j] = *(const f32x4*)(g + c) * (*(const f32x4*)(mrow + 4 * D + c) + 1.f); B[j] = *(const f32x4*)(mrow + 3 * D + c); }
            const u32x2* xr = (const u32x2*)(XB + (size_t)(u * 64 + wave * 8) * D) + lane;
#pragma unroll
            for (int j = 0; j < 4; ++j) nv[j] = xr[64 * j]; }
        for (int rr = 0; rr < 8; ++rr) {
            const int row = u * 64 + wave * 8 + rr;
            f32x4 v[4]; float s = 0.f;
#pragma unroll
            for (int j = 0; j < 4; ++j) { v[j] = bf4(nv[j]); s += (v[j].x * v[j].x + v[j].y * v[j].y) + (v[j].z * v[j].z + v[j].w * v[j].w); }
            if (rr + 1 < 8) { const u32x2* xn = (const u32x2*)(XB + (size_t)(row + 1) * D) + lane;
#pragma unroll
                for (int j = 0; j < 4; ++j) nv[j] = xn[64 * j]; }
            const float rs = rsqrtf(wave_sum(s) * (1.f / D) + 1e-6f);
            u32x2* o8 = (u32x2*)(TOK + (size_t)row * D) + lane;
#pragma unroll
            for (int j = 0; j < 4; ++j) { v[j] = v[j] * rs * A[j] + B[j];
                u32x2 w; w.x = pk2(v[j].x, v[j].y); w.y = pk2(v[j].z, v[j].w); o8[64 * j] = w; }
            float lg[20];
#pragma unroll
            for (int e = 0; e < 20; ++e) { float a = 0.f;
#pragma unroll
                for (int j = 0; j < 4; ++j) { const f32x4 w = *(const LAS f32x4*)(RW + e * D + 4 * lane + 256 * j); a += (v[j].x * w.x + v[j].y * w.y) + (v[j].z * w.z + v[j].w * w.w); }
                lg[e] = wave_sum(a); }
            float gl0 = lg[0] + rgb[0], gl1 = lg[1] + rgb[1], gl2 = lg[2] + rgb[2], gl3 = lg[3] + rgb[3];
            int gs = 0; float gm = gl0;
            if (gl1 > gm) { gm = gl1; gs = 1; } if (gl2 > gm) { gm = gl2; gs = 2; } if (gl3 > gm) { gm = gl3; gs = 3; }
            const float pg = 1.f / (__expf(gl0 - gm) + __expf(gl1 - gm) + __expf(gl2 - gm) + __expf(gl3 - gm));
            float e0, e1, e2, e3;
            e0 = gs == 0 ? lg[4] : (gs == 1 ? lg[8] : (gs == 2 ? lg[12] : lg[16])); e1 = gs == 0 ? lg[5] : (gs == 1 ? lg[9] : (gs == 2 ? lg[13] : lg[17]));
            e2 = gs == 0 ? lg[6] : (gs == 1 ? lg[10] : (gs == 2 ? lg[14] : lg[18])); e3 = gs == 0 ? lg[7] : (gs == 1 ? lg[11] : (gs == 2 ? lg[15] : lg[19]));
            e0 += reb[gs * 4 + 0]; e1 += reb[gs * 4 + 1]; e2 += reb[gs * 4 + 2]; e3 += reb[gs * 4 + 3];
            int i1 = 0; float m1 = e0;
            if (e1 > m1) { m1 = e1; i1 = 1; } if (e2 > m1) { m1 = e2; i1 = 2; } if (e3 > m1) { m1 = e3; i1 = 3; }
            int i2 = -1; float m2 = -3.0e38f;
            if (i1 != 0 && e0 > m2) { m2 = e0; i2 = 0; } if (i1 != 1 && e1 > m2) { m2 = e1; i2 = 1; } if (i1 != 2 && e2 > m2) { m2 = e2; i2 = 2; } if (i1 != 3 && e3 > m2) { m2 = e3; i2 = 3; }
            const float p1 = 1.f, p2 = __expf(m2 - m1);
            const float w1 = pg * p1 / (p1 + p2), w2 = pg * p2 / (p1 + p2);
            const int lo = i1 < i2 ? i1 : i2, hi = i1 < i2 ? i2 : i1;
            const int pr = lo == 0 ? hi - 1 : (lo == 1 ? hi + 1 : 5);
            const int cls = gs * 6 + pr;
            const float wa = i1 < i2 ? w1 : w2, wb = i1 < i2 ? w2 : w1;
            if (lane == 0) { const int rank = atomicAdd((int*)(lcnt + cls), 1);
                TI[row] = make_int4(cls, __float_as_int(wa), __float_as_int(wb), rank); }
        }
        LDS_BARRIER();
        if (tid < NCLS) { CNT[u * NCLS + tid] = lcnt[tid]; lcnt[tid] = 0; }
        LDS_BARRIER();
    }
}

__device__ __forceinline__ void phase_scatter(const Frame& F0) {
    PH_ENTER(F0);
    const int tid = F.tid, lane = F.lane, wave = F.wave;
    LAS int* C = (LAS int*)F.lds;
    LAS int* tot = (LAS int*)(F.lds + 102400);
    LAS int* cs = (LAS int*)(F.lds + 102400 + 128);
    LAS int* base = (LAS int*)(F.lds + 102400 + 256);
    const int* CNT = (const int*)(F.ws + WS_CNT);
    int* MI = (int*)(F.ws + WS_CNT) + NUNIT64 * NCLS;
    for (int i = tid; i < NUNIT64 * NCLS; i += 512) C[i] = CNT[i];
    LDS_BARRIER();
    if (tid < NCLS * 16) { const int c = tid >> 4, s16 = tid & 15; int part = 0; for (int uu = s16; uu < NUNIT64; uu += 16) part += C[uu * NCLS + c];
        const float pf = sum16((float)part); if (s16 == 0) tot[c] = (int)pf; }
    LDS_BARRIER();
    if (tid == 0) { int s = 0; for (int c = 0; c < NCLS; ++c) { cs[c] = s; s += (tot[c] + 255) & ~255; } cs[NCLS] = s; }
    LDS_BARRIER();
    if (F.bid == 0 && tid <= NCLS) MI[tid] = cs[tid];
    const int4* TI = (const int4*)(F.ws + WS_TOKINFO);
    int* LIST = (int*)(F.ws + WS_LIST); f32x2* WSL = (f32x2*)(F.ws + WS_WSLOT);
    for (int c = F.bid; c < NCLS; c += F.G) {
        const int s0 = cs[c] + tot[c], s1 = cs[c + 1];
        for (int s = s0 + tid; s < s1; s += 512) { LIST[s] = -1; WSL[s] = (f32x2){0.f, 0.f}; }
    }
    const bool skipctx = F.l == 1;
    for (int j_ = F.bid; j_ < n_units(skipctx); j_ += F.G) {
        const int u = unit_of(skipctx, j_);
        LDS_BARRIER();
        if (tid < NCLS * 16) { const int c = tid >> 4, s = tid & 15; int part = 0; for (int uu = s; uu < u; uu += 16) part += C[uu * NCLS + c];
            float pf = sum16((float)part);
            if (s == 0) base[c] = cs[c] + (int)pf; }
        LDS_BARRIER();
        {
#pragma unroll
            for (int rr = 0; rr < 8; ++rr) { const int row = u * 64 + wave * 8 + rr;
                if (lane == 0) { const int4 ti = TI[row]; const int slot = base[ti.x] + ti.w; LIST[slot] = row; WSL[slot] = (f32x2){__int_as_float(ti.y), __int_as_float(ti.z)}; } } }
    }
}

__device__ __forceinline__ void phase_final(const Frame& F0) {
    PH_ENTER(F0);
    const AS4 Args* KA = kargs();
    const int gw = F.bid * 8 + F.wave, NGW = F.G * 8, lane = F.lane;
    const float* g = INP(38);
    constexpr int NR = NB * TL; const int R = (NR + NGW - 1) / NGW, r0 = gw * R, r1 = min(NR, r0 + R);
    const bf16* XB = (const bf16*)(F.ws + WS_XB);
    f32x4 G4[4]; u32x2 nv[4];
#pragma unroll
    for (int j = 0; j < 4; ++j) G4[j] = *(const f32x4*)(g + 4 * lane + 256 * j);
#define FN_ROW(r) (XB + ((size_t)((r) / TL) * TB + TC + (r) % TL) * D)
    if (r0 < r1) { const u32x2* xr = (const u32x2*)FN_ROW(r0) + lane;
#pragma unroll
        for (int j = 0; j < 4; ++j) nv[j] = xr[64 * j]; }
    for (int row = r0; row < r1; ++row) {
        f32x4 v[4];
#pragma unroll
        for (int j = 0; j < 4; ++j) v[j] = bf4(nv[j]);
        if (row + 1 < r1) { const u32x2* xn = (const u32x2*)FN_ROW(row + 1) + lane;
#pragma unroll
            for (int j = 0; j < 4; ++j) nv[j] = xn[64 * j]; }
        float s = 0.f;
#pragma unroll
        for (int j = 0; j < 4; ++j) s += (v[j].x * v[j].x + v[j].y * v[j].y) + (v[j].z * v[j].z + v[j].w * v[j].w);
        const float rs = rsqrtf(wave_sum(s) * (1.f / D) + 1e-6f);
        f32x4* xr = (f32x4*)(F.out + (size_t)row * D) + lane;
#pragma unroll
        for (int j = 0; j < 4; ++j) xr[64 * j] = v[j] * rs * G4[j];
    }
#undef FN_ROW
}

constexpr int PH_PER_LAYER = 12, PH_FINAL = 1 + 2 * PH_PER_LAYER, PH_END = PH_FINAL + 1;
template <int L> __device__ __forceinline__ void run_layer(Frame& F0, const XcdBarrier& bar, const int lo, const int hi) {
    constexpr int l = L;
#define IN(k) (lo <= (k) && (k) < hi)
#define SEAM(k) do { if (IN(k) && IN((k) + 1)) { XcdBarrier bb = bar; GAS unsigned* _b = (GAS unsigned*)bb.bar; asm volatile("" : "+s"(_b)); bb.bar = (unsigned*)_b; xcd_barrier(bb); } } while (0)
        F0.l = l;
        const int pb = 1 + PH_PER_LAYER * l;
        if (HAS(1) && IN(pb + 1)) { for (int rep = 0; rep < REP(1); ++rep) phase_norm1(F0); if (l == 1 && HAS(0)) phase_convert(F0); } SEAM(pb + 1);
        if (HAS(2) && IN(pb + 2)) {
            PH_ENTER(F0);
            SchedStatic S; S.nM = T / 256; S.nN = IN_PAD / 256; S.nwg = S.nM * S.nN; S.G = F.G; S.c = F.bid; S.ws = F.ws; S.offA = WS_ACT; S.offB = WS_WIN; S.skipctx = 0;
            EpiU E{F.ws};
            for (int rep = 0; rep < REP(2); ++rep) pg8::gemm_phase<EpiU, SchedStatic, true, false, 1024>(F.lds, F.tid, S, E);
        } SEAM(pb + 2);
        if (HAS(3) && IN(pb + 3)) { phase_conv(F0); for (int rep = 0; rep < REP(3); ++rep) phase_prep(F0); } SEAM(pb + 3);
#define GBAR() do { if (hi - lo > 1) { XcdBarrier bb = bar; GAS unsigned* _b = (GAS unsigned*)bb.bar; asm volatile("" : "+s"(_b)); bb.bar = (unsigned*)_b; xcd_barrier(bb); } } while (0)
        if (HAS(4) && IN(pb + 5)) {
            if (MK_PROBE_RW >= 1) { phase_rwkv_local(F0); GBAR(); if (MK_PROBE_RW >= 2) { phase_rwkv_combine(F0); GBAR(); } phase_prep(F0); GBAR(); }
            if (MK_PROBE_RW == 0) { for (int rep = 0; rep < REP(4); ++rep) phase_states(F0); } phase_rwkv_local(F0); if (MK_PROBE_RW) { GBAR(); phase_states(F0); GBAR(); } if (F0.G != 256) { phase_combine_ssd(F0); phase_combine_gla(F0); } GBAR(); phase_rwkv_combine(F0); phase_combine_side(F0); } SEAM(pb + 5);
        if (HAS(6) && IN(pb + 6)) { phase_finish_rwkv(F0); GBAR(); phase_finish_ssd(F0); phase_finish_gla(F0); phase_copy_yrw(F0); } SEAM(pb + 6);
#undef GBAR
        if (HAS(7) && IN(pb + 7)) {
            PH_ENTER(F0);
            const AS4 Args* KA = kargs();
            SchedStatic S; S.skipctx = (F.l == 1); S.nM = S.skipctx ? NB * TL / 256 : T / 256; S.nN = D / 256; S.nwg = S.nM * S.nN; S.G = F.G; S.c = F.bid; S.ws = F.ws; S.offA = WS_ACT; S.offB = WS_WOUT;
            EpiRes E{INP(0), INP(2), F.ws, F.l};
            pg8::gemm_phase<EpiRes, SchedStatic, true, false, 1024>(F.lds, F.tid, S, E);
        } SEAM(pb + 7);
        if (HAS(8) && IN(pb + 8)) { for (int rep = 0; rep < REP(8); ++rep) phase_router(F0); } SEAM(pb + 8);
        if (HAS(9) && IN(pb + 9)) { for (int rep = 0; rep < REP(9); ++rep) phase_scatter(F0); } SEAM(pb + 9);
        if (IN(pb + 10) || IN(pb + 11)) {
            PH_ENTER(F0);
            LAS int* cs = (LAS int*)(F.lds + CSTAB_OFF);
            const int* MI = (const int*)(F.ws + WS_CNT) + NUNIT64 * NCLS;
            __syncthreads();
            if (F.tid <= NCLS) cs[F.tid] = MI[F.tid];
            __syncthreads();
        }
        if (HAS(10) && IN(pb + 10)) {
            PH_ENTER(F0);
            LAS int* cs = (LAS int*)(F.lds + CSTAB_OFF);
            SchedMoE<8> S; S.ntiles = cs[NCLS] / 256; S.G = F.G; S.c = F.bid; S.cs = cs; S.ws = F.ws;
            EpiSwiGLU E{F.ws};
            for (int rep = 0; rep < REP(10); ++rep) pg8::gemm_phase<EpiSwiGLU, SchedMoE<8>, true, false, 1024, true>(F.lds, F.tid, S, E);
        } SEAM(pb + 10);
        if (HAS(11) && IN(pb + 11)) {
            PH_ENTER(F0);
            LAS int* cs = (LAS int*)(F.lds + CSTAB_OFF);
            SchedMoE<4> S; S.ntiles = cs[NCLS] / 256; S.G = F.G; S.c = F.bid; S.cs = cs; S.ws = F.ws;
            EpiScatter E{F.ws, F.l};
            pg8::gemm_phase<EpiScatter, SchedMoE<4>, true, true, 512>(F.lds, F.tid, S, E);
        } SEAM(pb + 11);
    }
#undef IN
#undef SEAM
__global__ void __launch_bounds__(512, 2) mk_fwd(Args args) {
    extern __shared__ __attribute__((aligned(16))) unsigned char lds_raw[];
    Frame F0;
    F0.lds = (LAS unsigned char*)lds_raw;
    F0.tid = threadIdx.x; F0.lane = F0.tid & 63; F0.wave = __builtin_amdgcn_readfirstlane(F0.tid >> 6);
    F0.G = gridDim.x; F0.bid = blockIdx.x; F0.out = args.out; F0.ws = args.ws; F0.l = 0;
    for (int u = F0.tid; u < (LDS_BYTES - LDSCTL_OFF) / 4; u += 512) ((LAS unsigned*)(F0.lds + LDSCTL_OFF))[u] = 0u;
    __syncthreads();
    const int lo = args.ph_lo, hi = args.ph_hi;
    const bool use_bar = (hi - lo) > 1;
    XcdBarrier bar; bar.bar = (unsigned*)(F0.ws + WS_CTL) + CW_BAR; bar.x = 0; bar.st = nullptr;
    if (use_bar) bar = xcd_barrier_post((unsigned*)(F0.ws + WS_CTL) + CW_BAR, (volatile LAS unsigned*)(F0.lds + MISC_OFF) + 8);
#define IN(k) (lo <= (k) && (k) < hi)
#define SEAM(k) do { if (IN(k) && IN((k) + 1)) { XcdBarrier bb = bar; GAS unsigned* _b = (GAS unsigned*)bb.bar; asm volatile("" : "+s"(_b)); bb.bar = (unsigned*)_b; xcd_barrier(bb); } } while (0)
    if (HAS(12) && IN(0)) { phase_mods(F0); } if (HAS(0) && IN(0)) { F0.l = 0; phase_convert(F0); } SEAM(0);
    run_layer<0>(F0, bar, lo, hi);
    run_layer<1>(F0, bar, lo, hi);
    if (HAS(13) && IN(PH_FINAL)) { phase_final(F0); }
#undef IN
#undef SEAM
}

extern "C" void kernel_launch(void* const* d_in, const int* in_sizes, int n_in, void* d_out, int out_size, void* d_ws, size_t ws_size, hipStream_t stream) {
    static int grid = 0;
    if (grid == 0) {
        if (n_in != 39 || ws_size < WS_END) { fprintf(stderr, "kernel_launch: unexpected n_in %d / ws %zu\n", n_in, ws_size); grid = -1; return; }
        int dev = 0, cus = 0;
        if (hipGetDevice(&dev) != hipSuccess || hipDeviceGetAttribute(&cus, hipDeviceAttributeMultiprocessorCount, dev) != hipSuccess) { grid = -1; return; }
        if (hipFuncSetAttribute((const void*)mk_fwd, hipFuncAttributeMaxDynamicSharedMemorySize, LDS_BYTES) != hipSuccess) { fprintf(stderr, "kernel_launch: hipFuncSetAttribute failed\n"); grid = -1; return; }
        int per_cu = 0;
        (void)hipOccupancyMaxActiveBlocksPerMultiprocessor(&per_cu, (const void*)mk_fwd, 512, LDS_BYTES);
        (void)hipGetLastError();
        grid = cus;
    }
    if (grid < 0) return;
    (void)hipMemsetAsync((char*)d_ws + WS_CTL, 0, CTL_ZERO_BYTES, stream);
    Args a{};
    for (int i = 0; i < 39; ++i) a.in[i] = (const float*)d_in[i];
    a.out = (float*)d_out; a.ws = (unsigned char*)d_ws;
#if MK_ONE_LAUNCH
    a.ph_lo = 0; a.ph_hi = PH_END;
    hipLaunchKernelGGL(mk_fwd, dim3(grid), dim3(512), LDS_BYTES, stream, a);
#else
    for (int ph = 0; ph < PH_END; ++ph) { a.ph_lo = ph; a.ph_hi = ph + 1; hipLaunchKernelGGL(mk_fwd, dim3(grid), dim3(512), LDS_BYTES, stream, a); }
#endif
}
```

```cpp
#include <hip/hip_runtime.h>
#include <cstdio>
#include <cstdint>

#define GAS __attribute__((address_space(1)))
#define LAS __attribute__((address_space(3)))
typedef unsigned short bf16;
typedef short bf16x8 __attribute__((ext_vector_type(8)));
typedef float f32x4 __attribute__((ext_vector_type(4)));
typedef float f32x2 __attribute__((ext_vector_type(2)));
typedef unsigned u32x4 __attribute__((ext_vector_type(4)));
typedef unsigned u32x2 __attribute__((ext_vector_type(2)));
typedef _Float16 h16;
typedef _Float16 h16x8 __attribute__((ext_vector_type(8)));
typedef _Float16 h16x4 __attribute__((ext_vector_type(4)));

#ifndef MK_ONE_LAUNCH
#define MK_ONE_LAUNCH 1
#endif
#ifndef MK_PHMASK
#define MK_PHMASK 0xffffffffu
#endif
#define HAS(k) ((MK_PHMASK >> (k)) & 1u)
#ifndef MK_REP
#define MK_REP 0u
#endif
#define REP(k) (((MK_REP >> (k)) & 1u) ? 2 : 1)
#ifndef MK_SUB
#define MK_SUB 0u
#endif
#ifndef MK_PROBE_RW
#define MK_PROBE_RW 0
#endif
#ifndef MK_PROBE_COMB
#define MK_PROBE_COMB 0
#endif
#define SUBREP(k) for (int _r = 0; _r < ((((MK_SUB) >> (k)) & 1u) ? 2 : 1); ++_r)

constexpr int D = 1024, NB = 8, TL = 8192, TC = 256, TB = TL + TC, T = NB * TB;
constexpr int NTILE64 = TB / 64;
constexpr int IN_COLS = 3096, IN_PAD = 3328;
constexpr int NCLS = 24, MAXSLOT = T + NCLS * 256;
constexpr int NUNIT64 = NB * NTILE64;

constexpr size_t MiB = 1u << 20;
constexpr size_t WS_CTL = 0, CTL_ZERO_BYTES = 1 * MiB;
constexpr size_t WS_MOD = 1 * MiB;
constexpr size_t WS_CNT = 2 * MiB;
constexpr size_t WS_TOKINFO = 3 * MiB;
constexpr size_t WS_LIST = 5 * MiB;
constexpr size_t WS_WSLOT = 6 * MiB;
constexpr size_t WS_WIN = 16 * MiB;
constexpr size_t WS_WOUT = 23 * MiB;
constexpr size_t WS_W13 = 25 * MiB;
constexpr size_t WS_W2T = 57 * MiB;
constexpr size_t WS_ACT = 74 * MiB;
constexpr size_t WS_REC = 74 * MiB;
constexpr size_t WS_RECS = WS_REC, WS_RECD = WS_REC + (size_t)T * 4 * 256 * 2;
constexpr size_t WS_LOWR = 73 * MiB;
constexpr size_t WS_TOKS = 206 * MiB;
constexpr size_t WS_URW = 371 * MiB;
constexpr size_t WS_SS = 371 * MiB;
constexpr size_t WS_GS = 503 * MiB;
constexpr size_t WS_SDEC = 7 * MiB;
constexpr size_t WS_H1 = 371 * MiB;
constexpr size_t WS_UXBC = 503 * MiB;
constexpr size_t WS_UZ = 602 * MiB;
constexpr size_t WS_UGLA = 668 * MiB;
constexpr size_t WS_UMISC = 767 * MiB;
constexpr size_t WS_XB = 776 * MiB;
constexpr size_t OUT_XBCA = 0;
constexpr size_t OUT_MIX = 99 * MiB;
constexpr size_t WS_BONUS = 946 * MiB;
constexpr size_t WS_GATE = 908 * MiB;
constexpr size_t WS_GDEC = 941 * MiB;
constexpr size_t WS_RPL = 943 * MiB;
constexpr size_t WS_END = 979 * MiB;
static_assert(WS_RECD + (size_t)T * 8 * 128 * 2 <= WS_URW, "records fit");
static_assert(WS_SS + (size_t)128 * 132 * 4096 * 2 <= WS_GS && WS_GS + (size_t)64 * 132 * 2048 * 2 <= WS_UZ, "state buffers fit");
static_assert(WS_TOKS + (size_t)MAXSLOT * 1024 * 2 <= WS_H1, "toks fits");
static_assert(WS_XB + (size_t)T * 1024 * 2 <= WS_GATE && OUT_XBCA + (size_t)T * 768 * 2 <= OUT_MIX && OUT_MIX + (size_t)T * 1024 * 2 <= (size_t)NB * TL * D * 4 && WS_RPL + (size_t)64 * 132 * 64 * 4 <= WS_BONUS && WS_BONUS + (size_t)T * 256 * 2 <= WS_END, "stream / d_out scratch fit");
static_assert(WS_H1 + (size_t)MAXSLOT * 1024 * 2 <= WS_UMISC, "h1 fits");

constexpr int CW_BAR = 4096;

constexpr int RING_BYTES = 131072;
constexpr int LDS_BYTES = 163840;
constexpr int LDSCTL_OFF = LDS_BYTES - 2048, MISC_OFF = LDSCTL_OFF + 320, CSTAB_OFF = LDSCTL_OFF + 1024;

#define RLX_AGENT __ATOMIC_RELAXED, __HIP_MEMORY_SCOPE_AGENT
#define LDS_WAIT() asm volatile("s_waitcnt lgkmcnt(0)" ::: "memory")
#define LDS_BARRIER() asm volatile("s_waitcnt lgkmcnt(0)\n\ts_barrier" ::: "memory")
#define VM_WAIT() asm volatile("s_waitcnt vmcnt(0)" ::: "memory")
__device__ __forceinline__ float bf2f(unsigned short h) { return __uint_as_float(((unsigned)h) << 16); }
typedef __bf16 hwbf16x2 __attribute__((ext_vector_type(2)));
__device__ __forceinline__ unsigned pk2(float lo, float hi) { const f32x2 v = {lo, hi}; const hwbf16x2 b = __builtin_convertvector(v, hwbf16x2); return __builtin_bit_cast(unsigned, b); }
__device__ __forceinline__ unsigned f2bf(float f) { return pk2(f, 0.f) & 0xffffu; }
__device__ __forceinline__ float sigm(float x) { return 1.f / (1.f + __expf(-x)); }
__device__ __forceinline__ float siluf(float x) { return x / (1.f + __expf(-x)); }
__device__ __forceinline__ float softplusf_(float x) { return x > 20.f ? x : log1pf(__expf(x)); }
__device__ __forceinline__ void unpack8(u32x4 v, float* o) {
    o[0] = __uint_as_float(v.x << 16); o[1] = __uint_as_float(v.x & 0xffff0000u); o[2] = __uint_as_float(v.y << 16); o[3] = __uint_as_float(v.y & 0xffff0000u);
    o[4] = __uint_as_float(v.z << 16); o[5] = __uint_as_float(v.z & 0xffff0000u); o[6] = __uint_as_float(v.w << 16); o[7] = __uint_as_float(v.w & 0xffff0000u);
}
__device__ __forceinline__ f32x4 bf4(u32x2 w) { return (f32x4){__uint_as_float(w.x << 16), __uint_as_float(w.x & 0xffff0000u), __uint_as_float(w.y << 16), __uint_as_float(w.y & 0xffff0000u)}; }
__device__ __forceinline__ u32x4 pack8(const float* o) { u32x4 v; v.x = pk2(o[0], o[1]); v.y = pk2(o[2], o[3]); v.z = pk2(o[4], o[5]); v.w = pk2(o[6], o[7]); return v; }
__device__ __forceinline__ int launder_i(int v) { asm volatile("" : "+v"(v)); return v; }
template <int CTRL> __device__ __forceinline__ float dpp_mov(float v) { return __int_as_float(__builtin_amdgcn_update_dpp(0, __float_as_int(v), CTRL, 0xf, 0xf, false)); }
__device__ __forceinline__ float sum8(float v) { v += dpp_mov<0xB1>(v); v += dpp_mov<0x4E>(v); v += dpp_mov<0x141>(v); return v; }
__device__ __forceinline__ float sum16(float v) { v = sum8(v); v += dpp_mov<0x140>(v); return v; }
__device__ __forceinline__ float wave_sum(float v) {
    v = sum16(v);
    v += __int_as_float(__builtin_amdgcn_update_dpp(0, __float_as_int(v), 0x142, 0xa, 0xf, false));
    v += __int_as_float(__builtin_amdgcn_update_dpp(0, __float_as_int(v), 0x143, 0xc, 0xf, false));
    return __int_as_float(__builtin_amdgcn_readlane(__float_as_int(v), 63));
}

namespace pg8 {
constexpr int BM = 256, BK = 64, HALF = 128, HTB = HALF * BK * 2, STAGE_BYTES = 8 * HTB, NXCD = 8, WGM = 8;
__host__ __device__ __forceinline__ int lds_byte(int r, int c) { const int st = (r >> 4) * 2 + (c >> 5), rr = r & 15, cc = c & 31, ob = rr * 64 + cc * 2; return st * 1024 + (ob ^ (((ob >> 9) & 1) << 5)); }
__host__ __device__ __forceinline__ void stage_rc(int b, int& R, int& C) { const int st = b / 1024, sb = b % 1024, swz = sb ^ (((sb >> 9) & 1) << 5); R = (st >> 1) * 16 + swz / 64; C = (st & 1) * 32 + (swz % 64) / 2; }
__host__ __device__ __forceinline__ int perm32(int rho) { const int n = rho >> 4, i = rho & 15; return 8 * (i >> 2) + 4 * n + (i & 3); }
struct Unit { int pm, pn, aux; };
__device__ __forceinline__ const GAS char* uni_ptr(const char* p) { const unsigned long long v = (unsigned long long)p;
    const unsigned lo = __builtin_amdgcn_readfirstlane((unsigned)v), hi = __builtin_amdgcn_readfirstlane((unsigned)(v >> 32)); return (const GAS char*)(((unsigned long long)hi << 32) | lo); }
__device__ __forceinline__ unsigned cvt_pk_bf16(float lo, float hi) { unsigned r; asm volatile("v_cvt_pk_bf16_f32 %0, %1, %2" : "=v"(r) : "v"(lo), "v"(hi)); return r; }

template <class Epi, class Sched, bool ALIGN_EPI, bool KSPLIT, int LDB, bool GATHER = false>
__device__ __forceinline__ void gemm_phase(LAS unsigned char* lds, const int tid, const Sched& S, const Epi& E) {
    constexpr int K = 1024, nt = K / BK, ntb = KSPLIT ? nt / 2 : nt;
    const int wid = __builtin_amdgcn_readfirstlane(tid >> 6), lane = tid & 63, wr = wid >> 2, wc = wid & 3, fr = lane & 15, fq = lane >> 4;
    unsigned voffA[2], voffB[2];
#pragma unroll
    for (int i = 0; i < 2; ++i) { int R, C; stage_rc(tid * 16 + i * 8192, R, C); const int Rb = Epi::PERM ? ((R & ~31) + perm32(R & 31)) : R;
        voffA[i] = (unsigned)(R * K + C) * 2u; voffB[i] = (unsigned)(Rb * LDB + C) * 2u; }
    unsigned cvA[2][2], nvA[2][2]; int arow[2][2];
#pragma unroll
    for (int i = 0; i < 2; ++i) { int R, C; stage_rc(tid * 16 + i * 8192, R, C); arow[0][i] = R; arow[1][i] = C * 2; }
    constexpr size_t kstep = (size_t)(BK * 2);
    constexpr size_t hstepA = (size_t)HALF * K * 2, hstepB = (size_t)HALF * LDB * 2;
    const unsigned ldsw = (unsigned)wid * 1024u;
    const int aoff = lds_byte(wr * 64 + fr, fq * 8), boff = lds_byte(wc * 32 + fr, fq * 8);
#define PG8_SA(b, h) (((b) * 2 + (h)) * HTB)
#define PG8_SB(b, h) ((4 + (b) * 2 + (h)) * HTB)
#define PG8_STAGE(bufoff, gbase, voff) do { const GAS char* _gb = (const GAS char*)(gbase); _Pragma("unroll") for (int _i = 0; _i < 2; ++_i) \
        __builtin_amdgcn_global_load_lds((const GAS unsigned*)(_gb + (voff)[_i]), (LAS unsigned*)(lds + (bufoff) + ldsw + _i * 8192), 16, 0, 0); } while (0)
#define PG8_LDA(dst, b, h) do { _Pragma("unroll") for (int m = 0; m < 4; ++m) _Pragma("unroll") for (int k = 0; k < 2; ++k) dst[m][k] = *(const LAS bf16x8*)(lds + PG8_SA(b, h) + aoff + m * 2048 + k * 1024); } while (0)
#define PG8_LDB(dst, b, h) do { _Pragma("unroll") for (int n = 0; n < 2; ++n) _Pragma("unroll") for (int k = 0; k < 2; ++k) dst[n][k] = *(const LAS bf16x8*)(lds + PG8_SB(b, h) + boff + n * 2048 + k * 1024); } while (0)
#define PG8_MMA(ai, bj, At, Bt) do { __builtin_amdgcn_s_setprio(1); _Pragma("unroll") for (int m = 0; m < 4; ++m) _Pragma("unroll") for (int n = 0; n < 2; ++n) _Pragma("unroll") for (int k = 0; k < 2; ++k) \
        acc[ai][bj][m][n] = __builtin_amdgcn_mfma_f32_16x16x32_bf16(Bt[n][k], At[m][k], acc[ai][bj][m][n], 0, 0, 0); __builtin_amdgcn_s_setprio(0); } while (0)
#define PG8_WAIT_V(n) asm volatile("s_waitcnt vmcnt(" #n ")" ::: "memory")
#define PG8_WAIT_L(n) asm volatile("s_waitcnt lgkmcnt(" #n ")" ::: "memory")
#define PG8_BAR __builtin_amdgcn_s_barrier()
#define PG8_SCHED __builtin_amdgcn_sched_barrier(0)
    Unit cur, nxt; int ui = 0;
    if (!S.next(0, cur)) return;
    f32x4 acc[2][2][4][2];
#pragma unroll
    for (int a = 0; a < 2; ++a)
#pragma unroll
        for (int b = 0; b < 2; ++b)
#pragma unroll
            for (int m = 0; m < 4; ++m)
#pragma unroll
                for (int n = 0; n < 2; ++n) acc[a][b][m][n] = (f32x4){0.f, 0.f, 0.f, 0.f};
    bf16x8 At[4][2], B0[2][2], B1[2][2];
    const char* cA = (const char*)uni_ptr(S.aptr(cur)); const char* cB = (const char*)uni_ptr(S.bptr(cur));
#define PG8_LOADROWS(dst, u) do { if constexpr (GATHER) { const int* rl_ = S.rowlist(u); _Pragma("unroll") for (int hh = 0; hh < 2; ++hh) _Pragma("unroll") for (int i = 0; i < 2; ++i) { \
        const int r_ = rl_[hh * HALF + arow[0][i]]; dst[hh][i] = (unsigned)(r_ < 0 ? 0 : r_) * (unsigned)(K * 2) + (unsigned)arow[1][i]; } } } while (0)
    PG8_LOADROWS(cvA, cur);
#define PG8_STAGE_A(bufoff, gbase, half, next) do { if constexpr (GATHER) { PG8_STAGE(bufoff, gbase, (next) ? nvA[half] : cvA[half]); } else { PG8_STAGE(bufoff, (gbase) + (half) * hstepA, voffA); } } while (0)
    {
        PG8_STAGE(PG8_SB(0, 0), cB, voffB); PG8_STAGE(PG8_SB(0, 1), cB + hstepB, voffB); PG8_STAGE_A(PG8_SA(0, 0), cA, 0, false); PG8_STAGE_A(PG8_SA(0, 1), cA, 1, false);
        if (wr == 1) PG8_BAR;
        PG8_WAIT_V(2); PG8_BAR;
        PG8_STAGE(PG8_SB(1, 0), cB + kstep, voffB); PG8_STAGE_A(PG8_SA(1, 0), cA + kstep, 0, false); PG8_STAGE(PG8_SB(1, 1), cB + hstepB + kstep, voffB);
        PG8_WAIT_V(6); PG8_BAR;
    }
    for (;;) {
        const bool has_next = S.next(ui + 1, nxt);
        if (has_next) PG8_LOADROWS(nvA, nxt); else { _Pragma("unroll") for (int hh = 0; hh < 2; ++hh) _Pragma("unroll") for (int i = 0; i < 2; ++i) nvA[hh][i] = cvA[hh][i]; }
#pragma unroll 1
        for (int t = 0; t < nt; t += 2) {
            const bool last = (t == nt - 2);
            const char* a1 = cA + (size_t)(t + 1) * kstep;
            const char* a2; const char* b2;
            if (last) { a2 = has_next ? S.aptr(nxt) : cA; b2 = has_next ? S.bptr(nxt) : cB; }
            else { a2 = cA + (size_t)(t + 2) * kstep; if (KSPLIT && t + 2 >= ntb) b2 = S.bptr2(cur) + (size_t)(t + 2 - ntb) * kstep; else b2 = cB + (size_t)(t + 2) * kstep; }
            a2 = (const char*)uni_ptr(a2); b2 = (const char*)uni_ptr(b2);
            const char* a3 = a2 + kstep; const char* b3 = b2 + kstep;
            PG8_LDB(B0, 0, 0); PG8_LDB(B1, 0, 1); PG8_SCHED; PG8_LDA(At, 0, 0); PG8_STAGE_A(PG8_SA(1, 1), a1, 1, false);
            PG8_WAIT_V(8); PG8_WAIT_L(0); PG8_BAR; PG8_MMA(0, 0, At, B0); PG8_MMA(0, 1, At, B1); PG8_BAR; PG8_SCHED;
            PG8_LDA(At, 0, 1); PG8_STAGE(PG8_SB(0, 0), b2, voffB); PG8_STAGE(PG8_SB(0, 1), b2 + hstepB, voffB); PG8_STAGE_A(PG8_SA(0, 0), a2, 0, last);
            PG8_WAIT_V(8); PG8_WAIT_L(0); PG8_BAR; PG8_MMA(1, 0, At, B0); PG8_MMA(1, 1, At, B1); PG8_BAR; PG8_SCHED;
            PG8_LDB(B0, 1, 0); PG8_LDB(B1, 1, 1); PG8_SCHED; PG8_LDA(At, 1, 0); PG8_STAGE_A(PG8_SA(0, 1), a2, 1, last);
            PG8_WAIT_V(8); PG8_WAIT_L(0); PG8_BAR; PG8_MMA(0, 0, At, B0); PG8_MMA(0, 1, At, B1); PG8_BAR; PG8_SCHED;
            PG8_LDA(At, 1, 1); PG8_STAGE(PG8_SB(1, 0), b3, voffB); PG8_STAGE(PG8_SB(1, 1), b3 + hstepB, voffB); PG8_STAGE_A(PG8_SA(1, 0), a3, 0, last);
            PG8_WAIT_V(8); PG8_WAIT_L(0); PG8_BAR; PG8_MMA(1, 0, At, B0); PG8_MMA(1, 1, At, B1); PG8_BAR; PG8_SCHED;
        }
        if constexpr (ALIGN_EPI) { if (wr == 0) PG8_BAR; }
        E(acc, cur, wr, wc, fr, fq);
        if (!has_next) break;
#pragma unroll
        for (int a = 0; a < 2; ++a)
#pragma unroll
            for (int b = 0; b < 2; ++b)
#pragma unroll
                for (int m = 0; m < 4; ++m)
#pragma unroll
                    for (int n = 0; n < 2; ++n) acc[a][b][m][n] = (f32x4){0.f, 0.f, 0.f, 0.f};
        cur = nxt; cA = (const char*)uni_ptr(S.aptr(cur)); cB = (const char*)uni_ptr(S.bptr(cur)); ++ui;
        if constexpr (GATHER) { _Pragma("unroll") for (int hh = 0; hh < 2; ++hh) _Pragma("unroll") for (int i = 0; i < 2; ++i) cvA[hh][i] = nvA[hh][i]; }
        if constexpr (ALIGN_EPI) { if (wr == 1) PG8_BAR; }
    }
    PG8_WAIT_V(0);
    if constexpr (!ALIGN_EPI) { if (wr == 0) PG8_BAR; }
    PG8_BAR;
#undef PG8_SA
#undef PG8_LOADROWS
#undef PG8_STAGE_A
#undef PG8_SB
#undef PG8_STAGE
#undef PG8_LDA
#undef PG8_LDB
#undef PG8_MMA
#undef PG8_WAIT_V
#undef PG8_WAIT_L
#undef PG8_BAR
#undef PG8_SCHED
}
}

#define XB_TMO      128
#define XB_XCNT(j)  (256  + 64 * (j))
#define XB_XSUB(j)  (1280 + 64 * (j))
#define XB_XGEN(j)  (2304 + 64 * (j))
#define XB_TOP      3328
#define XB_TOPGEN   3392
#define XCD_BAR_WORDS 3456
#define XB_SPIN_CAP (1u << 25)
__device__ __forceinline__ unsigned xb_ld(unsigned* p)              { return __hip_atomic_load(p, __ATOMIC_RELAXED, __HIP_MEMORY_SCOPE_AGENT); }
__device__ __forceinline__ unsigned xb_add(unsigned* p, unsigned v) { return __hip_atomic_fetch_add(p, v, __ATOMIC_RELAXED, __HIP_MEMORY_SCOPE_AGENT); }
__device__ __forceinline__ unsigned xb_xcc_id() { return (unsigned)__builtin_amdgcn_s_getreg((3 << 11) | 20) & 0xFu; }
#define XB_SPIN(cond, bar) do { unsigned _sp = 0; while (cond) { __builtin_amdgcn_s_sleep(1); \
    if ((++_sp & 255u) == 0u) { if (xb_ld(&(bar)[XB_TMO])) break; if (_sp > XB_SPIN_CAP) { atomicAdd(&(bar)[XB_TMO], 1u); break; } } } } while (0)
struct XcdBarrier { unsigned* bar; unsigned x; volatile LAS unsigned* st; };
__device__ __forceinline__ XcdBarrier xcd_barrier_post(unsigned* bar, volatile LAS unsigned* st) {
    XcdBarrier b; b.bar = bar; b.x = xb_xcc_id(); b.st = st;
    if (threadIdx.x == 0) (void)xb_add(&bar[XB_XCNT(b.x)], 1u);
    return b;
}
__device__ __forceinline__ void xcd_barrier_complete(unsigned* bar, unsigned x, unsigned& nloc, unsigned& nx) {
    const unsigned G = gridDim.x * gridDim.y * gridDim.z;
    unsigned sum, cnt, mine, sp = 0u;
    for (;;) {
        sum = 0u; cnt = 0u; mine = 0u;
#pragma unroll 1
        for (unsigned j = 0; j < 16; ++j) { const unsigned c = xb_ld(&bar[XB_XCNT(j)]); sum += c; cnt += (c > 0u) ? 1u : 0u; mine = (j == x) ? c : mine; }
        if (sum == G) break;
        __builtin_amdgcn_s_sleep(1);
        if ((++sp & 255u) == 0u) { if (xb_ld(&bar[XB_TMO])) break; if (sp > XB_SPIN_CAP) { atomicAdd(&bar[XB_TMO], 1u); break; } }
    }
    nloc = mine > 0u ? mine : 1u; nx = cnt > 0u ? cnt : 1u;
}
__device__ __forceinline__ void xcd_barrier(const XcdBarrier& b) {
    asm volatile("s_waitcnt vmcnt(0)" ::: "memory");
    __syncthreads();
    if (threadIdx.x == 0) {
        unsigned* bar = b.bar;
        __builtin_amdgcn_s_waitcnt(0);
        unsigned nloc = b.st[0], nx = b.st[1];
        if (nloc == 0u) { xcd_barrier_complete(bar, b.x, nloc, nx); b.st[0] = nloc; b.st[1] = nx; }
        const unsigned old = xb_add(&bar[XB_XSUB(b.x)], 1u);
        const unsigned gen = old / nloc;
        if (old + 1u == (gen + 1u) * nloc) {
            __builtin_amdgcn_fence(__ATOMIC_RELEASE, "agent");
            asm volatile("s_waitcnt vmcnt(0)" ::: "memory");
            const unsigned og = xb_add(&bar[XB_TOP], 1u);
            const unsigned tg = og / nx;
            if (og + 1u == (tg + 1u) * nx) xb_add(&bar[XB_TOPGEN], 1u);
            else XB_SPIN(xb_ld(&bar[XB_TOPGEN]) == tg, bar);
            __builtin_amdgcn_fence(__ATOMIC_ACQUIRE, "agent");
            xb_add(&bar[XB_XGEN(b.x)], 1u);
            asm volatile("s_waitcnt vmcnt(0)" ::: "memory");
        } else {
            XB_SPIN(xb_ld(&bar[XB_XGEN(b.x)]) == gen, bar);
            __builtin_amdgcn_fence(__ATOMIC_ACQUIRE, "agent");
            asm volatile("s_waitcnt vmcnt(0)" ::: "memory");
        }
    }
    __syncthreads();
}

struct Args { const float* in[39]; float* out; unsigned char* ws; int ph_lo, ph_hi; };
struct Frame {
    LAS unsigned char* lds;
    int tid, lane, wave, G, bid;
    float* out; unsigned char* ws;
    int l;
};
#define AS4 __attribute__((address_space(4)))
#define PH_ENTER(F0) Frame F = (F0); { GAS unsigned char* _w = (GAS unsigned char*)F.ws; GAS float* _o = (GAS float*)F.out; \
    asm volatile("" : "+s"(_w), "+s"(_o), "+v"(F.tid), "+s"(F.wave), "+s"(F.bid), "+s"(F.G), "+s"(F.l)); F.ws = (unsigned char*)_w; F.out = (float*)_o; } F.lane = F.tid & 63
__device__ __forceinline__ const AS4 Args* kargs() { const AS4 Args* p = (const AS4 Args*)__builtin_amdgcn_kernarg_segment_ptr(); asm volatile("" : "+s"(p)); return p; }
#define INP(i) ((const float*)(GAS const float*)(KA->in[i]))
#define LP(i, stride) (INP(i) + (size_t)F.l * (stride))

__device__ __forceinline__ const float* xin_row(const float* xl, const float* xc, int row) {
    const int b = row / TB, p = row % TB;
    if (p < TC) return xc + ((size_t)b * TC + p) * D;
    return xl + ((size_t)b * TL + (p - TC)) * D;
}
__device__ __forceinline__ int n_units(bool skipctx) { return skipctx ? NB * 128 : NUNIT64; }
__device__ __forceinline__ int unit_of(bool skipctx, int j) { return skipctx ? (j >> 7) * NTILE64 + 4 + (j & 127) : j; }
__device__ __forceinline__ int mod_index(int row) { const int b = row / TB, p = row % TB; return p < TC ? 8 : b; }

__device__ __forceinline__ int in_colmap(int n) {
    if (n < 2304) return n;
    if (n < 2816) return n + 8;
    if (n < 3072) return n + 24;
    if (n < 3080) return n - 768;
    if (n < 3096) return n - 256;
    return -1;
}
__device__ __forceinline__ void tr_item(const float* src, int ldsrc, int scol, bf16* dst, int K, int n0, int k0, LAS float* scr, int lane) {
#pragma unroll 8
    for (int i = 0; i < 32; ++i) { const int kk = 2 * i + (lane >> 5); scr[kk * 33 + (lane & 31)] = scol >= 0 ? src[(size_t)(k0 + kk) * ldsrc + scol] : 0.f; }
    LDS_WAIT(); asm volatile("" ::: "memory");
    const int c = lane & 7;
#pragma unroll
    for (int j = 0; j < 4; ++j) { const int n = (lane >> 3) + 8 * j; const LAS float* s = scr + (8 * c) * 33 + n;
        u32x4 o; o.x = pk2(s[0 * 33], s[1 * 33]); o.y = pk2(s[2 * 33], s[3 * 33]); o.z = pk2(s[4 * 33], s[5 * 33]); o.w = pk2(s[6 * 33], s[7 * 33]);
        *(GAS u32x4*)(dst + (size_t)(n0 + n) * K + k0 + 8 * c) = o; }
    LDS_WAIT(); asm volatile("" ::: "memory");
}
__device__ __forceinline__ void phase_convert(const Frame& F0) {
    PH_ENTER(F0);
    const AS4 Args* KA = kargs();
    LAS float* scr = (LAS float*)(F.lds + F.wave * 16384);
    const int gw = F.bid * 8 + F.wave, NGW = F.G * 8, l = F.l, lane = F.lane;
    constexpr int I_A = 16 * 104, I_B = 16 * 32, I_C = 16 * 16 * 32, I_D = 16 * 8 * 32, I_E = 48;
    for (int it = gw; it < I_A + I_B + I_C + I_D + I_E; it += NGW) {
        int r = it;
        if (r < I_A) { const int kb = r / 104, nb = r % 104; tr_item(INP(8) + (size_t)l * D * IN_COLS, IN_COLS, in_colmap(nb * 32 + (lane & 31)), (bf16*)(F.ws + WS_WIN), D, nb * 32, kb * 64, scr, lane); continue; }
        r -= I_A;
        if (r < I_B) { const int kb = r / 32, nb = r % 32; tr_item(INP(9) + (size_t)l * D * D, D, nb * 32 + (lane & 31), (bf16*)(F.ws + WS_WOUT), D, nb * 32, kb * 64, scr, lane); continue; }
        r -= I_B;
        if (r < I_C) { const int e = r / 512, rr = r % 512, kb = rr / 32, nb = rr % 32; const int n0 = nb * 32, j = n0 >> 8, wi = n0 & 255;
            const float* src = (wi < 128 ? INP(35) : INP(36)) + (size_t)(l * 16 + e) * D * 512;
            tr_item(src, 512, 128 * j + (wi & 127) + (lane & 31), (bf16*)(F.ws + WS_W13) + (size_t)e * D * D, D, n0, kb * 64, scr, lane); continue; }
        r -= I_C;
        if (r < I_D) { const int e = r / 256, rr = r % 256, kb = rr / 32, nb = rr % 32;
            tr_item(INP(37) + (size_t)(l * 16 + e) * 512 * D, D, nb * 32 + (lane & 31), (bf16*)(F.ws + WS_W2T) + (size_t)e * D * 512, 512, nb * 32, kb * 64, scr, lane); continue; }
        r -= I_D;
        { bf16* LW = (bf16*)(F.ws + WS_LOWR);
            if (r < 16) { const int d = r >> 3, nb = r & 7; tr_item(INP(13) + (size_t)(l * 2 + d) * 64 * 256, 256, nb * 32 + (lane & 31), LW + (size_t)d * 256 * 64, 64, nb * 32, 0, scr, lane); }
            else if (r < 32) { const int d = (r - 16) >> 3, nb = r & 7; tr_item(INP(15) + (size_t)(l * 2 + d) * 64 * 256, 256, nb * 32 + (lane & 31), LW + 32768 + (size_t)d * 256 * 64, 64, nb * 32, 0, scr, lane); }
            else { const int kb = (r - 32) >> 3, nb = r & 7; tr_item(INP(16) + (size_t)l * 128 * 256, 256, nb * 32 + (lane & 31), LW + 65536, 128, nb * 32, kb * 64, scr, lane); } }
    }
}
__device__ __forceinline__ void phase_mods(const Frame& F0) {
    PH_ENTER(F0);
    const AS4 Args* KA = kargs();
    LAS float* cond = (LAS float*)F.lds;
    LAS float* red = (LAS float*)(F.lds + 40960);
    for (int i = F.tid; i < 9 * D; i += 512) { const float v = i < 8 * D ? INP(1)[i] : INP(3)[i - 8 * D]; cond[i] = siluf(v); }
    LDS_BARRIER();
    float* mod = (float*)(F.ws + WS_MOD);
    for (int u = F.bid; u < 2 * 96; u += F.G) {
        const int l = u / 96, cb = u % 96, col = cb * 64 + F.lane;
        const float* W = INP(4) + (size_t)l * D * 6144;
        float acc[9];
#pragma unroll
        for (int i = 0; i < 9; ++i) acc[i] = 0.f;
#pragma unroll 1
        for (int k0 = F.wave * 128; k0 < F.wave * 128 + 128; k0 += 16) { float w[16];
#pragma unroll
            for (int kk = 0; kk < 16; ++kk) w[kk] = W[(size_t)(k0 + kk) * 6144 + col];
#pragma unroll
            for (int kk = 0; kk < 16; kk += 4)
#pragma unroll
                for (int i = 0; i < 9; ++i) { const f32x4 c4 = *(const LAS f32x4*)(cond + i * D + k0 + kk); acc[i] += c4.x * w[kk] + c4.y * w[kk + 1] + c4.z * w[kk + 2] + c4.w * w[kk + 3]; } }
#pragma unroll
        for (int i = 0; i < 9; ++i) red[(F.wave * 9 + i) * 64 + F.lane] = acc[i];
        LDS_BARRIER();
        for (int o = F.tid; o < 9 * 64; o += 512) { const int i = o / 64, ln = o % 64; float s = 0.f;
#pragma unroll
            for (int w = 0; w < 8; ++w) s += red[(w * 9 + i) * 64 + ln];
            mod[((size_t)l * 9 + i) * 6144 + cb * 64 + ln] = s + INP(5)[(size_t)l * 6144 + cb * 64 + ln]; }
        LDS_BARRIER();
    }
}

__device__ __forceinline__ void phase_norm1(const Frame& F0) {
    PH_ENTER(F0);
    const AS4 Args* KA = kargs();
    const float* xl = INP(0); const float* xc = INP(2); const bf16* XB = (const bf16*)(F.ws + WS_XB); const bool first = F.l == 0;
    const int gw = F.bid * 8 + F.wave, NGW = F.G * 8, lane = F.lane;
    const float* g = LP(6, D);
    const float* mod = (const float*)(F.ws + WS_MOD) + (size_t)F.l * 9 * 6144;
    bf16* H = (bf16*)(F.ws + WS_ACT);
    const int R = (T + NGW - 1) / NGW, r0 = gw * R, r1 = min(T, r0 + R);
    f32x4 A[4], B[4], nv[4]; u32x2 nb[4]; int curmi = -1;
#define N1_LOAD(row) do { if (first) { const f32x4* xr = (const f32x4*)xin_row(xl, xc, (row)) + lane; _Pragma("unroll") for (int j = 0; j < 4; ++j) nv[j] = xr[64 * j]; } \
        else { const u32x2* xr = (const u32x2*)(XB + (size_t)(row) * D) + lane; _Pragma("unroll") for (int j = 0; j < 4; ++j) nb[j] = xr[64 * j]; } } while (0)
    if (r0 < r1) N1_LOAD(r0);
    for (int row = r0; row < r1; ++row) {
        f32x4 v[4];
        if (first) {
#pragma unroll
            for (int j = 0; j < 4; ++j) v[j] = nv[j];
        } else {
#pragma unroll
            for (int j = 0; j < 4; ++j) v[j] = bf4(nb[j]);
        }
        if (row + 1 < r1) N1_LOAD(row + 1);
        const int mi = mod_index(row);
        if (mi != curmi) { curmi = mi; const float* mrow = mod + (size_t)mi * 6144;
#pragma unroll
            for (int j = 0; j < 4; ++j) { const int c = 4 * lane + 256 * j; A[j] = *(const f32x4*)(g + c) * (*(const f32x4*)(mrow + D + c) + 1.f); B[j] = *(const f32x4*)(mrow + c); } }
        float s = 0.f;
#pragma unroll
        for (int j = 0; j < 4; ++j) s += (v[j].x * v[j].x + v[j].y * v[j].y) + (v[j].z * v[j].z + v[j].w * v[j].w);
        const float rs = rsqrtf(wave_sum(s) * (1.f / D) + 1e-6f);
        u32x2* o8 = (u32x2*)(H + (size_t)row * D) + lane;
#pragma unroll
        for (int j = 0; j < 4; ++j) { const f32x4 h = v[j] * rs * A[j] + B[j]; u32x2 w; w.x = pk2(h.x, h.y); w.y = pk2(h.z, h.w); o8[64 * j] = w; }
    }
#undef N1_LOAD
}

struct SchedStatic {
    int nM, nN, nwg, G, c; const unsigned char* ws; const unsigned char* wsA; size_t offA, offB; int skipctx;
    __device__ __forceinline__ bool next(int i, pg8::Unit& u) const {
        const long L = (long)i * G + c; if (L >= nwg) return false;
        int wgid = (int)L; { const int q = nwg / 8, r = nwg % 8, xcd = wgid % 8, off = wgid / 8; wgid = (xcd < r ? xcd * (q + 1) : r * (q + 1) + (xcd - r) * q) + off; }
        const int nig = 8 * nN, gid = wgid / nig, fm = gid * 8, gsz = (nM - fm) < 8 ? (nM - fm) : 8;
        u.pm = fm + ((wgid % nig) % gsz); u.pn = (wgid % nig) / gsz; u.aux = 0;
        if (skipctx) u.pm = (u.pm >> 5) * 33 + 1 + (u.pm & 31);
        return true;
    }
    __device__ __forceinline__ const char* aptr(const pg8::Unit& u) const { return (const char*)wsA + offA + (size_t)u.pm * (256 * 1024 * 2); }
    __device__ __forceinline__ const char* bptr(const pg8::Unit& u) const { return (const char*)ws + offB + (size_t)u.pn * (256 * 1024 * 2); }
    __device__ __forceinline__ const char* bptr2(const pg8::Unit& u) const { return bptr(u); }
    __device__ __forceinline__ const int* rowlist(const pg8::Unit&) const { return nullptr; }
};
struct EpiU {
    static constexpr bool PERM = true;
    unsigned char* ws;
    __device__ __forceinline__ void operator()(const f32x4 (&acc)[2][2][4][2], const pg8::Unit& u, int wr, int wc, int fr, int fq) const {
        const int row0 = u.pm * 256 + wr * 64 + fr, pn = u.pn;
        float* u_misc = (float*)(ws + WS_UMISC);
        if (pn < 12) {
            bf16* base; int ld, c0;
            if (pn < 4) { base = (bf16*)(ws + WS_URW); ld = 1024; c0 = pn * 256; } else if (pn < 6) { base = (bf16*)(ws + WS_UZ); ld = 512; c0 = (pn - 4) * 256; }
            else if (pn < 9) { base = (bf16*)(ws + WS_UXBC); ld = 768; c0 = (pn - 6) * 256; } else { base = (bf16*)(ws + WS_UGLA); ld = 768; c0 = (pn - 9) * 256; }
            const int col0 = c0 + wc * 32 + 8 * fq;
#pragma unroll
            for (int ai = 0; ai < 2; ++ai)
#pragma unroll
                for (int m = 0; m < 4; ++m) { bf16* rowp = base + (size_t)(row0 + ai * 128 + m * 16) * ld + col0;
#pragma unroll
                    for (int bj = 0; bj < 2; ++bj) { const f32x4 v0 = acc[ai][bj][m][0], v1 = acc[ai][bj][m][1];
                        u32x4 w; w.x = pg8::cvt_pk_bf16(v0[0], v0[1]); w.y = pg8::cvt_pk_bf16(v0[2], v0[3]); w.z = pg8::cvt_pk_bf16(v1[0], v1[1]); w.w = pg8::cvt_pk_bf16(v1[2], v1[3]);
                        *(u32x4*)(rowp + bj * 128) = w; } }
        } else if (wc == 0) {
#pragma unroll
            for (int ai = 0; ai < 2; ++ai)
#pragma unroll
                for (int m = 0; m < 4; ++m) { float* rp = u_misc + (size_t)(row0 + ai * 128 + m * 16) * 32 + 8 * fq;
                    *(f32x4*)rp = acc[ai][0][m][0]; *(f32x4*)(rp + 4) = acc[ai][0][m][1]; }
        }
    }
};
struct EpiRes {
    static constexpr bool PERM = true;
    const float* xin_lat; const float* xin_ctx; unsigned char* ws; int l;
    __device__ __forceinline__ void operator()(const f32x4 (&acc)[2][2][4][2], const pg8::Unit& u, int wr, int wc, int fr, int fq) const {
        const int b = u.pm / 33, tb = u.pm % 33;
        const float* mrow = (const float*)(ws + WS_MOD) + (size_t)l * 9 * 6144 + (size_t)(tb == 0 ? 8 : b) * 6144 + 2 * D;
        const float* xi = tb == 0 ? xin_ctx + (size_t)b * TC * D : xin_lat + ((size_t)b * TL + (size_t)(tb - 1) * 256) * D;
        bf16* xo = (bf16*)(ws + WS_XB) + (size_t)u.pm * 256 * D;
        const int r0 = wr * 64 + fr, col0 = u.pn * 256 + wc * 32 + 8 * fq;
        const bool first = l == 0;
#pragma unroll
        for (int ai = 0; ai < 2; ++ai)
#pragma unroll
            for (int m = 0; m < 4; ++m) { const size_t off = (size_t)(r0 + ai * 128 + m * 16) * D + col0;
#pragma unroll
                for (int bj = 0; bj < 2; ++bj) { const f32x4 g0 = *(const f32x4*)(mrow + col0 + bj * 128), g1 = *(const f32x4*)(mrow + col0 + bj * 128 + 4);
                    f32x4 x0, x1;
                    if (first) { x0 = *(const f32x4*)(xi + off + bj * 128); x1 = *(const f32x4*)(xi + off + bj * 128 + 4); }
                    else { const u32x4 w = *(const u32x4*)(xo + off + bj * 128); x0 = bf4((u32x2){w.x, w.y}); x1 = bf4((u32x2){w.z, w.w}); }
                    x0 = x0 + g0 * acc[ai][bj][m][0]; x1 = x1 + g1 * acc[ai][bj][m][1];
                    u32x4 o; o.x = pg8::cvt_pk_bf16(x0[0], x0[1]); o.y = pg8::cvt_pk_bf16(x0[2], x0[3]); o.z = pg8::cvt_pk_bf16(x1[0], x1[1]); o.w = pg8::cvt_pk_bf16(x1[2], x1[3]);
                    *(u32x4*)(xo + off + bj * 128) = o; }
                asm volatile("" ::: "memory"); }
    }
};
__device__ __forceinline__ void cls_experts(int cls, int& ea, int& eb) {
    const int g = cls / 6, pr = cls % 6;
    const int pa = pr < 3 ? 0 : (pr < 5 ? 1 : 2);
    const int pb = pr == 0 ? 1 : (pr == 1 ? 2 : (pr == 2 ? 3 : (pr == 3 ? 2 : 3)));
    ea = g * 4 + pa; eb = g * 4 + pb;
}
template <int NJ> struct SchedMoE {
    int ntiles, G, c; const LAS int* cs; const unsigned char* ws;
    __device__ __forceinline__ bool next(int i, pg8::Unit& u) const {
        const long L = (long)i * G + c; if (L >= (long)ntiles * NJ) return false;
        const int tile = (int)(L / NJ), j = (int)(L % NJ), slot0 = tile * 256;
        int cls = 0;
#pragma unroll 1
        for (int k = 1; k < NCLS; ++k) cls = (slot0 >= cs[k]) ? k : cls;
        u.pm = tile; u.pn = j; u.aux = cls; return true;
    }
    __device__ __forceinline__ const char* aptr(const pg8::Unit& u) const { return NJ == 8 ? (const char*)ws + WS_ACT : (const char*)ws + WS_H1 + (size_t)u.pm * (256 * 1024 * 2); }
    __device__ __forceinline__ const int* rowlist(const pg8::Unit& u) const { return (const int*)(ws + WS_LIST) + u.pm * 256; }
    __device__ __forceinline__ const char* bptr(const pg8::Unit& u) const { int ea, eb; cls_experts(u.aux, ea, eb);
        if (NJ == 8) { const int e = u.pn < 4 ? ea : eb; return (const char*)ws + WS_W13 + ((size_t)e * D + (size_t)(u.pn & 3) * 256) * D * 2; }
        return (const char*)ws + WS_W2T + ((size_t)ea * D + (size_t)u.pn * 256) * 512 * 2; }
    __device__ __forceinline__ const char* bptr2(const pg8::Unit& u) const { int ea, eb; cls_experts(u.aux, ea, eb);
        return (const char*)ws + WS_W2T + ((size_t)eb * D + (size_t)u.pn * 256) * 512 * 2; }
};
struct EpiSwiGLU {
    static constexpr bool PERM = true;
    unsigned char* ws;
    __device__ __forceinline__ void operator()(const f32x4 (&acc)[2][2][4][2], const pg8::Unit& u, int wr, int wc, int fr, int fq) const {
        bf16* H1 = (bf16*)(ws + WS_H1); const f32x2* wslot = (const f32x2*)(ws + WS_WSLOT);
        const int row0 = u.pm * 256 + wr * 64 + fr, j = u.pn;
        const int col0 = (j >> 2) * 512 + (j & 3) * 128 + wc * 32 + 8 * fq;
#pragma unroll
        for (int ai = 0; ai < 2; ++ai)
#pragma unroll
            for (int m = 0; m < 4; ++m) { const int row = row0 + ai * 128 + m * 16; const f32x2 wv = wslot[row]; const float w = j < 4 ? wv.x : wv.y;
                float o[8];
#pragma unroll
                for (int n = 0; n < 2; ++n)
#pragma unroll
                    for (int i = 0; i < 4; ++i) { const float gt = acc[ai][0][m][n][i], up = acc[ai][1][m][n][i]; o[n * 4 + i] = siluf(gt) * up * w; }
                u32x4 wv4; wv4.x = pg8::cvt_pk_bf16(o[0], o[1]); wv4.y = pg8::cvt_pk_bf16(o[2], o[3]); wv4.z = pg8::cvt_pk_bf16(o[4], o[5]); wv4.w = pg8::cvt_pk_bf16(o[6], o[7]);
                *(u32x4*)(H1 + (size_t)row * D + col0) = wv4; }
    }
};
struct EpiScatter {
    static constexpr bool PERM = true;
    unsigned char* ws; int l;
    __device__ __forceinline__ void operator()(const f32x4 (&acc)[2][2][4][2], const pg8::Unit& u, int wr, int wc, int fr, int fq) const {
        const int* list = (const int*)(ws + WS_LIST); bf16* XB = (bf16*)(ws + WS_XB); const float* mod = (const float*)(ws + WS_MOD) + (size_t)l * 9 * 6144;
        const int row0 = u.pm * 256 + wr * 64 + fr, col0 = u.pn * 256 + wc * 32 + 8 * fq;
#pragma unroll
        for (int ai = 0; ai < 2; ++ai)
#pragma unroll
            for (int m = 0; m < 4; ++m) { const int tok = list[row0 + ai * 128 + m * 16];
                if (tok >= 0) { const int b = tok / TB, p = tok % TB;
                    bf16* xr = XB + (size_t)tok * D + col0;
                    const float* mrow = mod + (size_t)(p < TC ? 8 : b) * 6144 + 5 * D + col0;
#pragma unroll
                    for (int bj = 0; bj < 2; ++bj) { const f32x4 g0 = *(const f32x4*)(mrow + bj * 128), g1 = *(const f32x4*)(mrow + bj * 128 + 4);
                        const u32x4 w = *(const u32x4*)(xr + bj * 128);
                        const f32x4 x0 = bf4((u32x2){w.x, w.y}) + g0 * acc[ai][bj][m][0], x1 = bf4((u32x2){w.z, w.w}) + g1 * acc[ai][bj][m][1];
                        u32x4 o; o.x = pg8::cvt_pk_bf16(x0[0], x0[1]); o.y = pg8::cvt_pk_bf16(x0[2], x0[3]); o.z = pg8::cvt_pk_bf16(x1[0], x1[1]); o.w = pg8::cvt_pk_bf16(x1[2], x1[3]);
                        *(u32x4*)(xr + bj * 128) = o; } }
                asm volatile("" ::: "memory"); }
    }
};

constexpr int LD64 = 72;
__device__ __forceinline__ f32x4 mma16g(f32x4 acc, const LAS bf16* A, int lda, const bf16* Btg, int ldb, int lane) {
    const int r = lane & 15, kq = (lane >> 4) * 8;
    const bf16x8 a = *(const LAS bf16x8*)(A + r * lda + kq);
    const bf16x8 b = *(const bf16x8*)(Btg + (size_t)r * ldb + kq);
    return __builtin_amdgcn_mfma_f32_16x16x32_bf16(a, b, acc, 0, 0, 0);
}
__device__ __forceinline__ void phase_conv(const Frame& F0) {
    PH_ENTER(F0);
    const AS4 Args* KA = kargs();
    const bf16* UXBC = (const bf16*)(F.ws + WS_UXBC); bf16* XBCA = (bf16*)((unsigned char*)F.out + OUT_XBCA);
    const float* cw = LP(22, 9 * 768); const float* cb = LP(23, 768);
    const int cg = F.tid % 96, sub = F.tid / 96;
    if (sub >= 5) return;
    const int ch0 = cg * 8;
    float wgt0[9][8], bias[8];
#pragma unroll
    for (int k = 0; k < 9; ++k) { const f32x4 wa = *(const f32x4*)(cw + k * 768 + ch0), wb = *(const f32x4*)(cw + k * 768 + ch0 + 4);
        wgt0[k][0] = wa.x; wgt0[k][1] = wa.y; wgt0[k][2] = wa.z; wgt0[k][3] = wa.w; wgt0[k][4] = wb.x; wgt0[k][5] = wb.y; wgt0[k][6] = wb.z; wgt0[k][7] = wb.w; }
    { const f32x4 b0 = *(const f32x4*)(cb + ch0), b1 = *(const f32x4*)(cb + ch0 + 4); bias[0] = b0.x; bias[1] = b0.y; bias[2] = b0.z; bias[3] = b0.w; bias[4] = b1.x; bias[5] = b1.y; bias[6] = b1.z; bias[7] = b1.w; }
    for (int it = F.bid * 5 + sub; it < NUNIT64 * 4; it += F.G * 5) {
        const int u = it >> 2, run = it & 3, b = u / NTILE64, tl = u % NTILE64, p0 = tl * 64; const size_t rowbase = (size_t)b * TB;
        const bool lat = p0 >= TC; const int gr = (p0 - TC) >> 6;
        const int xhi = lat ? 64 : TC, x0 = (lat ? 0 : p0) + run * 16;
        const bf16* rp0; const bf16* rp1; const bf16* rp2; bool rv0, rv2;
        { const int y0 = gr - 1, y2 = gr + 1; rv0 = lat && y0 >= 0; rv2 = lat && y2 < 128;
            rp1 = UXBC + (rowbase + (lat ? TC + gr * 64 : 0)) * 768 + ch0; rp0 = rv0 ? rp1 - 64 * 768 : rp1; rp2 = rv2 ? rp1 + 64 * 768 : rp1; }
        const float m0 = rv0 ? 1.f : 0.f, m2 = rv2 ? 1.f : 0.f;
        u32x4 w00, w01, w02, w10, w11, w12;
        { const int xa = x0 - 1; const bool va = xa >= 0; const size_t oa = (size_t)(va ? xa : 0) * 768; const u32x4 z4 = {0u, 0u, 0u, 0u};
            w00 = va ? *(const u32x4*)(rp0 + oa) : z4; w01 = va ? *(const u32x4*)(rp1 + oa) : z4; w02 = va ? *(const u32x4*)(rp2 + oa) : z4;
            const size_t ob = (size_t)x0 * 768; w10 = *(const u32x4*)(rp0 + ob); w11 = *(const u32x4*)(rp1 + ob); w12 = *(const u32x4*)(rp2 + ob); }
#pragma unroll 4
        for (int k = 0; k < 16; ++k) { const int x = x0 + k, xn = x + 1; const bool vn = xn < xhi; const size_t on = (size_t)(vn ? xn : x) * 768; const u32x4 z4 = {0u, 0u, 0u, 0u};
            u32x4 w20 = *(const u32x4*)(rp0 + on), w21 = *(const u32x4*)(rp1 + on), w22 = *(const u32x4*)(rp2 + on);
            if (!vn) { w20 = z4; w21 = z4; w22 = z4; }
            float acc[8], t0[8], t2[8];
#pragma unroll
            for (int i = 0; i < 8; ++i) { acc[i] = bias[i]; t0[i] = 0.f; t2[i] = 0.f; }
            float v[8];
#define CONV_TAP(W, K, DST) unpack8(W, v); _Pragma("unroll") for (int i = 0; i < 8; ++i) DST[i] += v[i] * wgt0[K][i];
            CONV_TAP(w00, 0, t0) CONV_TAP(w10, 1, t0) CONV_TAP(w20, 2, t0) CONV_TAP(w01, 3, acc) CONV_TAP(w11, 4, acc) CONV_TAP(w21, 5, acc) CONV_TAP(w02, 6, t2) CONV_TAP(w12, 7, t2) CONV_TAP(w22, 8, t2)
#undef CONV_TAP
#pragma unroll
            for (int i = 0; i < 8; ++i) acc[i] = siluf(acc[i] + m0 * t0[i] + m2 * t2[i]);
            *(u32x4*)(XBCA + (rowbase + (lat ? TC + gr * 64 + x : x)) * 768 + ch0) = pack8(acc);
            w00 = w10; w01 = w11; w02 = w12; w10 = w20; w11 = w21; w12 = w22;
        }
    }
}
__device__ __forceinline__ void phase_prep(const Frame& F0) {
    PH_ENTER(F0);
    const AS4 Args* KA = kargs();
    const int tid = F.tid, lane = F.lane, wave = F.wave;
    const bf16* URW = (const bf16*)(F.ws + WS_URW); const bf16* UXBC = (const bf16*)(F.ws + WS_UXBC);
    bf16* XBCA = (bf16*)((unsigned char*)F.out + OUT_XBCA);
    h16* RECS = (h16*)(F.ws + WS_RECS); h16* RECD = (h16*)(F.ws + WS_RECD); h16* BONUS = (h16*)(F.ws + WS_BONUS); h16* GATE = (h16*)(F.ws + WS_GATE);
    const bf16* LW = (const bf16*)(F.ws + WS_LOWR);
    const float* mup = LP(10, 1024); const float* mun = LP(11, 1024);
    const float* w0 = LP(12, 512); const float* a0 = LP(14, 512);
    const float* k_k = LP(17, 256); const float* r_k = LP(19, 256);
    const float* cw = LP(22, 9 * 768); const float* cb = LP(23, 768);
    constexpr int LDR = 776, LDG = 136;
    LAS h16* RKV = (LAS h16*)F.lds;
    LAS bf16* WLi = (LAS bf16*)(F.lds + 99328);
    LAS bf16* ALi = (LAS bf16*)(F.lds + 108544);
    LAS bf16* GSi = (LAS bf16*)(F.lds + 117760);
    bf16x8 Bf[5][2][4];
    { const int c0 = wave * 32, r = lane & 15, kq = (lane >> 4) * 8;
#pragma unroll
        for (int mm = 0; mm < 4; ++mm) { const bf16* Bt = mm < 2 ? LW + (size_t)mm * 16384 : (mm < 4 ? LW + 32768 + (size_t)(mm - 2) * 16384 : LW + 65536); const int ldb = mm < 4 ? 64 : 128;
#pragma unroll
            for (int nt = 0; nt < 2; ++nt)
#pragma unroll
                for (int ks = 0; ks < 4; ++ks) if (ks < (mm < 4 ? 2 : 4)) Bf[mm][nt][ks] = *(const bf16x8*)(Bt + (size_t)(c0 + nt * 16 + r) * ldb + ks * 32 + kq); } }
    float pbias[4][2];
#pragma unroll
    for (int mm = 0; mm < 4; ++mm)
#pragma unroll
        for (int nt = 0; nt < 2; ++nt) { const int c = wave * 32 + nt * 16 + (lane & 15); pbias[mm][nt] = mm < 2 ? w0[mm * 256 + c] : a0[(mm - 2) * 256 + c]; }
    for (int u = F.bid; u < NUNIT64; u += F.G) {
        const int b = u / NTILE64, tl = u % NTILE64, p0 = tl * 64;
        const int seg_lo = p0 < TC ? 0 : TC, seg_hi = p0 < TC ? TC : TB;
        const size_t rowbase = (size_t)b * TB;
        LDS_BARRIER();
        SUBREP(1) { const int t = tid >> 3, part = tid & 7, p = p0 + t; const bf16* ur = URW + (rowbase + p) * 1024;
            const bool hp = p - 1 >= seg_lo, hn = p + 1 < seg_hi;
#pragma unroll 4
            for (int j = 0; j < 16; ++j) { const int c0 = (j * 8 + part) * 8;
                float uc[8], up[8], un[8];
                unpack8(*(const u32x4*)(ur + c0), uc);
                if (hp) unpack8(*(const u32x4*)(ur - 1024 + c0), up); else {
#pragma unroll
                    for (int i = 0; i < 8; ++i) up[i] = 0.f; }
                if (hn) unpack8(*(const u32x4*)(ur + 1024 + c0), un); else {
#pragma unroll
                    for (int i = 0; i < 8; ++i) un[i] = 0.f; }
                const f32x4 mp0 = *(const f32x4*)(mup + c0), mp1 = *(const f32x4*)(mup + c0 + 4), mn0 = *(const f32x4*)(mun + c0), mn1 = *(const f32x4*)(mun + c0 + 4);
                float sv[8];
#pragma unroll
                for (int i = 0; i < 4; ++i) { sv[i] = uc[i] + mp0[i] * (up[i] - uc[i]) + mn0[i] * (un[i] - uc[i]); sv[4 + i] = uc[4 + i] + mp1[i] * (up[4 + i] - uc[4 + i]) + mn1[i] * (un[4 + i] - uc[4 + i]); }
                if (c0 < 768) { h16x8 hv;
#pragma unroll
                    for (int i = 0; i < 8; ++i) hv[i] = (h16)sv[i];
                    *(LAS h16x8*)(RKV + t * LDR + c0) = hv; }
                else if (c0 < 832) {
#pragma unroll
                    for (int i = 0; i < 8; ++i) sv[i] = tanhf(sv[i]);
                    *(LAS u32x4*)(WLi + t * LD64 + (c0 - 768)) = pack8(sv); }
                else if (c0 < 896) *(LAS u32x4*)(ALi + t * LD64 + (c0 - 832)) = pack8(sv);
                else {
#pragma unroll
                    for (int i = 0; i < 8; ++i) sv[i] = sigm(sv[i]);
                    *(LAS u32x4*)(GSi + t * LDG + (c0 - 896)) = pack8(sv); }
            } }
        LDS_BARRIER();
        SUBREP(2) { const int t = tid >> 3, hq = tid & 7, h = hq >> 1, c0 = h * 64 + (hq & 1) * 32, p = p0 + t;
            float ss = 0.f, bs = 0.f;
#pragma unroll
            for (int j = 0; j < 4; ++j) { const h16x8 rv = *(const LAS h16x8*)(RKV + t * LDR + c0 + 8 * j), kv = *(const LAS h16x8*)(RKV + t * LDR + 256 + c0 + 8 * j);
                const f32x4 kk0 = *(const f32x4*)(k_k + c0 + 8 * j), kk1 = *(const f32x4*)(k_k + c0 + 8 * j + 4), rk0 = *(const f32x4*)(r_k + c0 + 8 * j), rk1 = *(const f32x4*)(r_k + c0 + 8 * j + 4);
#pragma unroll
                for (int i = 0; i < 8; ++i) { const float kf = (float)kv[i], rf = (float)rv[i], kc = i < 4 ? kk0[i & 3] : kk1[i & 3], rc = i < 4 ? rk0[i & 3] : rk1[i & 3];
                    const float kr = kf * kc; ss += kr * kr; bs += rf * kf * rc; } }
            ss += dpp_mov<0xB1>(ss); bs += dpp_mov<0xB1>(bs);
            const float rs = rsqrtf(ss + 1e-12f);
            h16* rec = RECS + (((size_t)b * 4 + h) * TB + p) * 256 + (hq & 1) * 32;
            h16* bon = BONUS + (rowbase + p) * 256 + c0;
#pragma unroll
            for (int j = 0; j < 4; ++j) { const h16x8 rv = *(const LAS h16x8*)(RKV + t * LDR + c0 + 8 * j), kv = *(const LAS h16x8*)(RKV + t * LDR + 256 + c0 + 8 * j), vv = *(const LAS h16x8*)(RKV + t * LDR + 512 + c0 + 8 * j);
                const f32x4 kk0 = *(const f32x4*)(k_k + c0 + 8 * j), kk1 = *(const f32x4*)(k_k + c0 + 8 * j + 4);
                h16x8 kkv, bv;
#pragma unroll
                for (int i = 0; i < 8; ++i) { kkv[i] = (h16)((float)kv[i] * (i < 4 ? kk0[i & 3] : kk1[i & 3]) * rs); bv[i] = (h16)(bs * (float)vv[i]); }
                *(h16x8*)(rec + 8 * j) = rv; *(h16x8*)(rec + 64 + 8 * j) = vv; *(h16x8*)(rec + 128 + 8 * j) = kkv; *(h16x8*)(rec + 192 + 8 * j) = kv;
                *(h16x8*)(bon + 8 * j) = bv; asm volatile("" ::: "memory"); } }
        LDS_BARRIER();
        SUBREP(3) { const int c0 = wave * 32, h = wave >> 1, lr = (lane >> 4) * 4, lc = lane & 15;
#pragma unroll
            for (int nt = 0; nt < 2; ++nt)
#pragma unroll
                for (int ks = 0; ks < 4; ++ks) Bf[4][nt][ks] = *(const bf16x8*)(LW + 65536 + (size_t)(c0 + nt * 16 + (lane & 15)) * 128 + ks * 32 + (lane >> 4) * 8);
#pragma unroll
            for (int mm = 0; mm < 5; ++mm) {
                const LAS bf16* Ai = mm < 2 ? WLi : (mm < 4 ? ALi : GSi); const int lda = mm < 4 ? LD64 : LDG, nks = mm < 4 ? 2 : 4;
                f32x4 acc[4][2];
#pragma unroll
                for (int tt = 0; tt < 4; ++tt)
#pragma unroll
                    for (int nt = 0; nt < 2; ++nt) acc[tt][nt] = (f32x4){0.f, 0.f, 0.f, 0.f};
#pragma unroll
                for (int ks = 0; ks < 4; ++ks) if (ks < nks)
#pragma unroll
                    for (int tt = 0; tt < 4; ++tt) { const bf16x8 af = *(const LAS bf16x8*)(Ai + (tt * 16 + (lane & 15)) * lda + ks * 32 + (lane >> 4) * 8);
#pragma unroll
                        for (int nt = 0; nt < 2; ++nt) acc[tt][nt] = __builtin_amdgcn_mfma_f32_16x16x32_bf16(af, Bf[mm][nt][ks], acc[tt][nt], 0, 0, 0); }
                LAS h16* STG = (LAS h16*)F.lds + (mm & 1) * (64 * 264);
#pragma unroll
                for (int nt = 0; nt < 2; ++nt) { const int c = c0 + nt * 16 + lc;
                    const float bias = mm < 4 ? pbias[mm < 4 ? mm : 0][nt] : 0.f;
#pragma unroll
                    for (int tt = 0; tt < 4; ++tt)
#pragma unroll
                        for (int i = 0; i < 4; ++i) { const float x = acc[tt][nt][i] + bias; const float sg = sigm(x);
                            const float o = mm < 2 ? 1.f - __expf(-0.60653066f * sg) : (mm < 4 ? sg : x);
                            STG[(tt * 16 + lr + i) * 264 + c] = (h16)o; } }
                LDS_BARRIER();
#pragma unroll
                for (int i = 0; i < 4; ++i) { const int id = tid + 512 * i, t = id >> 5, ch = id & 31, hh = ch >> 3;
                    const h16x8 v = *(const LAS h16x8*)(STG + t * 264 + ch * 8);
                    h16* dst = mm < 2 ? RECD + ((((size_t)b * 4 + hh) * 2 + mm) * TB + p0 + t) * 128 + (ch & 7) * 8
                             : (mm < 4 ? RECD + ((((size_t)b * 4 + hh) * 2 + (mm - 2)) * TB + p0 + t) * 128 + 64 + (ch & 7) * 8 : GATE + (rowbase + p0 + t) * 256 + ch * 8);
                    *(h16x8*)dst = v; }
            } }
    }
}

__device__ __forceinline__ f32x4 mma16(f32x4 acc, const LAS bf16* A, int lda, const LAS bf16* Bt, int ldb, int lane) {
    const int r = lane & 15, kq = (lane >> 4) * 8;
    const bf16x8 a = *(const LAS bf16x8*)(A + r * lda + kq);
    const bf16x8 b = *(const LAS bf16x8*)(Bt + r * ldb + kq);
    return __builtin_amdgcn_mfma_f32_16x16x32_bf16(a, b, acc, 0, 0, 0);
}
typedef short v4i16 __attribute__((ext_vector_type(4)));
__device__ __forceinline__ bf16x8 frag_tr(const LAS bf16* T, int ld, int k0, int c0, int lane) {
    const int g = lane >> 4, q = (lane & 15) >> 2, p = lane & 3;
    const LAS bf16* a = T + (k0 + 8 * g + q) * ld + c0 + 4 * p;
    const v4i16 lo = __builtin_amdgcn_ds_read_tr16_b64_v4i16((LAS v4i16*)a);
    const v4i16 hi = __builtin_amdgcn_ds_read_tr16_b64_v4i16((LAS v4i16*)(a + 4 * ld));
    return (bf16x8){lo[0], lo[1], lo[2], lo[3], hi[0], hi[1], hi[2], hi[3]};
}
__device__ __forceinline__ bf16x8 frag_row(const LAS bf16* A, int lda, int lane) { return *(const LAS bf16x8*)(A + (lane & 15) * lda + (lane >> 4) * 8); }
template <int MT, int NT, int KS> __device__ __forceinline__ void mm_block(f32x4 (&acc)[MT][NT], const LAS bf16* A, int lda, const LAS bf16* Bt, int ldb, int lane) {
    bf16x8 af[MT][KS], bfr[NT][KS];
#pragma unroll
    for (int mi = 0; mi < MT; ++mi)
#pragma unroll
        for (int ks = 0; ks < KS; ++ks) af[mi][ks] = frag_row(A + mi * 16 * lda + ks * 32, lda, lane);
#pragma unroll
    for (int nt = 0; nt < NT; ++nt)
#pragma unroll
        for (int ks = 0; ks < KS; ++ks) bfr[nt][ks] = frag_row(Bt + nt * 16 * ldb + ks * 32, ldb, lane);
#pragma unroll
    for (int mi = 0; mi < MT; ++mi)
#pragma unroll
        for (int nt = 0; nt < NT; ++nt)
#pragma unroll
            for (int ks = 0; ks < KS; ++ks) acc[mi][nt] = __builtin_amdgcn_mfma_f32_16x16x32_bf16(af[mi][ks], bfr[nt][ks], acc[mi][nt], 0, 0, 0);
}
__device__ __forceinline__ float scan_incl(float v, int lane, bool rev) {
#pragma unroll
    for (int o = 1; o < 64; o <<= 1) { const float t = rev ? __shfl_down(v, o) : __shfl_up(v, o); if (rev ? (lane + o < 64) : (lane >= o)) v += t; }
    return v;
}


__device__ __forceinline__ void gla_bcs(const Frame& F, const AS4 Args* KA, size_t row0, LAS float* LG, LAS float* GLT) {
    const int tid = F.tid;
    const float* UM = (const float*)(F.ws + WS_UMISC); const float* ga2 = LP(28, 2 * 16 * 128); const float* gb = LP(29, 256);
    LDS_BARRIER();
    if (tid < 256) { const int s = tid >> 2, j4 = (tid & 3) * 4; *(LAS f32x4*)(GLT + s * 16 + j4) = *(const f32x4*)(UM + (row0 + s) * 32 + 8 + j4); }
    LDS_BARRIER();
    { const int ch2 = tid & 255, d = ch2 >> 7, ch = ch2 & 127, sh = tid >> 8;
        float w[16];
#pragma unroll
        for (int j = 0; j < 16; ++j) w[j] = ga2[(size_t)(d * 16 + j) * 128 + ch];
        const float bias = gb[d * 128 + ch];
#pragma unroll 4
        for (int t = 0; t < 32; ++t) { const int s = sh * 32 + t; float z = bias;
#pragma unroll
            for (int j4 = 0; j4 < 4; ++j4) { const f32x4 g4 = *(const LAS f32x4*)(GLT + s * 16 + j4 * 4); z += g4.x * w[j4 * 4] + g4.y * w[j4 * 4 + 1] + g4.z * w[j4 * 4 + 2] + g4.w * w[j4 * 4 + 3]; }
            LG[(d * 64 + s) * 128 + ch] = -softplusf_(-z) * (1.f / 16.f); } }
    LDS_BARRIER();
    if (tid < 256) { const int d = tid >> 7, ch = tid & 127; float a = 0.f;
#pragma unroll 8
        for (int t = 0; t < 64; ++t) { const int s = d ? 63 - t : t; a += LG[(d * 64 + s) * 128 + ch]; LG[(d * 64 + s) * 128 + ch] = a; } }
    LDS_BARRIER();
}
__device__ __forceinline__ void phase_combine_gla(const Frame& F0) {
    PH_ENTER(F0);
    const int gid = F.bid * 512 + F.tid;
    if (gid >= 64 * 1024) return;
    const int chain = gid >> 10, e0 = (gid & 1023) * 2, d = chain & 1, bh = chain >> 1, b = bh >> 2, h = bh & 3;
    bf16* GS = (bf16*)(F.ws + WS_GS) + (size_t)chain * NTILE64 * 2048 + e0; const float* GDEC = (const float*)(F.ws + WS_GDEC) + (size_t)b * NTILE64 * 256 + d * 128 + h * 32 + (e0 & 31);
    float S0 = 0.f, S1 = 0.f;
#pragma unroll 4
    for (int it = 0; it < NTILE64; ++it) {
        const int c = d == 0 ? it : (it < 4 ? 3 - it : 131 - (it - 4));
        unsigned* p = (unsigned*)(GS + (size_t)c * 2048); const unsigned st = *p; const f32x2 dec = *(const f32x2*)(GDEC + (size_t)c * 256);
        *p = pk2(S0, S1);
        S0 = S0 * dec.x + __uint_as_float(st << 16); S1 = S1 * dec.y + __uint_as_float(st & 0xffff0000u);
    }
}
__device__ __forceinline__ void phase_finish_gla(const Frame& F0) {
    PH_ENTER(F0);
    const AS4 Args* KA = kargs();
    const int tid = F.tid, lane = F.lane, wave = F.wave;
    const bf16* UG = (const bf16*)(F.ws + WS_UGLA); const bf16* GS = (const bf16*)(F.ws + WS_GS); bf16* MIX = (bf16*)((unsigned char*)F.out + OUT_MIX);
    const float* gln = LP(30, 256);
    constexpr int LD32 = 40;
    LAS float* LG = (LAS float*)F.lds;
    LAS bf16* QE = (LAS bf16*)(F.lds + 65536);
    LAS bf16* KE = (LAS bf16*)(F.lds + 86016);
    LAS bf16* VT = (LAS bf16*)(F.lds + 96256);
    LAS bf16* ST = (LAS bf16*)(F.lds + 105472);
    LAS bf16* ATT = (LAS bf16*)(F.lds + 115712);
    LAS bf16* OB = (LAS bf16*)(F.lds + 124928);
    LAS float* RSQ = (LAS float*)(F.lds + 134144);
    LAS float* GLT = (LAS float*)(F.lds + 134656);
    LAS bf16* RT = (LAS bf16*)(F.lds + 138752);
    const int lt = wave & 3, cth = wave >> 2, lr = (lane >> 4) * 4, lc = lane & 15;
    const bool skipctx = F.l == 1;
    for (int j_ = F.G - 1 - F.bid; j_ < n_units(skipctx); j_ += F.G) {
        const int u = unit_of(skipctx, j_);
        const int b = u / NTILE64, c = u % NTILE64; const size_t row0 = (size_t)b * TB + (size_t)c * 64;
        u32x2 pq, pk; u32x4 pv, pst, prt;
        { const int l = tid >> 3, g4 = (tid & 7) * 4; const bf16* ur = UG + (row0 + l) * 768;
            pq = *(const u32x2*)(ur + g4); pk = *(const u32x2*)(ur + 128 + g4);
            pv = *(const u32x4*)(UG + (row0 + (tid & 63)) * 768 + 256 + (tid >> 6) * 8);
            { const int d = tid >> 8, r = (tid & 255) >> 2, ch = tid & 3; pst = *(const u32x4*)(GS + ((((size_t)b * 4) * 2 + d) * NTILE64 + c) * 2048 + r * 32 + ch * 8); }
            prt = *(const u32x4*)(UG + (row0 + (tid >> 3)) * 768 + 512 + (tid & 7) * 8); }
        gla_bcs(F, KA, row0, LG, GLT);
#pragma unroll 1
        for (int h = 0; h < 4; ++h) {
            { const int l = tid >> 3, g4 = (tid & 7) * 4, ch = h * 32 + g4;
                const u32x2 qr = pq, kr = pk;
                const float q[4] = { bf2f(qr.x & 0xffff) * 0.17677669529663687f, bf2f(qr.x >> 16) * 0.17677669529663687f, bf2f(qr.y & 0xffff) * 0.17677669529663687f, bf2f(qr.y >> 16) * 0.17677669529663687f };
                const float k[4] = { bf2f(kr.x & 0xffff), bf2f(kr.x >> 16), bf2f(kr.y & 0xffff), bf2f(kr.y >> 16) };
#pragma unroll
                for (int d = 0; d < 2; ++d) { const f32x4 bc = *(const LAS f32x4*)(LG + (d * 64 + l) * 128 + ch), rf = *(const LAS f32x4*)(LG + (d * 64 + 32) * 128 + ch);
                    float qe[4], ke[4], qb[4];
#pragma unroll
                    for (int i = 0; i < 4; ++i) { qe[i] = q[i] * __expf(bc[i] - rf[i]); ke[i] = k[i] * __expf(rf[i] - bc[i]); qb[i] = q[i] * __expf(bc[i]); }
                    u32x2 w; w.x = pk2(qe[0], qe[1]); w.y = pk2(qe[2], qe[3]); *(LAS u32x2*)(QE + (d * 64 + l) * LD32 + g4) = w;
                    w.x = pk2(qb[0], qb[1]); w.y = pk2(qb[2], qb[3]); *(LAS u32x2*)(QE + ((2 + d) * 64 + l) * LD32 + g4) = w;
                    w.x = pk2(ke[0], ke[1]); w.y = pk2(ke[2], ke[3]); *(LAS u32x2*)(KE + (d * 64 + l) * LD32 + g4) = w; } }
            { const int s = tid & 63, g8 = tid >> 6; const unsigned w[4] = {pv.x, pv.y, pv.z, pv.w};
#pragma unroll
                for (int i = 0; i < 8; ++i) VT[(g8 * 8 + i) * LD64 + s] = (bf16)(i & 1 ? w[i >> 1] >> 16 : w[i >> 1] & 0xffffu); }
            { const int d = tid >> 8, r = (tid & 255) >> 2, ch = tid & 3; *(LAS u32x4*)(ST + (d * 64 + r) * LD32 + ch * 8) = pst; }
            *(LAS u32x4*)(RT + (tid >> 3) * LD64 + (tid & 7) * 8) = prt;
            { const int hn = h < 3 ? h + 1 : 3; const int l = tid >> 3, g4 = (tid & 7) * 4; const bf16* ur = UG + (row0 + l) * 768;
                pq = *(const u32x2*)(ur + hn * 32 + g4); pk = *(const u32x2*)(ur + 128 + hn * 32 + g4);
                pv = *(const u32x4*)(UG + (row0 + (tid & 63)) * 768 + 256 + hn * 64 + (tid >> 6) * 8);
                { const int d = tid >> 8, r = (tid & 255) >> 2, ch = tid & 3; pst = *(const u32x4*)(GS + ((((size_t)b * 4 + hn) * 2 + d) * NTILE64 + c) * 2048 + r * 32 + ch * 8); }
                prt = *(const u32x4*)(UG + (row0 + (tid >> 3)) * 768 + 512 + hn * 64 + (tid & 7) * 8); }
            LDS_BARRIER();
#pragma unroll
            for (int j = 0; j < 2; ++j) { const int st = 2 * cth + j; const f32x4 z4 = {0.f, 0.f, 0.f, 0.f};
                const f32x4 af = mma16(z4, QE + (lt * 16) * LD32, LD32, KE + (st * 16) * LD32, LD32, lane);
                const f32x4 ab = mma16(z4, QE + (64 + lt * 16) * LD32, LD32, KE + (64 + st * 16) * LD32, LD32, lane);
                const int s = st * 16 + lc;
#pragma unroll
                for (int i = 0; i < 4; ++i) { const int l = lt * 16 + lr + i; ATT[l * LD64 + s] = (bf16)f2bf((s <= l ? af[i] : 0.f) + (s >= l ? ab[i] : 0.f)); } }
            LDS_BARRIER();
            f32x4 o[2];
#pragma unroll
            for (int j = 0; j < 2; ++j) { const int vt = 2 * cth + j; f32x4 acc = {0.f, 0.f, 0.f, 0.f};
#pragma unroll
                for (int ks = 0; ks < 2; ++ks) acc = mma16(acc, ATT + lt * 16 * LD64 + ks * 32, LD64, VT + vt * 16 * LD64 + ks * 32, LD64, lane);
                acc = mma16(acc, QE + (128 + lt * 16) * LD32, LD32, ST + (vt * 16) * LD32, LD32, lane);
                acc = mma16(acc, QE + (192 + lt * 16) * LD32, LD32, ST + (64 + vt * 16) * LD32, LD32, lane);
                o[j] = acc; }
#pragma unroll
            for (int i = 0; i < 4; ++i) { const float t = sum16(o[0][i] * o[0][i] + o[1][i] * o[1][i]); if (lc == 0) RSQ[cth * 64 + lt * 16 + lr + i] = t; }
            LDS_BARRIER();
#pragma unroll
            for (int j = 0; j < 2; ++j) { const int dv = (2 * cth + j) * 16 + lc; const float gn = gln[h * 64 + dv];
#pragma unroll
                for (int i = 0; i < 4; ++i) { const int l = lt * 16 + lr + i; const float scl = rsqrtf((RSQ[l] + RSQ[64 + l]) * (1.f / 64.f) + 1e-6f);
                    const float r = bf2f(RT[l * LD64 + dv]);
                    OB[l * LD64 + dv] = (bf16)f2bf(o[j][i] * scl * gn * siluf(r)); } }
            LDS_BARRIER();
            { const int r = tid >> 3, ch = tid & 7; *(u32x4*)(MIX + (row0 + r) * D + 768 + h * 64 + ch * 8) = *(const LAS u32x4*)(OB + r * LD64 + ch * 8); }
        }
    }
}

__device__ __forceinline__ void phase_states(const Frame& F0) {
    PH_ENTER(F0);
    const AS4 Args* KA = kargs();
    const int tid = F.tid, lane = F.lane, wave = F.wave;
    const bf16* XBCA = (const bf16*)((const unsigned char*)F.out + OUT_XBCA); const float* UM = (const float*)(F.ws + WS_UMISC);
    bf16* SS = (bf16*)(F.ws + WS_SS); float* SDEC = (float*)(F.ws + WS_SDEC);
    const float* dtb = LP(24, 16); const float* alog = LP(25, 16);
    LAS bf16* CT = (LAS bf16*)F.lds;
    LAS bf16* XTW = (LAS bf16*)(F.lds + 99328);
    LAS bf16* BT = (LAS bf16*)(F.lds + 117760);
    LAS float* WTS = (LAS float*)(F.lds + 136192);
    const bf16* UG = (const bf16*)(F.ws + WS_UGLA); bf16* GS = (bf16*)(F.ws + WS_GS); float* GDEC = (float*)(F.ws + WS_GDEC);
    LAS float* LG = (LAS float*)F.lds;
    LAS bf16* VT4 = (LAS bf16*)(F.lds + 65536);
    LAS bf16* KTE = (LAS bf16*)(F.lds + 102400);
    LAS float* GLT = (LAS float*)(F.lds + 139264);
    for (int u = F.G - 1 - F.bid; u < NUNIT64; u += F.G) {
        const int b = u / NTILE64, c = u % NTILE64; const size_t row0 = (size_t)b * TB + (size_t)c * 64;
        LDS_BARRIER();
#pragma unroll
        for (int i = 0; i < 12; ++i) { const int id = tid + 512 * i, r = id / 96, ch = id % 96;
            *(LAS u32x4*)(CT + r * 776 + ch * 8) = *(const u32x4*)(XBCA + (row0 + r) * 768 + ch * 8); }
#pragma unroll
        for (int j = 0; j < 2; ++j) { const int q = wave * 2 + j, h = q >> 1, d = q & 1;
            const float dtp = softplusf_(UM[(row0 + lane) * 32 + h] + dtb[d * 8 + h]);
            const float dA = -__expf(alog[d * 8 + h]) * dtp;
            const float cs = scan_incl(dA, lane, d == 1);
            const float ce = __shfl(cs, d == 0 ? 63 : 0);
            WTS[q * 64 + lane] = __expf(ce - cs) * dtp;
            if (lane == 0) SDEC[((size_t)b * NTILE64 + c) * 16 + q] = __expf(ce); }
        LDS_BARRIER();
#pragma unroll 1
        for (int hp = 0; hp < 4; ++hp) {
            { const int sr = tid >> 3, ch = tid & 7, g = hp >> 1; float bv[8]; unpack8(*(const LAS u32x4*)(CT + sr * 776 + 512 + g * 64 + ch * 8), bv);
#pragma unroll
                for (int q = 0; q < 4; ++q) { const float w = WTS[(hp * 4 + q) * 64 + sr]; float o[8];
#pragma unroll
                    for (int i = 0; i < 8; ++i) o[i] = bv[i] * w;
                    *(LAS u32x4*)(XTW + (q * 64 + sr) * LD64 + ch * 8) = pack8(o); } }
            LDS_BARRIER();
            { const int d = wave >> 2, mt = wave & 3;
#pragma unroll
                for (int hh = 0; hh < 2; ++hh) { const int h = hp * 2 + hh;
                    bf16* dst = SS + ((((size_t)b * 8 + h) * 2 + d) * NTILE64 + c) * 4096;
                    bf16x8 af[2];
#pragma unroll
                    for (int ks = 0; ks < 2; ++ks) af[ks] = frag_tr(CT, 776, ks * 32, h * 64 + mt * 16, lane);
#pragma unroll
                    for (int nt = 0; nt < 4; ++nt) { f32x4 acc = {0.f, 0.f, 0.f, 0.f};
#pragma unroll
                        for (int ks = 0; ks < 2; ++ks) acc = __builtin_amdgcn_mfma_f32_16x16x32_bf16(af[ks], frag_tr(XTW + (hh * 2 + d) * 64 * LD64, LD64, ks * 32, nt * 16, lane), acc, 0, 0, 0);
#pragma unroll
                        for (int i = 0; i < 4; ++i) dst[(mt * 16 + (lane >> 4) * 4 + i) * 64 + nt * 16 + (lane & 15)] = (bf16)f2bf(acc[i]); } } }
            LDS_BARRIER();
        }
        gla_bcs(F, KA, row0, LG, GLT);
        if (tid < 256) GDEC[((size_t)b * NTILE64 + c) * 256 + tid] = __expf(LG[((tid >> 7) * 64 + ((tid >> 7) ? 0 : 63)) * 128 + (tid & 127)]);
        { const int sr = tid >> 3, q8 = tid & 7; const bf16* ur = UG + (row0 + sr) * 768;
#pragma unroll
            for (int i = 0; i < 4; ++i) { const int col = (q8 * 4 + i) * 8; *(LAS u32x4*)(VT4 + sr * 264 + col) = *(const u32x4*)(ur + 256 + col); }
#pragma unroll
            for (int i = 0; i < 2; ++i) { const int col = (q8 * 2 + i) * 8; float kv[8]; unpack8(*(const u32x4*)(ur + 128 + col), kv);
#pragma unroll
                for (int d = 0; d < 2; ++d) { const LAS float* be = LG + (d * 64 + (d ? 0 : 63)) * 128 + col; const LAS float* bc = LG + (d * 64 + sr) * 128 + col; float o[8];
#pragma unroll
                    for (int k = 0; k < 8; ++k) o[k] = kv[k] * __expf(be[k] - bc[k]);
                    *(LAS u32x4*)(KTE + (d * 64 + sr) * 136 + col) = pack8(o); } } }
        LDS_BARRIER();
        { const int d = wave >> 2, mt = wave & 3;
#pragma unroll
            for (int h = 0; h < 4; ++h) { bf16* dst = GS + ((((size_t)b * 4 + h) * 2 + d) * NTILE64 + c) * 2048;
                bf16x8 af[2];
#pragma unroll
                for (int ks = 0; ks < 2; ++ks) af[ks] = frag_tr(VT4, 264, ks * 32, h * 64 + mt * 16, lane);
#pragma unroll
                for (int nt = 0; nt < 2; ++nt) { f32x4 acc = {0.f, 0.f, 0.f, 0.f};
#pragma unroll
                    for (int ks = 0; ks < 2; ++ks) acc = __builtin_amdgcn_mfma_f32_16x16x32_bf16(af[ks], frag_tr(KTE + d * 64 * 136, 136, ks * 32, h * 32 + nt * 16, lane), acc, 0, 0, 0);
#pragma unroll
                    for (int i = 0; i < 4; ++i) dst[(mt * 16 + (lane >> 4) * 4 + i) * 32 + nt * 16 + (lane & 15)] = (bf16)f2bf(acc[i]); } } }
    }
}
__device__ __forceinline__ void phase_combine_ssd(const Frame& F0) {
    PH_ENTER(F0);
    const int gid = F.bid * 512 + F.tid;
    if (gid >= 128 * 1024) return;
    const int chain = gid >> 10, e0 = (gid & 1023) * 4, d = chain & 1, bh = chain >> 1, b = bh >> 3, h = bh & 7;
    bf16* SS = (bf16*)(F.ws + WS_SS) + (size_t)chain * NTILE64 * 4096 + e0; const float* SDEC = (const float*)(F.ws + WS_SDEC) + (size_t)b * NTILE64 * 16 + h * 2 + d;
    float S0 = 0.f, S1 = 0.f, S2 = 0.f, S3 = 0.f;
#pragma unroll 4
    for (int it = 0; it < NTILE64; ++it) {
        const int c = d == 0 ? it : (it < 4 ? 3 - it : 131 - (it - 4));
        u32x2* p = (u32x2*)(SS + (size_t)c * 4096); const u32x2 st = *p; const float dec = SDEC[c * 16];
        u32x2 o; o.x = pk2(S0, S1); o.y = pk2(S2, S3); *p = o;
        S0 = S0 * dec + __uint_as_float(st.x << 16); S1 = S1 * dec + __uint_as_float(st.x & 0xffff0000u); S2 = S2 * dec + __uint_as_float(st.y << 16); S3 = S3 * dec + __uint_as_float(st.y & 0xffff0000u);
    }
}
__device__ __forceinline__ void phase_finish_ssd(const Frame& F0) {
    PH_ENTER(F0);
    const AS4 Args* KA = kargs();
    const int tid = F.tid, lane = F.lane, wave = F.wave;
    const bf16* XBCA = (const bf16*)((const unsigned char*)F.out + OUT_XBCA); const float* UM = (const float*)(F.ws + WS_UMISC); const bf16* UZ = (const bf16*)(F.ws + WS_UZ);
    const bf16* SS = (const bf16*)(F.ws + WS_SS); bf16* MIX = (bf16*)((unsigned char*)F.out + OUT_MIX);
    const float* dtb = LP(24, 16); const float* alog = LP(25, 16); const float* dsk = LP(26, 8); const float* sng = LP(27, 512);
    LAS bf16* CB = (LAS bf16*)F.lds;
    LAS bf16* BI = (LAS bf16*)(F.lds + 18432);
    LAS bf16* XT = (LAS bf16*)(F.lds + 18432);
    LAS bf16* MI = (LAS bf16*)(F.lds + 27648);
    LAS bf16* SFB = (LAS bf16*)(F.lds + 36864);
    LAS float* ACS = (LAS float*)(F.lds + 55296);
    LAS float* RSQ = (LAS float*)(F.lds + 63488);
    LAS bf16* GB = (LAS bf16*)(F.lds + 64000);
    LAS bf16* ZT = (LAS bf16*)(F.lds + 129536);
    const int lt = wave & 3, cth = wave >> 2, lr = (lane >> 4) * 4, lc = lane & 15;
    const bool skipctx = F.l == 1;
    for (int j_ = F.bid; j_ < n_units(skipctx); j_ += F.G) {
        const int u = unit_of(skipctx, j_);
        const int b = u / NTILE64, c = u % NTILE64; const size_t row0 = (size_t)b * TB + (size_t)c * 64;
        u32x4 pxt, psf, psb, pzt;
        { const int s_ = tid & 63, pg = tid >> 6, r = tid >> 3, ch = tid & 7;
            pxt = *(const u32x4*)(XBCA + (row0 + r) * 768 + ch * 8);
            psf = *(const u32x4*)(SS + ((((size_t)b * 8) * 2 + 0) * NTILE64 + c) * 4096 + r * 64 + ch * 8); psb = *(const u32x4*)(SS + ((((size_t)b * 8) * 2 + 1) * NTILE64 + c) * 4096 + r * 64 + ch * 8);
            pzt = *(const u32x4*)(UZ + (row0 + r) * 512 + ch * 8); }
        LDS_BARRIER();
#pragma unroll
        for (int i = 0; i < 4; ++i) { const int id = tid + 512 * i, r = id >> 5, ch = id & 31;
            const int which = ch >> 3;
            LAS bf16* dst = (which < 2 ? BI + (which * 64 + r) * LD64 : CB + ((which - 2) * 64 + r) * LD64) + (ch & 7) * 8;
            *(LAS u32x4*)dst = *(const u32x4*)(XBCA + (row0 + r) * 768 + 512 + ch * 8); }
        { const int h = wave;
#pragma unroll
            for (int d = 0; d < 2; ++d) { const float dtp = softplusf_(UM[(row0 + lane) * 32 + h] + dtb[d * 8 + h]);
                const float cs = scan_incl(-__expf(alog[d * 8 + h]) * dtp, lane, d == 1);
                ACS[(d * 8 + h) * 64 + lane] = cs; ACS[((2 + d) * 8 + h) * 64 + lane] = dtp; } }
        LDS_BARRIER();
        f32x4 G00 = {0.f, 0.f, 0.f, 0.f}, G01 = G00, G10 = G00, G11 = G00;
#pragma unroll
        for (int ks = 0; ks < 2; ++ks) {
            G00 = mma16(G00, CB + (lt * 16) * LD64 + ks * 32, LD64, BI + ((2 * cth) * 16) * LD64 + ks * 32, LD64, lane);
            G01 = mma16(G01, CB + (lt * 16) * LD64 + ks * 32, LD64, BI + ((2 * cth + 1) * 16) * LD64 + ks * 32, LD64, lane);
            G10 = mma16(G10, CB + (64 + lt * 16) * LD64 + ks * 32, LD64, BI + (64 + (2 * cth) * 16) * LD64 + ks * 32, LD64, lane);
            G11 = mma16(G11, CB + (64 + lt * 16) * LD64 + ks * 32, LD64, BI + (64 + (2 * cth + 1) * 16) * LD64 + ks * 32, LD64, lane); }
        LDS_BARRIER();
        f32x4 rsq = {0.f, 0.f, 0.f, 0.f};
#pragma unroll 1
        for (int h = 0; h < 8; ++h) {
            const int g = h >> 2;
            { const int r = tid >> 3, ch = tid & 7;
                *(LAS u32x4*)(XT + r * LD64 + ch * 8) = pxt;
                *(LAS u32x4*)(SFB + r * LD64 + ch * 8) = psf; *(LAS u32x4*)(SFB + (64 + r) * LD64 + ch * 8) = psb; *(LAS u32x4*)(ZT + r * LD64 + ch * 8) = pzt;
                const int hn = h < 7 ? h + 1 : 7;
                pxt = *(const u32x4*)(XBCA + (row0 + r) * 768 + hn * 64 + ch * 8);
                psf = *(const u32x4*)(SS + ((((size_t)b * 8 + hn) * 2 + 0) * NTILE64 + c) * 4096 + r * 64 + ch * 8); psb = *(const u32x4*)(SS + ((((size_t)b * 8 + hn) * 2 + 1) * NTILE64 + c) * 4096 + r * 64 + ch * 8);
                pzt = *(const u32x4*)(UZ + (row0 + r) * 512 + hn * 64 + ch * 8); }
            const LAS float* af = ACS + h * 64; const LAS float* ab = ACS + (8 + h) * 64; const LAS float* pf = ACS + (16 + h) * 64; const LAS float* pb = ACS + (24 + h) * 64;
#pragma unroll
            for (int j = 0; j < 2; ++j) { const int s = (2 * cth + j) * 16 + lc; const float afs = af[s], abs_ = ab[s], pfs = pf[s], pbs = pb[s];
                const f32x4 gt = g ? (j ? G11 : G10) : (j ? G01 : G00);
#pragma unroll
                for (int i = 0; i < 4; ++i) { const int l = lt * 16 + lr + i;
                    const float wf = s <= l ? __expf(af[l] - afs) * pfs : 0.f, wb = s >= l ? __expf(ab[l] - abs_) * pbs : 0.f;
                    MI[l * LD64 + s] = (bf16)f2bf(gt[i] * (wf + wb)); } }
            LDS_BARRIER();
#pragma unroll
            for (int j = 0; j < 2; ++j) { const int pt = 2 * cth + j; f32x4 acc = {0.f, 0.f, 0.f, 0.f}, tf = {0.f, 0.f, 0.f, 0.f}, tb = {0.f, 0.f, 0.f, 0.f};
#pragma unroll
                for (int ks = 0; ks < 2; ++ks) { acc = __builtin_amdgcn_mfma_f32_16x16x32_bf16(frag_row(MI + lt * 16 * LD64 + ks * 32, LD64, lane), frag_tr(XT, LD64, ks * 32, pt * 16, lane), acc, 0, 0, 0);
                    tf = mma16(tf, CB + (g * 64 + lt * 16) * LD64 + ks * 32, LD64, SFB + pt * 16 * LD64 + ks * 32, LD64, lane);
                    tb = mma16(tb, CB + (g * 64 + lt * 16) * LD64 + ks * 32, LD64, SFB + (64 + pt * 16) * LD64 + ks * 32, LD64, lane); }
                const int p = pt * 16 + lc; const float ds = dsk[h];
#pragma unroll
                for (int i = 0; i < 4; ++i) { const int l = lt * 16 + lr + i;
                    const float y = acc[i] + __expf(af[l]) * tf[i] + __expf(ab[l]) * tb[i];
                    const float xs = bf2f(XT[l * LD64 + p]), z = bf2f(ZT[l * LD64 + p]);
                    const float gv = (y + ds * xs) * siluf(z); GB[l * 512 + h * 64 + p] = (bf16)f2bf(gv); rsq[i] += gv * gv; } }
            LDS_BARRIER();
        }
#pragma unroll
        for (int i = 0; i < 4; ++i) { const float t = sum16(rsq[i]); if (lc == 0) RSQ[cth * 64 + lt * 16 + lr + i] = t; }
        LDS_BARRIER();
#pragma unroll
        for (int i = 0; i < 8; ++i) { const int id = tid + 512 * i, r = id >> 6, ch = id & 63;
            const float scl = rsqrtf((RSQ[r] + RSQ[64 + r]) * (1.f / 512.f) + 1e-6f);
            float v[8]; unpack8(*(const LAS u32x4*)(GB + r * 512 + ch * 8), v);
            const f32x4 n0 = *(const f32x4*)(sng + ch * 8), n1 = *(const f32x4*)(sng + ch * 8 + 4);
#pragma unroll
            for (int k = 0; k < 4; ++k) { v[k] *= scl * n0[k]; v[4 + k] *= scl * n1[k]; }
            *(u32x4*)(MIX + (row0 + r) * D + 256 + ch * 8) = pack8(v); }
    }
}


__device__ __forceinline__ bf16* rw_out(unsigned char* ws, int b, int h, int d, int c, int which) {
    h16* RECS = (h16*)(ws + WS_RECS); h16* RECD = (h16*)(ws + WS_RECD); const size_t p0 = (size_t)c * 64;
    if (d == 0) return (bf16*)(RECS + (((size_t)b * 4 + h) * TB + p0) * 256) + which * 4096;
    return (bf16*)(RECD + ((((size_t)b * 4 + h) * 2 + (which >> 1)) * TB + p0) * 128) + (which & 1) * 4096;
}
__device__ __forceinline__ void phase_rwkv_local(const Frame& F0) {
    PH_ENTER(F0);
    const AS4 Args* KA = kargs();
    const int tid0 = F.tid, wave = F.wave;
#define RL_STEP const int tid = launder_i(tid0); const int lane = tid & 63; const int lr = (lane >> 4) * 4, lc = lane & 15;
    const h16* RECS = (const h16*)(F.ws + WS_RECS); const h16* RECD = (const h16*)(F.ws + WS_RECD);
    float* RPL = (float*)(F.ws + WS_RPL);
    const float* k_a = LP(18, 256);
    constexpr int LDS_S = 264, LDS_D = 136, LDF = 68;
    LAS h16* STS = (LAS h16*)F.lds;
    LAS h16* STD = (LAS h16*)(F.lds + 33792);
    LAS float* AABF = (LAS float*)(F.lds + 33792);
    LAS bf16* ULT = (LAS bf16*)(F.lds + 33792);
    LAS float* TF = (LAS float*)(F.lds + 51200);
    LAS bf16* AVT = (LAS bf16*)(F.lds + 51200); LAS bf16* W0T = (LAS bf16*)(F.lds + 60416);
    LAS bf16* NAT = (LAS bf16*)(F.lds + 69632);
    LAS bf16* TRN = (LAS bf16*)(F.lds + 106496);
    LAS bf16* R0I = (LAS bf16*)(F.lds + 143360);
    LAS float* M1 = (LAS float*)(F.lds + 152576);
    LAS float* GSUM = (LAS float*)(F.lds + 157184);
    h16x8 ps[4], pd[2];
#define RL_LOAD_S(uu) do { const int h_ = (uu) & 3, bc_ = (uu) >> 2, b_ = bc_ / NTILE64, c_ = bc_ % NTILE64; const h16* src = RECS + (((size_t)b_ * 4 + h_) * TB + (size_t)c_ * 64) * 256; \
        _Pragma("unroll") for (int i = 0; i < 4; ++i) { const int id = launder_i(tid0) + 512 * i, r = id >> 5, ch = id & 31; ps[i] = *(const h16x8*)(src + (size_t)r * 256 + ch * 8); } } while (0)
#define RL_LOAD_D(uu, dd) do { const int h_ = (uu) & 3, bc_ = (uu) >> 2, b_ = bc_ / NTILE64, c_ = bc_ % NTILE64; const h16* src = RECD + ((((size_t)b_ * 4 + h_) * 2 + (dd)) * TB + (size_t)c_ * 64) * 128; \
        _Pragma("unroll") for (int i = 0; i < 2; ++i) { const int id = launder_i(tid0) + 512 * i, r = id >> 4, ch = id & 15; pd[i] = *(const h16x8*)(src + (size_t)r * 128 + ch * 8); } } while (0)
    if (F.bid < NUNIT64 * 4) { RL_LOAD_S(F.bid); RL_LOAD_D(F.bid, 0); }
    for (int u = F.bid; u < NUNIT64 * 4; u += F.G) {
        const int h = u & 3, bc = u >> 2, b = bc / NTILE64, c = bc % NTILE64;
        LDS_BARRIER();
        { RL_STEP
#pragma unroll
            for (int i = 0; i < 4; ++i) { const int id = tid + 512 * i, r = id >> 5, ch = id & 31; *(LAS h16x8*)(STS + r * LDS_S + ch * 8) = ps[i]; } }
#pragma unroll 1
        for (int d = 0; d < 2; ++d) {
            LDS_BARRIER();
            { RL_STEP
#pragma unroll
                for (int i = 0; i < 2; ++i) { const int id = tid + 512 * i, r = id >> 4, ch = id & 15; *(LAS h16x8*)(STD + r * LDS_D + ch * 8) = pd[i]; } }
            if (d == 0) RL_LOAD_D(u, 1); else if (u + F.G < NUNIT64 * 4) { RL_LOAD_S(u + F.G); RL_LOAD_D(u + F.G, 0); }
            LDS_BARRIER();
            SUBREP(8) { RL_STEP const int kp = tid & 31, tg = tid >> 5, k = 2 * kp;
                f32x2 wv[4], li[4]; f32x2 run = {1.f, 1.f};
#pragma unroll
                for (int i = 0; i < 4; ++i) { const int t = tg * 4 + i, srow = d ? 63 - t : t; const unsigned raw = *(const LAS unsigned*)(STD + srow * LDS_D + k);
                    const h16 o0 = __builtin_bit_cast(h16, (unsigned short)(raw & 0xffff)), o1 = __builtin_bit_cast(h16, (unsigned short)(raw >> 16));
                    wv[i] = (f32x2){1.f - (float)o0, 1.f - (float)o1}; run = run * wv[i]; li[i] = run; }
                *(LAS f32x2*)(GSUM + tg * 64 + k) = run;
                for (int i = tid; i < 64 * LDF; i += 512) TF[i] = 0.f;
                LDS_BARRIER();
                f32x2 off = {1.f, 1.f}, pref = {1.f, 1.f}, pend = {1.f, 1.f};
#pragma unroll
                for (int g = 0; g < 16; ++g) { const f32x2 gs = *(const LAS f32x2*)(GSUM + g * 64 + k); if (g < tg) off = off * gs; if (g < 8) pref = pref * gs; pend = pend * gs; }
                const f32x2 kac = *(const f32x2*)(k_a + h * 64 + k);
                const f32x2 ipref = {1.f / pref.x, 1.f / pref.y};
                f32x2 pexcl = off;
                unsigned vt[4], a0t[4], bht[4], kht[4];
#pragma unroll
                for (int i = 0; i < 4; ++i) { const int t = tg * 4 + i, srow = d ? 63 - t : t;
                    const f32x2 pin = off * li[i];
                    const unsigned rr = *(const LAS unsigned*)(STS + srow * LDS_S + k), vr = *(const LAS unsigned*)(STS + srow * LDS_S + 64 + k), kkr = *(const LAS unsigned*)(STS + srow * LDS_S + 128 + k), kxr = *(const LAS unsigned*)(STS + srow * LDS_S + 192 + k);
                    const unsigned ar_ = *(const LAS unsigned*)(STD + srow * LDS_D + 64 + k);
#define H2F(x, hi) ((float)__builtin_bit_cast(h16, (unsigned short)((hi) ? ((x) >> 16) : ((x) & 0xffff))))
                    const f32x2 r = {H2F(rr, 0), H2F(rr, 1)}, vv = {H2F(vr, 0), H2F(vr, 1)}, kk = {H2F(kkr, 0), H2F(kkr, 1)}, kx = {H2F(kxr, 0), H2F(kxr, 1)}, av = {H2F(ar_, 0), H2F(ar_, 1)};
#undef H2F
                    const f32x2 kmod = kx * ((av - 1.f) * kac + 1.f), bb = kk * av;
                    const f32x2 ipin = {1.f / pin.x, 1.f / pin.y};
                    const f32x2 e1 = pexcl * ipref, e2 = pin * ipref, e3 = pref * ipin, eL = pend * ipin;
                    const f32x2 at = -kk * e1, rt = r * e2, bt = bb * e3, kt = kmod * e3, r0 = r * pin, a0 = -kk * pexcl, bh = bb * eL, kh = kmod * eL;
                    *(LAS unsigned*)(NAT + (0 * 64 + t) * LD64 + k) = pk2(at.x, at.y); *(LAS unsigned*)(NAT + (1 * 64 + t) * LD64 + k) = pk2(rt.x, rt.y);
                    *(LAS unsigned*)(NAT + (2 * 64 + t) * LD64 + k) = pk2(bt.x, bt.y); *(LAS unsigned*)(NAT + (3 * 64 + t) * LD64 + k) = pk2(kt.x, kt.y);
                    *(LAS unsigned*)(R0I + t * LD64 + k) = pk2(r0.x, r0.y);
                    vt[i] = pk2(vv.x, vv.y); a0t[i] = pk2(a0.x, a0.y); bht[i] = pk2(bh.x, bh.y); kht[i] = pk2(kh.x, kh.y);
                    pexcl = pin; }
#define TR_WR(SLOT, ARR) do { u32x2 lo, hi; lo.x = (ARR[0] & 0xffffu) | (ARR[1] << 16); lo.y = (ARR[2] & 0xffffu) | (ARR[3] << 16); hi.x = (ARR[0] >> 16) | (ARR[1] & 0xffff0000u); hi.y = (ARR[2] >> 16) | (ARR[3] & 0xffff0000u); \
                    *(LAS u32x2*)(TRN + ((SLOT) * 64 + k) * LD64 + tg * 4) = lo; *(LAS u32x2*)(TRN + ((SLOT) * 64 + k + 1) * LD64 + tg * 4) = hi; } while (0)
                TR_WR(0, vt); TR_WR(1, a0t); TR_WR(2, bht); TR_WR(3, kht);
#undef TR_WR
                if (tg == 15) *(f32x2*)(RPL + (((((size_t)b * 4 + h) * 2 + d) * NTILE64) + c) * 64 + k) = pend; }
            LDS_BARRIER();
            { RL_STEP const int pr = wave >> 1, rh = wave & 1; f32x4 acc[2][4];
#pragma unroll
                for (int mi = 0; mi < 2; ++mi)
#pragma unroll
                    for (int nt = 0; nt < 4; ++nt) acc[mi][nt] = (f32x4){0.f, 0.f, 0.f, 0.f};
                mm_block<2, 4, 2>(acc, NAT + ((pr >> 1) * 64 + (2 * rh) * 16) * LD64, LD64, NAT + ((2 + (pr & 1)) * 64) * LD64, LD64, lane);
                LDS_BARRIER();
#pragma unroll
                for (int mi = 0; mi < 2; ++mi)
#pragma unroll
                    for (int nt = 0; nt < 4; ++nt)
#pragma unroll
                        for (int i = 0; i < 4; ++i) { const int t = (2 * rh + mi) * 16 + lr + i, ii = nt * 16 + lc;
                            const float v = (pr < 2 ? ii < t : ii <= t) ? acc[mi][nt][i] : 0.f;
                            if (pr == 0) AABF[t * LDF + ii] = v; else NAT[((pr - 1) * 64 + t) * LD64 + ii] = (bf16)f2bf(v); } }
            LDS_BARRIER();
            SUBREP(9) if (wave == 0) { RL_STEP const int blk = lane >> 4, j = lane & 15; float Tr[16]; const LAS float* ab = AABF + (blk * 16) * LDF + blk * 16;
#pragma unroll
                for (int t = 0; t < 16; ++t) { float a0 = (j == t) ? 1.f : 0.f, a1 = 0.f;
#pragma unroll
                    for (int i4 = 0; i4 < t; i4 += 4) { const f32x4 av = *(const LAS f32x4*)(ab + t * LDF + i4);
                        a0 += av.x * Tr[i4]; if (i4 + 1 < t) a1 += av.y * Tr[i4 + 1]; if (i4 + 2 < t) a0 += av.z * Tr[i4 + 2]; if (i4 + 3 < t) a1 += av.w * Tr[i4 + 3]; }
                    Tr[t] = a0 + a1; TF[(blk * 16 + t) * LDF + blk * 16 + j] = Tr[t]; } }
            LDS_BARRIER();
            SUBREP(10) {
#define RL_LEVEL(M, ACTIVE, PP, TT, J0) do { \
                { RL_STEP if (ACTIVE) { const int pp = (PP), t = (TT), j0 = (J0), rb = pp * 2 * (M) + (M), cb = pp * 2 * (M); f32x2 mm = {0.f, 0.f}; \
                    _Pragma("unroll") for (int i = 0; i < (M); i += 4) { const f32x4 av = *(const LAS f32x4*)(AABF + (rb + t) * LDF + cb + i); \
                        mm += av.x * *(const LAS f32x2*)(TF + (cb + i) * LDF + cb + j0) + av.y * *(const LAS f32x2*)(TF + (cb + i + 1) * LDF + cb + j0) + av.z * *(const LAS f32x2*)(TF + (cb + i + 2) * LDF + cb + j0) + av.w * *(const LAS f32x2*)(TF + (cb + i + 3) * LDF + cb + j0); } \
                    *(LAS f32x2*)(M1 + pp * 576 + t * 36 + j0) = mm; } } \
                LDS_BARRIER(); \
                { RL_STEP if (ACTIVE) { const int pp = (PP), t = (TT), j0 = (J0), rb = pp * 2 * (M) + (M), cb = pp * 2 * (M); f32x2 xx = {0.f, 0.f}; \
                    _Pragma("unroll") for (int q = 0; q < (M); q += 4) { const f32x4 tv = *(const LAS f32x4*)(TF + (rb + t) * LDF + rb + q); \
                        xx += tv.x * *(const LAS f32x2*)(M1 + pp * 576 + q * 36 + j0) + tv.y * *(const LAS f32x2*)(M1 + pp * 576 + (q + 1) * 36 + j0) + tv.z * *(const LAS f32x2*)(M1 + pp * 576 + (q + 2) * 36 + j0) + tv.w * *(const LAS f32x2*)(M1 + pp * 576 + (q + 3) * 36 + j0); } \
                    *(LAS f32x2*)(TF + (rb + t) * LDF + cb + j0) = xx; } } \
                LDS_BARRIER(); } while (0)
                RL_LEVEL(16, tid < 256, tid >> 7, (tid >> 3) & 15, (tid & 7) * 2);
                RL_LEVEL(32, true, 0, tid >> 4, (tid & 15) * 2);
#undef RL_LEVEL
            }
            { RL_STEP const int t = tid >> 3, i0 = (tid & 7) * 8; float v[8];
#pragma unroll
                for (int i = 0; i < 8; ++i) v[i] = TF[t * LDF + i0 + i];
                *(LAS u32x4*)(NAT + (3 * 64 + t) * LD64 + i0) = pack8(v); }
            LDS_BARRIER();
            SUBREP(11) { RL_STEP const int pr = wave >> 2, mt = wave & 3; f32x4 acc[4];
#pragma unroll
                for (int nt = 0; nt < 4; ++nt) acc[nt] = (f32x4){0.f, 0.f, 0.f, 0.f};
                { f32x4 (&a2)[1][4] = *reinterpret_cast<f32x4 (*)[1][4]>(&acc); mm_block<1, 4, 2>(a2, TRN + (pr * 64 + mt * 16) * LD64, LD64, NAT + ((pr ? 3 : 0) * 64) * LD64, LD64, lane); }
                LAS bf16* dst = pr ? W0T : AVT;
#pragma unroll
                for (int nt = 0; nt < 4; ++nt)
#pragma unroll
                    for (int i = 0; i < 4; ++i) dst[(mt * 16 + lr + i) * LD64 + nt * 16 + lc] = (bf16)f2bf(acc[nt][i]); }
            LDS_BARRIER();
            SUBREP(11) { RL_STEP const int mt = wave & 3, nh = wave >> 2;
#pragma unroll
                for (int nn = 0; nn < 2; ++nn) { const int nt = 2 * nh + nn; f32x4 a4 = {0.f, 0.f, 0.f, 0.f};
#pragma unroll
                    for (int ks = 0; ks < 2; ++ks) a4 = mma16(a4, AVT + (mt * 16) * LD64 + ks * 32, LD64, NAT + (3 * 64 + nt * 16) * LD64 + ks * 32, LD64, lane);
#pragma unroll
                    for (int i = 0; i < 4; ++i) ULT[(mt * 16 + lr + i) * LD64 + nt * 16 + lc] = (bf16)f2bf(a4[i]); } }
            LDS_BARRIER();
            { RL_STEP const int o = wave >> 1, rh = wave & 1;
                const LAS bf16* A1 = o == 0 ? TRN + 2 * 64 * LD64 : (o == 1 ? ULT : NAT + 1 * 64 * LD64);
                const LAS bf16* B1 = o == 0 ? W0T : (o == 1 ? TRN + 2 * 64 * LD64 : (o == 2 ? W0T : ULT));
                const LAS bf16* A2 = o == 1 ? TRN : NAT + 2 * 64 * LD64;
                const LAS bf16* B2 = o == 1 ? TRN + 3 * 64 * LD64 : TRN;
                f32x4 res[2][4];
#pragma unroll
                for (int mi = 0; mi < 2; ++mi)
#pragma unroll
                    for (int nt = 0; nt < 4; ++nt) res[mi][nt] = (f32x4){0.f, 0.f, 0.f, 0.f};
                mm_block<2, 4, 2>(res, A1 + (2 * rh * 16) * LD64, LD64, B1, LD64, lane);
                if (o == 1 || o == 3) mm_block<2, 4, 2>(res, A2 + (2 * rh * 16) * LD64, LD64, B2, LD64, lane);
                if (o == 2) {
#pragma unroll
                    for (int mi = 0; mi < 2; ++mi)
#pragma unroll
                        for (int nt = 0; nt < 4; ++nt)
#pragma unroll
                            for (int i = 0; i < 4; ++i) { const int rr = (2 * rh + mi) * 16 + lr + i, cc = nt * 16 + lc; res[mi][nt][i] += bf2f(R0I[rr * LD64 + cc]); } }
                LDS_BARRIER();
#pragma unroll
                for (int mi = 0; mi < 2; ++mi)
#pragma unroll
                    for (int nt = 0; nt < 4; ++nt)
#pragma unroll
                        for (int i = 0; i < 4; ++i) NAT[o * 4096 + ((2 * rh + mi) * 16 + lr + i) * 64 + nt * 16 + lc] = (bf16)f2bf(res[mi][nt][i]);
                LDS_BARRIER();
#pragma unroll
                for (int i = 0; i < 4; ++i) { const int id = tid + 512 * i, oo = id >> 9, ch = id & 511; *(u32x4*)(rw_out(F.ws, b, h, d, c, oo) + ch * 8) = *(const LAS u32x4*)(NAT + oo * 4096 + ch * 8); } }
        }
    }
#undef RL_STEP
#undef RL_LOAD_S
#undef RL_LOAD_D
}
template <bool DRY> __device__ __forceinline__ void phase_rwkv_combine(const Frame& F0) {
    PH_ENTER(F0);
    const int lane = F.lane;
    if (F.wave != 0 || F.bid >= 256) return;
    const int chain = F.bid >> 2, q = F.bid & 3, d = chain & 1, bh = chain >> 1, b = bh >> 2, h = bh & 3;
    constexpr int LA = 5, NSLOT = LA + 1, SLOT_B = 8192 + 2048 + 256;
    static_assert(NTILE64 % NSLOT == 0, "ring period");
    LAS unsigned char* RING = F.lds;
    LAS bf16* SA = (LAS bf16*)(F.lds + NSLOT * SLOT_B);
    const float* RPL = (const float*)(F.ws + WS_RPL) + (size_t)chain * NTILE64 * 64;
    const int lr = (lane >> 4) * 4, lc = lane & 15, ar = lane & 15, akq = (lane >> 4) * 8;
    const unsigned vphi = (unsigned)(ar * 64 + akq) * 2u;
    f32x4 S[4];
#pragma unroll
    for (int nt = 0; nt < 4; ++nt) S[nt] = (f32x4){0.f, 0.f, 0.f, 0.f};
#define RWC_CIDX(k) (d == 0 ? (k) : ((k) < 4 ? 3 - (k) : 131 - ((k) - 4)))
#define RWC_ISSUE(k, SLOT) do { const int c_ = RWC_CIDX(k); LAS unsigned char* sl_ = RING + (SLOT) * SLOT_B; \
        const GAS char* phit = (const GAS char*)rw_out(F.ws, b, h, d, c_, 0) + vphi; const GAS char* psip = (const GAS char*)(rw_out(F.ws, b, h, d, c_, 1) + (size_t)q * 16 * 64) + lane * 16; \
        _Pragma("unroll") for (int nt = 0; nt < 4; ++nt) _Pragma("unroll") for (int ks = 0; ks < 2; ++ks) \
            __builtin_amdgcn_global_load_lds((const GAS unsigned*)(phit + nt * 2048 + ks * 64), (LAS unsigned*)(sl_ + (nt * 2 + ks) * 1024), 16, 0, 0); \
        _Pragma("unroll") for (int i = 0; i < 2; ++i) __builtin_amdgcn_global_load_lds((const GAS unsigned*)(psip + i * 1024), (LAS unsigned*)(sl_ + 8192 + i * 1024), 16, 0, 0); \
        __builtin_amdgcn_global_load_lds((const GAS unsigned*)(RPL + (size_t)c_ * 64 + lane), (LAS unsigned*)(sl_ + 10240), 4, 0, 0); } while (0)
    RWC_ISSUE(0, 0); RWC_ISSUE(1, 1); RWC_ISSUE(2, 2); RWC_ISSUE(3, 3); RWC_ISSUE(4, 4);
#pragma unroll 1
    for (int k6 = 0; k6 < NTILE64; k6 += NSLOT) {
#pragma unroll
        for (int j = 0; j < NSLOT; ++j) {
            const int k = k6 + j, c = RWC_CIDX(k);
            const LAS unsigned char* sl = RING + j * SLOT_B;
#pragma unroll
            for (int nt = 0; nt < 4; ++nt)
#pragma unroll
                for (int i = 0; i < 4; ++i) SA[(lr + i) * LD64 + nt * 16 + lc] = (bf16)f2bf(S[nt][i]);
            if (k6 + NSLOT >= NTILE64) asm volatile("s_waitcnt vmcnt(0)" ::: "memory");
            else if (DRY || (k6 == 0 && j < 4)) asm volatile("s_waitcnt vmcnt(44)" ::: "memory");
            else asm volatile("s_waitcnt vmcnt(52)" ::: "memory");
            bf16x8 bfr[4][2]; f32x4 init[4];
#pragma unroll
            for (int nt = 0; nt < 4; ++nt) {
#pragma unroll
                for (int ks = 0; ks < 2; ++ks) bfr[nt][ks] = *(const LAS bf16x8*)(sl + (nt * 2 + ks) * 1024 + lane * 16);
                const float pl = *(const LAS float*)(sl + 10240 + (nt * 16 + lc) * 4);
#pragma unroll
                for (int i = 0; i < 4; ++i) init[nt][i] = S[nt][i] * pl + bf2f(*(const LAS unsigned short*)(sl + 8192 + ((lr + i) * 64 + nt * 16 + lc) * 2)); }
            LDS_WAIT();
            const bf16x8 a0 = *(const LAS bf16x8*)(SA + ar * LD64 + akq), a1 = *(const LAS bf16x8*)(SA + ar * LD64 + 32 + akq);
            if (!DRY) { bf16* s0p = rw_out(F.ws, b, h, d, c, 1) + (size_t)q * 16 * 64;
#pragma unroll
                for (int i = 0; i < 2; ++i) { const int id = lane + 64 * i, r = id >> 3, ch = id & 7; *(u32x4*)(s0p + r * 64 + ch * 8) = *(const LAS u32x4*)(SA + r * LD64 + ch * 8); } }
            LDS_WAIT();
            if (k + LA < NTILE64) RWC_ISSUE(k + LA, (j + LA) % NSLOT);
#pragma unroll
            for (int nt = 0; nt < 4; ++nt) { f32x4 a4 = init[nt];
                a4 = __builtin_amdgcn_mfma_f32_16x16x32_bf16(a0, bfr[nt][0], a4, 0, 0, 0); a4 = __builtin_amdgcn_mfma_f32_16x16x32_bf16(a1, bfr[nt][1], a4, 0, 0, 0); S[nt] = a4; }
        }
    }
    asm volatile("s_waitcnt vmcnt(0)" ::: "memory");
#undef RWC_ISSUE
#undef RWC_CIDX
}
template <bool DRY> __device__ __forceinline__ void phase_combine_side(const Frame& F0) {
    PH_ENTER(F0);
    if (F.wave < 4 || F.G != 256) return;
    const int lgid = F.bid * 256 + (F.tid - 256);
    const int sch = lgid >> 9, sd = sch & 1, sbh = sch >> 1; bf16* SSp = (bf16*)(F.ws + WS_SS) + (size_t)sch * NTILE64 * 4096 + (lgid & 511) * 8;
    const float* SDp = (const float*)(F.ws + WS_SDEC) + (size_t)(sbh >> 3) * NTILE64 * 16 + (sbh & 7) * 2 + sd;
    const int gch = lgid >> 10, gd = gch & 1, gbh = gch >> 1, ge0 = (lgid & 1023) * 2; bf16* GSp = (bf16*)(F.ws + WS_GS) + (size_t)gch * NTILE64 * 2048 + ge0;
    const float* GDp = (const float*)(F.ws + WS_GDEC) + (size_t)(gbh >> 2) * NTILE64 * 256 + gd * 128 + (gbh & 3) * 32 + (ge0 & 31);
    float cS[8] = {0.f, 0.f, 0.f, 0.f, 0.f, 0.f, 0.f, 0.f}, cG0 = 0.f, cG1 = 0.f;
    u32x4 pS[4]; float pSd[4]; unsigned pG[4]; f32x2 pGd[4];
#define CS_CIDX(k, dd) ((dd) == 0 ? (k) : ((k) < 4 ? 3 - (k) : 131 - ((k) - 4)))
#define CS_LOAD(SET, k) do { const int cs_ = CS_CIDX(k, sd), cg_ = CS_CIDX(k, gd); pS[SET] = *(const u32x4*)(SSp + (size_t)cs_ * 4096); pSd[SET] = SDp[cs_ * 16]; \
        pG[SET] = *(const unsigned*)(GSp + (size_t)cg_ * 2048); pGd[SET] = *(const f32x2*)(GDp + (size_t)cg_ * 256); } while (0)
    CS_LOAD(0, 0); CS_LOAD(1, 1); CS_LOAD(2, 2);
#pragma unroll 1
    for (int k4 = 0; k4 < NTILE64; k4 += 4) {
#pragma unroll
        for (int j = 0; j < 4; ++j) { const int k = k4 + j, cs = CS_CIDX(k, sd), cg = CS_CIDX(k, gd);
            float f[8]; unpack8(pS[j], f); const float dec = pSd[j]; const unsigned gt = pG[j]; const f32x2 gdec = pGd[j];
            asm volatile("" : "+v"(f[0]), "+v"(f[7]) : "v"(dec), "v"(gt), "v"(gdec.x), "v"(gdec.y) : "memory");
            if (k + 3 < NTILE64) CS_LOAD((j + 3) & 3, k + 3);
            u32x4 o; o.x = pk2(cS[0], cS[1]); o.y = pk2(cS[2], cS[3]); o.z = pk2(cS[4], cS[5]); o.w = pk2(cS[6], cS[7]); if (!DRY) *(u32x4*)(SSp + (size_t)cs * 4096) = o;
#pragma unroll
            for (int i = 0; i < 8; ++i) cS[i] = cS[i] * dec + f[i];
            if (!DRY) *(unsigned*)(GSp + (size_t)cg * 2048) = pk2(cG0, cG1);
            cG0 = cG0 * gdec.x + __uint_as_float(gt << 16); cG1 = cG1 * gdec.y + __uint_as_float(gt & 0xffff0000u); }
    }
#undef CS_LOAD
#undef CS_CIDX
}
__device__ __forceinline__ void phase_finish_rwkv(const Frame& F0) {
    PH_ENTER(F0);
    const AS4 Args* KA = kargs();
    const int lane = F.lane, wave = F.wave;
    const h16* BONUS = (const h16*)(F.ws + WS_BONUS); const h16* GATE = (const h16*)(F.ws + WS_GATE);
    bf16* MIX = (bf16*)((unsigned char*)F.out + OUT_MIX);
    const float* gng = LP(20, 256); const float* gnb = LP(21, 256);
    const int h = wave >> 1, rh = wave & 1, lr = (lane >> 4) * 4, lc = lane & 15, ar = lane & 15, akq = (lane >> 4) * 8;
    const bool skipctx = F.l == 1;
    for (int j_ = F.bid; j_ < n_units(skipctx); j_ += F.G) {
        const int u = unit_of(skipctx, j_);
        const int b = u / NTILE64, c = u % NTILE64; const size_t row0 = (size_t)b * TB + (size_t)c * 64;
        f32x4 acc[2][4];
#pragma unroll
        for (int mi = 0; mi < 2; ++mi)
#pragma unroll
            for (int nt = 0; nt < 4; ++nt) acc[mi][nt] = (f32x4){0.f, 0.f, 0.f, 0.f};
#pragma unroll
        for (int d = 0; d < 2; ++d) { const bf16* om = rw_out(F.ws, b, h, d, c, 2); const bf16* s0 = rw_out(F.ws, b, h, d, c, 1); const bf16* yl = rw_out(F.ws, b, h, d, c, 3);
#pragma unroll
            for (int mi = 0; mi < 2; ++mi) { const int srow = (2 * rh + mi) * 16 + ar, trow = d ? 63 - srow : srow;
                const bf16x8 a0 = *(const bf16x8*)(om + trow * 64 + akq), a1 = *(const bf16x8*)(om + trow * 64 + 32 + akq);
#pragma unroll
                for (int nt = 0; nt < 4; ++nt) { const bf16x8 b0 = *(const bf16x8*)(s0 + (nt * 16 + ar) * 64 + akq), b1 = *(const bf16x8*)(s0 + (nt * 16 + ar) * 64 + 32 + akq);
                    f32x4 a4 = acc[mi][nt];
                    a4 = __builtin_amdgcn_mfma_f32_16x16x32_bf16(a0, b0, a4, 0, 0, 0); a4 = __builtin_amdgcn_mfma_f32_16x16x32_bf16(a1, b1, a4, 0, 0, 0);
#pragma unroll
                    for (int i = 0; i < 4; ++i) { const int s = (2 * rh + mi) * 16 + lr + i, t = d ? 63 - s : s; a4[i] += bf2f(yl[t * 64 + nt * 16 + lc]); }
                    acc[mi][nt] = a4; } } }
#pragma unroll
        for (int mi = 0; mi < 2; ++mi)
#pragma unroll
            for (int i = 0; i < 4; ++i) { const int s = (2 * rh + mi) * 16 + lr + i; const size_t r = row0 + s;
                float y0 = acc[mi][0][i], y1 = acc[mi][1][i], y2 = acc[mi][2][i], y3 = acc[mi][3][i];
                const float mu = sum16((y0 + y1) + (y2 + y3)) * (1.f / 64.f);
                y0 -= mu; y1 -= mu; y2 -= mu; y3 -= mu;
                const float rs = rsqrtf(sum16((y0 * y0 + y1 * y1) + (y2 * y2 + y3 * y3)) * (1.f / 64.f) + 64e-5f);
                const float yy[4] = {y0, y1, y2, y3};
#pragma unroll
                for (int nt = 0; nt < 4; ++nt) { const int cc = h * 64 + nt * 16 + lc;
                    const float o = (yy[nt] * rs * gng[cc] + gnb[cc] + (float)BONUS[r * 256 + cc]) * (float)GATE[r * 256 + cc];
                    MIX[r * D + cc] = (bf16)f2bf(o); } }
    }
}
__device__ __forceinline__ void phase_router(const Frame& F0) {
    PH_ENTER(F0);
    const AS4 Args* KA = kargs();
    const int tid = F.tid, lane = F.lane, wave = F.wave;
    LAS float* RW = (LAS float*)F.lds;
    LAS int* lcnt = (LAS int*)(F.lds + 81920);
    const float* rgw = LP(31, D * 4); const float* rew = LP(33, D * 16); const float* rgb = LP(32, 4); const float* reb = LP(34, 16);
    for (int i = tid; i < 20 * D; i += 512) { const int e = i / D, k = i % D; RW[i] = e < 4 ? rgw[k * 4 + e] : rew[k * 16 + (e - 4)]; }
    if (tid < NCLS) lcnt[tid] = 0;
    LDS_BARRIER();
    const float* g = LP(7, D);
    const float* mod = (const float*)(F.ws + WS_MOD) + (size_t)F.l * 9 * 6144;
    bf16* TOK = (bf16*)(F.ws + WS_ACT); const bf16* XB = (const bf16*)(F.ws + WS_XB);
    int4* TI = (int4*)(F.ws + WS_TOKINFO);
    int* CNT = (int*)(F.ws + WS_CNT);
    const bool skipctx = F.l == 1;
    if (skipctx && F.bid < 32 && tid < NCLS) CNT[((F.bid >> 2) * NTILE64 + (F.bid & 3)) * NCLS + tid] = 0;
    for (int j_ = F.bid; j_ < n_units(skipctx); j_ += F.G) {
        const int u = unit_of(skipctx, j_);
        f32x4 A[4], B[4]; u32x2 nv[4];
        { const float* mrow = mod + (size_t)mod_index(u * 64) * 6144;
#pragma unroll
            for (int j = 0; j < 4; ++j) { const int c = 4 * lane + 256 * j; A[j] = *(const f32x4*)(g + c) * (*(const f32x4*)(mrow + 4 * D + c) + 1.f); B[j] = *(const f32x4*)(mrow + 3 * D + c); }
            const u32x2* xr = (const u32x2*)(XB + (size_t)(u * 64 + wave * 8) * D) + lane;
#pragma unroll
            for (int j = 0; j < 4; ++j) nv[j] = xr[64 * j]; }
        for (int rr = 0; rr < 8; ++rr) {
            const int row = u * 64 + wave * 8 + rr;
            f32x4 v[4]; float s = 0.f;
#pragma unroll
            for (int j = 0; j < 4; ++j) { v[j] = bf4(nv[j]); s += (v[j].x * v[j].x + v[j].y * v[j].y) + (v[j].z * v[j].z + v[j].w * v[j].w); }
            if (rr + 1 < 8) { const u32x2* xn = (const u32x2*)(XB + (size_t)(row + 1) * D) + lane;
#pragma unroll
                for (int j = 0; j < 4; ++j) nv[j] = xn[64 * j]; }
            const float rs = rsqrtf(wave_sum(s) * (1.f / D) + 1e-6f);
            u32x2* o8 = (u32x2*)(TOK + (size_t)row * D) + lane;
#pragma unroll
            for (int j = 0; j < 4; ++j) { v[j] = v[j] * rs * A[j] + B[j];
                u32x2 w; w.x = pk2(v[j].x, v[j].y); w.y = pk2(v[j].z, v[j].w); o8[64 * j] = w; }
            float lg[20];
#pragma unroll
            for (int e = 0; e < 20; ++e) { float a = 0.f;
#pragma unroll
                for (int j = 0; j < 4; ++j) { const f32x4 w = *(const LAS f32x4*)(RW + e * D + 4 * lane + 256 * j); a += (v[j].x * w.x + v[j].y * w.y) + (v[j].z * w.z + v[j].w * w.w); }
                lg[e] = wave_sum(a); }
            float gl0 = lg[0] + rgb[0], gl1 = lg[1] + rgb[1], gl2 = lg[2] + rgb[2], gl3 = lg[3] + rgb[3];
            int gs = 0; float gm = gl0;
            if (gl1 > gm) { gm = gl1; gs = 1; } if (gl2 > gm) { gm = gl2; gs = 2; } if (gl3 > gm) { gm = gl3; gs = 3; }
            const float pg = 1.f / (__expf(gl0 - gm) + __expf(gl1 - gm) + __expf(gl2 - gm) + __expf(gl3 - gm));
            float e0, e1, e2, e3;
            e0 = gs == 0 ? lg[4] : (gs == 1 ? lg[8] : (gs == 2 ? lg[12] : lg[16])); e1 = gs == 0 ? lg[5] : (gs == 1 ? lg[9] : (gs == 2 ? lg[13] : lg[17]));
            e2 = gs == 0 ? lg[6] : (gs == 1 ? lg[10] : (gs == 2 ? lg[14] : lg[18])); e3 = gs == 0 ? lg[7] : (gs == 1 ? lg[11] : (gs == 2 ? lg[15] : lg[19]));
            e0 += reb[gs * 4 + 0]; e1 += reb[gs * 4 + 1]; e2 += reb[gs * 4 + 2]; e3 += reb[gs * 4 + 3];
            int i1 = 0; float m1 = e0;
            if (e1 > m1) { m1 = e1; i1 = 1; } if (e2 > m1) { m1 = e2; i1 = 2; } if (e3 > m1) { m1 = e3; i1 = 3; }
            int i2 = -1; float m2 = -3.0e38f;
            if (i1 != 0 && e0 > m2) { m2 = e0; i2 = 0; } if (i1 != 1 && e1 > m2) { m2 = e1; i2 = 1; } if (i1 != 2 && e2 > m2) { m2 = e2; i2 = 2; } if (i1 != 3 && e3 > m2) { m2 = e3; i2 = 3; }
            const float p1 = 1.f, p2 = __expf(m2 - m1);
            const float w1 = pg * p1 / (p1 + p2), w2 = pg * p2 / (p1 + p2);
            const int lo = i1 < i2 ? i1 : i2, hi = i1 < i2 ? i2 : i1;
            const int pr = lo == 0 ? hi - 1 : (lo == 1 ? hi + 1 : 5);
            const int cls = gs * 6 + pr;
            const float wa = i1 < i2 ? w1 : w2, wb = i1 < i2 ? w2 : w1;
            if (lane == 0) { const int rank = atomicAdd((int*)(lcnt + cls), 1);
                TI[row] = make_int4(cls, __float_as_int(wa), __float_as_int(wb), rank); }
        }
        LDS_BARRIER();
        if (tid < NCLS) { CNT[u * NCLS + tid] = lcnt[tid]; lcnt[tid] = 0; }
        LDS_BARRIER();
    }
}

__device__ __forceinline__ void phase_scatter(const Frame& F0) {
    PH_ENTER(F0);
    const int tid = F.tid, lane = F.lane, wave = F.wave;
    LAS int* C = (LAS int*)F.lds;
    LAS int* tot = (LAS int*)(F.lds + 102400);
    LAS int* cs = (LAS int*)(F.lds + 102400 + 128);
    LAS int* base = (LAS int*)(F.lds + 102400 + 256);
    const int* CNT = (const int*)(F.ws + WS_CNT);
    int* MI = (int*)(F.ws + WS_CNT) + NUNIT64 * NCLS;
    for (int i = tid; i < NUNIT64 * NCLS; i += 512) C[i] = CNT[i];
    LDS_BARRIER();
    if (tid < NCLS * 16) { const int c = tid >> 4, s16 = tid & 15; int part = 0; for (int uu = s16; uu < NUNIT64; uu += 16) part += C[uu * NCLS + c];
        const float pf = sum16((float)part); if (s16 == 0) tot[c] = (int)pf; }
    LDS_BARRIER();
    if (tid == 0) { int s = 0; for (int c = 0; c < NCLS; ++c) { cs[c] = s; s += (tot[c] + 255) & ~255; } cs[NCLS] = s; }
    LDS_BARRIER();
    if (F.bid == 0 && tid <= NCLS) MI[tid] = cs[tid];
    const int4* TI = (const int4*)(F.ws + WS_TOKINFO);
    int* LIST = (int*)(F.ws + WS_LIST); f32x2* WSL = (f32x2*)(F.ws + WS_WSLOT);
    for (int c = F.bid; c < NCLS; c += F.G) {
        const int s0 = cs[c] + tot[c], s1 = cs[c + 1];
        for (int s = s0 + tid; s < s1; s += 512) { LIST[s] = -1; WSL[s] = (f32x2){0.f, 0.f}; }
    }
    const bool skipctx = F.l == 1;
    for (int j_ = F.bid; j_ < n_units(skipctx); j_ += F.G) {
        const int u = unit_of(skipctx, j_);
        LDS_BARRIER();
        if (tid < NCLS * 16) { const int c = tid >> 4, s = tid & 15; int part = 0; for (int uu = s; uu < u; uu += 16) part += C[uu * NCLS + c];
            float pf = sum16((float)part);
            if (s == 0) base[c] = cs[c] + (int)pf; }
        LDS_BARRIER();
        {
#pragma unroll
            for (int rr = 0; rr < 8; ++rr) { const int row = u * 64 + wave * 8 + rr;
                if (lane == 0) { const int4 ti = TI[row]; const int slot = base[ti.x] + ti.w; LIST[slot] = row; WSL[slot] = (f32x2){__int_as_float(ti.y), __int_as_float(ti.z)}; } } }
    }
}

__device__ __forceinline__ void phase_final(const Frame& F0) {
    PH_ENTER(F0);
    const AS4 Args* KA = kargs();
    const int gw = F.bid * 8 + F.wave, NGW = F.G * 8, lane = F.lane;
    const float* g = INP(38);
    constexpr int NR = NB * TL; const int R = (NR + NGW - 1) / NGW, r0 = gw * R, r1 = min(NR, r0 + R);
    const bf16* XB = (const bf16*)(F.ws + WS_XB);
    f32x4 G4[4]; u32x2 nv[4];
#pragma unroll
    for (int j = 0; j < 4; ++j) G4[j] = *(const f32x4*)(g + 4 * lane + 256 * j);
#define FN_ROW(r) (XB + ((size_t)((r) / TL) * TB + TC + (r) % TL) * D)
    if (r0 < r1) { const u32x2* xr = (const u32x2*)FN_ROW(r0) + lane;
#pragma unroll
        for (int j = 0; j < 4; ++j) nv[j] = xr[64 * j]; }
    for (int row = r0; row < r1; ++row) {
        f32x4 v[4];
#pragma unroll
        for (int j = 0; j < 4; ++j) v[j] = bf4(nv[j]);
        if (row + 1 < r1) { const u32x2* xn = (const u32x2*)FN_ROW(row + 1) + lane;
#pragma unroll
            for (int j = 0; j < 4; ++j) nv[j] = xn[64 * j]; }
        float s = 0.f;
#pragma unroll
        for (int j = 0; j < 4; ++j) s += (v[j].x * v[j].x + v[j].y * v[j].y) + (v[j].z * v[j].z + v[j].w * v[j].w);
        const float rs = rsqrtf(wave_sum(s) * (1.f / D) + 1e-6f);
        f32x4* xr = (f32x4*)(F.out + (size_t)row * D) + lane;
#pragma unroll
        for (int j = 0; j < 4; ++j) xr[64 * j] = v[j] * rs * G4[j];
    }
#undef FN_ROW
}

constexpr int PH_PER_LAYER = 12, PH_FINAL = 1 + 2 * PH_PER_LAYER, PH_END = PH_FINAL + 1;
template <int L> __device__ __forceinline__ void run_layer(Frame& F0, const XcdBarrier& bar, const int lo, const int hi) {
    constexpr int l = L;
#define IN(k) (lo <= (k) && (k) < hi)
#define SEAM(k) do { if (IN(k) && IN((k) + 1)) { XcdBarrier bb = bar; GAS unsigned* _b = (GAS unsigned*)bb.bar; asm volatile("" : "+s"(_b)); bb.bar = (unsigned*)_b; xcd_barrier(bb); } } while (0)
        F0.l = l;
        const int pb = 1 + PH_PER_LAYER * l;
        if (HAS(1) && IN(pb + 1)) { for (int rep = 0; rep < REP(1); ++rep) phase_norm1(F0); if (l == 1 && HAS(0)) phase_convert(F0); } SEAM(pb + 1);
        if (HAS(2) && IN(pb + 2)) {
            PH_ENTER(F0);
            SchedStatic S; S.nM = T / 256; S.nN = IN_PAD / 256; S.nwg = S.nM * S.nN; S.G = F.G; S.c = F.bid; S.ws = F.ws; S.wsA = F.ws; S.offA = WS_ACT; S.offB = WS_WIN; S.skipctx = 0;
            EpiU E{F.ws};
            for (int rep = 0; rep < REP(2); ++rep) pg8::gemm_phase<EpiU, SchedStatic, true, false, 1024>(F.lds, F.tid, S, E);
        } SEAM(pb + 2);
        if (HAS(3) && IN(pb + 3)) { phase_conv(F0); for (int rep = 0; rep < REP(3); ++rep) phase_prep(F0); } SEAM(pb + 3);
#define GBAR() do { if (hi - lo > 1) { XcdBarrier bb = bar; GAS unsigned* _b = (GAS unsigned*)bb.bar; asm volatile("" : "+s"(_b)); bb.bar = (unsigned*)_b; xcd_barrier(bb); } } while (0)
        if (HAS(4) && IN(pb + 5)) {
            if (MK_PROBE_RW >= 1) { phase_rwkv_local(F0); GBAR(); if (MK_PROBE_RW >= 2) { phase_rwkv_combine<false>(F0); GBAR(); } phase_prep(F0); GBAR(); }
            if (MK_PROBE_RW == 0) { for (int rep = 0; rep < REP(4); ++rep) phase_states(F0); } phase_rwkv_local(F0); if (MK_PROBE_RW) { GBAR(); phase_states(F0); GBAR(); } if (F0.G != 256) { phase_combine_ssd(F0); phase_combine_gla(F0); } GBAR(); if (MK_PROBE_COMB & 1) phase_rwkv_combine<true>(F0); if (MK_PROBE_COMB & 2) phase_combine_side<true>(F0); if (MK_PROBE_COMB) GBAR(); phase_rwkv_combine<false>(F0); phase_combine_side<false>(F0); } SEAM(pb + 5);
        if (HAS(6) && IN(pb + 6)) { phase_finish_rwkv(F0); phase_finish_ssd(F0); phase_finish_gla(F0); } SEAM(pb + 6);
#undef GBAR
        if (HAS(7) && IN(pb + 7)) {
            PH_ENTER(F0);
            const AS4 Args* KA = kargs();
            SchedStatic S; S.skipctx = (F.l == 1); S.nM = S.skipctx ? NB * TL / 256 : T / 256; S.nN = D / 256; S.nwg = S.nM * S.nN; S.G = F.G; S.c = F.bid; S.ws = F.ws; S.wsA = (const unsigned char*)F.out; S.offA = OUT_MIX; S.offB = WS_WOUT;
            EpiRes E{INP(0), INP(2), F.ws, F.l};
            pg8::gemm_phase<EpiRes, SchedStatic, true, false, 1024>(F.lds, F.tid, S, E);
        } SEAM(pb + 7);
        if (HAS(8) && IN(pb + 8)) { for (int rep = 0; rep < REP(8); ++rep) phase_router(F0); } SEAM(pb + 8);
        if (HAS(9) && IN(pb + 9)) { for (int rep = 0; rep < REP(9); ++rep) phase_scatter(F0); } SEAM(pb + 9);
        if (IN(pb + 10) || IN(pb + 11)) {
            PH_ENTER(F0);
            LAS int* cs = (LAS int*)(F.lds + CSTAB_OFF);
            const int* MI = (const int*)(F.ws + WS_CNT) + NUNIT64 * NCLS;
            __syncthreads();
            if (F.tid <= NCLS) cs[F.tid] = MI[F.tid];
            __syncthreads();
        }
        if (HAS(10) && IN(pb + 10)) {
            PH_ENTER(F0);
            LAS int* cs = (LAS int*)(F.lds + CSTAB_OFF);
            SchedMoE<8> S; S.ntiles = cs[NCLS] / 256; S.G = F.G; S.c = F.bid; S.cs = cs; S.ws = F.ws;
            EpiSwiGLU E{F.ws};
            for (int rep = 0; rep < REP(10); ++rep) pg8::gemm_phase<EpiSwiGLU, SchedMoE<8>, true, false, 1024, true>(F.lds, F.tid, S, E);
        } SEAM(pb + 10);
        if (HAS(11) && IN(pb + 11)) {
            PH_ENTER(F0);
            LAS int* cs = (LAS int*)(F.lds + CSTAB_OFF);
            SchedMoE<4> S; S.ntiles = cs[NCLS] / 256; S.G = F.G; S.c = F.bid; S.cs = cs; S.ws = F.ws;
            EpiScatter E{F.ws, F.l};
            pg8::gemm_phase<EpiScatter, SchedMoE<4>, true, true, 512>(F.lds, F.tid, S, E);
        } SEAM(pb + 11);
    }
#undef IN
#undef SEAM
__global__ void __launch_bounds__(512, 2) mk_fwd(Args args) {
    extern __shared__ __attribute__((aligned(16))) unsigned char lds_raw[];
    Frame F0;
    F0.lds = (LAS unsigned char*)lds_raw;
    F0.tid = threadIdx.x; F0.lane = F0.tid & 63; F0.wave = __builtin_amdgcn_readfirstlane(F0.tid >> 6);
    F0.G = gridDim.x; F0.bid = blockIdx.x; F0.out = args.out; F0.ws = args.ws; F0.l = 0;
    for (int u = F0.tid; u < (LDS_BYTES - LDSCTL_OFF) / 4; u += 512) ((LAS unsigned*)(F0.lds + LDSCTL_OFF))[u] = 0u;
    __syncthreads();
    const int lo = args.ph_lo, hi = args.ph_hi;
    const bool use_bar = (hi - lo) > 1;
    XcdBarrier bar; bar.bar = (unsigned*)(F0.ws + WS_CTL) + CW_BAR; bar.x = 0; bar.st = nullptr;
    if (use_bar) bar = xcd_barrier_post((unsigned*)(F0.ws + WS_CTL) + CW_BAR, (volatile LAS unsigned*)(F0.lds + MISC_OFF) + 8);
#define IN(k) (lo <= (k) && (k) < hi)
#define SEAM(k) do { if (IN(k) && IN((k) + 1)) { XcdBarrier bb = bar; GAS unsigned* _b = (GAS unsigned*)bb.bar; asm volatile("" : "+s"(_b)); bb.bar = (unsigned*)_b; xcd_barrier(bb); } } while (0)
    if (HAS(12) && IN(0)) { phase_mods(F0); } if (HAS(0) && IN(0)) { F0.l = 0; phase_convert(F0); } SEAM(0);
    run_layer<0>(F0, bar, lo, hi);
    run_layer<1>(F0, bar, lo, hi);
    if (HAS(13) && IN(PH_FINAL)) { phase_final(F0); }
#undef IN
#undef SEAM
}

extern "C" void kernel_launch(void* const* d_in, const int* in_sizes, int n_in, void* d_out, int out_size, void* d_ws, size_t ws_size, hipStream_t stream) {
    static int grid = 0;
    if (grid == 0) {
        if (n_in != 39 || ws_size < WS_END) { fprintf(stderr, "kernel_launch: unexpected n_in %d / ws %zu\n", n_in, ws_size); grid = -1; return; }
        int dev = 0, cus = 0;
        if (hipGetDevice(&dev) != hipSuccess || hipDeviceGetAttribute(&cus, hipDeviceAttributeMultiprocessorCount, dev) != hipSuccess) { grid = -1; return; }
        if (hipFuncSetAttribute((const void*)mk_fwd, hipFuncAttributeMaxDynamicSharedMemorySize, LDS_BYTES) != hipSuccess) { fprintf(stderr, "kernel_launch: hipFuncSetAttribute failed\n"); grid = -1; return; }
        int per_cu = 0;
        (void)hipOccupancyMaxActiveBlocksPerMultiprocessor(&per_cu, (const void*)mk_fwd, 512, LDS_BYTES);
        (void)hipGetLastError();
        grid = cus;
    }
    if (grid < 0) return;
    (void)hipMemsetAsync((char*)d_ws + WS_CTL, 0, CTL_ZERO_BYTES, stream);
    Args a{};
    for (int i = 0; i < 39; ++i) a.in[i] = (const float*)d_in[i];
    a.out = (float*)d_out; a.ws = (unsigned char*)d_ws;
#if MK_ONE_LAUNCH
    a.ph_lo = 0; a.ph_hi = PH_END;
    hipLaunchKernelGGL(mk_fwd, dim3(grid), dim3(512), LDS_BYTES, stream, a);
#else
    for (int ph = 0; ph < PH_END; ++ph) { a.ph_lo = ph; a.ph_hi = ph + 1; hipLaunchKernelGGL(mk_fwd, dim3(grid), dim3(512), LDS_BYTES, stream, a); }
#endif
}
```

```cpp
#include <hip/hip_runtime.h>
#include <cstdio>
#include <cstdint>

#define GAS __attribute__((address_space(1)))
#define LAS __attribute__((address_space(3)))
typedef unsigned short bf16;
typedef short bf16x8 __attribute__((ext_vector_type(8)));
typedef float f32x4 __attribute__((ext_vector_type(4)));
typedef float f32x2 __attribute__((ext_vector_type(2)));
typedef unsigned u32x4 __attribute__((ext_vector_type(4)));
typedef unsigned u32x2 __attribute__((ext_vector_type(2)));
typedef _Float16 h16;
typedef _Float16 h16x8 __attribute__((ext_vector_type(8)));
typedef _Float16 h16x4 __attribute__((ext_vector_type(4)));

#ifndef MK_ONE_LAUNCH
#define MK_ONE_LAUNCH 1
#endif
#ifndef MK_PHMASK
#define MK_PHMASK 0xffffffffu
#endif
#define HAS(k) ((MK_PHMASK >> (k)) & 1u)
#ifndef MK_REP
#define MK_REP 0u
#endif
#define REP(k) (((MK_REP >> (k)) & 1u) ? 2 : 1)
#ifndef MK_SUB
#define MK_SUB 0u
#endif
#ifndef MK_PROBE_RW
#define MK_PROBE_RW 0
#endif
#ifndef MK_PROBE_COMB
#define MK_PROBE_COMB 0
#endif
#ifndef MK_TA
#define MK_TA -1
#endif
#ifndef MK_TB
#define MK_TB -2
#endif
#ifndef MK_TK
#define MK_TK 4
#endif
#define STAMP(F) do { if (MK_TB >= 0) { if ((F).seamc == MK_TA) (F).tA = (unsigned)__builtin_amdgcn_s_memrealtime(); if ((F).seamc == MK_TB) (F).tB = (unsigned)__builtin_amdgcn_s_memrealtime(); ++(F).seamc; } } while (0)
#define SUBREP(k) for (int _r = 0; _r < ((((MK_SUB) >> (k)) & 1u) ? 2 : 1); ++_r)

constexpr int D = 1024, NB = 8, TL = 8192, TC = 256, TB = TL + TC, T = NB * TB;
constexpr int NTILE64 = TB / 64;
constexpr int IN_COLS = 3096, IN_PAD = 3328;
constexpr int NCLS = 24, MAXSLOT = T + NCLS * 256;
constexpr int NUNIT64 = NB * NTILE64;

constexpr size_t MiB = 1u << 20;
constexpr size_t WS_CTL = 0, CTL_ZERO_BYTES = 1 * MiB;
constexpr size_t WS_MOD = 1 * MiB;
constexpr size_t WS_CNT = 2 * MiB;
constexpr size_t WS_TOKINFO = 3 * MiB;
constexpr size_t WS_LIST = 5 * MiB;
constexpr size_t WS_WSLOT = 6 * MiB;
constexpr size_t WS_WIN = 16 * MiB;
constexpr size_t WS_WOUT = 23 * MiB;
constexpr size_t WS_W13 = 25 * MiB;
constexpr size_t WS_W2T = 57 * MiB;
constexpr size_t WS_ACT = 74 * MiB;
constexpr size_t WS_REC = 74 * MiB;
constexpr size_t WS_RECS = WS_REC, WS_RECD = WS_REC + (size_t)T * 4 * 256 * 2;
constexpr size_t WS_LOWR = 73 * MiB;
constexpr size_t WS_TOKS = 206 * MiB;
constexpr size_t WS_URW = 371 * MiB;
constexpr size_t WS_SS = 371 * MiB;
constexpr size_t WS_GS = 503 * MiB;
constexpr size_t WS_SDEC = 7 * MiB;
constexpr size_t WS_H1 = 371 * MiB;
constexpr size_t WS_UXBC = 503 * MiB;
constexpr size_t WS_UZ = 602 * MiB;
constexpr size_t WS_UGLA = 668 * MiB;
constexpr size_t WS_UMISC = 767 * MiB;
constexpr size_t WS_XB = 776 * MiB;
constexpr size_t OUT_XBCA = 0;
constexpr size_t OUT_MIX = 99 * MiB;
constexpr size_t WS_BONUS = 946 * MiB;
constexpr size_t WS_GATE = 908 * MiB;
constexpr size_t WS_GDEC = 941 * MiB;
constexpr size_t WS_RPL = 943 * MiB;
constexpr size_t WS_END = 979 * MiB;
static_assert(WS_RECD + (size_t)T * 8 * 128 * 2 <= WS_URW, "records fit");
static_assert(WS_SS + (size_t)128 * 132 * 4096 * 2 <= WS_GS && WS_GS + (size_t)64 * 132 * 2048 * 2 <= WS_UZ, "state buffers fit");
static_assert(WS_TOKS + (size_t)MAXSLOT * 1024 * 2 <= WS_H1, "toks fits");
static_assert(WS_XB + (size_t)T * 1024 * 2 <= WS_GATE && OUT_XBCA + (size_t)T * 768 * 2 <= OUT_MIX && OUT_MIX + (size_t)T * 1024 * 2 <= (size_t)NB * TL * D * 4 && WS_RPL + (size_t)64 * 132 * 64 * 4 <= WS_BONUS && WS_BONUS + (size_t)T * 256 * 2 <= WS_END, "stream / d_out scratch fit");
static_assert(WS_H1 + (size_t)MAXSLOT * 1024 * 2 <= WS_UMISC, "h1 fits");

constexpr int CW_BAR = 4096;

constexpr int RING_BYTES = 131072;
constexpr int LDS_BYTES = 163840;
constexpr int LDSCTL_OFF = LDS_BYTES - 2048, MISC_OFF = LDSCTL_OFF + 320, CSTAB_OFF = LDSCTL_OFF + 1024;

#define RLX_AGENT __ATOMIC_RELAXED, __HIP_MEMORY_SCOPE_AGENT
#define LDS_WAIT() asm volatile("s_waitcnt lgkmcnt(0)" ::: "memory")
#define LDS_BARRIER() asm volatile("s_waitcnt lgkmcnt(0)\n\ts_barrier" ::: "memory")
#define VM_WAIT() asm volatile("s_waitcnt vmcnt(0)" ::: "memory")
__device__ __forceinline__ float bf2f(unsigned short h) { return __uint_as_float(((unsigned)h) << 16); }
typedef __bf16 hwbf16x2 __attribute__((ext_vector_type(2)));
__device__ __forceinline__ unsigned pk2(float lo, float hi) { const f32x2 v = {lo, hi}; const hwbf16x2 b = __builtin_convertvector(v, hwbf16x2); return __builtin_bit_cast(unsigned, b); }
__device__ __forceinline__ unsigned f2bf(float f) { return pk2(f, 0.f) & 0xffffu; }
__device__ __forceinline__ float sigm(float x) { return 1.f / (1.f + __expf(-x)); }
__device__ __forceinline__ float siluf(float x) { return x / (1.f + __expf(-x)); }
__device__ __forceinline__ float softplusf_(float x) { return x > 20.f ? x : log1pf(__expf(x)); }
__device__ __forceinline__ void unpack8(u32x4 v, float* o) {
    o[0] = __uint_as_float(v.x << 16); o[1] = __uint_as_float(v.x & 0xffff0000u); o[2] = __uint_as_float(v.y << 16); o[3] = __uint_as_float(v.y & 0xffff0000u);
    o[4] = __uint_as_float(v.z << 16); o[5] = __uint_as_float(v.z & 0xffff0000u); o[6] = __uint_as_float(v.w << 16); o[7] = __uint_as_float(v.w & 0xffff0000u);
}
__device__ __forceinline__ f32x4 bf4(u32x2 w) { return (f32x4){__uint_as_float(w.x << 16), __uint_as_float(w.x & 0xffff0000u), __uint_as_float(w.y << 16), __uint_as_float(w.y & 0xffff0000u)}; }
__device__ __forceinline__ u32x4 pack8(const float* o) { u32x4 v; v.x = pk2(o[0], o[1]); v.y = pk2(o[2], o[3]); v.z = pk2(o[4], o[5]); v.w = pk2(o[6], o[7]); return v; }
__device__ __forceinline__ int launder_i(int v) { asm volatile("" : "+v"(v)); return v; }
template <int CTRL> __device__ __forceinline__ float dpp_mov(float v) { return __int_as_float(__builtin_amdgcn_update_dpp(0, __float_as_int(v), CTRL, 0xf, 0xf, false)); }
__device__ __forceinline__ float sum8(float v) { v += dpp_mov<0xB1>(v); v += dpp_mov<0x4E>(v); v += dpp_mov<0x141>(v); return v; }
__device__ __forceinline__ float sum16(float v) { v = sum8(v); v += dpp_mov<0x140>(v); return v; }
__device__ __forceinline__ float wave_sum(float v) {
    v = sum16(v);
    v += __int_as_float(__builtin_amdgcn_update_dpp(0, __float_as_int(v), 0x142, 0xa, 0xf, false));
    v += __int_as_float(__builtin_amdgcn_update_dpp(0, __float_as_int(v), 0x143, 0xc, 0xf, false));
    return __int_as_float(__builtin_amdgcn_readlane(__float_as_int(v), 63));
}

namespace pg8 {
constexpr int BM = 256, BK = 64, HALF = 128, HTB = HALF * BK * 2, STAGE_BYTES = 8 * HTB, NXCD = 8, WGM = 8;
__host__ __device__ __forceinline__ int lds_byte(int r, int c) { const int st = (r >> 4) * 2 + (c >> 5), rr = r & 15, cc = c & 31, ob = rr * 64 + cc * 2; return st * 1024 + (ob ^ (((ob >> 9) & 1) << 5)); }
__host__ __device__ __forceinline__ void stage_rc(int b, int& R, int& C) { const int st = b / 1024, sb = b % 1024, swz = sb ^ (((sb >> 9) & 1) << 5); R = (st >> 1) * 16 + swz / 64; C = (st & 1) * 32 + (swz % 64) / 2; }
__host__ __device__ __forceinline__ int perm32(int rho) { const int n = rho >> 4, i = rho & 15; return 8 * (i >> 2) + 4 * n + (i & 3); }
struct Unit { int pm, pn, aux; };
__device__ __forceinline__ const GAS char* uni_ptr(const char* p) { const unsigned long long v = (unsigned long long)p;
    const unsigned lo = __builtin_amdgcn_readfirstlane((unsigned)v), hi = __builtin_amdgcn_readfirstlane((unsigned)(v >> 32)); return (const GAS char*)(((unsigned long long)hi << 32) | lo); }
__device__ __forceinline__ unsigned cvt_pk_bf16(float lo, float hi) { unsigned r; asm volatile("v_cvt_pk_bf16_f32 %0, %1, %2" : "=v"(r) : "v"(lo), "v"(hi)); return r; }

template <class Epi, class Sched, bool ALIGN_EPI, bool KSPLIT, int LDB, bool GATHER = false>
__device__ __forceinline__ void gemm_phase(LAS unsigned char* lds, const int tid, const Sched& S, const Epi& E) {
    constexpr int K = 1024, nt = K / BK, ntb = KSPLIT ? nt / 2 : nt;
    const int wid = __builtin_amdgcn_readfirstlane(tid >> 6), lane = tid & 63, wr = wid >> 2, wc = wid & 3, fr = lane & 15, fq = lane >> 4;
    unsigned voffA[2], voffB[2];
#pragma unroll
    for (int i = 0; i < 2; ++i) { int R, C; stage_rc(tid * 16 + i * 8192, R, C); const int Rb = Epi::PERM ? ((R & ~31) + perm32(R & 31)) : R;
        voffA[i] = (unsigned)(R * K + C) * 2u; voffB[i] = (unsigned)(Rb * LDB + C) * 2u; }
    unsigned cvA[2][2], nvA[2][2]; int arow[2][2];
#pragma unroll
    for (int i = 0; i < 2; ++i) { int R, C; stage_rc(tid * 16 + i * 8192, R, C); arow[0][i] = R; arow[1][i] = C * 2; }
    constexpr size_t kstep = (size_t)(BK * 2);
    constexpr size_t hstepA = (size_t)HALF * K * 2, hstepB = (size_t)HALF * LDB * 2;
    const unsigned ldsw = (unsigned)wid * 1024u;
    const int aoff = lds_byte(wr * 64 + fr, fq * 8), boff = lds_byte(wc * 32 + fr, fq * 8);
#define PG8_SA(b, h) (((b) * 2 + (h)) * HTB)
#define PG8_SB(b, h) ((4 + (b) * 2 + (h)) * HTB)
#define PG8_STAGE(bufoff, gbase, voff) do { const GAS char* _gb = (const GAS char*)(gbase); _Pragma("unroll") for (int _i = 0; _i < 2; ++_i) \
        __builtin_amdgcn_global_load_lds((const GAS unsigned*)(_gb + (voff)[_i]), (LAS unsigned*)(lds + (bufoff) + ldsw + _i * 8192), 16, 0, 0); } while (0)
#define PG8_LDA(dst, b, h) do { _Pragma("unroll") for (int m = 0; m < 4; ++m) _Pragma("unroll") for (int k = 0; k < 2; ++k) dst[m][k] = *(const LAS bf16x8*)(lds + PG8_SA(b, h) + aoff + m * 2048 + k * 1024); } while (0)
#define PG8_LDB(dst, b, h) do { _Pragma("unroll") for (int n = 0; n < 2; ++n) _Pragma("unroll") for (int k = 0; k < 2; ++k) dst[n][k] = *(const LAS bf16x8*)(lds + PG8_SB(b, h) + boff + n * 2048 + k * 1024); } while (0)
#define PG8_MMA(ai, bj, At, Bt) do { __builtin_amdgcn_s_setprio(1); _Pragma("unroll") for (int m = 0; m < 4; ++m) _Pragma("unroll") for (int n = 0; n < 2; ++n) _Pragma("unroll") for (int k = 0; k < 2; ++k) \
        acc[ai][bj][m][n] = __builtin_amdgcn_mfma_f32_16x16x32_bf16(Bt[n][k], At[m][k], acc[ai][bj][m][n], 0, 0, 0); __builtin_amdgcn_s_setprio(0); } while (0)
#define PG8_WAIT_V(n) asm volatile("s_waitcnt vmcnt(" #n ")" ::: "memory")
#define PG8_WAIT_L(n) asm volatile("s_waitcnt lgkmcnt(" #n ")" ::: "memory")
#define PG8_BAR __builtin_amdgcn_s_barrier()
#define PG8_SCHED __builtin_amdgcn_sched_barrier(0)
    Unit cur, nxt; int ui = 0;
    if (!S.next(0, cur)) return;
    f32x4 acc[2][2][4][2];
#pragma unroll
    for (int a = 0; a < 2; ++a)
#pragma unroll
        for (int b = 0; b < 2; ++b)
#pragma unroll
            for (int m = 0; m < 4; ++m)
#pragma unroll
                for (int n = 0; n < 2; ++n) acc[a][b][m][n] = (f32x4){0.f, 0.f, 0.f, 0.f};
    bf16x8 At[4][2], B0[2][2], B1[2][2];
    const char* cA = (const char*)uni_ptr(S.aptr(cur)); const char* cB = (const char*)uni_ptr(S.bptr(cur));
#define PG8_LOADROWS(dst, u) do { if constexpr (GATHER) { const int* rl_ = S.rowlist(u); _Pragma("unroll") for (int hh = 0; hh < 2; ++hh) _Pragma("unroll") for (int i = 0; i < 2; ++i) { \
        const int r_ = rl_[hh * HALF + arow[0][i]]; dst[hh][i] = (unsigned)(r_ < 0 ? 0 : r_) * (unsigned)(K * 2) + (unsigned)arow[1][i]; } } } while (0)
    PG8_LOADROWS(cvA, cur);
#define PG8_STAGE_A(bufoff, gbase, half, next) do { if constexpr (GATHER) { PG8_STAGE(bufoff, gbase, (next) ? nvA[half] : cvA[half]); } else { PG8_STAGE(bufoff, (gbase) + (half) * hstepA, voffA); } } while (0)
    {
        PG8_STAGE(PG8_SB(0, 0), cB, voffB); PG8_STAGE(PG8_SB(0, 1), cB + hstepB, voffB); PG8_STAGE_A(PG8_SA(0, 0), cA, 0, false); PG8_STAGE_A(PG8_SA(0, 1), cA, 1, false);
        if (wr == 1) PG8_BAR;
        PG8_WAIT_V(2); PG8_BAR;
        PG8_STAGE(PG8_SB(1, 0), cB + kstep, voffB); PG8_STAGE_A(PG8_SA(1, 0), cA + kstep, 0, false); PG8_STAGE(PG8_SB(1, 1), cB + hstepB + kstep, voffB);
        PG8_WAIT_V(6); PG8_BAR;
    }
    for (;;) {
        const bool has_next = S.next(ui + 1, nxt);
        if (has_next) PG8_LOADROWS(nvA, nxt); else { _Pragma("unroll") for (int hh = 0; hh < 2; ++hh) _Pragma("unroll") for (int i = 0; i < 2; ++i) nvA[hh][i] = cvA[hh][i]; }
#pragma unroll 1
        for (int t = 0; t < nt; t += 2) {
            const bool last = (t == nt - 2);
            const char* a1 = cA + (size_t)(t + 1) * kstep;
            const char* a2; const char* b2;
            if (last) { a2 = has_next ? S.aptr(nxt) : cA; b2 = has_next ? S.bptr(nxt) : cB; }
            else { a2 = cA + (size_t)(t + 2) * kstep; if (KSPLIT && t + 2 >= ntb) b2 = S.bptr2(cur) + (size_t)(t + 2 - ntb) * kstep; else b2 = cB + (size_t)(t + 2) * kstep; }
            a2 = (const char*)uni_ptr(a2); b2 = (const char*)uni_ptr(b2);
            const char* a3 = a2 + kstep; const char* b3 = b2 + kstep;
            PG8_LDB(B0, 0, 0); PG8_LDB(B1, 0, 1); PG8_SCHED; PG8_LDA(At, 0, 0); PG8_STAGE_A(PG8_SA(1, 1), a1, 1, false);
            PG8_WAIT_V(8); PG8_WAIT_L(0); PG8_BAR; PG8_MMA(0, 0, At, B0); PG8_MMA(0, 1, At, B1); PG8_BAR; PG8_SCHED;
            PG8_LDA(At, 0, 1); PG8_STAGE(PG8_SB(0, 0), b2, voffB); PG8_STAGE(PG8_SB(0, 1), b2 + hstepB, voffB); PG8_STAGE_A(PG8_SA(0, 0), a2, 0, last);
            PG8_WAIT_V(8); PG8_WAIT_L(0); PG8_BAR; PG8_MMA(1, 0, At, B0); PG8_MMA(1, 1, At, B1); PG8_BAR; PG8_SCHED;
            PG8_LDB(B0, 1, 0); PG8_LDB(B1, 1, 1); PG8_SCHED; PG8_LDA(At, 1, 0); PG8_STAGE_A(PG8_SA(0, 1), a2, 1, last);
            PG8_WAIT_V(8); PG8_WAIT_L(0); PG8_BAR; PG8_MMA(0, 0, At, B0); PG8_MMA(0, 1, At, B1); PG8_BAR; PG8_SCHED;
            PG8_LDA(At, 1, 1); PG8_STAGE(PG8_SB(1, 0), b3, voffB); PG8_STAGE(PG8_SB(1, 1), b3 + hstepB, voffB); PG8_STAGE_A(PG8_SA(1, 0), a3, 0, last);
            PG8_WAIT_V(8); PG8_WAIT_L(0); PG8_BAR; PG8_MMA(1, 0, At, B0); PG8_MMA(1, 1, At, B1); PG8_BAR; PG8_SCHED;
        }
        if constexpr (ALIGN_EPI) { if (wr == 0) PG8_BAR; }
        E(acc, cur, wr, wc, fr, fq);
        if (!has_next) break;
#pragma unroll
        for (int a = 0; a < 2; ++a)
#pragma unroll
            for (int b = 0; b < 2; ++b)
#pragma unroll
                for (int m = 0; m < 4; ++m)
#pragma unroll
                    for (int n = 0; n < 2; ++n) acc[a][b][m][n] = (f32x4){0.f, 0.f, 0.f, 0.f};
        cur = nxt; cA = (const char*)uni_ptr(S.aptr(cur)); cB = (const char*)uni_ptr(S.bptr(cur)); ++ui;
        if constexpr (GATHER) { _Pragma("unroll") for (int hh = 0; hh < 2; ++hh) _Pragma("unroll") for (int i = 0; i < 2; ++i) cvA[hh][i] = nvA[hh][i]; }
        if constexpr (ALIGN_EPI) { if (wr == 1) PG8_BAR; }
    }
    PG8_WAIT_V(0);
    if constexpr (!ALIGN_EPI) { if (wr == 0) PG8_BAR; }
    PG8_BAR;
#undef PG8_SA
#undef PG8_LOADROWS
#undef PG8_STAGE_A
#undef PG8_SB
#undef PG8_STAGE
#undef PG8_LDA
#undef PG8_LDB
#undef PG8_MMA
#undef PG8_WAIT_V
#undef PG8_WAIT_L
#undef PG8_BAR
#undef PG8_SCHED
}
}

#define XB_TMO      128
#define XB_XCNT(j)  (256  + 64 * (j))
#define XB_XSUB(j)  (1280 + 64 * (j))
#define XB_XGEN(j)  (2304 + 64 * (j))
#define XB_TOP      3328
#define XB_TOPGEN   3392
#define XCD_BAR_WORDS 3456
#define XB_SPIN_CAP (1u << 25)
__device__ __forceinline__ unsigned xb_ld(unsigned* p)              { return __hip_atomic_load(p, __ATOMIC_RELAXED, __HIP_MEMORY_SCOPE_AGENT); }
__device__ __forceinline__ unsigned xb_add(unsigned* p, unsigned v) { return __hip_atomic_fetch_add(p, v, __ATOMIC_RELAXED, __HIP_MEMORY_SCOPE_AGENT); }
__device__ __forceinline__ unsigned xb_xcc_id() { return (unsigned)__builtin_amdgcn_s_getreg((3 << 11) | 20) & 0xFu; }
#define XB_SPIN(cond, bar) do { unsigned _sp = 0; while (cond) { __builtin_amdgcn_s_sleep(1); \
    if ((++_sp & 255u) == 0u) { if (xb_ld(&(bar)[XB_TMO])) break; if (_sp > XB_SPIN_CAP) { atomicAdd(&(bar)[XB_TMO], 1u); break; } } } } while (0)
struct XcdBarrier { unsigned* bar; unsigned x; volatile LAS unsigned* st; };
__device__ __forceinline__ XcdBarrier xcd_barrier_post(unsigned* bar, volatile LAS unsigned* st) {
    XcdBarrier b; b.bar = bar; b.x = xb_xcc_id(); b.st = st;
    if (threadIdx.x == 0) (void)xb_add(&bar[XB_XCNT(b.x)], 1u);
    return b;
}
__device__ __forceinline__ void xcd_barrier_complete(unsigned* bar, unsigned x, unsigned& nloc, unsigned& nx) {
    const unsigned G = gridDim.x * gridDim.y * gridDim.z;
    unsigned sum, cnt, mine, sp = 0u;
    for (;;) {
        sum = 0u; cnt = 0u; mine = 0u;
#pragma unroll 1
        for (unsigned j = 0; j < 16; ++j) { const unsigned c = xb_ld(&bar[XB_XCNT(j)]); sum += c; cnt += (c > 0u) ? 1u : 0u; mine = (j == x) ? c : mine; }
        if (sum == G) break;
        __builtin_amdgcn_s_sleep(1);
        if ((++sp & 255u) == 0u) { if (xb_ld(&bar[XB_TMO])) break; if (sp > XB_SPIN_CAP) { atomicAdd(&bar[XB_TMO], 1u); break; } }
    }
    nloc = mine > 0u ? mine : 1u; nx = cnt > 0u ? cnt : 1u;
}
__device__ __forceinline__ void xcd_barrier(const XcdBarrier& b) {
    asm volatile("s_waitcnt vmcnt(0)" ::: "memory");
    __syncthreads();
    if (threadIdx.x == 0) {
        unsigned* bar = b.bar;
        __builtin_amdgcn_s_waitcnt(0);
        unsigned nloc = b.st[0], nx = b.st[1];
        if (nloc == 0u) { xcd_barrier_complete(bar, b.x, nloc, nx); b.st[0] = nloc; b.st[1] = nx; }
        const unsigned old = xb_add(&bar[XB_XSUB(b.x)], 1u);
        const unsigned gen = old / nloc;
        if (old + 1u == (gen + 1u) * nloc) {
            __builtin_amdgcn_fence(__ATOMIC_RELEASE, "agent");
            asm volatile("s_waitcnt vmcnt(0)" ::: "memory");
            const unsigned og = xb_add(&bar[XB_TOP], 1u);
            const unsigned tg = og / nx;
            if (og + 1u == (tg + 1u) * nx) xb_add(&bar[XB_TOPGEN], 1u);
            else XB_SPIN(xb_ld(&bar[XB_TOPGEN]) == tg, bar);
            __builtin_amdgcn_fence(__ATOMIC_ACQUIRE, "agent");
            xb_add(&bar[XB_XGEN(b.x)], 1u);
            asm volatile("s_waitcnt vmcnt(0)" ::: "memory");
        } else {
            XB_SPIN(xb_ld(&bar[XB_XGEN(b.x)]) == gen, bar);
            __builtin_amdgcn_fence(__ATOMIC_ACQUIRE, "agent");
            asm volatile("s_waitcnt vmcnt(0)" ::: "memory");
        }
    }
    __syncthreads();
}

struct Args { const float* in[39]; float* out; unsigned char* ws; int ph_lo, ph_hi; };
struct Frame {
    LAS unsigned char* lds;
    int tid, lane, wave, G, bid;
    float* out; unsigned char* ws;
    int l;
    unsigned tA, tB; int seamc;
};
#define AS4 __attribute__((address_space(4)))
#define PH_ENTER(F0) Frame F = (F0); { GAS unsigned char* _w = (GAS unsigned char*)F.ws; GAS float* _o = (GAS float*)F.out; \
    asm volatile("" : "+s"(_w), "+s"(_o), "+v"(F.tid), "+s"(F.wave), "+s"(F.bid), "+s"(F.G), "+s"(F.l)); F.ws = (unsigned char*)_w; F.out = (float*)_o; } F.lane = F.tid & 63
__device__ __forceinline__ const AS4 Args* kargs() { const AS4 Args* p = (const AS4 Args*)__builtin_amdgcn_kernarg_segment_ptr(); asm volatile("" : "+s"(p)); return p; }
#define INP(i) ((const float*)(GAS const float*)(KA->in[i]))
#define LP(i, stride) (INP(i) + (size_t)F.l * (stride))

__device__ __forceinline__ const float* xin_row(const float* xl, const float* xc, int row) {
    const int b = row / TB, p = row % TB;
    if (p < TC) return xc + ((size_t)b * TC + p) * D;
    return xl + ((size_t)b * TL + (p - TC)) * D;
}
__device__ __forceinline__ int n_units(bool skipctx) { return skipctx ? NB * 128 : NUNIT64; }
__device__ __forceinline__ int unit_of(bool skipctx, int j) { return skipctx ? (j >> 7) * NTILE64 + 4 + (j & 127) : j; }
__device__ __forceinline__ int mod_index(int row) { const int b = row / TB, p = row % TB; return p < TC ? 8 : b; }

__device__ __forceinline__ int in_colmap(int n) {
    if (n < 2304) return n;
    if (n < 2816) return n + 8;
    if (n < 3072) return n + 24;
    if (n < 3080) return n - 768;
    if (n < 3096) return n - 256;
    return -1;
}
__device__ __forceinline__ void tr_item(const float* src, int ldsrc, int scol, bf16* dst, int K, int n0, int k0, LAS float* scr, int lane) {
#pragma unroll 8
    for (int i = 0; i < 32; ++i) { const int kk = 2 * i + (lane >> 5); scr[kk * 33 + (lane & 31)] = scol >= 0 ? src[(size_t)(k0 + kk) * ldsrc + scol] : 0.f; }
    LDS_WAIT(); asm volatile("" ::: "memory");
    const int c = lane & 7;
#pragma unroll
    for (int j = 0; j < 4; ++j) { const int n = (lane >> 3) + 8 * j; const LAS float* s = scr + (8 * c) * 33 + n;
        u32x4 o; o.x = pk2(s[0 * 33], s[1 * 33]); o.y = pk2(s[2 * 33], s[3 * 33]); o.z = pk2(s[4 * 33], s[5 * 33]); o.w = pk2(s[6 * 33], s[7 * 33]);
        *(GAS u32x4*)(dst + (size_t)(n0 + n) * K + k0 + 8 * c) = o; }
    LDS_WAIT(); asm volatile("" ::: "memory");
}
__device__ __forceinline__ void phase_convert(const Frame& F0) {
    PH_ENTER(F0);
    const AS4 Args* KA = kargs();
    LAS float* scr = (LAS float*)(F.lds + F.wave * 16384);
    const int gw = F.bid * 8 + F.wave, NGW = F.G * 8, l = F.l, lane = F.lane;
    constexpr int I_A = 16 * 104, I_B = 16 * 32, I_C = 16 * 16 * 32, I_D = 16 * 8 * 32, I_E = 48;
    for (int it = gw; it < I_A + I_B + I_C + I_D + I_E; it += NGW) {
        int r = it;
        if (r < I_A) { const int kb = r / 104, nb = r % 104; tr_item(INP(8) + (size_t)l * D * IN_COLS, IN_COLS, in_colmap(nb * 32 + (lane & 31)), (bf16*)(F.ws + WS_WIN), D, nb * 32, kb * 64, scr, lane); continue; }
        r -= I_A;
        if (r < I_B) { const int kb = r / 32, nb = r % 32; tr_item(INP(9) + (size_t)l * D * D, D, nb * 32 + (lane & 31), (bf16*)(F.ws + WS_WOUT), D, nb * 32, kb * 64, scr, lane); continue; }
        r -= I_B;
        if (r < I_C) { const int e = r / 512, rr = r % 512, kb = rr / 32, nb = rr % 32; const int n0 = nb * 32, j = n0 >> 8, wi = n0 & 255;
            const float* src = (wi < 128 ? INP(35) : INP(36)) + (size_t)(l * 16 + e) * D * 512;
            tr_item(src, 512, 128 * j + (wi & 127) + (lane & 31), (bf16*)(F.ws + WS_W13) + (size_t)e * D * D, D, n0, kb * 64, scr, lane); continue; }
        r -= I_C;
        if (r < I_D) { const int e = r / 256, rr = r % 256, kb = rr / 32, nb = rr % 32;
            tr_item(INP(37) + (size_t)(l * 16 + e) * 512 * D, D, nb * 32 + (lane & 31), (bf16*)(F.ws + WS_W2T) + (size_t)e * D * 512, 512, nb * 32, kb * 64, scr, lane); continue; }
        r -= I_D;
        { bf16* LW = (bf16*)(F.ws + WS_LOWR);
            if (r < 16) { const int d = r >> 3, nb = r & 7; tr_item(INP(13) + (size_t)(l * 2 + d) * 64 * 256, 256, nb * 32 + (lane & 31), LW + (size_t)d * 256 * 64, 64, nb * 32, 0, scr, lane); }
            else if (r < 32) { const int d = (r - 16) >> 3, nb = r & 7; tr_item(INP(15) + (size_t)(l * 2 + d) * 64 * 256, 256, nb * 32 + (lane & 31), LW + 32768 + (size_t)d * 256 * 64, 64, nb * 32, 0, scr, lane); }
            else { const int kb = (r - 32) >> 3, nb = r & 7; tr_item(INP(16) + (size_t)l * 128 * 256, 256, nb * 32 + (lane & 31), LW + 65536, 128, nb * 32, kb * 64, scr, lane); } }
    }
}
__device__ __forceinline__ void phase_mods(const Frame& F0) {
    PH_ENTER(F0);
    const AS4 Args* KA = kargs();
    LAS float* cond = (LAS float*)F.lds;
    LAS float* red = (LAS float*)(F.lds + 40960);
    for (int i = F.tid; i < 9 * D; i += 512) { const float v = i < 8 * D ? INP(1)[i] : INP(3)[i - 8 * D]; cond[i] = siluf(v); }
    LDS_BARRIER();
    float* mod = (float*)(F.ws + WS_MOD);
    for (int u = F.bid; u < 2 * 96; u += F.G) {
        const int l = u / 96, cb = u % 96, col = cb * 64 + F.lane;
        const float* W = INP(4) + (size_t)l * D * 6144;
        float acc[9];
#pragma unroll
        for (int i = 0; i < 9; ++i) acc[i] = 0.f;
#pragma unroll 1
        for (int k0 = F.wave * 128; k0 < F.wave * 128 + 128; k0 += 16) { float w[16];
#pragma unroll
            for (int kk = 0; kk < 16; ++kk) w[kk] = W[(size_t)(k0 + kk) * 6144 + col];
#pragma unroll
            for (int kk = 0; kk < 16; kk += 4)
#pragma unroll
                for (int i = 0; i < 9; ++i) { const f32x4 c4 = *(const LAS f32x4*)(cond + i * D + k0 + kk); acc[i] += c4.x * w[kk] + c4.y * w[kk + 1] + c4.z * w[kk + 2] + c4.w * w[kk + 3]; } }
#pragma unroll
        for (int i = 0; i < 9; ++i) red[(F.wave * 9 + i) * 64 + F.lane] = acc[i];
        LDS_BARRIER();
        for (int o = F.tid; o < 9 * 64; o += 512) { const int i = o / 64, ln = o % 64; float s = 0.f;
#pragma unroll
            for (int w = 0; w < 8; ++w) s += red[(w * 9 + i) * 64 + ln];
            mod[((size_t)l * 9 + i) * 6144 + cb * 64 + ln] = s + INP(5)[(size_t)l * 6144 + cb * 64 + ln]; }
        LDS_BARRIER();
    }
}

__device__ __forceinline__ void phase_norm1(const Frame& F0) {
    PH_ENTER(F0);
    const AS4 Args* KA = kargs();
    const float* xl = INP(0); const float* xc = INP(2); const bf16* XB = (const bf16*)(F.ws + WS_XB); const bool first = F.l == 0;
    const int gw = F.bid * 8 + F.wave, NGW = F.G * 8, lane = F.lane;
    const float* g = LP(6, D);
    const float* mod = (const float*)(F.ws + WS_MOD) + (size_t)F.l * 9 * 6144;
    bf16* H = (bf16*)(F.ws + WS_ACT);
    const int R = (T + NGW - 1) / NGW, r0 = gw * R, r1 = min(T, r0 + R);
    f32x4 A[4], B[4], nv[4]; u32x2 nb[4]; int curmi = -1;
#define N1_LOAD(row) do { if (first) { const f32x4* xr = (const f32x4*)xin_row(xl, xc, (row)) + lane; _Pragma("unroll") for (int j = 0; j < 4; ++j) nv[j] = xr[64 * j]; } \
        else { const u32x2* xr = (const u32x2*)(XB + (size_t)(row) * D) + lane; _Pragma("unroll") for (int j = 0; j < 4; ++j) nb[j] = xr[64 * j]; } } while (0)
    if (r0 < r1) N1_LOAD(r0);
    for (int row = r0; row < r1; ++row) {
        f32x4 v[4];
        if (first) {
#pragma unroll
            for (int j = 0; j < 4; ++j) v[j] = nv[j];
        } else {
#pragma unroll
            for (int j = 0; j < 4; ++j) v[j] = bf4(nb[j]);
        }
        if (row + 1 < r1) N1_LOAD(row + 1);
        const int mi = mod_index(row);
        if (mi != curmi) { curmi = mi; const float* mrow = mod + (size_t)mi * 6144;
#pragma unroll
            for (int j = 0; j < 4; ++j) { const int c = 4 * lane + 256 * j; A[j] = *(const f32x4*)(g + c) * (*(const f32x4*)(mrow + D + c) + 1.f); B[j] = *(const f32x4*)(mrow + c); } }
        float s = 0.f;
#pragma unroll
        for (int j = 0; j < 4; ++j) s += (v[j].x * v[j].x + v[j].y * v[j].y) + (v[j].z * v[j].z + v[j].w * v[j].w);
        const float rs = rsqrtf(wave_sum(s) * (1.f / D) + 1e-6f);
        u32x2* o8 = (u32x2*)(H + (size_t)row * D) + lane;
#pragma unroll
        for (int j = 0; j < 4; ++j) { const f32x4 h = v[j] * rs * A[j] + B[j]; u32x2 w; w.x = pk2(h.x, h.y); w.y = pk2(h.z, h.w); o8[64 * j] = w; }
    }
#undef N1_LOAD
}

struct SchedStatic {
    int nM, nN, nwg, G, c; const unsigned char* ws; const unsigned char* wsA; size_t offA, offB; int skipctx;
    __device__ __forceinline__ bool next(int i, pg8::Unit& u) const {
        const long L = (long)i * G + c; if (L >= nwg) return false;
        int wgid = (int)L; { const int q = nwg / 8, r = nwg % 8, xcd = wgid % 8, off = wgid / 8; wgid = (xcd < r ? xcd * (q + 1) : r * (q + 1) + (xcd - r) * q) + off; }
        const int nig = 8 * nN, gid = wgid / nig, fm = gid * 8, gsz = (nM - fm) < 8 ? (nM - fm) : 8;
        u.pm = fm + ((wgid % nig) % gsz); u.pn = (wgid % nig) / gsz; u.aux = 0;
        if (skipctx) u.pm = (u.pm >> 5) * 33 + 1 + (u.pm & 31);
        return true;
    }
    __device__ __forceinline__ const char* aptr(const pg8::Unit& u) const { return (const char*)wsA + offA + (size_t)u.pm * (256 * 1024 * 2); }
    __device__ __forceinline__ const char* bptr(const pg8::Unit& u) const { return (const char*)ws + offB + (size_t)u.pn * (256 * 1024 * 2); }
    __device__ __forceinline__ const char* bptr2(const pg8::Unit& u) const { return bptr(u); }
    __device__ __forceinline__ const int* rowlist(const pg8::Unit&) const { return nullptr; }
};
struct EpiU {
    static constexpr bool PERM = true;
    unsigned char* ws;
    __device__ __forceinline__ void operator()(const f32x4 (&acc)[2][2][4][2], const pg8::Unit& u, int wr, int wc, int fr, int fq) const {
        const int row0 = u.pm * 256 + wr * 64 + fr, pn = u.pn;
        float* u_misc = (float*)(ws + WS_UMISC);
        if (pn < 12) {
            bf16* base; int ld, c0;
            if (pn < 4) { base = (bf16*)(ws + WS_URW); ld = 1024; c0 = pn * 256; } else if (pn < 6) { base = (bf16*)(ws + WS_UZ); ld = 512; c0 = (pn - 4) * 256; }
            else if (pn < 9) { base = (bf16*)(ws + WS_UXBC); ld = 768; c0 = (pn - 6) * 256; } else { base = (bf16*)(ws + WS_UGLA); ld = 768; c0 = (pn - 9) * 256; }
            const int col0 = c0 + wc * 32 + 8 * fq;
#pragma unroll
            for (int ai = 0; ai < 2; ++ai)
#pragma unroll
                for (int m = 0; m < 4; ++m) { bf16* rowp = base + (size_t)(row0 + ai * 128 + m * 16) * ld + col0;
#pragma unroll
                    for (int bj = 0; bj < 2; ++bj) { const f32x4 v0 = acc[ai][bj][m][0], v1 = acc[ai][bj][m][1];
                        u32x4 w; w.x = pg8::cvt_pk_bf16(v0[0], v0[1]); w.y = pg8::cvt_pk_bf16(v0[2], v0[3]); w.z = pg8::cvt_pk_bf16(v1[0], v1[1]); w.w = pg8::cvt_pk_bf16(v1[2], v1[3]);
                        *(u32x4*)(rowp + bj * 128) = w; } }
        } else if (wc == 0) {
#pragma unroll
            for (int ai = 0; ai < 2; ++ai)
#pragma unroll
                for (int m = 0; m < 4; ++m) { float* rp = u_misc + (size_t)(row0 + ai * 128 + m * 16) * 32 + 8 * fq;
                    *(f32x4*)rp = acc[ai][0][m][0]; *(f32x4*)(rp + 4) = acc[ai][0][m][1]; }
        }
    }
};
struct EpiRes {
    static constexpr bool PERM = true;
    const float* xin_lat; const float* xin_ctx; unsigned char* ws; int l;
    __device__ __forceinline__ void operator()(const f32x4 (&acc)[2][2][4][2], const pg8::Unit& u, int wr, int wc, int fr, int fq) const {
        const int b = u.pm / 33, tb = u.pm % 33;
        const float* mrow = (const float*)(ws + WS_MOD) + (size_t)l * 9 * 6144 + (size_t)(tb == 0 ? 8 : b) * 6144 + 2 * D;
        const float* xi = tb == 0 ? xin_ctx + (size_t)b * TC * D : xin_lat + ((size_t)b * TL + (size_t)(tb - 1) * 256) * D;
        bf16* xo = (bf16*)(ws + WS_XB) + (size_t)u.pm * 256 * D;
        const int r0 = wr * 64 + fr, col0 = u.pn * 256 + wc * 32 + 8 * fq;
        const bool first = l == 0;
#pragma unroll
        for (int ai = 0; ai < 2; ++ai)
#pragma unroll
            for (int m = 0; m < 4; ++m) { const size_t off = (size_t)(r0 + ai * 128 + m * 16) * D + col0;
#pragma unroll
                for (int bj = 0; bj < 2; ++bj) { const f32x4 g0 = *(const f32x4*)(mrow + col0 + bj * 128), g1 = *(const f32x4*)(mrow + col0 + bj * 128 + 4);
                    f32x4 x0, x1;
                    if (first) { x0 = *(const f32x4*)(xi + off + bj * 128); x1 = *(const f32x4*)(xi + off + bj * 128 + 4); }
                    else { const u32x4 w = *(const u32x4*)(xo + off + bj * 128); x0 = bf4((u32x2){w.x, w.y}); x1 = bf4((u32x2){w.z, w.w}); }
                    x0 = x0 + g0 * acc[ai][bj][m][0]; x1 = x1 + g1 * acc[ai][bj][m][1];
                    u32x4 o; o.x = pg8::cvt_pk_bf16(x0[0], x0[1]); o.y = pg8::cvt_pk_bf16(x0[2], x0[3]); o.z = pg8::cvt_pk_bf16(x1[0], x1[1]); o.w = pg8::cvt_pk_bf16(x1[2], x1[3]);
                    *(u32x4*)(xo + off + bj * 128) = o; }
                asm volatile("" ::: "memory"); }
    }
};
__device__ __forceinline__ void cls_experts(int cls, int& ea, int& eb) {
    const int g = cls / 6, pr = cls % 6;
    const int pa = pr < 3 ? 0 : (pr < 5 ? 1 : 2);
    const int pb = pr == 0 ? 1 : (pr == 1 ? 2 : (pr == 2 ? 3 : (pr == 3 ? 2 : 3)));
    ea = g * 4 + pa; eb = g * 4 + pb;
}
template <int NJ> struct SchedMoE {
    int ntiles, G, c; const LAS int* cs; const unsigned char* ws;
    __device__ __forceinline__ bool next(int i, pg8::Unit& u) const {
        const long L = (long)i * G + c; if (L >= (long)ntiles * NJ) return false;
        const int tile = (int)(L / NJ), j = (int)(L % NJ), slot0 = tile * 256;
        int cls = 0;
#pragma unroll 1
        for (int k = 1; k < NCLS; ++k) cls = (slot0 >= cs[k]) ? k : cls;
        u.pm = tile; u.pn = j; u.aux = cls; return true;
    }
    __device__ __forceinline__ const char* aptr(const pg8::Unit& u) const { return NJ == 8 ? (const char*)ws + WS_ACT : (const char*)ws + WS_H1 + (size_t)u.pm * (256 * 1024 * 2); }
    __device__ __forceinline__ const int* rowlist(const pg8::Unit& u) const { return (const int*)(ws + WS_LIST) + u.pm * 256; }
    __device__ __forceinline__ const char* bptr(const pg8::Unit& u) const { int ea, eb; cls_experts(u.aux, ea, eb);
        if (NJ == 8) { const int e = u.pn < 4 ? ea : eb; return (const char*)ws + WS_W13 + ((size_t)e * D + (size_t)(u.pn & 3) * 256) * D * 2; }
        return (const char*)ws + WS_W2T + ((size_t)ea * D + (size_t)u.pn * 256) * 512 * 2; }
    __device__ __forceinline__ const char* bptr2(const pg8::Unit& u) const { int ea, eb; cls_experts(u.aux, ea, eb);
        return (const char*)ws + WS_W2T + ((size_t)eb * D + (size_t)u.pn * 256) * 512 * 2; }
};
struct EpiSwiGLU {
    static constexpr bool PERM = true;
    unsigned char* ws;
    __device__ __forceinline__ void operator()(const f32x4 (&acc)[2][2][4][2], const pg8::Unit& u, int wr, int wc, int fr, int fq) const {
        bf16* H1 = (bf16*)(ws + WS_H1); const f32x2* wslot = (const f32x2*)(ws + WS_WSLOT);
        const int row0 = u.pm * 256 + wr * 64 + fr, j = u.pn;
        const int col0 = (j >> 2) * 512 + (j & 3) * 128 + wc * 32 + 8 * fq;
#pragma unroll
        for (int ai = 0; ai < 2; ++ai)
#pragma unroll
            for (int m = 0; m < 4; ++m) { const int row = row0 + ai * 128 + m * 16; const f32x2 wv = wslot[row]; const float w = j < 4 ? wv.x : wv.y;
                float o[8];
#pragma unroll
                for (int n = 0; n < 2; ++n)
#pragma unroll
                    for (int i = 0; i < 4; ++i) { const float gt = acc[ai][0][m][n][i], up = acc[ai][1][m][n][i]; o[n * 4 + i] = siluf(gt) * up * w; }
                u32x4 wv4; wv4.x = pg8::cvt_pk_bf16(o[0], o[1]); wv4.y = pg8::cvt_pk_bf16(o[2], o[3]); wv4.z = pg8::cvt_pk_bf16(o[4], o[5]); wv4.w = pg8::cvt_pk_bf16(o[6], o[7]);
                *(u32x4*)(H1 + (size_t)row * D + col0) = wv4; }
    }
};
struct EpiScatter {
    static constexpr bool PERM = true;
    unsigned char* ws; int l;
    __device__ __forceinline__ void operator()(const f32x4 (&acc)[2][2][4][2], const pg8::Unit& u, int wr, int wc, int fr, int fq) const {
        const int* list = (const int*)(ws + WS_LIST); bf16* XB = (bf16*)(ws + WS_XB); const float* mod = (const float*)(ws + WS_MOD) + (size_t)l * 9 * 6144;
        const int row0 = u.pm * 256 + wr * 64 + fr, col0 = u.pn * 256 + wc * 32 + 8 * fq;
#pragma unroll
        for (int ai = 0; ai < 2; ++ai)
#pragma unroll
            for (int m = 0; m < 4; ++m) { const int tok = list[row0 + ai * 128 + m * 16];
                if (tok >= 0) { const int b = tok / TB, p = tok % TB;
                    bf16* xr = XB + (size_t)tok * D + col0;
                    const float* mrow = mod + (size_t)(p < TC ? 8 : b) * 6144 + 5 * D + col0;
#pragma unroll
                    for (int bj = 0; bj < 2; ++bj) { const f32x4 g0 = *(const f32x4*)(mrow + bj * 128), g1 = *(const f32x4*)(mrow + bj * 128 + 4);
                        const u32x4 w = *(const u32x4*)(xr + bj * 128);
                        const f32x4 x0 = bf4((u32x2){w.x, w.y}) + g0 * acc[ai][bj][m][0], x1 = bf4((u32x2){w.z, w.w}) + g1 * acc[ai][bj][m][1];
                        u32x4 o; o.x = pg8::cvt_pk_bf16(x0[0], x0[1]); o.y = pg8::cvt_pk_bf16(x0[2], x0[3]); o.z = pg8::cvt_pk_bf16(x1[0], x1[1]); o.w = pg8::cvt_pk_bf16(x1[2], x1[3]);
                        *(u32x4*)(xr + bj * 128) = o; } }
                asm volatile("" ::: "memory"); }
    }
};

constexpr int LD64 = 72;
__device__ __forceinline__ f32x4 mma16g(f32x4 acc, const LAS bf16* A, int lda, const bf16* Btg, int ldb, int lane) {
    const int r = lane & 15, kq = (lane >> 4) * 8;
    const bf16x8 a = *(const LAS bf16x8*)(A + r * lda + kq);
    const bf16x8 b = *(const bf16x8*)(Btg + (size_t)r * ldb + kq);
    return __builtin_amdgcn_mfma_f32_16x16x32_bf16(a, b, acc, 0, 0, 0);
}
__device__ __forceinline__ void phase_conv(const Frame& F0) {
    PH_ENTER(F0);
    const AS4 Args* KA = kargs();
    const bf16* UXBC = (const bf16*)(F.ws + WS_UXBC); bf16* XBCA = (bf16*)((unsigned char*)F.out + OUT_XBCA);
    const float* cw = LP(22, 9 * 768); const float* cb = LP(23, 768);
    const int cg = F.tid % 96, sub = F.tid / 96;
    if (sub >= 5) return;
    const int ch0 = cg * 8;
    float wgt0[9][8], bias[8];
#pragma unroll
    for (int k = 0; k < 9; ++k) { const f32x4 wa = *(const f32x4*)(cw + k * 768 + ch0), wb = *(const f32x4*)(cw + k * 768 + ch0 + 4);
        wgt0[k][0] = wa.x; wgt0[k][1] = wa.y; wgt0[k][2] = wa.z; wgt0[k][3] = wa.w; wgt0[k][4] = wb.x; wgt0[k][5] = wb.y; wgt0[k][6] = wb.z; wgt0[k][7] = wb.w; }
    { const f32x4 b0 = *(const f32x4*)(cb + ch0), b1 = *(const f32x4*)(cb + ch0 + 4); bias[0] = b0.x; bias[1] = b0.y; bias[2] = b0.z; bias[3] = b0.w; bias[4] = b1.x; bias[5] = b1.y; bias[6] = b1.z; bias[7] = b1.w; }
    for (int it = F.bid * 5 + sub; it < NUNIT64 * 4; it += F.G * 5) {
        const int u = it >> 2, run = it & 3, b = u / NTILE64, tl = u % NTILE64, p0 = tl * 64; const size_t rowbase = (size_t)b * TB;
        const bool lat = p0 >= TC; const int gr = (p0 - TC) >> 6;
        const int xhi = lat ? 64 : TC, x0 = (lat ? 0 : p0) + run * 16;
        const bf16* rp0; const bf16* rp1; const bf16* rp2; bool rv0, rv2;
        { const int y0 = gr - 1, y2 = gr + 1; rv0 = lat && y0 >= 0; rv2 = lat && y2 < 128;
            rp1 = UXBC + (rowbase + (lat ? TC + gr * 64 : 0)) * 768 + ch0; rp0 = rv0 ? rp1 - 64 * 768 : rp1; rp2 = rv2 ? rp1 + 64 * 768 : rp1; }
        const float m0 = rv0 ? 1.f : 0.f, m2 = rv2 ? 1.f : 0.f;
        u32x4 w00, w01, w02, w10, w11, w12;
        { const int xa = x0 - 1; const bool va = xa >= 0; const size_t oa = (size_t)(va ? xa : 0) * 768; const u32x4 z4 = {0u, 0u, 0u, 0u};
            w00 = va ? *(const u32x4*)(rp0 + oa) : z4; w01 = va ? *(const u32x4*)(rp1 + oa) : z4; w02 = va ? *(const u32x4*)(rp2 + oa) : z4;
            const size_t ob = (size_t)x0 * 768; w10 = *(const u32x4*)(rp0 + ob); w11 = *(const u32x4*)(rp1 + ob); w12 = *(const u32x4*)(rp2 + ob); }
#pragma unroll 4
        for (int k = 0; k < 16; ++k) { const int x = x0 + k, xn = x + 1; const bool vn = xn < xhi; const size_t on = (size_t)(vn ? xn : x) * 768; const u32x4 z4 = {0u, 0u, 0u, 0u};
            u32x4 w20 = *(const u32x4*)(rp0 + on), w21 = *(const u32x4*)(rp1 + on), w22 = *(const u32x4*)(rp2 + on);
            if (!vn) { w20 = z4; w21 = z4; w22 = z4; }
            float acc[8], t0[8], t2[8];
#pragma unroll
            for (int i = 0; i < 8; ++i) { acc[i] = bias[i]; t0[i] = 0.f; t2[i] = 0.f; }
            float v[8];
#define CONV_TAP(W, K, DST) unpack8(W, v); _Pragma("unroll") for (int i = 0; i < 8; ++i) DST[i] += v[i] * wgt0[K][i];
            CONV_TAP(w00, 0, t0) CONV_TAP(w10, 1, t0) CONV_TAP(w20, 2, t0) CONV_TAP(w01, 3, acc) CONV_TAP(w11, 4, acc) CONV_TAP(w21, 5, acc) CONV_TAP(w02, 6, t2) CONV_TAP(w12, 7, t2) CONV_TAP(w22, 8, t2)
#undef CONV_TAP
#pragma unroll
            for (int i = 0; i < 8; ++i) acc[i] = siluf(acc[i] + m0 * t0[i] + m2 * t2[i]);
            *(u32x4*)(XBCA + (rowbase + (lat ? TC + gr * 64 + x : x)) * 768 + ch0) = pack8(acc);
            w00 = w10; w01 = w11; w02 = w12; w10 = w20; w11 = w21; w12 = w22;
        }
    }
}
__device__ __forceinline__ void phase_prep(const Frame& F0) {
    PH_ENTER(F0);
    const AS4 Args* KA = kargs();
    const int tid = F.tid, lane = F.lane, wave = F.wave;
    const bf16* URW = (const bf16*)(F.ws + WS_URW); const bf16* UXBC = (const bf16*)(F.ws + WS_UXBC);
    bf16* XBCA = (bf16*)((unsigned char*)F.out + OUT_XBCA);
    h16* RECS = (h16*)(F.ws + WS_RECS); h16* RECD = (h16*)(F.ws + WS_RECD); h16* BONUS = (h16*)(F.ws + WS_BONUS); h16* GATE = (h16*)(F.ws + WS_GATE);
    const bf16* LW = (const bf16*)(F.ws + WS_LOWR);
    const float* mup = LP(10, 1024); const float* mun = LP(11, 1024);
    const float* w0 = LP(12, 512); const float* a0 = LP(14, 512);
    const float* k_k = LP(17, 256); const float* r_k = LP(19, 256);
    const float* cw = LP(22, 9 * 768); const float* cb = LP(23, 768);
    constexpr int LDR = 776, LDG = 136;
    LAS h16* RKV = (LAS h16*)F.lds;
    LAS bf16* WLi = (LAS bf16*)(F.lds + 99328);
    LAS bf16* ALi = (LAS bf16*)(F.lds + 108544);
    LAS bf16* GSi = (LAS bf16*)(F.lds + 117760);
    bf16x8 Bf[5][2][4];
    { const int c0 = wave * 32, r = lane & 15, kq = (lane >> 4) * 8;
#pragma unroll
        for (int mm = 0; mm < 4; ++mm) { const bf16* Bt = mm < 2 ? LW + (size_t)mm * 16384 : (mm < 4 ? LW + 32768 + (size_t)(mm - 2) * 16384 : LW + 65536); const int ldb = mm < 4 ? 64 : 128;
#pragma unroll
            for (int nt = 0; nt < 2; ++nt)
#pragma unroll
                for (int ks = 0; ks < 4; ++ks) if (ks < (mm < 4 ? 2 : 4)) Bf[mm][nt][ks] = *(const bf16x8*)(Bt + (size_t)(c0 + nt * 16 + r) * ldb + ks * 32 + kq); } }
    float pbias[4][2];
#pragma unroll
    for (int mm = 0; mm < 4; ++mm)
#pragma unroll
        for (int nt = 0; nt < 2; ++nt) { const int c = wave * 32 + nt * 16 + (lane & 15); pbias[mm][nt] = mm < 2 ? w0[mm * 256 + c] : a0[(mm - 2) * 256 + c]; }
    for (int u = F.bid; u < NUNIT64; u += F.G) {
        const int b = u / NTILE64, tl = u % NTILE64, p0 = tl * 64;
        const int seg_lo = p0 < TC ? 0 : TC, seg_hi = p0 < TC ? TC : TB;
        const size_t rowbase = (size_t)b * TB;
        LDS_BARRIER();
        SUBREP(1) { const int t = tid >> 3, part = tid & 7, p = p0 + t; const bf16* ur = URW + (rowbase + p) * 1024;
            const bool hp = p - 1 >= seg_lo, hn = p + 1 < seg_hi;
#pragma unroll 4
            for (int j = 0; j < 16; ++j) { const int c0 = (j * 8 + part) * 8;
                float uc[8], up[8], un[8];
                unpack8(*(const u32x4*)(ur + c0), uc);
                if (hp) unpack8(*(const u32x4*)(ur - 1024 + c0), up); else {
#pragma unroll
                    for (int i = 0; i < 8; ++i) up[i] = 0.f; }
                if (hn) unpack8(*(const u32x4*)(ur + 1024 + c0), un); else {
#pragma unroll
                    for (int i = 0; i < 8; ++i) un[i] = 0.f; }
                const f32x4 mp0 = *(const f32x4*)(mup + c0), mp1 = *(const f32x4*)(mup + c0 + 4), mn0 = *(const f32x4*)(mun + c0), mn1 = *(const f32x4*)(mun + c0 + 4);
                float sv[8];
#pragma unroll
                for (int i = 0; i < 4; ++i) { sv[i] = uc[i] + mp0[i] * (up[i] - uc[i]) + mn0[i] * (un[i] - uc[i]); sv[4 + i] = uc[4 + i] + mp1[i] * (up[4 + i] - uc[4 + i]) + mn1[i] * (un[4 + i] - uc[4 + i]); }
                if (c0 < 768) { h16x8 hv;
#pragma unroll
                    for (int i = 0; i < 8; ++i) hv[i] = (h16)sv[i];
                    *(LAS h16x8*)(RKV + t * LDR + c0) = hv; }
                else if (c0 < 832) {
#pragma unroll
                    for (int i = 0; i < 8; ++i) sv[i] = tanhf(sv[i]);
                    *(LAS u32x4*)(WLi + t * LD64 + (c0 - 768)) = pack8(sv); }
                else if (c0 < 896) *(LAS u32x4*)(ALi + t * LD64 + (c0 - 832)) = pack8(sv);
                else {
#pragma unroll
                    for (int i = 0; i < 8; ++i) sv[i] = sigm(sv[i]);
                    *(LAS u32x4*)(GSi + t * LDG + (c0 - 896)) = pack8(sv); }
            } }
        LDS_BARRIER();
        SUBREP(2) { const int t = tid >> 3, hq = tid & 7, h = hq >> 1, c0 = h * 64 + (hq & 1) * 32, p = p0 + t;
            float ss = 0.f, bs = 0.f;
#pragma unroll
            for (int j = 0; j < 4; ++j) { const h16x8 rv = *(const LAS h16x8*)(RKV + t * LDR + c0 + 8 * j), kv = *(const LAS h16x8*)(RKV + t * LDR + 256 + c0 + 8 * j);
                const f32x4 kk0 = *(const f32x4*)(k_k + c0 + 8 * j), kk1 = *(const f32x4*)(k_k + c0 + 8 * j + 4), rk0 = *(const f32x4*)(r_k + c0 + 8 * j), rk1 = *(const f32x4*)(r_k + c0 + 8 * j + 4);
#pragma unroll
                for (int i = 0; i < 8; ++i) { const float kf = (float)kv[i], rf = (float)rv[i], kc = i < 4 ? kk0[i & 3] : kk1[i & 3], rc = i < 4 ? rk0[i & 3] : rk1[i & 3];
                    const float kr = kf * kc; ss += kr * kr; bs += rf * kf * rc; } }
            ss += dpp_mov<0xB1>(ss); bs += dpp_mov<0xB1>(bs);
            const float rs = rsqrtf(ss + 1e-12f);
            h16* rec = RECS + (((size_t)b * 4 + h) * TB + p) * 256 + (hq & 1) * 32;
            h16* bon = BONUS + (rowbase + p) * 256 + c0;
#pragma unroll
            for (int j = 0; j < 4; ++j) { const h16x8 rv = *(const LAS h16x8*)(RKV + t * LDR + c0 + 8 * j), kv = *(const LAS h16x8*)(RKV + t * LDR + 256 + c0 + 8 * j), vv = *(const LAS h16x8*)(RKV + t * LDR + 512 + c0 + 8 * j);
                const f32x4 kk0 = *(const f32x4*)(k_k + c0 + 8 * j), kk1 = *(const f32x4*)(k_k + c0 + 8 * j + 4);
                h16x8 kkv, bv;
#pragma unroll
                for (int i = 0; i < 8; ++i) { kkv[i] = (h16)((float)kv[i] * (i < 4 ? kk0[i & 3] : kk1[i & 3]) * rs); bv[i] = (h16)(bs * (float)vv[i]); }
                *(h16x8*)(rec + 8 * j) = rv; *(h16x8*)(rec + 64 + 8 * j) = vv; *(h16x8*)(rec + 128 + 8 * j) = kkv; *(h16x8*)(rec + 192 + 8 * j) = kv;
                *(h16x8*)(bon + 8 * j) = bv; asm volatile("" ::: "memory"); } }
        LDS_BARRIER();
        SUBREP(3) { const int c0 = wave * 32, h = wave >> 1, lr = (lane >> 4) * 4, lc = lane & 15;
#pragma unroll
            for (int nt = 0; nt < 2; ++nt)
#pragma unroll
                for (int ks = 0; ks < 4; ++ks) Bf[4][nt][ks] = *(const bf16x8*)(LW + 65536 + (size_t)(c0 + nt * 16 + (lane & 15)) * 128 + ks * 32 + (lane >> 4) * 8);
#pragma unroll
            for (int mm = 0; mm < 5; ++mm) {
                const LAS bf16* Ai = mm < 2 ? WLi : (mm < 4 ? ALi : GSi); const int lda = mm < 4 ? LD64 : LDG, nks = mm < 4 ? 2 : 4;
                f32x4 acc[4][2];
#pragma unroll
                for (int tt = 0; tt < 4; ++tt)
#pragma unroll
                    for (int nt = 0; nt < 2; ++nt) acc[tt][nt] = (f32x4){0.f, 0.f, 0.f, 0.f};
#pragma unroll
                for (int ks = 0; ks < 4; ++ks) if (ks < nks)
#pragma unroll
                    for (int tt = 0; tt < 4; ++tt) { const bf16x8 af = *(const LAS bf16x8*)(Ai + (tt * 16 + (lane & 15)) * lda + ks * 32 + (lane >> 4) * 8);
#pragma unroll
                        for (int nt = 0; nt < 2; ++nt) acc[tt][nt] = __builtin_amdgcn_mfma_f32_16x16x32_bf16(af, Bf[mm][nt][ks], acc[tt][nt], 0, 0, 0); }
                LAS h16* STG = (LAS h16*)F.lds + (mm & 1) * (64 * 264);
#pragma unroll
                for (int nt = 0; nt < 2; ++nt) { const int c = c0 + nt * 16 + lc;
                    const float bias = mm < 4 ? pbias[mm < 4 ? mm : 0][nt] : 0.f;
#pragma unroll
                    for (int tt = 0; tt < 4; ++tt)
#pragma unroll
                        for (int i = 0; i < 4; ++i) { const float x = acc[tt][nt][i] + bias; const float sg = sigm(x);
                            const float o = mm < 2 ? 1.f - __expf(-0.60653066f * sg) : (mm < 4 ? sg : x);
                            STG[(tt * 16 + lr + i) * 264 + c] = (h16)o; } }
                LDS_BARRIER();
#pragma unroll
                for (int i = 0; i < 4; ++i) { const int id = tid + 512 * i, t = id >> 5, ch = id & 31, hh = ch >> 3;
                    const h16x8 v = *(const LAS h16x8*)(STG + t * 264 + ch * 8);
                    h16* dst = mm < 2 ? RECD + ((((size_t)b * 4 + hh) * 2 + mm) * TB + p0 + t) * 128 + (ch & 7) * 8
                             : (mm < 4 ? RECD + ((((size_t)b * 4 + hh) * 2 + (mm - 2)) * TB + p0 + t) * 128 + 64 + (ch & 7) * 8 : GATE + (rowbase + p0 + t) * 256 + ch * 8);
                    *(h16x8*)dst = v; }
            } }
    }
}

__device__ __forceinline__ f32x4 mma16(f32x4 acc, const LAS bf16* A, int lda, const LAS bf16* Bt, int ldb, int lane) {
    const int r = lane & 15, kq = (lane >> 4) * 8;
    const bf16x8 a = *(const LAS bf16x8*)(A + r * lda + kq);
    const bf16x8 b = *(const LAS bf16x8*)(Bt + r * ldb + kq);
    return __builtin_amdgcn_mfma_f32_16x16x32_bf16(a, b, acc, 0, 0, 0);
}
typedef short v4i16 __attribute__((ext_vector_type(4)));
__device__ __forceinline__ bf16x8 frag_tr(const LAS bf16* T, int ld, int k0, int c0, int lane) {
    const int g = lane >> 4, q = (lane & 15) >> 2, p = lane & 3;
    const LAS bf16* a = T + (k0 + 8 * g + q) * ld + c0 + 4 * p;
    const v4i16 lo = __builtin_amdgcn_ds_read_tr16_b64_v4i16((LAS v4i16*)a);
    const v4i16 hi = __builtin_amdgcn_ds_read_tr16_b64_v4i16((LAS v4i16*)(a + 4 * ld));
    return (bf16x8){lo[0], lo[1], lo[2], lo[3], hi[0], hi[1], hi[2], hi[3]};
}
__device__ __forceinline__ bf16x8 frag_row(const LAS bf16* A, int lda, int lane) { return *(const LAS bf16x8*)(A + (lane & 15) * lda + (lane >> 4) * 8); }
template <int MT, int NT, int KS> __device__ __forceinline__ void mm_block(f32x4 (&acc)[MT][NT], const LAS bf16* A, int lda, const LAS bf16* Bt, int ldb, int lane) {
    bf16x8 af[MT][KS], bfr[NT][KS];
#pragma unroll
    for (int mi = 0; mi < MT; ++mi)
#pragma unroll
        for (int ks = 0; ks < KS; ++ks) af[mi][ks] = frag_row(A + mi * 16 * lda + ks * 32, lda, lane);
#pragma unroll
    for (int nt = 0; nt < NT; ++nt)
#pragma unroll
        for (int ks = 0; ks < KS; ++ks) bfr[nt][ks] = frag_row(Bt + nt * 16 * ldb + ks * 32, ldb, lane);
#pragma unroll
    for (int mi = 0; mi < MT; ++mi)
#pragma unroll
        for (int nt = 0; nt < NT; ++nt)
#pragma unroll
            for (int ks = 0; ks < KS; ++ks) acc[mi][nt] = __builtin_amdgcn_mfma_f32_16x16x32_bf16(af[mi][ks], bfr[nt][ks], acc[mi][nt], 0, 0, 0);
}
__device__ __forceinline__ float scan_incl(float v, int lane, bool rev) {
#pragma unroll
    for (int o = 1; o < 64; o <<= 1) { const float t = rev ? __shfl_down(v, o) : __shfl_up(v, o); if (rev ? (lane + o < 64) : (lane >= o)) v += t; }
    return v;
}


__device__ __forceinline__ void gla_bcs(const Frame& F, const AS4 Args* KA, size_t row0, LAS float* LG, LAS float* GLT) {
    const int tid = F.tid;
    const float* UM = (const float*)(F.ws + WS_UMISC); const float* ga2 = LP(28, 2 * 16 * 128); const float* gb = LP(29, 256);
    LDS_BARRIER();
    if (tid < 256) { const int s = tid >> 2, j4 = (tid & 3) * 4; *(LAS f32x4*)(GLT + s * 16 + j4) = *(const f32x4*)(UM + (row0 + s) * 32 + 8 + j4); }
    LDS_BARRIER();
    { const int ch2 = tid & 255, d = ch2 >> 7, ch = ch2 & 127, sh = tid >> 8;
        float w[16];
#pragma unroll
        for (int j = 0; j < 16; ++j) w[j] = ga2[(size_t)(d * 16 + j) * 128 + ch];
        const float bias = gb[d * 128 + ch];
#pragma unroll 4
        for (int t = 0; t < 32; ++t) { const int s = sh * 32 + t; float z = bias;
#pragma unroll
            for (int j4 = 0; j4 < 4; ++j4) { const f32x4 g4 = *(const LAS f32x4*)(GLT + s * 16 + j4 * 4); z += g4.x * w[j4 * 4] + g4.y * w[j4 * 4 + 1] + g4.z * w[j4 * 4 + 2] + g4.w * w[j4 * 4 + 3]; }
            LG[(d * 64 + s) * 128 + ch] = -softplusf_(-z) * (1.f / 16.f); } }
    LDS_BARRIER();
    if (tid < 256) { const int d = tid >> 7, ch = tid & 127; float a = 0.f;
#pragma unroll 8
        for (int t = 0; t < 64; ++t) { const int s = d ? 63 - t : t; a += LG[(d * 64 + s) * 128 + ch]; LG[(d * 64 + s) * 128 + ch] = a; } }
    LDS_BARRIER();
}
__device__ __forceinline__ void phase_combine_gla(const Frame& F0) {
    PH_ENTER(F0);
    const int gid = F.bid * 512 + F.tid;
    if (gid >= 64 * 1024) return;
    const int chain = gid >> 10, e0 = (gid & 1023) * 2, d = chain & 1, bh = chain >> 1, b = bh >> 2, h = bh & 3;
    bf16* GS = (bf16*)(F.ws + WS_GS) + (size_t)chain * NTILE64 * 2048 + e0; const float* GDEC = (const float*)(F.ws + WS_GDEC) + (size_t)b * NTILE64 * 256 + d * 128 + h * 32 + (e0 & 31);
    float S0 = 0.f, S1 = 0.f;
#pragma unroll 4
    for (int it = 0; it < NTILE64; ++it) {
        const int c = d == 0 ? it : (it < 4 ? 3 - it : 131 - (it - 4));
        unsigned* p = (unsigned*)(GS + (size_t)c * 2048); const unsigned st = *p; const f32x2 dec = *(const f32x2*)(GDEC + (size_t)c * 256);
        *p = pk2(S0, S1);
        S0 = S0 * dec.x + __uint_as_float(st << 16); S1 = S1 * dec.y + __uint_as_float(st & 0xffff0000u);
    }
}
__device__ __forceinline__ void phase_finish_gla(const Frame& F0) {
    PH_ENTER(F0);
    const AS4 Args* KA = kargs();
    const int tid = F.tid, lane = F.lane, wave = F.wave;
    const bf16* UG = (const bf16*)(F.ws + WS_UGLA); const bf16* GS = (const bf16*)(F.ws + WS_GS); bf16* MIX = (bf16*)((unsigned char*)F.out + OUT_MIX);
    const float* gln = LP(30, 256);
    constexpr int LD32 = 40;
    LAS float* LG = (LAS float*)F.lds;
    LAS bf16* QE = (LAS bf16*)(F.lds + 65536);
    LAS bf16* KE = (LAS bf16*)(F.lds + 86016);
    LAS bf16* VT = (LAS bf16*)(F.lds + 96256);
    LAS bf16* ST = (LAS bf16*)(F.lds + 105472);
    LAS bf16* ATT = (LAS bf16*)(F.lds + 115712);
    LAS bf16* OB = (LAS bf16*)(F.lds + 124928);
    LAS float* RSQ = (LAS float*)(F.lds + 134144);
    LAS float* GLT = (LAS float*)(F.lds + 134656);
    LAS bf16* RT = (LAS bf16*)(F.lds + 138752);
    const int lt = wave & 3, cth = wave >> 2, lr = (lane >> 4) * 4, lc = lane & 15;
    const bool skipctx = F.l == 1;
    for (int j_ = F.G - 1 - F.bid; j_ < n_units(skipctx); j_ += F.G) {
        const int u = unit_of(skipctx, j_);
        const int b = u / NTILE64, c = u % NTILE64; const size_t row0 = (size_t)b * TB + (size_t)c * 64;
        u32x2 pq, pk; u32x4 pv, pst, prt;
        { const int l = tid >> 3, g4 = (tid & 7) * 4; const bf16* ur = UG + (row0 + l) * 768;
            pq = *(const u32x2*)(ur + g4); pk = *(const u32x2*)(ur + 128 + g4);
            pv = *(const u32x4*)(UG + (row0 + (tid & 63)) * 768 + 256 + (tid >> 6) * 8);
            { const int d = tid >> 8, r = (tid & 255) >> 2, ch = tid & 3; pst = *(const u32x4*)(GS + ((((size_t)b * 4) * 2 + d) * NTILE64 + c) * 2048 + r * 32 + ch * 8); }
            prt = *(const u32x4*)(UG + (row0 + (tid >> 3)) * 768 + 512 + (tid & 7) * 8); }
        gla_bcs(F, KA, row0, LG, GLT);
#pragma unroll 1
        for (int h = 0; h < 4; ++h) {
            { const int l = tid >> 3, g4 = (tid & 7) * 4, ch = h * 32 + g4;
                const u32x2 qr = pq, kr = pk;
                const float q[4] = { bf2f(qr.x & 0xffff) * 0.17677669529663687f, bf2f(qr.x >> 16) * 0.17677669529663687f, bf2f(qr.y & 0xffff) * 0.17677669529663687f, bf2f(qr.y >> 16) * 0.17677669529663687f };
                const float k[4] = { bf2f(kr.x & 0xffff), bf2f(kr.x >> 16), bf2f(kr.y & 0xffff), bf2f(kr.y >> 16) };
#pragma unroll
                for (int d = 0; d < 2; ++d) { const f32x4 bc = *(const LAS f32x4*)(LG + (d * 64 + l) * 128 + ch), rf = *(const LAS f32x4*)(LG + (d * 64 + 32) * 128 + ch);
                    float qe[4], ke[4], qb[4];
#pragma unroll
                    for (int i = 0; i < 4; ++i) { qe[i] = q[i] * __expf(bc[i] - rf[i]); ke[i] = k[i] * __expf(rf[i] - bc[i]); qb[i] = q[i] * __expf(bc[i]); }
                    u32x2 w; w.x = pk2(qe[0], qe[1]); w.y = pk2(qe[2], qe[3]); *(LAS u32x2*)(QE + (d * 64 + l) * LD32 + g4) = w;
                    w.x = pk2(qb[0], qb[1]); w.y = pk2(qb[2], qb[3]); *(LAS u32x2*)(QE + ((2 + d) * 64 + l) * LD32 + g4) = w;
                    w.x = pk2(ke[0], ke[1]); w.y = pk2(ke[2], ke[3]); *(LAS u32x2*)(KE + (d * 64 + l) * LD32 + g4) = w; } }
            { const int s = tid & 63, g8 = tid >> 6; const unsigned w[4] = {pv.x, pv.y, pv.z, pv.w};
#pragma unroll
                for (int i = 0; i < 8; ++i) VT[(g8 * 8 + i) * LD64 + s] = (bf16)(i & 1 ? w[i >> 1] >> 16 : w[i >> 1] & 0xffffu); }
            { const int d = tid >> 8, r = (tid & 255) >> 2, ch = tid & 3; *(LAS u32x4*)(ST + (d * 64 + r) * LD32 + ch * 8) = pst; }
            *(LAS u32x4*)(RT + (tid >> 3) * LD64 + (tid & 7) * 8) = prt;
            { const int hn = h < 3 ? h + 1 : 3; const int l = tid >> 3, g4 = (tid & 7) * 4; const bf16* ur = UG + (row0 + l) * 768;
                pq = *(const u32x2*)(ur + hn * 32 + g4); pk = *(const u32x2*)(ur + 128 + hn * 32 + g4);
                pv = *(const u32x4*)(UG + (row0 + (tid & 63)) * 768 + 256 + hn * 64 + (tid >> 6) * 8);
                { const int d = tid >> 8, r = (tid & 255) >> 2, ch = tid & 3; pst = *(const u32x4*)(GS + ((((size_t)b * 4 + hn) * 2 + d) * NTILE64 + c) * 2048 + r * 32 + ch * 8); }
                prt = *(const u32x4*)(UG + (row0 + (tid >> 3)) * 768 + 512 + hn * 64 + (tid & 7) * 8); }
            LDS_BARRIER();
#pragma unroll
            for (int j = 0; j < 2; ++j) { const int st = 2 * cth + j; const f32x4 z4 = {0.f, 0.f, 0.f, 0.f};
                const f32x4 af = mma16(z4, QE + (lt * 16) * LD32, LD32, KE + (st * 16) * LD32, LD32, lane);
                const f32x4 ab = mma16(z4, QE + (64 + lt * 16) * LD32, LD32, KE + (64 + st * 16) * LD32, LD32, lane);
                const int s = st * 16 + lc;
#pragma unroll
                for (int i = 0; i < 4; ++i) { const int l = lt * 16 + lr + i; ATT[l * LD64 + s] = (bf16)f2bf((s <= l ? af[i] : 0.f) + (s >= l ? ab[i] : 0.f)); } }
            LDS_BARRIER();
            f32x4 o[2];
#pragma unroll
            for (int j = 0; j < 2; ++j) { const int vt = 2 * cth + j; f32x4 acc = {0.f, 0.f, 0.f, 0.f};
#pragma unroll
                for (int ks = 0; ks < 2; ++ks) acc = mma16(acc, ATT + lt * 16 * LD64 + ks * 32, LD64, VT + vt * 16 * LD64 + ks * 32, LD64, lane);
                acc = mma16(acc, QE + (128 + lt * 16) * LD32, LD32, ST + (vt * 16) * LD32, LD32, lane);
                acc = mma16(acc, QE + (192 + lt * 16) * LD32, LD32, ST + (64 + vt * 16) * LD32, LD32, lane);
                o[j] = acc; }
#pragma unroll
            for (int i = 0; i < 4; ++i) { const float t = sum16(o[0][i] * o[0][i] + o[1][i] * o[1][i]); if (lc == 0) RSQ[cth * 64 + lt * 16 + lr + i] = t; }
            LDS_BARRIER();
#pragma unroll
            for (int j = 0; j < 2; ++j) { const int dv = (2 * cth + j) * 16 + lc; const float gn = gln[h * 64 + dv];
#pragma unroll
                for (int i = 0; i < 4; ++i) { const int l = lt * 16 + lr + i; const float scl = rsqrtf((RSQ[l] + RSQ[64 + l]) * (1.f / 64.f) + 1e-6f);
                    const float r = bf2f(RT[l * LD64 + dv]);
                    OB[l * LD64 + dv] = (bf16)f2bf(o[j][i] * scl * gn * siluf(r)); } }
            LDS_BARRIER();
            { const int r = tid >> 3, ch = tid & 7; *(u32x4*)(MIX + (row0 + r) * D + 768 + h * 64 + ch * 8) = *(const LAS u32x4*)(OB + r * LD64 + ch * 8); }
        }
    }
}

__device__ __forceinline__ void phase_states(const Frame& F0) {
    PH_ENTER(F0);
    const AS4 Args* KA = kargs();
    const int tid = F.tid, lane = F.lane, wave = F.wave;
    const bf16* XBCA = (const bf16*)((const unsigned char*)F.out + OUT_XBCA); const float* UM = (const float*)(F.ws + WS_UMISC);
    bf16* SS = (bf16*)(F.ws + WS_SS); float* SDEC = (float*)(F.ws + WS_SDEC);
    const float* dtb = LP(24, 16); const float* alog = LP(25, 16);
    LAS bf16* CT = (LAS bf16*)F.lds;
    LAS bf16* XTW = (LAS bf16*)(F.lds + 99328);
    LAS bf16* BT = (LAS bf16*)(F.lds + 117760);
    LAS float* WTS = (LAS float*)(F.lds + 136192);
    const bf16* UG = (const bf16*)(F.ws + WS_UGLA); bf16* GS = (bf16*)(F.ws + WS_GS); float* GDEC = (float*)(F.ws + WS_GDEC);
    LAS float* LG = (LAS float*)F.lds;
    LAS bf16* VT4 = (LAS bf16*)(F.lds + 65536);
    LAS bf16* KTE = (LAS bf16*)(F.lds + 102400);
    LAS float* GLT = (LAS float*)(F.lds + 139264);
    for (int u = F.G - 1 - F.bid; u < NUNIT64; u += F.G) {
        const int b = u / NTILE64, c = u % NTILE64; const size_t row0 = (size_t)b * TB + (size_t)c * 64;
        LDS_BARRIER();
#pragma unroll
        for (int i = 0; i < 12; ++i) { const int id = tid + 512 * i, r = id / 96, ch = id % 96;
            *(LAS u32x4*)(CT + r * 776 + ch * 8) = *(const u32x4*)(XBCA + (row0 + r) * 768 + ch * 8); }
#pragma unroll
        for (int j = 0; j < 2; ++j) { const int q = wave * 2 + j, h = q >> 1, d = q & 1;
            const float dtp = softplusf_(UM[(row0 + lane) * 32 + h] + dtb[d * 8 + h]);
            const float dA = -__expf(alog[d * 8 + h]) * dtp;
            const float cs = scan_incl(dA, lane, d == 1);
            const float ce = __shfl(cs, d == 0 ? 63 : 0);
            WTS[q * 64 + lane] = __expf(ce - cs) * dtp;
            if (lane == 0) SDEC[((size_t)b * NTILE64 + c) * 16 + q] = __expf(ce); }
        LDS_BARRIER();
#pragma unroll 1
        for (int hp = 0; hp < 4; ++hp) {
            { const int sr = tid >> 3, ch = tid & 7, g = hp >> 1; float bv[8]; unpack8(*(const LAS u32x4*)(CT + sr * 776 + 512 + g * 64 + ch * 8), bv);
#pragma unroll
                for (int q = 0; q < 4; ++q) { const float w = WTS[(hp * 4 + q) * 64 + sr]; float o[8];
#pragma unroll
                    for (int i = 0; i < 8; ++i) o[i] = bv[i] * w;
                    *(LAS u32x4*)(XTW + (q * 64 + sr) * LD64 + ch * 8) = pack8(o); } }
            LDS_BARRIER();
            { const int d = wave >> 2, mt = wave & 3;
#pragma unroll
                for (int hh = 0; hh < 2; ++hh) { const int h = hp * 2 + hh;
                    bf16* dst = SS + ((((size_t)b * 8 + h) * 2 + d) * NTILE64 + c) * 4096;
                    bf16x8 af[2];
#pragma unroll
                    for (int ks = 0; ks < 2; ++ks) af[ks] = frag_tr(CT, 776, ks * 32, h * 64 + mt * 16, lane);
#pragma unroll
                    for (int nt = 0; nt < 4; ++nt) { f32x4 acc = {0.f, 0.f, 0.f, 0.f};
#pragma unroll
                        for (int ks = 0; ks < 2; ++ks) acc = __builtin_amdgcn_mfma_f32_16x16x32_bf16(af[ks], frag_tr(XTW + (hh * 2 + d) * 64 * LD64, LD64, ks * 32, nt * 16, lane), acc, 0, 0, 0);
#pragma unroll
                        for (int i = 0; i < 4; ++i) dst[(mt * 16 + (lane >> 4) * 4 + i) * 64 + nt * 16 + (lane & 15)] = (bf16)f2bf(acc[i]); } } }
            LDS_BARRIER();
        }
        gla_bcs(F, KA, row0, LG, GLT);
        if (tid < 256) GDEC[((size_t)b * NTILE64 + c) * 256 + tid] = __expf(LG[((tid >> 7) * 64 + ((tid >> 7) ? 0 : 63)) * 128 + (tid & 127)]);
        { const int sr = tid >> 3, q8 = tid & 7; const bf16* ur = UG + (row0 + sr) * 768;
#pragma unroll
            for (int i = 0; i < 4; ++i) { const int col = (q8 * 4 + i) * 8; *(LAS u32x4*)(VT4 + sr * 264 + col) = *(const u32x4*)(ur + 256 + col); }
#pragma unroll
            for (int i = 0; i < 2; ++i) { const int col = (q8 * 2 + i) * 8; float kv[8]; unpack8(*(const u32x4*)(ur + 128 + col), kv);
#pragma unroll
                for (int d = 0; d < 2; ++d) { const LAS float* be = LG + (d * 64 + (d ? 0 : 63)) * 128 + col; const LAS float* bc = LG + (d * 64 + sr) * 128 + col; float o[8];
#pragma unroll
                    for (int k = 0; k < 8; ++k) o[k] = kv[k] * __expf(be[k] - bc[k]);
                    *(LAS u32x4*)(KTE + (d * 64 + sr) * 136 + col) = pack8(o); } } }
        LDS_BARRIER();
        { const int d = wave >> 2, mt = wave & 3;
#pragma unroll
            for (int h = 0; h < 4; ++h) { bf16* dst = GS + ((((size_t)b * 4 + h) * 2 + d) * NTILE64 + c) * 2048;
                bf16x8 af[2];
#pragma unroll
                for (int ks = 0; ks < 2; ++ks) af[ks] = frag_tr(VT4, 264, ks * 32, h * 64 + mt * 16, lane);
#pragma unroll
                for (int nt = 0; nt < 2; ++nt) { f32x4 acc = {0.f, 0.f, 0.f, 0.f};
#pragma unroll
                    for (int ks = 0; ks < 2; ++ks) acc = __builtin_amdgcn_mfma_f32_16x16x32_bf16(af[ks], frag_tr(KTE + d * 64 * 136, 136, ks * 32, h * 32 + nt * 16, lane), acc, 0, 0, 0);
#pragma unroll
                    for (int i = 0; i < 4; ++i) dst[(mt * 16 + (lane >> 4) * 4 + i) * 32 + nt * 16 + (lane & 15)] = (bf16)f2bf(acc[i]); } } }
    }
}
__device__ __forceinline__ void phase_combine_ssd(const Frame& F0) {
    PH_ENTER(F0);
    const int gid = F.bid * 512 + F.tid;
    if (gid >= 128 * 1024) return;
    const int chain = gid >> 10, e0 = (gid & 1023) * 4, d = chain & 1, bh = chain >> 1, b = bh >> 3, h = bh & 7;
    bf16* SS = (bf16*)(F.ws + WS_SS) + (size_t)chain * NTILE64 * 4096 + e0; const float* SDEC = (const float*)(F.ws + WS_SDEC) + (size_t)b * NTILE64 * 16 + h * 2 + d;
    float S0 = 0.f, S1 = 0.f, S2 = 0.f, S3 = 0.f;
#pragma unroll 4
    for (int it = 0; it < NTILE64; ++it) {
        const int c = d == 0 ? it : (it < 4 ? 3 - it : 131 - (it - 4));
        u32x2* p = (u32x2*)(SS + (size_t)c * 4096); const u32x2 st = *p; const float dec = SDEC[c * 16];
        u32x2 o; o.x = pk2(S0, S1); o.y = pk2(S2, S3); *p = o;
        S0 = S0 * dec + __uint_as_float(st.x << 16); S1 = S1 * dec + __uint_as_float(st.x & 0xffff0000u); S2 = S2 * dec + __uint_as_float(st.y << 16); S3 = S3 * dec + __uint_as_float(st.y & 0xffff0000u);
    }
}
__device__ __forceinline__ void phase_finish_ssd(const Frame& F0) {
    PH_ENTER(F0);
    const AS4 Args* KA = kargs();
    const int tid = F.tid, lane = F.lane, wave = F.wave;
    const bf16* XBCA = (const bf16*)((const unsigned char*)F.out + OUT_XBCA); const float* UM = (const float*)(F.ws + WS_UMISC); const bf16* UZ = (const bf16*)(F.ws + WS_UZ);
    const bf16* SS = (const bf16*)(F.ws + WS_SS); bf16* MIX = (bf16*)((unsigned char*)F.out + OUT_MIX);
    const float* dtb = LP(24, 16); const float* alog = LP(25, 16); const float* dsk = LP(26, 8); const float* sng = LP(27, 512);
    LAS bf16* CB = (LAS bf16*)F.lds;
    LAS bf16* BI = (LAS bf16*)(F.lds + 18432);
    LAS bf16* XT = (LAS bf16*)(F.lds + 18432);
    LAS bf16* MI = (LAS bf16*)(F.lds + 27648);
    LAS bf16* SFB = (LAS bf16*)(F.lds + 36864);
    LAS float* ACS = (LAS float*)(F.lds + 55296);
    LAS float* RSQ = (LAS float*)(F.lds + 63488);
    LAS bf16* GB = (LAS bf16*)(F.lds + 64000);
    LAS bf16* ZT = (LAS bf16*)(F.lds + 129536);
    const int lt = wave & 3, cth = wave >> 2, lr = (lane >> 4) * 4, lc = lane & 15;
    const bool skipctx = F.l == 1;
    for (int j_ = F.bid; j_ < n_units(skipctx); j_ += F.G) {
        const int u = unit_of(skipctx, j_);
        const int b = u / NTILE64, c = u % NTILE64; const size_t row0 = (size_t)b * TB + (size_t)c * 64;
        u32x4 pxt, psf, psb, pzt;
        { const int s_ = tid & 63, pg = tid >> 6, r = tid >> 3, ch = tid & 7;
            pxt = *(const u32x4*)(XBCA + (row0 + r) * 768 + ch * 8);
            psf = *(const u32x4*)(SS + ((((size_t)b * 8) * 2 + 0) * NTILE64 + c) * 4096 + r * 64 + ch * 8); psb = *(const u32x4*)(SS + ((((size_t)b * 8) * 2 + 1) * NTILE64 + c) * 4096 + r * 64 + ch * 8);
            pzt = *(const u32x4*)(UZ + (row0 + r) * 512 + ch * 8); }
        LDS_BARRIER();
#pragma unroll
        for (int i = 0; i < 4; ++i) { const int id = tid + 512 * i, r = id >> 5, ch = id & 31;
            const int which = ch >> 3;
            LAS bf16* dst = (which < 2 ? BI + (which * 64 + r) * LD64 : CB + ((which - 2) * 64 + r) * LD64) + (ch & 7) * 8;
            *(LAS u32x4*)dst = *(const u32x4*)(XBCA + (row0 + r) * 768 + 512 + ch * 8); }
        { const int h = wave;
#pragma unroll
            for (int d = 0; d < 2; ++d) { const float dtp = softplusf_(UM[(row0 + lane) * 32 + h] + dtb[d * 8 + h]);
                const float cs = scan_incl(-__expf(alog[d * 8 + h]) * dtp, lane, d == 1);
                ACS[(d * 8 + h) * 64 + lane] = cs; ACS[((2 + d) * 8 + h) * 64 + lane] = dtp; } }
        LDS_BARRIER();
        f32x4 G00 = {0.f, 0.f, 0.f, 0.f}, G01 = G00, G10 = G00, G11 = G00;
#pragma unroll
        for (int ks = 0; ks < 2; ++ks) {
            G00 = mma16(G00, CB + (lt * 16) * LD64 + ks * 32, LD64, BI + ((2 * cth) * 16) * LD64 + ks * 32, LD64, lane);
            G01 = mma16(G01, CB + (lt * 16) * LD64 + ks * 32, LD64, BI + ((2 * cth + 1) * 16) * LD64 + ks * 32, LD64, lane);
            G10 = mma16(G10, CB + (64 + lt * 16) * LD64 + ks * 32, LD64, BI + (64 + (2 * cth) * 16) * LD64 + ks * 32, LD64, lane);
            G11 = mma16(G11, CB + (64 + lt * 16) * LD64 + ks * 32, LD64, BI + (64 + (2 * cth + 1) * 16) * LD64 + ks * 32, LD64, lane); }
        LDS_BARRIER();
        f32x4 rsq = {0.f, 0.f, 0.f, 0.f};
#pragma unroll 1
        for (int h = 0; h < 8; ++h) {
            const int g = h >> 2;
            { const int r = tid >> 3, ch = tid & 7;
                *(LAS u32x4*)(XT + r * LD64 + ch * 8) = pxt;
                *(LAS u32x4*)(SFB + r * LD64 + ch * 8) = psf; *(LAS u32x4*)(SFB + (64 + r) * LD64 + ch * 8) = psb; *(LAS u32x4*)(ZT + r * LD64 + ch * 8) = pzt;
                const int hn = h < 7 ? h + 1 : 7;
                pxt = *(const u32x4*)(XBCA + (row0 + r) * 768 + hn * 64 + ch * 8);
                psf = *(const u32x4*)(SS + ((((size_t)b * 8 + hn) * 2 + 0) * NTILE64 + c) * 4096 + r * 64 + ch * 8); psb = *(const u32x4*)(SS + ((((size_t)b * 8 + hn) * 2 + 1) * NTILE64 + c) * 4096 + r * 64 + ch * 8);
                pzt = *(const u32x4*)(UZ + (row0 + r) * 512 + hn * 64 + ch * 8); }
            const LAS float* af = ACS + h * 64; const LAS float* ab = ACS + (8 + h) * 64; const LAS float* pf = ACS + (16 + h) * 64; const LAS float* pb = ACS + (24 + h) * 64;
#pragma unroll
            for (int j = 0; j < 2; ++j) { const int s = (2 * cth + j) * 16 + lc; const float afs = af[s], abs_ = ab[s], pfs = pf[s], pbs = pb[s];
                const f32x4 gt = g ? (j ? G11 : G10) : (j ? G01 : G00);
#pragma unroll
                for (int i = 0; i < 4; ++i) { const int l = lt * 16 + lr + i;
                    const float wf = s <= l ? __expf(af[l] - afs) * pfs : 0.f, wb = s >= l ? __expf(ab[l] - abs_) * pbs : 0.f;
                    MI[l * LD64 + s] = (bf16)f2bf(gt[i] * (wf + wb)); } }
            LDS_BARRIER();
#pragma unroll
            for (int j = 0; j < 2; ++j) { const int pt = 2 * cth + j; f32x4 acc = {0.f, 0.f, 0.f, 0.f}, tf = {0.f, 0.f, 0.f, 0.f}, tb = {0.f, 0.f, 0.f, 0.f};
#pragma unroll
                for (int ks = 0; ks < 2; ++ks) { acc = __builtin_amdgcn_mfma_f32_16x16x32_bf16(frag_row(MI + lt * 16 * LD64 + ks * 32, LD64, lane), frag_tr(XT, LD64, ks * 32, pt * 16, lane), acc, 0, 0, 0);
                    tf = mma16(tf, CB + (g * 64 + lt * 16) * LD64 + ks * 32, LD64, SFB + pt * 16 * LD64 + ks * 32, LD64, lane);
                    tb = mma16(tb, CB + (g * 64 + lt * 16) * LD64 + ks * 32, LD64, SFB + (64 + pt * 16) * LD64 + ks * 32, LD64, lane); }
                const int p = pt * 16 + lc; const float ds = dsk[h];
#pragma unroll
                for (int i = 0; i < 4; ++i) { const int l = lt * 16 + lr + i;
                    const float y = acc[i] + __expf(af[l]) * tf[i] + __expf(ab[l]) * tb[i];
                    const float xs = bf2f(XT[l * LD64 + p]), z = bf2f(ZT[l * LD64 + p]);
                    const float gv = (y + ds * xs) * siluf(z); GB[l * 512 + h * 64 + p] = (bf16)f2bf(gv); rsq[i] += gv * gv; } }
            LDS_BARRIER();
        }
#pragma unroll
        for (int i = 0; i < 4; ++i) { const float t = sum16(rsq[i]); if (lc == 0) RSQ[cth * 64 + lt * 16 + lr + i] = t; }
        LDS_BARRIER();
#pragma unroll
        for (int i = 0; i < 8; ++i) { const int id = tid + 512 * i, r = id >> 6, ch = id & 63;
            const float scl = rsqrtf((RSQ[r] + RSQ[64 + r]) * (1.f / 512.f) + 1e-6f);
            float v[8]; unpack8(*(const LAS u32x4*)(GB + r * 512 + ch * 8), v);
            const f32x4 n0 = *(const f32x4*)(sng + ch * 8), n1 = *(const f32x4*)(sng + ch * 8 + 4);
#pragma unroll
            for (int k = 0; k < 4; ++k) { v[k] *= scl * n0[k]; v[4 + k] *= scl * n1[k]; }
            *(u32x4*)(MIX + (row0 + r) * D + 256 + ch * 8) = pack8(v); }
    }
}


__device__ __forceinline__ bf16* rw_out(unsigned char* ws, int b, int h, int d, int c, int which) {
    h16* RECS = (h16*)(ws + WS_RECS); h16* RECD = (h16*)(ws + WS_RECD); const size_t p0 = (size_t)c * 64;
    if (d == 0) return (bf16*)(RECS + (((size_t)b * 4 + h) * TB + p0) * 256) + which * 4096;
    return (bf16*)(RECD + ((((size_t)b * 4 + h) * 2 + (which >> 1)) * TB + p0) * 128) + (which & 1) * 4096;
}
__device__ __forceinline__ void phase_rwkv_local(const Frame& F0) {
    PH_ENTER(F0);
    const AS4 Args* KA = kargs();
    const int tid0 = F.tid, wave = F.wave;
#define RL_STEP const int tid = launder_i(tid0); const int lane = tid & 63; const int lr = (lane >> 4) * 4, lc = lane & 15;
    const h16* RECS = (const h16*)(F.ws + WS_RECS); const h16* RECD = (const h16*)(F.ws + WS_RECD);
    float* RPL = (float*)(F.ws + WS_RPL);
    const float* k_a = LP(18, 256);
    constexpr int LDS_S = 264, LDS_D = 136, LDF = 68;
    LAS h16* STS = (LAS h16*)F.lds;
    LAS h16* STD = (LAS h16*)(F.lds + 33792);
    LAS float* AABF = (LAS float*)(F.lds + 33792);
    LAS bf16* ULT = (LAS bf16*)(F.lds + 33792);
    LAS float* TF = (LAS float*)(F.lds + 51200);
    LAS bf16* AVT = (LAS bf16*)(F.lds + 51200); LAS bf16* W0T = (LAS bf16*)(F.lds + 60416);
    LAS bf16* NAT = (LAS bf16*)(F.lds + 69632);
    LAS bf16* TRN = (LAS bf16*)(F.lds + 106496);
    LAS bf16* R0I = (LAS bf16*)(F.lds + 143360);
    LAS float* M1 = (LAS float*)(F.lds + 152576);
    LAS float* GSUM = (LAS float*)(F.lds + 157184);
    h16x8 ps[4], pd[2];
#define RL_LOAD_S(uu) do { const int h_ = (uu) & 3, bc_ = (uu) >> 2, b_ = bc_ / NTILE64, c_ = bc_ % NTILE64; const h16* src = RECS + (((size_t)b_ * 4 + h_) * TB + (size_t)c_ * 64) * 256; \
        _Pragma("unroll") for (int i = 0; i < 4; ++i) { const int id = launder_i(tid0) + 512 * i, r = id >> 5, ch = id & 31; ps[i] = *(const h16x8*)(src + (size_t)r * 256 + ch * 8); } } while (0)
#define RL_LOAD_D(uu, dd) do { const int h_ = (uu) & 3, bc_ = (uu) >> 2, b_ = bc_ / NTILE64, c_ = bc_ % NTILE64; const h16* src = RECD + ((((size_t)b_ * 4 + h_) * 2 + (dd)) * TB + (size_t)c_ * 64) * 128; \
        _Pragma("unroll") for (int i = 0; i < 2; ++i) { const int id = launder_i(tid0) + 512 * i, r = id >> 4, ch = id & 15; pd[i] = *(const h16x8*)(src + (size_t)r * 128 + ch * 8); } } while (0)
    if (F.bid < NUNIT64 * 4) { RL_LOAD_S(F.bid); RL_LOAD_D(F.bid, 0); }
    for (int u = F.bid; u < NUNIT64 * 4; u += F.G) {
        const int h = u & 3, bc = u >> 2, b = bc / NTILE64, c = bc % NTILE64;
        LDS_BARRIER();
        { RL_STEP
#pragma unroll
            for (int i = 0; i < 4; ++i) { const int id = tid + 512 * i, r = id >> 5, ch = id & 31; *(LAS h16x8*)(STS + r * LDS_S + ch * 8) = ps[i]; } }
#pragma unroll 1
        for (int d = 0; d < 2; ++d) {
            LDS_BARRIER();
            { RL_STEP
#pragma unroll
                for (int i = 0; i < 2; ++i) { const int id = tid + 512 * i, r = id >> 4, ch = id & 15; *(LAS h16x8*)(STD + r * LDS_D + ch * 8) = pd[i]; } }
            if (d == 0) RL_LOAD_D(u, 1); else if (u + F.G < NUNIT64 * 4) { RL_LOAD_S(u + F.G); RL_LOAD_D(u + F.G, 0); }
            LDS_BARRIER();
            SUBREP(8) { RL_STEP const int kp = tid & 31, tg = tid >> 5, k = 2 * kp;
                f32x2 wv[4], li[4]; f32x2 run = {1.f, 1.f};
#pragma unroll
                for (int i = 0; i < 4; ++i) { const int t = tg * 4 + i, srow = d ? 63 - t : t; const unsigned raw = *(const LAS unsigned*)(STD + srow * LDS_D + k);
                    const h16 o0 = __builtin_bit_cast(h16, (unsigned short)(raw & 0xffff)), o1 = __builtin_bit_cast(h16, (unsigned short)(raw >> 16));
                    wv[i] = (f32x2){1.f - (float)o0, 1.f - (float)o1}; run = run * wv[i]; li[i] = run; }
                *(LAS f32x2*)(GSUM + tg * 64 + k) = run;
                for (int i = tid; i < 64 * LDF; i += 512) TF[i] = 0.f;
                LDS_BARRIER();
                f32x2 off = {1.f, 1.f}, pref = {1.f, 1.f}, pend = {1.f, 1.f};
#pragma unroll
                for (int g = 0; g < 16; ++g) { const f32x2 gs = *(const LAS f32x2*)(GSUM + g * 64 + k); if (g < tg) off = off * gs; if (g < 8) pref = pref * gs; pend = pend * gs; }
                const f32x2 kac = *(const f32x2*)(k_a + h * 64 + k);
                const f32x2 ipref = {1.f / pref.x, 1.f / pref.y};
                f32x2 pexcl = off;
                unsigned vt[4], a0t[4], bht[4], kht[4];
#pragma unroll
                for (int i = 0; i < 4; ++i) { const int t = tg * 4 + i, srow = d ? 63 - t : t;
                    const f32x2 pin = off * li[i];
                    const unsigned rr = *(const LAS unsigned*)(STS + srow * LDS_S + k), vr = *(const LAS unsigned*)(STS + srow * LDS_S + 64 + k), kkr = *(const LAS unsigned*)(STS + srow * LDS_S + 128 + k), kxr = *(const LAS unsigned*)(STS + srow * LDS_S + 192 + k);
                    const unsigned ar_ = *(const LAS unsigned*)(STD + srow * LDS_D + 64 + k);
#define H2F(x, hi) ((float)__builtin_bit_cast(h16, (unsigned short)((hi) ? ((x) >> 16) : ((x) & 0xffff))))
                    const f32x2 r = {H2F(rr, 0), H2F(rr, 1)}, vv = {H2F(vr, 0), H2F(vr, 1)}, kk = {H2F(kkr, 0), H2F(kkr, 1)}, kx = {H2F(kxr, 0), H2F(kxr, 1)}, av = {H2F(ar_, 0), H2F(ar_, 1)};
#undef H2F
                    const f32x2 kmod = kx * ((av - 1.f) * kac + 1.f), bb = kk * av;
                    const f32x2 ipin = {1.f / pin.x, 1.f / pin.y};
                    const f32x2 e1 = pexcl * ipref, e2 = pin * ipref, e3 = pref * ipin, eL = pend * ipin;
                    const f32x2 at = -kk * e1, rt = r * e2, bt = bb * e3, kt = kmod * e3, r0 = r * pin, a0 = -kk * pexcl, bh = bb * eL, kh = kmod * eL;
                    *(LAS unsigned*)(NAT + (0 * 64 + t) * LD64 + k) = pk2(at.x, at.y); *(LAS unsigned*)(NAT + (1 * 64 + t) * LD64 + k) = pk2(rt.x, rt.y);
                    *(LAS unsigned*)(NAT + (2 * 64 + t) * LD64 + k) = pk2(bt.x, bt.y); *(LAS unsigned*)(NAT + (3 * 64 + t) * LD64 + k) = pk2(kt.x, kt.y);
                    *(LAS unsigned*)(R0I + t * LD64 + k) = pk2(r0.x, r0.y);
                    vt[i] = pk2(vv.x, vv.y); a0t[i] = pk2(a0.x, a0.y); bht[i] = pk2(bh.x, bh.y); kht[i] = pk2(kh.x, kh.y);
                    pexcl = pin; }
#define TR_WR(SLOT, ARR) do { u32x2 lo, hi; lo.x = (ARR[0] & 0xffffu) | (ARR[1] << 16); lo.y = (ARR[2] & 0xffffu) | (ARR[3] << 16); hi.x = (ARR[0] >> 16) | (ARR[1] & 0xffff0000u); hi.y = (ARR[2] >> 16) | (ARR[3] & 0xffff0000u); \
                    *(LAS u32x2*)(TRN + ((SLOT) * 64 + k) * LD64 + tg * 4) = lo; *(LAS u32x2*)(TRN + ((SLOT) * 64 + k + 1) * LD64 + tg * 4) = hi; } while (0)
                TR_WR(0, vt); TR_WR(1, a0t); TR_WR(2, bht); TR_WR(3, kht);
#undef TR_WR
                if (tg == 15) *(f32x2*)(RPL + (((((size_t)b * 4 + h) * 2 + d) * NTILE64) + c) * 64 + k) = pend; }
            LDS_BARRIER();
            { RL_STEP const int pr = wave >> 1, rh = wave & 1; f32x4 acc[2][4];
#pragma unroll
                for (int mi = 0; mi < 2; ++mi)
#pragma unroll
                    for (int nt = 0; nt < 4; ++nt) acc[mi][nt] = (f32x4){0.f, 0.f, 0.f, 0.f};
                mm_block<2, 4, 2>(acc, NAT + ((pr >> 1) * 64 + (2 * rh) * 16) * LD64, LD64, NAT + ((2 + (pr & 1)) * 64) * LD64, LD64, lane);
                LDS_BARRIER();
#pragma unroll
                for (int mi = 0; mi < 2; ++mi)
#pragma unroll
                    for (int nt = 0; nt < 4; ++nt)
#pragma unroll
                        for (int i = 0; i < 4; ++i) { const int t = (2 * rh + mi) * 16 + lr + i, ii = nt * 16 + lc;
                            const float v = (pr < 2 ? ii < t : ii <= t) ? acc[mi][nt][i] : 0.f;
                            if (pr == 0) AABF[t * LDF + ii] = v; else NAT[((pr - 1) * 64 + t) * LD64 + ii] = (bf16)f2bf(v); } }
            LDS_BARRIER();
            SUBREP(9) if (wave == 0) { RL_STEP const int blk = lane >> 4, j = lane & 15; float Tr[16]; const LAS float* ab = AABF + (blk * 16) * LDF + blk * 16;
#pragma unroll
                for (int t = 0; t < 16; ++t) { float a0 = (j == t) ? 1.f : 0.f, a1 = 0.f;
#pragma unroll
                    for (int i4 = 0; i4 < t; i4 += 4) { const f32x4 av = *(const LAS f32x4*)(ab + t * LDF + i4);
                        a0 += av.x * Tr[i4]; if (i4 + 1 < t) a1 += av.y * Tr[i4 + 1]; if (i4 + 2 < t) a0 += av.z * Tr[i4 + 2]; if (i4 + 3 < t) a1 += av.w * Tr[i4 + 3]; }
                    Tr[t] = a0 + a1; TF[(blk * 16 + t) * LDF + blk * 16 + j] = Tr[t]; } }
            LDS_BARRIER();
            SUBREP(10) {
#define RL_LEVEL(M, ACTIVE, PP, TT, J0) do { \
                { RL_STEP if (ACTIVE) { const int pp = (PP), t = (TT), j0 = (J0), rb = pp * 2 * (M) + (M), cb = pp * 2 * (M); f32x2 mm = {0.f, 0.f}; \
                    _Pragma("unroll") for (int i = 0; i < (M); i += 4) { const f32x4 av = *(const LAS f32x4*)(AABF + (rb + t) * LDF + cb + i); \
                        mm += av.x * *(const LAS f32x2*)(TF + (cb + i) * LDF + cb + j0) + av.y * *(const LAS f32x2*)(TF + (cb + i + 1) * LDF + cb + j0) + av.z * *(const LAS f32x2*)(TF + (cb + i + 2) * LDF + cb + j0) + av.w * *(const LAS f32x2*)(TF + (cb + i + 3) * LDF + cb + j0); } \
                    *(LAS f32x2*)(M1 + pp * 576 + t * 36 + j0) = mm; } } \
                LDS_BARRIER(); \
                { RL_STEP if (ACTIVE) { const int pp = (PP), t = (TT), j0 = (J0), rb = pp * 2 * (M) + (M), cb = pp * 2 * (M); f32x2 xx = {0.f, 0.f}; \
                    _Pragma("unroll") for (int q = 0; q < (M); q += 4) { const f32x4 tv = *(const LAS f32x4*)(TF + (rb + t) * LDF + rb + q); \
                        xx += tv.x * *(const LAS f32x2*)(M1 + pp * 576 + q * 36 + j0) + tv.y * *(const LAS f32x2*)(M1 + pp * 576 + (q + 1) * 36 + j0) + tv.z * *(const LAS f32x2*)(M1 + pp * 576 + (q + 2) * 36 + j0) + tv.w * *(const LAS f32x2*)(M1 + pp * 576 + (q + 3) * 36 + j0); } \
                    *(LAS f32x2*)(TF + (rb + t) * LDF + cb + j0) = xx; } } \
                LDS_BARRIER(); } while (0)
                RL_LEVEL(16, tid < 256, tid >> 7, (tid >> 3) & 15, (tid & 7) * 2);
                RL_LEVEL(32, true, 0, tid >> 4, (tid & 15) * 2);
#undef RL_LEVEL
            }
            { RL_STEP const int t = tid >> 3, i0 = (tid & 7) * 8; float v[8];
#pragma unroll
                for (int i = 0; i < 8; ++i) v[i] = TF[t * LDF + i0 + i];
                *(LAS u32x4*)(NAT + (3 * 64 + t) * LD64 + i0) = pack8(v); }
            LDS_BARRIER();
            SUBREP(11) { RL_STEP const int pr = wave >> 2, mt = wave & 3; f32x4 acc[4];
#pragma unroll
                for (int nt = 0; nt < 4; ++nt) acc[nt] = (f32x4){0.f, 0.f, 0.f, 0.f};
                { f32x4 (&a2)[1][4] = *reinterpret_cast<f32x4 (*)[1][4]>(&acc); mm_block<1, 4, 2>(a2, TRN + (pr * 64 + mt * 16) * LD64, LD64, NAT + ((pr ? 3 : 0) * 64) * LD64, LD64, lane); }
                LAS bf16* dst = pr ? W0T : AVT;
#pragma unroll
                for (int nt = 0; nt < 4; ++nt)
#pragma unroll
                    for (int i = 0; i < 4; ++i) dst[(mt * 16 + lr + i) * LD64 + nt * 16 + lc] = (bf16)f2bf(acc[nt][i]); }
            LDS_BARRIER();
            SUBREP(11) { RL_STEP const int mt = wave & 3, nh = wave >> 2;
#pragma unroll
                for (int nn = 0; nn < 2; ++nn) { const int nt = 2 * nh + nn; f32x4 a4 = {0.f, 0.f, 0.f, 0.f};
#pragma unroll
                    for (int ks = 0; ks < 2; ++ks) a4 = mma16(a4, AVT + (mt * 16) * LD64 + ks * 32, LD64, NAT + (3 * 64 + nt * 16) * LD64 + ks * 32, LD64, lane);
#pragma unroll
                    for (int i = 0; i < 4; ++i) ULT[(mt * 16 + lr + i) * LD64 + nt * 16 + lc] = (bf16)f2bf(a4[i]); } }
            LDS_BARRIER();
            { RL_STEP const int o = wave >> 1, rh = wave & 1;
                const LAS bf16* A1 = o == 0 ? TRN + 2 * 64 * LD64 : (o == 1 ? ULT : NAT + 1 * 64 * LD64);
                const LAS bf16* B1 = o == 0 ? W0T : (o == 1 ? TRN + 2 * 64 * LD64 : (o == 2 ? W0T : ULT));
                const LAS bf16* A2 = o == 1 ? TRN : NAT + 2 * 64 * LD64;
                const LAS bf16* B2 = o == 1 ? TRN + 3 * 64 * LD64 : TRN;
                f32x4 res[2][4];
#pragma unroll
                for (int mi = 0; mi < 2; ++mi)
#pragma unroll
                    for (int nt = 0; nt < 4; ++nt) res[mi][nt] = (f32x4){0.f, 0.f, 0.f, 0.f};
                mm_block<2, 4, 2>(res, A1 + (2 * rh * 16) * LD64, LD64, B1, LD64, lane);
                if (o == 1 || o == 3) mm_block<2, 4, 2>(res, A2 + (2 * rh * 16) * LD64, LD64, B2, LD64, lane);
                if (o == 2) {
#pragma unroll
                    for (int mi = 0; mi < 2; ++mi)
#pragma unroll
                        for (int nt = 0; nt < 4; ++nt)
#pragma unroll
                            for (int i = 0; i < 4; ++i) { const int rr = (2 * rh + mi) * 16 + lr + i, cc = nt * 16 + lc; res[mi][nt][i] += bf2f(R0I[rr * LD64 + cc]); } }
                LDS_BARRIER();
#pragma unroll
                for (int mi = 0; mi < 2; ++mi)
#pragma unroll
                    for (int nt = 0; nt < 4; ++nt)
#pragma unroll
                        for (int i = 0; i < 4; ++i) NAT[o * 4096 + ((2 * rh + mi) * 16 + lr + i) * 64 + nt * 16 + lc] = (bf16)f2bf(res[mi][nt][i]);
                LDS_BARRIER();
#pragma unroll
                for (int i = 0; i < 4; ++i) { const int id = tid + 512 * i, oo = id >> 9, ch = id & 511; *(u32x4*)(rw_out(F.ws, b, h, d, c, oo) + ch * 8) = *(const LAS u32x4*)(NAT + oo * 4096 + ch * 8); } }
        }
    }
#undef RL_STEP
#undef RL_LOAD_S
#undef RL_LOAD_D
}
template <bool DRY> __device__ __forceinline__ void phase_rwkv_combine(const Frame& F0) {
    PH_ENTER(F0);
    const int lane = F.lane;
    if (F.wave != 0 || F.bid >= 256) return;
    const int chain = F.bid >> 2, q = F.bid & 3, d = chain & 1, bh = chain >> 1, b = bh >> 2, h = bh & 3;
    constexpr int LA = 5, NSLOT = LA + 1, SLOT_B = 8192 + 2048 + 256;
    static_assert(NTILE64 % NSLOT == 0, "ring period");
    LAS unsigned char* RING = F.lds;
    LAS bf16* SA = (LAS bf16*)(F.lds + NSLOT * SLOT_B);
    const float* RPL = (const float*)(F.ws + WS_RPL) + (size_t)chain * NTILE64 * 64;
    const int lr = (lane >> 4) * 4, lc = lane & 15, ar = lane & 15, akq = (lane >> 4) * 8;
    const unsigned vphi = (unsigned)(ar * 64 + akq) * 2u;
    f32x4 S[4];
#pragma unroll
    for (int nt = 0; nt < 4; ++nt) S[nt] = (f32x4){0.f, 0.f, 0.f, 0.f};
#define RWC_CIDX(k) (d == 0 ? (k) : ((k) < 4 ? 3 - (k) : 131 - ((k) - 4)))
#define RWC_ISSUE(k, SLOT) do { const int c_ = RWC_CIDX(k); LAS unsigned char* sl_ = RING + (SLOT) * SLOT_B; \
        const GAS char* phit = (const GAS char*)rw_out(F.ws, b, h, d, c_, 0) + vphi; const GAS char* psip = (const GAS char*)(rw_out(F.ws, b, h, d, c_, 1) + (size_t)q * 16 * 64) + lane * 16; \
        _Pragma("unroll") for (int nt = 0; nt < 4; ++nt) _Pragma("unroll") for (int ks = 0; ks < 2; ++ks) \
            __builtin_amdgcn_global_load_lds((const GAS unsigned*)(phit + nt * 2048 + ks * 64), (LAS unsigned*)(sl_ + (nt * 2 + ks) * 1024), 16, 0, 0); \
        _Pragma("unroll") for (int i = 0; i < 2; ++i) __builtin_amdgcn_global_load_lds((const GAS unsigned*)(psip + i * 1024), (LAS unsigned*)(sl_ + 8192 + i * 1024), 16, 0, 0); \
        __builtin_amdgcn_global_load_lds((const GAS unsigned*)(RPL + (size_t)c_ * 64 + lane), (LAS unsigned*)(sl_ + 10240), 4, 0, 0); } while (0)
    RWC_ISSUE(0, 0); RWC_ISSUE(1, 1); RWC_ISSUE(2, 2); RWC_ISSUE(3, 3); RWC_ISSUE(4, 4);
#pragma unroll 1
    for (int k6 = 0; k6 < NTILE64; k6 += NSLOT) {
#pragma unroll
        for (int j = 0; j < NSLOT; ++j) {
            const int k = k6 + j, c = RWC_CIDX(k);
            const LAS unsigned char* sl = RING + j * SLOT_B;
#pragma unroll
            for (int nt = 0; nt < 4; ++nt)
#pragma unroll
                for (int i = 0; i < 4; ++i) SA[(lr + i) * LD64 + nt * 16 + lc] = (bf16)f2bf(S[nt][i]);
            if (k6 + NSLOT >= NTILE64) asm volatile("s_waitcnt vmcnt(0)" ::: "memory");
            else if (DRY || (k6 == 0 && j < 4)) asm volatile("s_waitcnt vmcnt(44)" ::: "memory");
            else asm volatile("s_waitcnt vmcnt(52)" ::: "memory");
            bf16x8 bfr[4][2]; f32x4 init[4];
#pragma unroll
            for (int nt = 0; nt < 4; ++nt) {
#pragma unroll
                for (int ks = 0; ks < 2; ++ks) bfr[nt][ks] = *(const LAS bf16x8*)(sl + (nt * 2 + ks) * 1024 + lane * 16);
                const float pl = *(const LAS float*)(sl + 10240 + (nt * 16 + lc) * 4);
#pragma unroll
                for (int i = 0; i < 4; ++i) init[nt][i] = S[nt][i] * pl + bf2f(*(const LAS unsigned short*)(sl + 8192 + ((lr + i) * 64 + nt * 16 + lc) * 2)); }
            LDS_WAIT();
            const bf16x8 a0 = *(const LAS bf16x8*)(SA + ar * LD64 + akq), a1 = *(const LAS bf16x8*)(SA + ar * LD64 + 32 + akq);
            if (!DRY) { bf16* s0p = rw_out(F.ws, b, h, d, c, 1) + (size_t)q * 16 * 64;
#pragma unroll
                for (int i = 0; i < 2; ++i) { const int id = lane + 64 * i, r = id >> 3, ch = id & 7; *(u32x4*)(s0p + r * 64 + ch * 8) = *(const LAS u32x4*)(SA + r * LD64 + ch * 8); } }
            LDS_WAIT();
            if (k + LA < NTILE64) RWC_ISSUE(k + LA, (j + LA) % NSLOT);
#pragma unroll
            for (int nt = 0; nt < 4; ++nt) { f32x4 a4 = init[nt];
                a4 = __builtin_amdgcn_mfma_f32_16x16x32_bf16(a0, bfr[nt][0], a4, 0, 0, 0); a4 = __builtin_amdgcn_mfma_f32_16x16x32_bf16(a1, bfr[nt][1], a4, 0, 0, 0); S[nt] = a4; }
        }
    }
    asm volatile("s_waitcnt vmcnt(0)" ::: "memory");
#undef RWC_ISSUE
#undef RWC_CIDX
}
template <bool DRY> __device__ __forceinline__ void phase_combine_side(const Frame& F0) {
    PH_ENTER(F0);
    if (F.wave < 4 || F.G != 256) return;
    const int lgid = F.bid * 256 + (F.tid - 256);
    const int sch = lgid >> 9, sd = sch & 1, sbh = sch >> 1; bf16* SSp = (bf16*)(F.ws + WS_SS) + (size_t)sch * NTILE64 * 4096 + (lgid & 511) * 8;
    const float* SDp = (const float*)(F.ws + WS_SDEC) + (size_t)(sbh >> 3) * NTILE64 * 16 + (sbh & 7) * 2 + sd;
    const int gch = lgid >> 10, gd = gch & 1, gbh = gch >> 1, ge0 = (lgid & 1023) * 2; bf16* GSp = (bf16*)(F.ws + WS_GS) + (size_t)gch * NTILE64 * 2048 + ge0;
    const float* GDp = (const float*)(F.ws + WS_GDEC) + (size_t)(gbh >> 2) * NTILE64 * 256 + gd * 128 + (gbh & 3) * 32 + (ge0 & 31);
    float cS[8] = {0.f, 0.f, 0.f, 0.f, 0.f, 0.f, 0.f, 0.f}, cG0 = 0.f, cG1 = 0.f;
    u32x4 pS[4]; float pSd[4]; unsigned pG[4]; f32x2 pGd[4];
#define CS_CIDX(k, dd) ((dd) == 0 ? (k) : ((k) < 4 ? 3 - (k) : 131 - ((k) - 4)))
#define CS_LOAD(SET, k) do { const int cs_ = CS_CIDX(k, sd), cg_ = CS_CIDX(k, gd); pS[SET] = *(const u32x4*)(SSp + (size_t)cs_ * 4096); pSd[SET] = SDp[cs_ * 16]; \
        pG[SET] = *(const unsigned*)(GSp + (size_t)cg_ * 2048); pGd[SET] = *(const f32x2*)(GDp + (size_t)cg_ * 256); } while (0)
    CS_LOAD(0, 0); CS_LOAD(1, 1); CS_LOAD(2, 2);
#pragma unroll 1
    for (int k4 = 0; k4 < NTILE64; k4 += 4) {
#pragma unroll
        for (int j = 0; j < 4; ++j) { const int k = k4 + j, cs = CS_CIDX(k, sd), cg = CS_CIDX(k, gd);
            float f[8]; unpack8(pS[j], f); const float dec = pSd[j]; const unsigned gt = pG[j]; const f32x2 gdec = pGd[j];
            asm volatile("" : "+v"(f[0]), "+v"(f[7]) : "v"(dec), "v"(gt), "v"(gdec.x), "v"(gdec.y) : "memory");
            if (k + 3 < NTILE64) CS_LOAD((j + 3) & 3, k + 3);
            u32x4 o; o.x = pk2(cS[0], cS[1]); o.y = pk2(cS[2], cS[3]); o.z = pk2(cS[4], cS[5]); o.w = pk2(cS[6], cS[7]); if (!DRY) *(u32x4*)(SSp + (size_t)cs * 4096) = o;
#pragma unroll
            for (int i = 0; i < 8; ++i) cS[i] = cS[i] * dec + f[i];
            if (!DRY) *(unsigned*)(GSp + (size_t)cg * 2048) = pk2(cG0, cG1);
            cG0 = cG0 * gdec.x + __uint_as_float(gt << 16); cG1 = cG1 * gdec.y + __uint_as_float(gt & 0xffff0000u); }
    }
#undef CS_LOAD
#undef CS_CIDX
}
__device__ __forceinline__ void phase_finish_rwkv(const Frame& F0) {
    PH_ENTER(F0);
    const AS4 Args* KA = kargs();
    const int lane = F.lane, wave = F.wave;
    const h16* BONUS = (const h16*)(F.ws + WS_BONUS); const h16* GATE = (const h16*)(F.ws + WS_GATE);
    bf16* MIX = (bf16*)((unsigned char*)F.out + OUT_MIX);
    const float* gng = LP(20, 256); const float* gnb = LP(21, 256);
    const int h = wave >> 1, rh = wave & 1, lr = (lane >> 4) * 4, lc = lane & 15, ar = lane & 15, akq = (lane >> 4) * 8;
    const bool skipctx = F.l == 1;
    for (int j_ = F.bid; j_ < n_units(skipctx); j_ += F.G) {
        const int u = unit_of(skipctx, j_);
        const int b = u / NTILE64, c = u % NTILE64; const size_t row0 = (size_t)b * TB + (size_t)c * 64;
        f32x4 acc[2][4];
#pragma unroll
        for (int mi = 0; mi < 2; ++mi)
#pragma unroll
            for (int nt = 0; nt < 4; ++nt) acc[mi][nt] = (f32x4){0.f, 0.f, 0.f, 0.f};
#pragma unroll
        for (int d = 0; d < 2; ++d) { const bf16* om = rw_out(F.ws, b, h, d, c, 2); const bf16* s0 = rw_out(F.ws, b, h, d, c, 1); const bf16* yl = rw_out(F.ws, b, h, d, c, 3);
#pragma unroll
            for (int mi = 0; mi < 2; ++mi) { const int srow = (2 * rh + mi) * 16 + ar, trow = d ? 63 - srow : srow;
                const bf16x8 a0 = *(const bf16x8*)(om + trow * 64 + akq), a1 = *(const bf16x8*)(om + trow * 64 + 32 + akq);
#pragma unroll
                for (int nt = 0; nt < 4; ++nt) { const bf16x8 b0 = *(const bf16x8*)(s0 + (nt * 16 + ar) * 64 + akq), b1 = *(const bf16x8*)(s0 + (nt * 16 + ar) * 64 + 32 + akq);
                    f32x4 a4 = acc[mi][nt];
                    a4 = __builtin_amdgcn_mfma_f32_16x16x32_bf16(a0, b0, a4, 0, 0, 0); a4 = __builtin_amdgcn_mfma_f32_16x16x32_bf16(a1, b1, a4, 0, 0, 0);
#pragma unroll
                    for (int i = 0; i < 4; ++i) { const int s = (2 * rh + mi) * 16 + lr + i, t = d ? 63 - s : s; a4[i] += bf2f(yl[t * 64 + nt * 16 + lc]); }
                    acc[mi][nt] = a4; } } }
#pragma unroll
        for (int mi = 0; mi < 2; ++mi)
#pragma unroll
            for (int i = 0; i < 4; ++i) { const int s = (2 * rh + mi) * 16 + lr + i; const size_t r = row0 + s;
                float y0 = acc[mi][0][i], y1 = acc[mi][1][i], y2 = acc[mi][2][i], y3 = acc[mi][3][i];
                const float mu = sum16((y0 + y1) + (y2 + y3)) * (1.f / 64.f);
                y0 -= mu; y1 -= mu; y2 -= mu; y3 -= mu;
                const float rs = rsqrtf(sum16((y0 * y0 + y1 * y1) + (y2 * y2 + y3 * y3)) * (1.f / 64.f) + 64e-5f);
                const float yy[4] = {y0, y1, y2, y3};
#pragma unroll
                for (int nt = 0; nt < 4; ++nt) { const int cc = h * 64 + nt * 16 + lc;
                    const float o = (yy[nt] * rs * gng[cc] + gnb[cc] + (float)BONUS[r * 256 + cc]) * (float)GATE[r * 256 + cc];
                    MIX[r * D + cc] = (bf16)f2bf(o); } }
    }
}
__device__ __forceinline__ void phase_router(const Frame& F0) {
    PH_ENTER(F0);
    const AS4 Args* KA = kargs();
    const int tid = F.tid, lane = F.lane, wave = F.wave;
    LAS float* WT = (LAS float*)F.lds;
    LAS float* AV = (LAS float*)(F.lds + 100352);
    LAS float* BV = AV + 1024;
    LAS float* CST = BV + 1024;
    LAS float* SQ = CST + 8 * 528;
    LAS float* BW = SQ + 512;
    LAS float* RS = BW + 192;
    LAS int* lcnt = (LAS int*)(RS + 64);
    const float* rgw = LP(31, D * 4); const float* rew = LP(33, D * 16); const float* rgb = LP(32, 4); const float* reb = LP(34, 16);
    for (int k = tid; k < D; k += 512) { LAS float* wr = WT + k * 24 + ((k >> 7) << 4);
#pragma unroll
        for (int e = 0; e < 4; ++e) wr[e] = rgw[k * 4 + e];
#pragma unroll
        for (int e = 0; e < 16; ++e) wr[4 + e] = rew[k * 16 + e];
#pragma unroll
        for (int e = 20; e < 24; ++e) wr[e] = 0.f; }
    if (tid < NCLS) lcnt[tid] = 0;
    const float* g = LP(7, D);
    const float* mod = (const float*)(F.ws + WS_MOD) + (size_t)F.l * 9 * 6144;
    bf16* TOK = (bf16*)(F.ws + WS_ACT); const bf16* XB = (const bf16*)(F.ws + WS_XB);
    int4* TI = (int4*)(F.ws + WS_TOKINFO);
    int* CNT = (int*)(F.ws + WS_CNT);
    const bool skipctx = F.l == 1;
    if (skipctx && F.bid < 32 && tid < NCLS) CNT[((F.bid >> 2) * NTILE64 + (F.bid & 3)) * NCLS + tid] = 0;
    const int rt = wave >> 1, hf = wave & 1, r = lane & 15, gq = lane >> 4, kb = 512 * hf + 128 * gq;
    u32x4 raw[8];
    for (int j_ = F.bid; j_ < n_units(skipctx); j_ += F.G) {
        const int u = unit_of(skipctx, j_);
        const int row = u * 64 + rt * 16 + r;
        const bf16* xr = XB + (size_t)row * D + kb;
        LDS_BARRIER();
        { const float* mrow = mod + (size_t)mod_index(u * 64) * 6144; float p[20];
#pragma unroll
            for (int e = 0; e < 20; ++e) p[e] = 0.f;
#pragma unroll
            for (int i = 0; i < 2; ++i) { const int c = tid + 512 * i; const float bv = mrow[3 * D + c]; AV[c] = g[c] * (mrow[4 * D + c] + 1.f); BV[c] = bv;
                const LAS float* wr = WT + c * 24 + ((c >> 7) << 4);
#pragma unroll
                for (int e = 0; e < 20; ++e) p[e] += bv * wr[e]; }
#pragma unroll
            for (int e = 0; e < 20; ++e) { const float t = wave_sum(p[e]); if (lane == 0) BW[wave * 20 + e] = t; } }
        LDS_BARRIER();
        if (tid < 20) { float t = 0.f;
#pragma unroll
            for (int w = 0; w < 8; ++w) t += BW[w * 20 + tid];
            BW[160 + tid] = t; }
        u32x4 ap[16]; f32x4 acc0 = {0.f, 0.f, 0.f, 0.f}, acc1 = {0.f, 0.f, 0.f, 0.f}; float sq = 0.f;
        const LAS float* wb0 = WT + kb * 24 + ((4 * hf + gq) << 4) + r; const LAS float* wb1 = wb0 + 16 - r + (r & 7);
#pragma unroll
        for (int half = 0; half < 2; ++half) {
#pragma unroll
            for (int s8 = 0; s8 < 8; ++s8) raw[s8] = *(const u32x4*)(xr + (half * 8 + s8) * 8);
#pragma unroll
            for (int s8 = 0; s8 < 8; ++s8) { const int s = half * 8 + s8, k0 = kb + 8 * s;
                float x[8], a[8]; { u32x4 rw = raw[s8]; asm volatile("" : "+v"(rw)); unpack8(rw, x); }
                const f32x4 a0 = *(const LAS f32x4*)(AV + k0), a1 = *(const LAS f32x4*)(AV + k0 + 4);
#pragma unroll
                for (int j = 0; j < 8; ++j) { a[j] = x[j] * (j < 4 ? a0[j & 3] : a1[j & 3]); sq += x[j] * x[j]; }
                { u32x4 pk = pack8(a); asm volatile("" : "+v"(pk)); ap[s] = pk; }
#pragma unroll
                for (int j = 0; j < 8; ++j) { const float b0 = wb0[(8 * s + j) * 24], b1 = wb1[(8 * s + j) * 24];
                    acc0 = __builtin_amdgcn_mfma_f32_16x16x4f32(a[j], b0, acc0, 0, 0, 0); acc1 = __builtin_amdgcn_mfma_f32_16x16x4f32(a[j], b1, acc1, 0, 0, 0); }
                __builtin_amdgcn_sched_barrier(0); } }
#pragma unroll
        for (int i = 0; i < 4; ++i) { CST[wave * 528 + (4 * gq + i) * 33 + r] = acc0[i]; CST[wave * 528 + (4 * gq + i) * 33 + 16 + r] = acc1[i]; }
        SQ[wave * 64 + r * 4 + gq] = sq;
        LDS_BARRIER();
        if (tid < 64) { const int rr = tid, rt_ = rr >> 4, r_ = rr & 15;
            float ss = 0.f;
#pragma unroll
            for (int i = 0; i < 4; ++i) ss += SQ[(2 * rt_) * 64 + r_ * 4 + i] + SQ[(2 * rt_ + 1) * 64 + r_ * 4 + i];
            const float rs = rsqrtf(ss * (1.f / D) + 1e-6f);
            float lg[20];
#pragma unroll
            for (int e = 0; e < 20; ++e) lg[e] = (CST[(2 * rt_) * 528 + r_ * 33 + e] + CST[(2 * rt_ + 1) * 528 + r_ * 33 + e]) * rs + BW[160 + e];
            float gl0 = lg[0] + rgb[0], gl1 = lg[1] + rgb[1], gl2 = lg[2] + rgb[2], gl3 = lg[3] + rgb[3];
            int gs = 0; float gm = gl0;
            if (gl1 > gm) { gm = gl1; gs = 1; } if (gl2 > gm) { gm = gl2; gs = 2; } if (gl3 > gm) { gm = gl3; gs = 3; }
            const float pg = 1.f / (__expf(gl0 - gm) + __expf(gl1 - gm) + __expf(gl2 - gm) + __expf(gl3 - gm));
            float e0, e1, e2, e3;
            e0 = gs == 0 ? lg[4] : (gs == 1 ? lg[8] : (gs == 2 ? lg[12] : lg[16])); e1 = gs == 0 ? lg[5] : (gs == 1 ? lg[9] : (gs == 2 ? lg[13] : lg[17]));
            e2 = gs == 0 ? lg[6] : (gs == 1 ? lg[10] : (gs == 2 ? lg[14] : lg[18])); e3 = gs == 0 ? lg[7] : (gs == 1 ? lg[11] : (gs == 2 ? lg[15] : lg[19]));
            e0 += reb[gs * 4 + 0]; e1 += reb[gs * 4 + 1]; e2 += reb[gs * 4 + 2]; e3 += reb[gs * 4 + 3];
            int i1 = 0; float m1 = e0;
            if (e1 > m1) { m1 = e1; i1 = 1; } if (e2 > m1) { m1 = e2; i1 = 2; } if (e3 > m1) { m1 = e3; i1 = 3; }
            int i2 = -1; float m2 = -3.0e38f;
            if (i1 != 0 && e0 > m2) { m2 = e0; i2 = 0; } if (i1 != 1 && e1 > m2) { m2 = e1; i2 = 1; } if (i1 != 2 && e2 > m2) { m2 = e2; i2 = 2; } if (i1 != 3 && e3 > m2) { m2 = e3; i2 = 3; }
            const float p1 = 1.f, p2 = __expf(m2 - m1);
            const float w1 = pg * p1 / (p1 + p2), w2 = pg * p2 / (p1 + p2);
            const int lo = i1 < i2 ? i1 : i2, hi = i1 < i2 ? i2 : i1;
            const int pr = lo == 0 ? hi - 1 : (lo == 1 ? hi + 1 : 5);
            const int cls = gs * 6 + pr;
            const float wa = i1 < i2 ? w1 : w2, wb = i1 < i2 ? w2 : w1;
            const int rank = atomicAdd((int*)(lcnt + cls), 1);
            TI[u * 64 + rr] = make_int4(cls, __float_as_int(wa), __float_as_int(wb), rank); }
        { const f32x4 q0 = *(const LAS f32x4*)(SQ + (2 * rt) * 64 + r * 4), q1 = *(const LAS f32x4*)(SQ + (2 * rt + 1) * 64 + r * 4);
            const float rs = rsqrtf((((q0.x + q1.x) + (q0.y + q1.y)) + ((q0.z + q1.z) + (q0.w + q1.w))) * (1.f / D) + 1e-6f); bf16* tr = TOK + (size_t)row * D + kb;
#pragma unroll
            for (int s = 0; s < 16; ++s) { const int k0 = kb + 8 * s; float a[8]; { u32x4 pk = ap[s]; asm volatile("" : "+v"(pk)); unpack8(pk, a); }
                const f32x4 b0 = *(const LAS f32x4*)(BV + k0), b1 = *(const LAS f32x4*)(BV + k0 + 4);
#pragma unroll
                for (int j = 0; j < 8; ++j) a[j] = a[j] * rs + (j < 4 ? b0[j & 3] : b1[j & 3]);
                *(u32x4*)(tr + 8 * s) = pack8(a); __builtin_amdgcn_sched_barrier(0); } }
        if (tid < NCLS) { CNT[u * NCLS + tid] = lcnt[tid]; lcnt[tid] = 0; }
    }
}

__device__ __forceinline__ void phase_scatter(const Frame& F0) {
    PH_ENTER(F0);
    const int tid = F.tid, lane = F.lane, wave = F.wave;
    LAS int* C = (LAS int*)F.lds;
    LAS int* tot = (LAS int*)(F.lds + 102400);
    LAS int* cs = (LAS int*)(F.lds + 102400 + 128);
    LAS int* base = (LAS int*)(F.lds + 102400 + 256);
    const int* CNT = (const int*)(F.ws + WS_CNT);
    int* MI = (int*)(F.ws + WS_CNT) + NUNIT64 * NCLS;
    for (int i = tid; i < NUNIT64 * NCLS; i += 512) C[i] = CNT[i];
    LDS_BARRIER();
    if (tid < NCLS * 16) { const int c = tid >> 4, s16 = tid & 15; int part = 0; for (int uu = s16; uu < NUNIT64; uu += 16) part += C[uu * NCLS + c];
        const float pf = sum16((float)part); if (s16 == 0) tot[c] = (int)pf; }
    LDS_BARRIER();
    if (tid == 0) { int s = 0; for (int c = 0; c < NCLS; ++c) { cs[c] = s; s += (tot[c] + 255) & ~255; } cs[NCLS] = s; }
    LDS_BARRIER();
    if (F.bid == 0 && tid <= NCLS) MI[tid] = cs[tid];
    const int4* TI = (const int4*)(F.ws + WS_TOKINFO);
    int* LIST = (int*)(F.ws + WS_LIST); f32x2* WSL = (f32x2*)(F.ws + WS_WSLOT);
    for (int c = F.bid; c < NCLS; c += F.G) {
        const int s0 = cs[c] + tot[c], s1 = cs[c + 1];
        for (int s = s0 + tid; s < s1; s += 512) { LIST[s] = -1; WSL[s] = (f32x2){0.f, 0.f}; }
    }
    const bool skipctx = F.l == 1;
    for (int j_ = F.bid; j_ < n_units(skipctx); j_ += F.G) {
        const int u = unit_of(skipctx, j_);
        LDS_BARRIER();
        if (tid < NCLS * 16) { const int c = tid >> 4, s = tid & 15; int part = 0; for (int uu = s; uu < u; uu += 16) part += C[uu * NCLS + c];
            float pf = sum16((float)part);
            if (s == 0) base[c] = cs[c] + (int)pf; }
        LDS_BARRIER();
        {
#pragma unroll
            for (int rr = 0; rr < 8; ++rr) { const int row = u * 64 + wave * 8 + rr;
                if (lane == 0) { const int4 ti = TI[row]; const int slot = base[ti.x] + ti.w; LIST[slot] = row; WSL[slot] = (f32x2){__int_as_float(ti.y), __int_as_float(ti.z)}; } } }
    }
}

__device__ __forceinline__ void phase_final(const Frame& F0) {
    PH_ENTER(F0);
    const AS4 Args* KA = kargs();
    const int gw = F.bid * 8 + F.wave, NGW = F.G * 8, lane = F.lane;
    const float* g = INP(38);
    constexpr int NR = NB * TL; const int R = (NR + NGW - 1) / NGW, r0 = gw * R, r1 = min(NR, r0 + R);
    const bf16* XB = (const bf16*)(F.ws + WS_XB);
    f32x4 G4[4]; u32x2 nv[4];
#pragma unroll
    for (int j = 0; j < 4; ++j) G4[j] = *(const f32x4*)(g + 4 * lane + 256 * j);
#define FN_ROW(r) (XB + ((size_t)((r) / TL) * TB + TC + (r) % TL) * D)
    if (r0 < r1) { const u32x2* xr = (const u32x2*)FN_ROW(r0) + lane;
#pragma unroll
        for (int j = 0; j < 4; ++j) nv[j] = xr[64 * j]; }
    for (int row = r0; row < r1; ++row) {
        f32x4 v[4];
#pragma unroll
        for (int j = 0; j < 4; ++j) v[j] = bf4(nv[j]);
        if (row + 1 < r1) { const u32x2* xn = (const u32x2*)FN_ROW(row + 1) + lane;
#pragma unroll
            for (int j = 0; j < 4; ++j) nv[j] = xn[64 * j]; }
        float s = 0.f;
#pragma unroll
        for (int j = 0; j < 4; ++j) s += (v[j].x * v[j].x + v[j].y * v[j].y) + (v[j].z * v[j].z + v[j].w * v[j].w);
        const float rs = rsqrtf(wave_sum(s) * (1.f / D) + 1e-6f);
        f32x4* xr = (f32x4*)(F.out + (size_t)row * D) + lane;
#pragma unroll
        for (int j = 0; j < 4; ++j) xr[64 * j] = v[j] * rs * G4[j];
    }
#undef FN_ROW
}

constexpr int PH_PER_LAYER = 12, PH_FINAL = 1 + 2 * PH_PER_LAYER, PH_END = PH_FINAL + 1;
template <int L> __device__ __forceinline__ void run_layer(Frame& F0, const XcdBarrier& bar, const int lo, const int hi) {
    constexpr int l = L;
#define IN(k) (lo <= (k) && (k) < hi)
#define SEAM(k) do { if (IN(k) && IN((k) + 1)) { XcdBarrier bb = bar; GAS unsigned* _b = (GAS unsigned*)bb.bar; asm volatile("" : "+s"(_b)); bb.bar = (unsigned*)_b; xcd_barrier(bb); STAMP(F0); } } while (0)
        F0.l = l;
        const int pb = 1 + PH_PER_LAYER * l;
        if (HAS(1) && IN(pb + 1)) { for (int rep = 0; rep < REP(1); ++rep) phase_norm1(F0); if (l == 1 && HAS(0)) phase_convert(F0); } SEAM(pb + 1);
        if (HAS(2) && IN(pb + 2)) {
            PH_ENTER(F0);
            SchedStatic S; S.nM = T / 256; S.nN = IN_PAD / 256; S.nwg = S.nM * S.nN; S.G = F.G; S.c = F.bid; S.ws = F.ws; S.wsA = F.ws; S.offA = WS_ACT; S.offB = WS_WIN; S.skipctx = 0;
            EpiU E{F.ws};
            for (int rep = 0; rep < REP(2); ++rep) pg8::gemm_phase<EpiU, SchedStatic, true, false, 1024>(F.lds, F.tid, S, E);
        } SEAM(pb + 2);
        if (HAS(3) && IN(pb + 3)) { phase_conv(F0); for (int rep = 0; rep < REP(3); ++rep) phase_prep(F0); } SEAM(pb + 3);
#define GBAR() do { if (hi - lo > 1) { XcdBarrier bb = bar; GAS unsigned* _b = (GAS unsigned*)bb.bar; asm volatile("" : "+s"(_b)); bb.bar = (unsigned*)_b; xcd_barrier(bb); STAMP(F0); } } while (0)
        if (HAS(4) && IN(pb + 5)) {
            if (MK_PROBE_RW >= 1) { phase_rwkv_local(F0); GBAR(); if (MK_PROBE_RW >= 2) { phase_rwkv_combine<false>(F0); GBAR(); } phase_prep(F0); GBAR(); }
            if (MK_PROBE_RW == 0) { for (int rep = 0; rep < REP(4); ++rep) phase_states(F0); } phase_rwkv_local(F0); if (MK_PROBE_RW) { GBAR(); phase_states(F0); GBAR(); } if (F0.G != 256) { phase_combine_ssd(F0); phase_combine_gla(F0); } GBAR(); if (MK_PROBE_COMB & 1) phase_rwkv_combine<true>(F0); if (MK_PROBE_COMB & 2) phase_combine_side<true>(F0); if (MK_PROBE_COMB) GBAR(); phase_rwkv_combine<false>(F0); phase_combine_side<false>(F0); } SEAM(pb + 5);
        if (HAS(6) && IN(pb + 6)) { phase_finish_rwkv(F0); phase_finish_ssd(F0); phase_finish_gla(F0); } SEAM(pb + 6);
#undef GBAR
        if (HAS(7) && IN(pb + 7)) {
            PH_ENTER(F0);
            const AS4 Args* KA = kargs();
            SchedStatic S; S.skipctx = (F.l == 1); S.nM = S.skipctx ? NB * TL / 256 : T / 256; S.nN = D / 256; S.nwg = S.nM * S.nN; S.G = F.G; S.c = F.bid; S.ws = F.ws; S.wsA = (const unsigned char*)F.out; S.offA = OUT_MIX; S.offB = WS_WOUT;
            EpiRes E{INP(0), INP(2), F.ws, F.l};
            pg8::gemm_phase<EpiRes, SchedStatic, true, false, 1024>(F.lds, F.tid, S, E);
        } SEAM(pb + 7);
        if (HAS(8) && IN(pb + 8)) { for (int rep = 0; rep < REP(8); ++rep) phase_router(F0); } SEAM(pb + 8);
        if (HAS(9) && IN(pb + 9)) { for (int rep = 0; rep < REP(9); ++rep) phase_scatter(F0); } SEAM(pb + 9);
        if (IN(pb + 10) || IN(pb + 11)) {
            PH_ENTER(F0);
            LAS int* cs = (LAS int*)(F.lds + CSTAB_OFF);
            const int* MI = (const int*)(F.ws + WS_CNT) + NUNIT64 * NCLS;
            __syncthreads();
            if (F.tid <= NCLS) cs[F.tid] = MI[F.tid];
            __syncthreads();
        }
        if (HAS(10) && IN(pb + 10)) {
            PH_ENTER(F0);
            LAS int* cs = (LAS int*)(F.lds + CSTAB_OFF);
            SchedMoE<8> S; S.ntiles = cs[NCLS] / 256; S.G = F.G; S.c = F.bid; S.cs = cs; S.ws = F.ws;
            EpiSwiGLU E{F.ws};
            for (int rep = 0; rep < REP(10); ++rep) pg8::gemm_phase<EpiSwiGLU, SchedMoE<8>, true, false, 1024, true>(F.lds, F.tid, S, E);
        } SEAM(pb + 10);
        if (HAS(11) && IN(pb + 11)) {
            PH_ENTER(F0);
            LAS int* cs = (LAS int*)(F.lds + CSTAB_OFF);
            SchedMoE<4> S; S.ntiles = cs[NCLS] / 256; S.G = F.G; S.c = F.bid; S.cs = cs; S.ws = F.ws;
            EpiScatter E{F.ws, F.l};
            pg8::gemm_phase<EpiScatter, SchedMoE<4>, true, true, 512>(F.lds, F.tid, S, E);
        } SEAM(pb + 11);
    }
#undef IN
#undef SEAM
__global__ void __launch_bounds__(512, 2) mk_fwd(Args args) {
    extern __shared__ __attribute__((aligned(16))) unsigned char lds_raw[];
    Frame F0;
    F0.lds = (LAS unsigned char*)lds_raw;
    F0.tid = threadIdx.x; F0.lane = F0.tid & 63; F0.wave = __builtin_amdgcn_readfirstlane(F0.tid >> 6);
    F0.G = gridDim.x; F0.bid = blockIdx.x; F0.out = args.out; F0.ws = args.ws; F0.l = 0;
    F0.seamc = 0; F0.tA = MK_TB >= 0 ? (unsigned)__builtin_amdgcn_s_memrealtime() : 0u; F0.tB = F0.tA;
    for (int u = F0.tid; u < (LDS_BYTES - LDSCTL_OFF) / 4; u += 512) ((LAS unsigned*)(F0.lds + LDSCTL_OFF))[u] = 0u;
    __syncthreads();
    const int lo = args.ph_lo, hi = args.ph_hi;
    const bool use_bar = (hi - lo) > 1;
    XcdBarrier bar; bar.bar = (unsigned*)(F0.ws + WS_CTL) + CW_BAR; bar.x = 0; bar.st = nullptr;
    if (use_bar) bar = xcd_barrier_post((unsigned*)(F0.ws + WS_CTL) + CW_BAR, (volatile LAS unsigned*)(F0.lds + MISC_OFF) + 8);
#define IN(k) (lo <= (k) && (k) < hi)
#define SEAM(k) do { if (IN(k) && IN((k) + 1)) { XcdBarrier bb = bar; GAS unsigned* _b = (GAS unsigned*)bb.bar; asm volatile("" : "+s"(_b)); bb.bar = (unsigned*)_b; xcd_barrier(bb); STAMP(F0); } } while (0)
    if (HAS(12) && IN(0)) { phase_mods(F0); } if (HAS(0) && IN(0)) { F0.l = 0; phase_convert(F0); } SEAM(0);
    run_layer<0>(F0, bar, lo, hi);
    run_layer<1>(F0, bar, lo, hi);
    if (HAS(13) && IN(PH_FINAL)) { phase_final(F0); }
    if (MK_TB >= 0) { if (MK_TB >= 100) F0.tB = (unsigned)__builtin_amdgcn_s_memrealtime(); if (F0.bid == 0 && F0.tid == 0) { const unsigned t0_ = (unsigned)__builtin_amdgcn_s_memrealtime(), span = (unsigned)MK_TK * (F0.tB - F0.tA); while ((unsigned)__builtin_amdgcn_s_memrealtime() - t0_ < span) __builtin_amdgcn_s_sleep(8); } }
#undef IN
#undef SEAM
}

extern "C" void kernel_launch(void* const* d_in, const int* in_sizes, int n_in, void* d_out, int out_size, void* d_ws, size_t ws_size, hipStream_t stream) {
    static int grid = 0;
    if (grid == 0) {
        if (n_in != 39 || ws_size < WS_END) { fprintf(stderr, "kernel_launch: unexpected n_in %d / ws %zu\n", n_in, ws_size); grid = -1; return; }
        int dev = 0, cus = 0;
        if (hipGetDevice(&dev) != hipSuccess || hipDeviceGetAttribute(&cus, hipDeviceAttributeMultiprocessorCount, dev) != hipSuccess) { grid = -1; return; }
        if (hipFuncSetAttribute((const void*)mk_fwd, hipFuncAttributeMaxDynamicSharedMemorySize, LDS_BYTES) != hipSuccess) { fprintf(stderr, "kernel_launch: hipFuncSetAttribute failed\n"); grid = -1; return; }
        int per_cu = 0;
        (void)hipOccupancyMaxActiveBlocksPerMultiprocessor(&per_cu, (const void*)mk_fwd, 512, LDS_BYTES);
        (void)hipGetLastError();
        grid = cus;
    }
    if (grid < 0) return;
    (void)hipMemsetAsync((char*)d_ws + WS_CTL, 0, CTL_ZERO_BYTES, stream);
    Args a{};
    for (int i = 0; i < 39; ++i) a.in[i] = (const float*)d_in[i];
    a.out = (float*)d_out; a.ws = (unsigned char*)d_ws;
#if MK_ONE_LAUNCH
    a.ph_lo = 0; a.ph_hi = PH_END;
    hipLaunchKernelGGL(mk_fwd, dim3(grid), dim3(512), LDS_BYTES, stream, a);
#else
    for (int ph = 0; ph < PH_END; ++ph) { a.ph_lo = ph; a.ph_hi = ph + 1; hipLaunchKernelGGL(mk_fwd, dim3(grid), dim3(512), LDS_BYTES, stream, a); }
#endif
}
```

```cpp
#include <hip/hip_runtime.h>
#include <cstdio>
#include <cstdint>

#define GAS __attribute__((address_space(1)))
#define LAS __attribute__((address_space(3)))
typedef unsigned short bf16;
typedef short bf16x8 __attribute__((ext_vector_type(8)));
typedef float f32x4 __attribute__((ext_vector_type(4)));
typedef float f32x2 __attribute__((ext_vector_type(2)));
typedef unsigned u32x4 __attribute__((ext_vector_type(4)));
typedef unsigned u32x2 __attribute__((ext_vector_type(2)));
typedef _Float16 h16;
typedef _Float16 h16x8 __attribute__((ext_vector_type(8)));
typedef _Float16 h16x4 __attribute__((ext_vector_type(4)));

#ifndef MK_ONE_LAUNCH
#define MK_ONE_LAUNCH 1
#endif
#ifndef MK_PHMASK
#define MK_PHMASK 0xffffffffu
#endif
#define HAS(k) ((MK_PHMASK >> (k)) & 1u)
#ifndef MK_REP
#define MK_REP 0u
#endif
#define REP(k) (((MK_REP >> (k)) & 1u) ? 2 : 1)
#ifndef MK_SUB
#define MK_SUB 0u
#endif
#ifndef MK_PROBE_RW
#define MK_PROBE_RW 0
#endif
#ifndef MK_PROBE_COMB
#define MK_PROBE_COMB 0
#endif
#ifndef MK_TA
#define MK_TA -1
#endif
#ifndef MK_TB
#define MK_TB -2
#endif
#ifndef MK_TK
#define MK_TK 4
#endif
#ifndef MK_TSEC
#define MK_TSEC 0
#endif
#define TS_B(id) unsigned _ts##id = 0u; if (MK_TSEC == (id)) _ts##id = (unsigned)__builtin_amdgcn_s_memrealtime()
#define TS_E(id) do { if (MK_TSEC == (id) && F.bid == 0 && F.tid == 0) *(LAS unsigned*)(F.lds + MISC_OFF + 128) += (unsigned)__builtin_amdgcn_s_memrealtime() - _ts##id; } while (0)
#define STAMP(F) do { if (MK_TB >= 0) { if ((F).seamc == MK_TA) (F).tA = (unsigned)__builtin_amdgcn_s_memrealtime(); if ((F).seamc == MK_TB) (F).tB = (unsigned)__builtin_amdgcn_s_memrealtime(); ++(F).seamc; } } while (0)
#define SUBREP(k) for (int _r = 0; _r < ((((MK_SUB) >> (k)) & 1u) ? 2 : 1); ++_r)

constexpr int D = 1024, NB = 8, TL = 8192, TC = 256, TB = TL + TC, T = NB * TB;
constexpr int NTILE64 = TB / 64;
constexpr int IN_COLS = 3096, IN_PAD = 3328;
constexpr int NCLS = 24, MAXSLOT = T + NCLS * 256;
constexpr int NUNIT64 = NB * NTILE64;

constexpr size_t MiB = 1u << 20;
constexpr size_t WS_CTL = 0, CTL_ZERO_BYTES = 1 * MiB;
constexpr size_t WS_MOD = 1 * MiB;
constexpr size_t WS_CNT = 2 * MiB;
constexpr size_t WS_TOKINFO = 3 * MiB;
constexpr size_t WS_LIST = 5 * MiB;
constexpr size_t WS_WSLOT = 6 * MiB;
constexpr size_t WS_WIN = 16 * MiB;
constexpr size_t WS_WOUT = 23 * MiB;
constexpr size_t WS_W13 = 25 * MiB;
constexpr size_t WS_W2T = 57 * MiB;
constexpr size_t WS_ACT = 74 * MiB;
constexpr size_t WS_REC = 74 * MiB;
constexpr size_t WS_RECS = WS_REC, WS_RECD = WS_REC + (size_t)T * 4 * 256 * 2;
constexpr size_t WS_LOWR = 73 * MiB;
constexpr size_t WS_TOKS = 206 * MiB;
constexpr size_t WS_URW = 371 * MiB;
constexpr size_t WS_SS = 371 * MiB;
constexpr size_t WS_GS = 503 * MiB;
constexpr size_t WS_SDEC = 7 * MiB;
constexpr size_t WS_H1 = 371 * MiB;
constexpr size_t WS_UXBC = 503 * MiB;
constexpr size_t WS_UZ = 602 * MiB;
constexpr size_t WS_UGLA = 668 * MiB;
constexpr size_t WS_UMISC = 767 * MiB;
constexpr size_t WS_XB = 776 * MiB;
constexpr size_t OUT_XBCA = 0;
constexpr size_t OUT_MIX = 99 * MiB;
constexpr size_t WS_BONUS = 946 * MiB;
constexpr size_t WS_GATE = 908 * MiB;
constexpr size_t WS_GDEC = 941 * MiB;
constexpr size_t WS_RPL = 943 * MiB;
constexpr size_t WS_END = 979 * MiB;
static_assert(WS_RECD + (size_t)T * 8 * 128 * 2 <= WS_URW, "records fit");
static_assert(WS_SS + (size_t)128 * 132 * 4096 * 2 <= WS_GS && WS_GS + (size_t)64 * 132 * 2048 * 2 <= WS_UZ, "state buffers fit");
static_assert(WS_TOKS + (size_t)MAXSLOT * 1024 * 2 <= WS_H1, "toks fits");
static_assert(WS_XB + (size_t)T * 1024 * 2 <= WS_GATE && OUT_XBCA + (size_t)T * 768 * 2 <= OUT_MIX && OUT_MIX + (size_t)T * 1024 * 2 <= (size_t)NB * TL * D * 4 && WS_RPL + (size_t)64 * 132 * 64 * 4 <= WS_BONUS && WS_BONUS + (size_t)T * 256 * 2 <= WS_END, "stream / d_out scratch fit");
static_assert(WS_H1 + (size_t)MAXSLOT * 1024 * 2 <= WS_UMISC, "h1 fits");

constexpr int CW_BAR = 4096;

constexpr int RING_BYTES = 131072;
constexpr int LDS_BYTES = 163840;
constexpr int LDSCTL_OFF = LDS_BYTES - 2048, MISC_OFF = LDSCTL_OFF + 320, CSTAB_OFF = LDSCTL_OFF + 1024;

#define RLX_AGENT __ATOMIC_RELAXED, __HIP_MEMORY_SCOPE_AGENT
#define LDS_WAIT() asm volatile("s_waitcnt lgkmcnt(0)" ::: "memory")
#define LDS_BARRIER() asm volatile("s_waitcnt lgkmcnt(0)\n\ts_barrier" ::: "memory")
#define VM_WAIT() asm volatile("s_waitcnt vmcnt(0)" ::: "memory")
__device__ __forceinline__ float bf2f(unsigned short h) { return __uint_as_float(((unsigned)h) << 16); }
typedef __bf16 hwbf16x2 __attribute__((ext_vector_type(2)));
__device__ __forceinline__ unsigned pk2(float lo, float hi) { const f32x2 v = {lo, hi}; const hwbf16x2 b = __builtin_convertvector(v, hwbf16x2); return __builtin_bit_cast(unsigned, b); }
__device__ __forceinline__ unsigned f2bf(float f) { return pk2(f, 0.f) & 0xffffu; }
__device__ __forceinline__ float frcp(float x) { return __builtin_amdgcn_rcpf(x); }
__device__ __forceinline__ float sigm(float x) { return frcp(1.f + __expf(-x)); }
__device__ __forceinline__ float siluf(float x) { return x * frcp(1.f + __expf(-x)); }
__device__ __forceinline__ float tanh_fast(float x) { return 1.f - 2.f * frcp(1.f + __expf(2.f * x)); }
__device__ __forceinline__ float softplusf_(float x) { return x > 20.f ? x : log1pf(__expf(x)); }
__device__ __forceinline__ void unpack8(u32x4 v, float* o) {
    o[0] = __uint_as_float(v.x << 16); o[1] = __uint_as_float(v.x & 0xffff0000u); o[2] = __uint_as_float(v.y << 16); o[3] = __uint_as_float(v.y & 0xffff0000u);
    o[4] = __uint_as_float(v.z << 16); o[5] = __uint_as_float(v.z & 0xffff0000u); o[6] = __uint_as_float(v.w << 16); o[7] = __uint_as_float(v.w & 0xffff0000u);
}
__device__ __forceinline__ f32x4 bf4(u32x2 w) { return (f32x4){__uint_as_float(w.x << 16), __uint_as_float(w.x & 0xffff0000u), __uint_as_float(w.y << 16), __uint_as_float(w.y & 0xffff0000u)}; }
__device__ __forceinline__ u32x4 pack8(const float* o) { u32x4 v; v.x = pk2(o[0], o[1]); v.y = pk2(o[2], o[3]); v.z = pk2(o[4], o[5]); v.w = pk2(o[6], o[7]); return v; }
__device__ __forceinline__ int launder_i(int v) { asm volatile("" : "+v"(v)); return v; }
template <int CTRL> __device__ __forceinline__ float dpp_mov(float v) { return __int_as_float(__builtin_amdgcn_update_dpp(0, __float_as_int(v), CTRL, 0xf, 0xf, false)); }
__device__ __forceinline__ float sum8(float v) { v += dpp_mov<0xB1>(v); v += dpp_mov<0x4E>(v); v += dpp_mov<0x141>(v); return v; }
__device__ __forceinline__ float sum16(float v) { v = sum8(v); v += dpp_mov<0x140>(v); return v; }
__device__ __forceinline__ float wave_sum(float v) {
    v = sum16(v);
    v += __int_as_float(__builtin_amdgcn_update_dpp(0, __float_as_int(v), 0x142, 0xa, 0xf, false));
    v += __int_as_float(__builtin_amdgcn_update_dpp(0, __float_as_int(v), 0x143, 0xc, 0xf, false));
    return __int_as_float(__builtin_amdgcn_readlane(__float_as_int(v), 63));
}

namespace pg8 {
constexpr int BM = 256, BK = 64, HALF = 128, HTB = HALF * BK * 2, STAGE_BYTES = 8 * HTB, NXCD = 8, WGM = 8;
__host__ __device__ __forceinline__ int lds_byte(int r, int c) { const int st = (r >> 4) * 2 + (c >> 5), rr = r & 15, cc = c & 31, ob = rr * 64 + cc * 2; return st * 1024 + (ob ^ (((ob >> 9) & 1) << 5)); }
__host__ __device__ __forceinline__ void stage_rc(int b, int& R, int& C) { const int st = b / 1024, sb = b % 1024, swz = sb ^ (((sb >> 9) & 1) << 5); R = (st >> 1) * 16 + swz / 64; C = (st & 1) * 32 + (swz % 64) / 2; }
__host__ __device__ __forceinline__ int perm32(int rho) { const int n = rho >> 4, i = rho & 15; return 8 * (i >> 2) + 4 * n + (i & 3); }
struct Unit { int pm, pn, aux, hm; };
__device__ __forceinline__ const GAS char* uni_ptr(const char* p) { const unsigned long long v = (unsigned long long)p;
    const unsigned lo = __builtin_amdgcn_readfirstlane((unsigned)v), hi = __builtin_amdgcn_readfirstlane((unsigned)(v >> 32)); return (const GAS char*)(((unsigned long long)hi << 32) | lo); }
__device__ __forceinline__ unsigned cvt_pk_bf16(float lo, float hi) { unsigned r; asm volatile("v_cvt_pk_bf16_f32 %0, %1, %2" : "=v"(r) : "v"(lo), "v"(hi)); return r; }

template <class Epi, class Sched, bool ALIGN_EPI, bool KSPLIT, int LDB, bool GATHER = false, bool SPLIT = false>
__device__ __forceinline__ void gemm_phase(LAS unsigned char* lds, const int tid, const Sched& S, const Epi& E) {
    constexpr int K = 1024, nt = K / BK, ntb = KSPLIT ? nt / 2 : nt;
    const int wid = __builtin_amdgcn_readfirstlane(tid >> 6), lane = tid & 63, wr = wid >> 2, wc = wid & 3, fr = lane & 15, fq = lane >> 4;
    unsigned voffA[2], voffB[2];
#pragma unroll
    for (int i = 0; i < 2; ++i) { int R, C; stage_rc(tid * 16 + i * 8192, R, C); const int Rb = Epi::PERM ? ((R & ~31) + perm32(R & 31)) : R;
        voffA[i] = (unsigned)(R * K + C) * 2u; voffB[i] = (unsigned)(Rb * LDB + C) * 2u; }
    unsigned cvA[2][2], nvA[2][2]; int arow[2][2];
#pragma unroll
    for (int i = 0; i < 2; ++i) { int R, C; stage_rc(tid * 16 + i * 8192, R, C); arow[0][i] = R; arow[1][i] = C * 2; }
    constexpr size_t kstep = (size_t)(BK * 2);
    constexpr size_t hstepA = (size_t)HALF * K * 2, hstepB = (size_t)HALF * LDB * 2;
    const unsigned ldsw = (unsigned)wid * 1024u;
    const int aoff = lds_byte(wr * 64 + fr, fq * 8), boff = lds_byte(wc * 32 + fr, fq * 8);
#define PG8_SA(b, h) (((b) * 2 + (h)) * HTB)
#define PG8_SB(b, h) ((4 + (b) * 2 + (h)) * HTB)
#define PG8_STAGE(bufoff, gbase, voff) do { const GAS char* _gb = (const GAS char*)(gbase); _Pragma("unroll") for (int _i = 0; _i < 2; ++_i) \
        __builtin_amdgcn_global_load_lds((const GAS unsigned*)(_gb + (voff)[_i]), (LAS unsigned*)(lds + (bufoff) + ldsw + _i * 8192), 16, 0, 0); } while (0)
#define PG8_LDA(dst, b, h) do { _Pragma("unroll") for (int m = 0; m < 4; ++m) _Pragma("unroll") for (int k = 0; k < 2; ++k) dst[m][k] = *(const LAS bf16x8*)(lds + PG8_SA(b, h) + aoff + m * 2048 + k * 1024); } while (0)
#define PG8_LDB(dst, b, h) do { _Pragma("unroll") for (int n = 0; n < 2; ++n) _Pragma("unroll") for (int k = 0; k < 2; ++k) dst[n][k] = *(const LAS bf16x8*)(lds + PG8_SB(b, h) + boff + n * 2048 + k * 1024); } while (0)
#define PG8_MMA(ai, bj, At, Bt) do { __builtin_amdgcn_s_setprio(1); _Pragma("unroll") for (int m = 0; m < 4; ++m) _Pragma("unroll") for (int n = 0; n < 2; ++n) _Pragma("unroll") for (int k = 0; k < 2; ++k) \
        acc[ai][bj][m][n] = __builtin_amdgcn_mfma_f32_16x16x32_bf16(Bt[n][k], At[m][k], acc[ai][bj][m][n], 0, 0, 0); __builtin_amdgcn_s_setprio(0); } while (0)
#define PG8_WAIT_V(n) asm volatile("s_waitcnt vmcnt(" #n ")" ::: "memory")
#define PG8_WAIT_L(n) asm volatile("s_waitcnt lgkmcnt(" #n ")" ::: "memory")
#define PG8_BAR __builtin_amdgcn_s_barrier()
#define PG8_SCHED __builtin_amdgcn_sched_barrier(0)
#define PG8_KLOOP(M0, M1) do { _Pragma("unroll 1")         for (int t = 0; t < nt; t += 2) { \
            const bool last = (t == nt - 2); \
            const char* a1 = cA + (size_t)(t + 1) * kstep; \
            const char* a2; const char* b2; \
            if (last) { a2 = has_next ? S.aptr(nxt) : cA; b2 = has_next ? S.bptr(nxt) : cB; } \
            else { a2 = cA + (size_t)(t + 2) * kstep; if (KSPLIT && t + 2 >= ntb) b2 = S.bptr2(cur) + (size_t)(t + 2 - ntb) * kstep; else b2 = cB + (size_t)(t + 2) * kstep; } \
            a2 = (const char*)uni_ptr(a2); b2 = (const char*)uni_ptr(b2); \
            const char* a3 = a2 + kstep; const char* b3 = b2 + kstep; \
            PG8_LDB(B0, 0, 0); PG8_LDB(B1, 0, 1); PG8_SCHED; PG8_LDA(At, 0, 0); PG8_STAGE_A(PG8_SA(1, 1), a1, 1, false); \
            PG8_WAIT_V(8); PG8_WAIT_L(0); PG8_BAR; if (M0) PG8_MMA(0, 0, At, B0); if (M1) PG8_MMA(0, 1, At, B1); PG8_BAR; PG8_SCHED; \
            PG8_LDA(At, 0, 1); PG8_STAGE(PG8_SB(0, 0), b2, voffB); PG8_STAGE(PG8_SB(0, 1), b2 + hstepB, voffB); PG8_STAGE_A(PG8_SA(0, 0), a2, 0, last); \
            PG8_WAIT_V(8); PG8_WAIT_L(0); PG8_BAR; if (M0) PG8_MMA(1, 0, At, B0); if (M1) PG8_MMA(1, 1, At, B1); PG8_BAR; PG8_SCHED; \
            PG8_LDB(B0, 1, 0); PG8_LDB(B1, 1, 1); PG8_SCHED; PG8_LDA(At, 1, 0); PG8_STAGE_A(PG8_SA(0, 1), a2, 1, last); \
            PG8_WAIT_V(8); PG8_WAIT_L(0); PG8_BAR; if (M0) PG8_MMA(0, 0, At, B0); if (M1) PG8_MMA(0, 1, At, B1); PG8_BAR; PG8_SCHED; \
            PG8_LDA(At, 1, 1); PG8_STAGE(PG8_SB(1, 0), b3, voffB); PG8_STAGE(PG8_SB(1, 1), b3 + hstepB, voffB); PG8_STAGE_A(PG8_SA(1, 0), a3, 0, last); \
            PG8_WAIT_V(8); PG8_WAIT_L(0); PG8_BAR; if (M0) PG8_MMA(1, 0, At, B0); if (M1) PG8_MMA(1, 1, At, B1); PG8_BAR; PG8_SCHED; \
        } } while (0)
    Unit cur, nxt; int ui = 0;
    if (!S.next(0, cur)) return;
    int hm = SPLIT ? __builtin_amdgcn_readfirstlane(cur.hm) : 3;
    f32x4 acc[2][2][4][2];
#pragma unroll
    for (int a = 0; a < 2; ++a)
#pragma unroll
        for (int b = 0; b < 2; ++b)
#pragma unroll
            for (int m = 0; m < 4; ++m)
#pragma unroll
                for (int n = 0; n < 2; ++n) acc[a][b][m][n] = (f32x4){0.f, 0.f, 0.f, 0.f};
    bf16x8 At[4][2], B0[2][2], B1[2][2];
    const char* cA = (const char*)uni_ptr(S.aptr(cur)); const char* cB = (const char*)uni_ptr(S.bptr(cur));
#define PG8_LOADROWS(dst, u) do { if constexpr (GATHER) { const int* rl_ = S.rowlist(u); _Pragma("unroll") for (int hh = 0; hh < 2; ++hh) _Pragma("unroll") for (int i = 0; i < 2; ++i) { \
        const int r_ = rl_[hh * HALF + arow[0][i]]; dst[hh][i] = (unsigned)(r_ < 0 ? 0 : r_) * (unsigned)(K * 2) + (unsigned)arow[1][i]; } } } while (0)
    PG8_LOADROWS(cvA, cur);
#define PG8_STAGE_A(bufoff, gbase, half, next) do { if constexpr (GATHER) { PG8_STAGE(bufoff, gbase, (next) ? nvA[half] : cvA[half]); } else { PG8_STAGE(bufoff, (gbase) + (half) * hstepA, voffA); } } while (0)
    {
        PG8_STAGE(PG8_SB(0, 0), cB, voffB); PG8_STAGE(PG8_SB(0, 1), cB + hstepB, voffB); PG8_STAGE_A(PG8_SA(0, 0), cA, 0, false); PG8_STAGE_A(PG8_SA(0, 1), cA, 1, false);
        if (wr == 1) PG8_BAR;
        PG8_WAIT_V(2); PG8_BAR;
        PG8_STAGE(PG8_SB(1, 0), cB + kstep, voffB); PG8_STAGE_A(PG8_SA(1, 0), cA + kstep, 0, false); PG8_STAGE(PG8_SB(1, 1), cB + hstepB + kstep, voffB);
        PG8_WAIT_V(6); PG8_BAR;
    }
    for (;;) {
        const bool has_next = S.next(ui + 1, nxt);
        if (has_next) PG8_LOADROWS(nvA, nxt); else { _Pragma("unroll") for (int hh = 0; hh < 2; ++hh) _Pragma("unroll") for (int i = 0; i < 2; ++i) nvA[hh][i] = cvA[hh][i]; }
        if (!SPLIT || hm == 3) PG8_KLOOP(true, true); else if (hm == 1) PG8_KLOOP(true, false); else PG8_KLOOP(false, true);
        if constexpr (ALIGN_EPI) { if (wr == 0) PG8_BAR; }
        E(acc, cur, wr, wc, fr, fq);
        if (!has_next) break;
#pragma unroll
        for (int a = 0; a < 2; ++a)
#pragma unroll
            for (int b = 0; b < 2; ++b)
#pragma unroll
                for (int m = 0; m < 4; ++m)
#pragma unroll
                    for (int n = 0; n < 2; ++n) acc[a][b][m][n] = (f32x4){0.f, 0.f, 0.f, 0.f};
        cur = nxt; hm = SPLIT ? __builtin_amdgcn_readfirstlane(cur.hm) : 3; cA = (const char*)uni_ptr(S.aptr(cur)); cB = (const char*)uni_ptr(S.bptr(cur)); ++ui;
        if constexpr (GATHER) { _Pragma("unroll") for (int hh = 0; hh < 2; ++hh) _Pragma("unroll") for (int i = 0; i < 2; ++i) cvA[hh][i] = nvA[hh][i]; }
        if constexpr (ALIGN_EPI) { if (wr == 1) PG8_BAR; }
    }
    PG8_WAIT_V(0);
    if constexpr (!ALIGN_EPI) { if (wr == 0) PG8_BAR; }
    PG8_BAR;
#undef PG8_KLOOP
#undef PG8_SA
#undef PG8_LOADROWS
#undef PG8_STAGE_A
#undef PG8_SB
#undef PG8_STAGE
#undef PG8_LDA
#undef PG8_LDB
#undef PG8_MMA
#undef PG8_WAIT_V
#undef PG8_WAIT_L
#undef PG8_BAR
#undef PG8_SCHED
}
}

#define XB_TMO      128
#define XB_XCNT(j)  (256  + 64 * (j))
#define XB_XSUB(j)  (1280 + 64 * (j))
#define XB_XGEN(j)  (2304 + 64 * (j))
#define XB_TOP      3328
#define XB_TOPGEN   3392
#define XCD_BAR_WORDS 3456
#define XB_SPIN_CAP (1u << 25)
__device__ __forceinline__ unsigned xb_ld(unsigned* p)              { return __hip_atomic_load(p, __ATOMIC_RELAXED, __HIP_MEMORY_SCOPE_AGENT); }
__device__ __forceinline__ unsigned xb_add(unsigned* p, unsigned v) { return __hip_atomic_fetch_add(p, v, __ATOMIC_RELAXED, __HIP_MEMORY_SCOPE_AGENT); }
__device__ __forceinline__ unsigned xb_xcc_id() { return (unsigned)__builtin_amdgcn_s_getreg((3 << 11) | 20) & 0xFu; }
#define XB_SPIN(cond, bar) do { unsigned _sp = 0; while (cond) { __builtin_amdgcn_s_sleep(1); \
    if ((++_sp & 255u) == 0u) { if (xb_ld(&(bar)[XB_TMO])) break; if (_sp > XB_SPIN_CAP) { atomicAdd(&(bar)[XB_TMO], 1u); break; } } } } while (0)
struct XcdBarrier { unsigned* bar; unsigned x; volatile LAS unsigned* st; };
__device__ __forceinline__ XcdBarrier xcd_barrier_post(unsigned* bar, volatile LAS unsigned* st) {
    XcdBarrier b; b.bar = bar; b.x = xb_xcc_id(); b.st = st;
    if (threadIdx.x == 0) (void)xb_add(&bar[XB_XCNT(b.x)], 1u);
    return b;
}
__device__ __forceinline__ void xcd_barrier_complete(unsigned* bar, unsigned x, unsigned& nloc, unsigned& nx) {
    const unsigned G = gridDim.x * gridDim.y * gridDim.z;
    unsigned sum, cnt, mine, sp = 0u;
    for (;;) {
        sum = 0u; cnt = 0u; mine = 0u;
#pragma unroll 1
        for (unsigned j = 0; j < 16; ++j) { const unsigned c = xb_ld(&bar[XB_XCNT(j)]); sum += c; cnt += (c > 0u) ? 1u : 0u; mine = (j == x) ? c : mine; }
        if (sum == G) break;
        __builtin_amdgcn_s_sleep(1);
        if ((++sp & 255u) == 0u) { if (xb_ld(&bar[XB_TMO])) break; if (sp > XB_SPIN_CAP) { atomicAdd(&bar[XB_TMO], 1u); break; } }
    }
    nloc = mine > 0u ? mine : 1u; nx = cnt > 0u ? cnt : 1u;
}
__device__ __forceinline__ void xcd_barrier(const XcdBarrier& b) {
    asm volatile("s_waitcnt vmcnt(0)" ::: "memory");
    __syncthreads();
    if (threadIdx.x == 0) {
        unsigned* bar = b.bar;
        __builtin_amdgcn_s_waitcnt(0);
        unsigned nloc = b.st[0], nx = b.st[1];
        if (nloc == 0u) { xcd_barrier_complete(bar, b.x, nloc, nx); b.st[0] = nloc; b.st[1] = nx; }
        const unsigned old = xb_add(&bar[XB_XSUB(b.x)], 1u);
        const unsigned gen = old / nloc;
        if (old + 1u == (gen + 1u) * nloc) {
            __builtin_amdgcn_fence(__ATOMIC_RELEASE, "agent");
            asm volatile("s_waitcnt vmcnt(0)" ::: "memory");
            const unsigned og = xb_add(&bar[XB_TOP], 1u);
            const unsigned tg = og / nx;
            if (og + 1u == (tg + 1u) * nx) xb_add(&bar[XB_TOPGEN], 1u);
            else XB_SPIN(xb_ld(&bar[XB_TOPGEN]) == tg, bar);
            __builtin_amdgcn_fence(__ATOMIC_ACQUIRE, "agent");
            xb_add(&bar[XB_XGEN(b.x)], 1u);
            asm volatile("s_waitcnt vmcnt(0)" ::: "memory");
        } else {
            XB_SPIN(xb_ld(&bar[XB_XGEN(b.x)]) == gen, bar);
            __builtin_amdgcn_fence(__ATOMIC_ACQUIRE, "agent");
            asm volatile("s_waitcnt vmcnt(0)" ::: "memory");
        }
    }
    __syncthreads();
}

struct Args { const float* in[39]; float* out; unsigned char* ws; int ph_lo, ph_hi; };
struct Frame {
    LAS unsigned char* lds;
    int tid, lane, wave, G, bid;
    float* out; unsigned char* ws;
    int l;
    unsigned tA, tB; int seamc;
};
#define AS4 __attribute__((address_space(4)))
#define PH_ENTER(F0) Frame F = (F0); { GAS unsigned char* _w = (GAS unsigned char*)F.ws; GAS float* _o = (GAS float*)F.out; \
    asm volatile("" : "+s"(_w), "+s"(_o), "+v"(F.tid), "+s"(F.wave), "+s"(F.bid), "+s"(F.G), "+s"(F.l)); F.ws = (unsigned char*)_w; F.out = (float*)_o; } F.lane = F.tid & 63
__device__ __forceinline__ const AS4 Args* kargs() { const AS4 Args* p = (const AS4 Args*)__builtin_amdgcn_kernarg_segment_ptr(); asm volatile("" : "+s"(p)); return p; }
#define INP(i) ((const float*)(GAS const float*)(KA->in[i]))
#define LP(i, stride) (INP(i) + (size_t)F.l * (stride))

__device__ __forceinline__ const float* xin_row(const float* xl, const float* xc, int row) {
    const int b = row / TB, p = row % TB;
    if (p < TC) return xc + ((size_t)b * TC + p) * D;
    return xl + ((size_t)b * TL + (p - TC)) * D;
}
__device__ __forceinline__ int n_units(bool skipctx) { return skipctx ? NB * 128 : NUNIT64; }
__device__ __forceinline__ int unit_of(bool skipctx, int j) { return skipctx ? (j >> 7) * NTILE64 + 4 + (j & 127) : j; }
__device__ __forceinline__ int mod_index(int row) { const int b = row / TB, p = row % TB; return p < TC ? 8 : b; }

__device__ __forceinline__ int in_colmap(int n) {
    if (n < 2304) return n;
    if (n < 2816) return n + 8;
    if (n < 3072) return n + 24;
    if (n < 3080) return n - 768;
    if (n < 3096) return n - 256;
    return -1;
}
__device__ __forceinline__ void tr_item(const float* src, int ldsrc, int scol, bf16* dst, int K, int n0, int k0, LAS float* scr, int lane) {
    float tv[32];
#pragma unroll
    for (int i = 0; i < 32; ++i) { const int kk = 2 * i + (lane >> 5); tv[i] = scol >= 0 ? src[(size_t)(k0 + kk) * ldsrc + scol] : 0.f; }
#pragma unroll
    for (int i = 0; i < 32; ++i) { const int kk = 2 * i + (lane >> 5); scr[kk * 33 + (lane & 31)] = tv[i]; }
    LDS_WAIT(); asm volatile("" ::: "memory");
    const int c = lane & 7;
#pragma unroll
    for (int j = 0; j < 4; ++j) { const int n = (lane >> 3) + 8 * j; const LAS float* s = scr + (8 * c) * 33 + n;
        u32x4 o; o.x = pk2(s[0 * 33], s[1 * 33]); o.y = pk2(s[2 * 33], s[3 * 33]); o.z = pk2(s[4 * 33], s[5 * 33]); o.w = pk2(s[6 * 33], s[7 * 33]);
        *(GAS u32x4*)(dst + (size_t)(n0 + n) * K + k0 + 8 * c) = o; }
    LDS_WAIT(); asm volatile("" ::: "memory");
}
__device__ __forceinline__ void phase_convert(const Frame& F0) {
    PH_ENTER(F0);
    const AS4 Args* KA = kargs();
    LAS float* scr = (LAS float*)(F.lds + F.wave * 16384);
    const int gw = F.bid * 8 + F.wave, NGW = F.G * 8, l = F.l, lane = F.lane;
    constexpr int I_A = 16 * 104, I_B = 16 * 32, I_C = 16 * 16 * 32, I_D = 16 * 8 * 32, I_E = 48;
    for (int it = gw; it < I_A + I_B + I_C + I_D + I_E; it += NGW) {
        int r = it;
        if (r < I_A) { const int kb = r / 104, nb = r % 104; tr_item(INP(8) + (size_t)l * D * IN_COLS, IN_COLS, in_colmap(nb * 32 + (lane & 31)), (bf16*)(F.ws + WS_WIN), D, nb * 32, kb * 64, scr, lane); continue; }
        r -= I_A;
        if (r < I_B) { const int kb = r / 32, nb = r % 32; tr_item(INP(9) + (size_t)l * D * D, D, nb * 32 + (lane & 31), (bf16*)(F.ws + WS_WOUT), D, nb * 32, kb * 64, scr, lane); continue; }
        r -= I_B;
        if (r < I_C) { const int e = r / 512, rr = r % 512, kb = rr / 32, nb = rr % 32; const int n0 = nb * 32, j = n0 >> 8, wi = n0 & 255;
            const float* src = (wi < 128 ? INP(35) : INP(36)) + (size_t)(l * 16 + e) * D * 512;
            tr_item(src, 512, 128 * j + (wi & 127) + (lane & 31), (bf16*)(F.ws + WS_W13) + (size_t)e * D * D, D, n0, kb * 64, scr, lane); continue; }
        r -= I_C;
        if (r < I_D) { const int e = r / 256, rr = r % 256, kb = rr / 32, nb = rr % 32;
            tr_item(INP(37) + (size_t)(l * 16 + e) * 512 * D, D, nb * 32 + (lane & 31), (bf16*)(F.ws + WS_W2T) + (size_t)e * D * 512, 512, nb * 32, kb * 64, scr, lane); continue; }
        r -= I_D;
        { bf16* LW = (bf16*)(F.ws + WS_LOWR);
            if (r < 16) { const int d = r >> 3, nb = r & 7; tr_item(INP(13) + (size_t)(l * 2 + d) * 64 * 256, 256, nb * 32 + (lane & 31), LW + (size_t)d * 256 * 64, 64, nb * 32, 0, scr, lane); }
            else if (r < 32) { const int d = (r - 16) >> 3, nb = r & 7; tr_item(INP(15) + (size_t)(l * 2 + d) * 64 * 256, 256, nb * 32 + (lane & 31), LW + 32768 + (size_t)d * 256 * 64, 64, nb * 32, 0, scr, lane); }
            else { const int kb = (r - 32) >> 3, nb = r & 7; tr_item(INP(16) + (size_t)l * 128 * 256, 256, nb * 32 + (lane & 31), LW + 65536, 128, nb * 32, kb * 64, scr, lane); } }
    }
}
__device__ __forceinline__ void phase_mods(const Frame& F0) {
    PH_ENTER(F0);
    const AS4 Args* KA = kargs();
    LAS float* cond = (LAS float*)F.lds;
    LAS float* red = (LAS float*)(F.lds + 40960);
    for (int i = F.tid; i < 9 * D; i += 512) { const float v = i < 8 * D ? INP(1)[i] : INP(3)[i - 8 * D]; cond[i] = siluf(v); }
    LDS_BARRIER();
    float* mod = (float*)(F.ws + WS_MOD);
    for (int u = F.bid; u < 2 * 96; u += F.G) {
        const int l = u / 96, cb = u % 96, col = cb * 64 + F.lane;
        const float* W = INP(4) + (size_t)l * D * 6144;
        float acc[9];
#pragma unroll
        for (int i = 0; i < 9; ++i) acc[i] = 0.f;
#pragma unroll 1
        for (int k0 = F.wave * 128; k0 < F.wave * 128 + 128; k0 += 32) { float w[32];
#pragma unroll
            for (int kk = 0; kk < 32; ++kk) w[kk] = W[(size_t)(k0 + kk) * 6144 + col];
#pragma unroll
            for (int kk = 0; kk < 32; kk += 4)
#pragma unroll
                for (int i = 0; i < 9; ++i) { const f32x4 c4 = *(const LAS f32x4*)(cond + i * D + k0 + kk); acc[i] += c4.x * w[kk] + c4.y * w[kk + 1] + c4.z * w[kk + 2] + c4.w * w[kk + 3]; } }
#pragma unroll
        for (int i = 0; i < 9; ++i) red[(F.wave * 9 + i) * 64 + F.lane] = acc[i];
        LDS_BARRIER();
        for (int o = F.tid; o < 9 * 64; o += 512) { const int i = o / 64, ln = o % 64; float s = 0.f;
#pragma unroll
            for (int w = 0; w < 8; ++w) s += red[(w * 9 + i) * 64 + ln];
            mod[((size_t)l * 9 + i) * 6144 + cb * 64 + ln] = s + INP(5)[(size_t)l * 6144 + cb * 64 + ln]; }
        LDS_BARRIER();
    }
}

__device__ __forceinline__ void phase_norm1(const Frame& F0) {
    PH_ENTER(F0);
    const AS4 Args* KA = kargs();
    const float* xl = INP(0); const float* xc = INP(2); const bf16* XB = (const bf16*)(F.ws + WS_XB); const bool first = F.l == 0;
    const int gw = F.bid * 8 + F.wave, NGW = F.G * 8, lane = F.lane;
    const float* g = LP(6, D);
    const float* mod = (const float*)(F.ws + WS_MOD) + (size_t)F.l * 9 * 6144;
    bf16* H = (bf16*)(F.ws + WS_ACT);
    const int R = (T + NGW - 1) / NGW, r0 = gw * R, r1 = min(T, r0 + R);
    f32x4 A[4], B[4], nv[4]; u32x2 nb[4]; int curmi = -1;
#define N1_LOAD(row) do { if (first) { const f32x4* xr = (const f32x4*)xin_row(xl, xc, (row)) + lane; _Pragma("unroll") for (int j = 0; j < 4; ++j) nv[j] = xr[64 * j]; } \
        else { const u32x2* xr = (const u32x2*)(XB + (size_t)(row) * D) + lane; _Pragma("unroll") for (int j = 0; j < 4; ++j) nb[j] = xr[64 * j]; } } while (0)
    if (r0 < r1) N1_LOAD(r0);
    for (int row = r0; row < r1; ++row) {
        f32x4 v[4];
        if (first) {
#pragma unroll
            for (int j = 0; j < 4; ++j) v[j] = nv[j];
        } else {
#pragma unroll
            for (int j = 0; j < 4; ++j) v[j] = bf4(nb[j]);
        }
        if (row + 1 < r1) N1_LOAD(row + 1);
        const int mi = mod_index(row);
        if (mi != curmi) { curmi = mi; const float* mrow = mod + (size_t)mi * 6144;
#pragma unroll
            for (int j = 0; j < 4; ++j) { const int c = 4 * lane + 256 * j; A[j] = *(const f32x4*)(g + c) * (*(const f32x4*)(mrow + D + c) + 1.f); B[j] = *(const f32x4*)(mrow + c); } }
        float s = 0.f;
#pragma unroll
        for (int j = 0; j < 4; ++j) s += (v[j].x * v[j].x + v[j].y * v[j].y) + (v[j].z * v[j].z + v[j].w * v[j].w);
        const float rs = rsqrtf(wave_sum(s) * (1.f / D) + 1e-6f);
        u32x2* o8 = (u32x2*)(H + (size_t)row * D) + lane;
#pragma unroll
        for (int j = 0; j < 4; ++j) { const f32x4 h = v[j] * rs * A[j] + B[j]; u32x2 w; w.x = pk2(h.x, h.y); w.y = pk2(h.z, h.w); o8[64 * j] = w; }
    }
#undef N1_LOAD
}

struct SchedStatic {
    int nM, nN, nwg, G, c; const unsigned char* ws; const unsigned char* wsA; size_t offA, offB; int skipctx, split;
    __device__ __forceinline__ bool next(int i, pg8::Unit& u) const {
        const int rounds = (nwg + G - 1) / G, full = (rounds - 1) * G, tail = nwg - full; long L; u.hm = 3;
        if (!split || i < rounds - 1 || 2 * tail > G) { L = (long)i * G + c; if (L >= nwg) return false; }
        else { if (i > rounds - 1 || c >= 2 * tail) return false; L = full + (c >> 1); u.hm = 1 + (c & 1); }
        int wgid = (int)L; { const int q = nwg / 8, r = nwg % 8, xcd = wgid % 8, off = wgid / 8; wgid = (xcd < r ? xcd * (q + 1) : r * (q + 1) + (xcd - r) * q) + off; }
        const int nig = 8 * nN, gid = wgid / nig, fm = gid * 8, gsz = (nM - fm) < 8 ? (nM - fm) : 8;
        u.pm = fm + ((wgid % nig) % gsz); u.pn = (wgid % nig) / gsz; u.aux = 0;
        if (skipctx) u.pm = (u.pm >> 5) * 33 + 1 + (u.pm & 31);
        return true;
    }
    __device__ __forceinline__ const char* aptr(const pg8::Unit& u) const { return (const char*)wsA + offA + (size_t)u.pm * (256 * 1024 * 2); }
    __device__ __forceinline__ const char* bptr(const pg8::Unit& u) const { return (const char*)ws + offB + (size_t)u.pn * (256 * 1024 * 2); }
    __device__ __forceinline__ const char* bptr2(const pg8::Unit& u) const { return bptr(u); }
    __device__ __forceinline__ const int* rowlist(const pg8::Unit&) const { return nullptr; }
};
struct EpiU {
    static constexpr bool PERM = true;
    unsigned char* ws;
    __device__ __forceinline__ void operator()(const f32x4 (&acc)[2][2][4][2], const pg8::Unit& u, int wr, int wc, int fr, int fq) const {
        const int row0 = u.pm * 256 + wr * 64 + fr, pn = u.pn;
        float* u_misc = (float*)(ws + WS_UMISC);
        if (pn < 12) {
            bf16* base; int ld, c0;
            if (pn < 4) { base = (bf16*)(ws + WS_URW); ld = 1024; c0 = pn * 256; } else if (pn < 6) { base = (bf16*)(ws + WS_UZ); ld = 512; c0 = (pn - 4) * 256; }
            else if (pn < 9) { base = (bf16*)(ws + WS_UXBC); ld = 768; c0 = (pn - 6) * 256; } else { base = (bf16*)(ws + WS_UGLA); ld = 768; c0 = (pn - 9) * 256; }
            const int col0 = c0 + wc * 32 + 8 * fq;
#pragma unroll
            for (int ai = 0; ai < 2; ++ai)
#pragma unroll
                for (int m = 0; m < 4; ++m) { bf16* rowp = base + (size_t)(row0 + ai * 128 + m * 16) * ld + col0;
#pragma unroll
                    for (int bj = 0; bj < 2; ++bj) { if (!((u.hm >> bj) & 1)) continue; const f32x4 v0 = acc[ai][bj][m][0], v1 = acc[ai][bj][m][1];
                        u32x4 w; w.x = pg8::cvt_pk_bf16(v0[0], v0[1]); w.y = pg8::cvt_pk_bf16(v0[2], v0[3]); w.z = pg8::cvt_pk_bf16(v1[0], v1[1]); w.w = pg8::cvt_pk_bf16(v1[2], v1[3]);
                        *(u32x4*)(rowp + bj * 128) = w; } }
        } else if (wc == 0 && (u.hm & 1)) {
#pragma unroll
            for (int ai = 0; ai < 2; ++ai)
#pragma unroll
                for (int m = 0; m < 4; ++m) { float* rp = u_misc + (size_t)(row0 + ai * 128 + m * 16) * 32 + 8 * fq;
                    *(f32x4*)rp = acc[ai][0][m][0]; *(f32x4*)(rp + 4) = acc[ai][0][m][1]; }
        }
    }
};
struct EpiRes {
    static constexpr bool PERM = true;
    const float* xin_lat; const float* xin_ctx; unsigned char* ws; int l;
    __device__ __forceinline__ void operator()(const f32x4 (&acc)[2][2][4][2], const pg8::Unit& u, int wr, int wc, int fr, int fq) const {
        const int b = u.pm / 33, tb = u.pm % 33;
        const float* mrow = (const float*)(ws + WS_MOD) + (size_t)l * 9 * 6144 + (size_t)(tb == 0 ? 8 : b) * 6144 + 2 * D;
        const float* xi = tb == 0 ? xin_ctx + (size_t)b * TC * D : xin_lat + ((size_t)b * TL + (size_t)(tb - 1) * 256) * D;
        bf16* xo = (bf16*)(ws + WS_XB) + (size_t)u.pm * 256 * D;
        const int r0 = wr * 64 + fr, col0 = u.pn * 256 + wc * 32 + 8 * fq;
        const bool first = l == 0;
#pragma unroll
        for (int ai = 0; ai < 2; ++ai)
#pragma unroll
            for (int m = 0; m < 4; ++m) { const size_t off = (size_t)(r0 + ai * 128 + m * 16) * D + col0;
#pragma unroll
                for (int bj = 0; bj < 2; ++bj) { if (!((u.hm >> bj) & 1)) continue; const f32x4 g0 = *(const f32x4*)(mrow + col0 + bj * 128), g1 = *(const f32x4*)(mrow + col0 + bj * 128 + 4);
                    f32x4 x0, x1;
                    if (first) { x0 = *(const f32x4*)(xi + off + bj * 128); x1 = *(const f32x4*)(xi + off + bj * 128 + 4); }
                    else { const u32x4 w = *(const u32x4*)(xo + off + bj * 128); x0 = bf4((u32x2){w.x, w.y}); x1 = bf4((u32x2){w.z, w.w}); }
                    x0 = x0 + g0 * acc[ai][bj][m][0]; x1 = x1 + g1 * acc[ai][bj][m][1];
                    u32x4 o; o.x = pg8::cvt_pk_bf16(x0[0], x0[1]); o.y = pg8::cvt_pk_bf16(x0[2], x0[3]); o.z = pg8::cvt_pk_bf16(x1[0], x1[1]); o.w = pg8::cvt_pk_bf16(x1[2], x1[3]);
                    *(u32x4*)(xo + off + bj * 128) = o; }
                asm volatile("" ::: "memory"); }
    }
};
__device__ __forceinline__ void cls_experts(int cls, int& ea, int& eb) {
    const int g = cls / 6, pr = cls % 6;
    const int pa = pr < 3 ? 0 : (pr < 5 ? 1 : 2);
    const int pb = pr == 0 ? 1 : (pr == 1 ? 2 : (pr == 2 ? 3 : (pr == 3 ? 2 : 3)));
    ea = g * 4 + pa; eb = g * 4 + pb;
}
template <int NJ> struct SchedMoE {
    int ntiles, G, c; const LAS int* cs; const unsigned char* ws;
    __device__ __forceinline__ bool next(int i, pg8::Unit& u) const {
        const int nwg = ntiles * NJ; long L0; u.hm = 3;
        { const int rounds = (nwg + G - 1) / G, full = (rounds - 1) * G, tail = nwg - full;
            if (NJ == 8 || i < rounds - 1 || 2 * tail > G) { L0 = (long)i * G + c; if (L0 >= (long)nwg) return false; }
            else { if (i > rounds - 1 || c >= 2 * tail) return false; L0 = full + (c >> 1); u.hm = 1 + (c & 1); } }
        int L = (int)L0; { const int q = nwg / 8, r = nwg % 8, xcd = L % 8, off = L / 8; L = (xcd < r ? xcd * (q + 1) : r * (q + 1) + (xcd - r) * q) + off; }
        const int tile = L / NJ, j = L % NJ, slot0 = tile * 256;
        int cls = 0;
#pragma unroll 1
        for (int k = 1; k < NCLS; ++k) cls = (slot0 >= cs[k]) ? k : cls;
        u.pm = tile; u.pn = j; u.aux = cls; return true;
    }
    __device__ __forceinline__ const char* aptr(const pg8::Unit& u) const { return NJ == 8 ? (const char*)ws + WS_ACT : (const char*)ws + WS_H1 + (size_t)u.pm * (256 * 1024 * 2); }
    __device__ __forceinline__ const int* rowlist(const pg8::Unit& u) const { return (const int*)(ws + WS_LIST) + u.pm * 256; }
    __device__ __forceinline__ const char* bptr(const pg8::Unit& u) const { int ea, eb; cls_experts(u.aux, ea, eb);
        if (NJ == 8) { const int e = u.pn < 4 ? ea : eb; return (const char*)ws + WS_W13 + ((size_t)e * D + (size_t)(u.pn & 3) * 256) * D * 2; }
        return (const char*)ws + WS_W2T + ((size_t)ea * D + (size_t)u.pn * 256) * 512 * 2; }
    __device__ __forceinline__ const char* bptr2(const pg8::Unit& u) const { int ea, eb; cls_experts(u.aux, ea, eb);
        return (const char*)ws + WS_W2T + ((size_t)eb * D + (size_t)u.pn * 256) * 512 * 2; }
};
struct EpiSwiGLU {
    static constexpr bool PERM = true;
    unsigned char* ws;
    __device__ __forceinline__ void operator()(const f32x4 (&acc)[2][2][4][2], const pg8::Unit& u, int wr, int wc, int fr, int fq) const {
        bf16* H1 = (bf16*)(ws + WS_H1); const f32x2* wslot = (const f32x2*)(ws + WS_WSLOT);
        const int row0 = u.pm * 256 + wr * 64 + fr, j = u.pn;
        const int col0 = (j >> 2) * 512 + (j & 3) * 128 + wc * 32 + 8 * fq;
#pragma unroll
        for (int ai = 0; ai < 2; ++ai)
#pragma unroll
            for (int m = 0; m < 4; ++m) { const int row = row0 + ai * 128 + m * 16; const f32x2 wv = wslot[row]; const float w = j < 4 ? wv.x : wv.y;
                float o[8];
#pragma unroll
                for (int n = 0; n < 2; ++n)
#pragma unroll
                    for (int i = 0; i < 4; ++i) { const float gt = acc[ai][0][m][n][i], up = acc[ai][1][m][n][i]; o[n * 4 + i] = siluf(gt) * up * w; }
                u32x4 wv4; wv4.x = pg8::cvt_pk_bf16(o[0], o[1]); wv4.y = pg8::cvt_pk_bf16(o[2], o[3]); wv4.z = pg8::cvt_pk_bf16(o[4], o[5]); wv4.w = pg8::cvt_pk_bf16(o[6], o[7]);
                *(u32x4*)(H1 + (size_t)row * D + col0) = wv4; }
    }
};
struct EpiScatter {
    static constexpr bool PERM = true;
    unsigned char* ws; int l;
    __device__ __forceinline__ void operator()(const f32x4 (&acc)[2][2][4][2], const pg8::Unit& u, int wr, int wc, int fr, int fq) const {
        const int* list = (const int*)(ws + WS_LIST); bf16* XB = (bf16*)(ws + WS_XB); const float* mod = (const float*)(ws + WS_MOD) + (size_t)l * 9 * 6144;
        const int row0 = u.pm * 256 + wr * 64 + fr, col0 = u.pn * 256 + wc * 32 + 8 * fq;
#pragma unroll
        for (int ai = 0; ai < 2; ++ai)
#pragma unroll
            for (int m = 0; m < 4; ++m) { const int tok = list[row0 + ai * 128 + m * 16];
                if (tok >= 0) { const int b = tok / TB, p = tok % TB;
                    bf16* xr = XB + (size_t)tok * D + col0;
                    const float* mrow = mod + (size_t)(p < TC ? 8 : b) * 6144 + 5 * D + col0;
#pragma unroll
                    for (int bj = 0; bj < 2; ++bj) { if (!((u.hm >> bj) & 1)) continue; const f32x4 g0 = *(const f32x4*)(mrow + bj * 128), g1 = *(const f32x4*)(mrow + bj * 128 + 4);
                        const u32x4 w = *(const u32x4*)(xr + bj * 128);
                        const f32x4 x0 = bf4((u32x2){w.x, w.y}) + g0 * acc[ai][bj][m][0], x1 = bf4((u32x2){w.z, w.w}) + g1 * acc[ai][bj][m][1];
                        u32x4 o; o.x = pg8::cvt_pk_bf16(x0[0], x0[1]); o.y = pg8::cvt_pk_bf16(x0[2], x0[3]); o.z = pg8::cvt_pk_bf16(x1[0], x1[1]); o.w = pg8::cvt_pk_bf16(x1[2], x1[3]);
                        *(u32x4*)(xr + bj * 128) = o; } }
                asm volatile("" ::: "memory"); }
    }
};

constexpr int LD64 = 72;
__device__ __forceinline__ f32x4 mma16g(f32x4 acc, const LAS bf16* A, int lda, const bf16* Btg, int ldb, int lane) {
    const int r = lane & 15, kq = (lane >> 4) * 8;
    const bf16x8 a = *(const LAS bf16x8*)(A + r * lda + kq);
    const bf16x8 b = *(const bf16x8*)(Btg + (size_t)r * ldb + kq);
    return __builtin_amdgcn_mfma_f32_16x16x32_bf16(a, b, acc, 0, 0, 0);
}
__device__ __forceinline__ void phase_conv(const Frame& F0) {
    PH_ENTER(F0);
    const AS4 Args* KA = kargs();
    const bf16* UXBC = (const bf16*)(F.ws + WS_UXBC); bf16* XBCA = (bf16*)((unsigned char*)F.out + OUT_XBCA);
    const float* cw = LP(22, 9 * 768); const float* cb = LP(23, 768);
    const int cg = F.tid % 96, sub = F.tid / 96;
    if (sub >= 5) return;
    const int ch0 = cg * 8;
    float wgt0[9][8], bias[8];
#pragma unroll
    for (int k = 0; k < 9; ++k) { const f32x4 wa = *(const f32x4*)(cw + k * 768 + ch0), wb = *(const f32x4*)(cw + k * 768 + ch0 + 4);
        wgt0[k][0] = wa.x; wgt0[k][1] = wa.y; wgt0[k][2] = wa.z; wgt0[k][3] = wa.w; wgt0[k][4] = wb.x; wgt0[k][5] = wb.y; wgt0[k][6] = wb.z; wgt0[k][7] = wb.w; }
    { const f32x4 b0 = *(const f32x4*)(cb + ch0), b1 = *(const f32x4*)(cb + ch0 + 4); bias[0] = b0.x; bias[1] = b0.y; bias[2] = b0.z; bias[3] = b0.w; bias[4] = b1.x; bias[5] = b1.y; bias[6] = b1.z; bias[7] = b1.w; }
    TS_B(24);
    const int nx = NUNIT64 % F.G; int it, step, end;
    if (F.bid < nx) { it = F.bid * 5 + sub; step = nx * 5; end = nx * 20; } else { it = nx * 20 + (F.bid - nx) * 5 + sub; step = (F.G - nx) * 5; end = NUNIT64 * 8; }
    for (; it < end; it += step) {
        const int u = it >> 3, run = it & 7, b = u / NTILE64, tl = u % NTILE64, p0 = tl * 64; const size_t rowbase = (size_t)b * TB;
        const bool lat = p0 >= TC; const int gr = (p0 - TC) >> 6;
        const int xhi = lat ? 64 : TC, x0 = (lat ? 0 : p0) + run * 8;
        const bf16* rp0; const bf16* rp1; const bf16* rp2; bool rv0, rv2;
        { const int y0 = gr - 1, y2 = gr + 1; rv0 = lat && y0 >= 0; rv2 = lat && y2 < 128;
            rp1 = UXBC + (rowbase + (lat ? TC + gr * 64 : 0)) * 768 + ch0; rp0 = rv0 ? rp1 - 64 * 768 : rp1; rp2 = rv2 ? rp1 + 64 * 768 : rp1; }
        const float m0 = rv0 ? 1.f : 0.f, m2 = rv2 ? 1.f : 0.f;
        u32x4 w00, w01, w02, w10, w11, w12;
        { const int xa = x0 - 1; const bool va = xa >= 0; const size_t oa = (size_t)(va ? xa : 0) * 768; const u32x4 z4 = {0u, 0u, 0u, 0u};
            w00 = va ? *(const u32x4*)(rp0 + oa) : z4; w01 = va ? *(const u32x4*)(rp1 + oa) : z4; w02 = va ? *(const u32x4*)(rp2 + oa) : z4;
            const size_t ob = (size_t)x0 * 768; w10 = *(const u32x4*)(rp0 + ob); w11 = *(const u32x4*)(rp1 + ob); w12 = *(const u32x4*)(rp2 + ob); }
#pragma unroll 4
        for (int k = 0; k < 8; ++k) { const int x = x0 + k, xn = x + 1; const bool vn = xn < xhi; const size_t on = (size_t)(vn ? xn : x) * 768; const u32x4 z4 = {0u, 0u, 0u, 0u};
            u32x4 w20 = *(const u32x4*)(rp0 + on), w21 = *(const u32x4*)(rp1 + on), w22 = *(const u32x4*)(rp2 + on);
            if (!vn) { w20 = z4; w21 = z4; w22 = z4; }
            float acc[8], t0[8], t2[8];
#pragma unroll
            for (int i = 0; i < 8; ++i) { acc[i] = bias[i]; t0[i] = 0.f; t2[i] = 0.f; }
            float v[8];
#define CONV_TAP(W, K, DST) unpack8(W, v); _Pragma("unroll") for (int i = 0; i < 8; ++i) DST[i] += v[i] * wgt0[K][i];
            CONV_TAP(w00, 0, t0) CONV_TAP(w10, 1, t0) CONV_TAP(w20, 2, t0) CONV_TAP(w01, 3, acc) CONV_TAP(w11, 4, acc) CONV_TAP(w21, 5, acc) CONV_TAP(w02, 6, t2) CONV_TAP(w12, 7, t2) CONV_TAP(w22, 8, t2)
#undef CONV_TAP
#pragma unroll
            for (int i = 0; i < 8; ++i) acc[i] = siluf(acc[i] + m0 * t0[i] + m2 * t2[i]);
            *(u32x4*)(XBCA + (rowbase + (lat ? TC + gr * 64 + x : x)) * 768 + ch0) = pack8(acc);
            w00 = w10; w01 = w11; w02 = w12; w10 = w20; w11 = w21; w12 = w22;
        }
    }
    TS_E(24);
}
__device__ __forceinline__ void phase_prep(const Frame& F0) {
    PH_ENTER(F0);
    const AS4 Args* KA = kargs();
    const int tid = F.tid, lane = F.lane, wave = F.wave;
    const bf16* URW = (const bf16*)(F.ws + WS_URW); const bf16* UXBC = (const bf16*)(F.ws + WS_UXBC);
    bf16* XBCA = (bf16*)((unsigned char*)F.out + OUT_XBCA);
    h16* RECS = (h16*)(F.ws + WS_RECS); h16* RECD = (h16*)(F.ws + WS_RECD); h16* BONUS = (h16*)(F.ws + WS_BONUS); h16* GATE = (h16*)(F.ws + WS_GATE);
    const bf16* LW = (const bf16*)(F.ws + WS_LOWR);
    const float* mup = LP(10, 1024); const float* mun = LP(11, 1024);
    const float* w0 = LP(12, 512); const float* a0 = LP(14, 512);
    const float* k_k = LP(17, 256); const float* r_k = LP(19, 256);
    const float* cw = LP(22, 9 * 768); const float* cb = LP(23, 768);
    constexpr int LDR = 776, LDG = 136;
    LAS float* PM = (LAS float*)F.lds;
    LAS bf16* WLi = (LAS bf16*)(F.lds + 99328);
    LAS bf16* ALi = (LAS bf16*)(F.lds + 108544);
    LAS bf16* GSi = (LAS bf16*)(F.lds + 117760);
    bf16x8 Bf[5][2][4];
    float pbias[4][2];
#pragma unroll
    for (int mm = 0; mm < 4; ++mm)
#pragma unroll
        for (int nt = 0; nt < 2; ++nt) { const int c = wave * 32 + nt * 16 + (lane & 15); pbias[mm][nt] = mm < 2 ? w0[mm * 256 + c] : a0[(mm - 2) * 256 + c]; }
    for (int i = tid; i < 1024; i += 512) { PM[i] = mup[i]; PM[1024 + i] = mun[i]; if (i < 256) { PM[2048 + i] = k_k[i]; PM[2304 + i] = r_k[i]; } }
    for (int u = F.bid; u < NUNIT64; u += F.G) {
        const int b = u / NTILE64, tl = u % NTILE64, p0 = tl * 64;
        const int seg_lo = p0 < TC ? 0 : TC, seg_hi = p0 < TC ? TC : TB;
        const size_t rowbase = (size_t)b * TB;
        TS_B(21);
        LDS_BARRIER();
        { const int t = tid >> 3, part = tid & 7, p = p0 + t; const bf16* ur = URW + (rowbase + p) * 1024 + part * 8;
            const bool hp = p - 1 >= seg_lo, hn = p + 1 < seg_hi;
            const u32x4 z4 = {0u, 0u, 0u, 0u};
            u32x4 ra[3][3], rb[3][3];
#define PA_LOAD(dst, slot, col) do { dst[slot][0] = *(const u32x4*)(ur + (col)); dst[slot][1] = hp ? *(const u32x4*)(ur - 1024 + (col)) : z4; dst[slot][2] = hn ? *(const u32x4*)(ur + 1024 + (col)) : z4; } while (0)
#define PA_SHIFT(sv, src, slot, col) do { float uc_[8], up_[8], un_[8]; unpack8(src[slot][0], uc_); unpack8(src[slot][1], up_); unpack8(src[slot][2], un_); \
                const f32x4 mp0 = *(const LAS f32x4*)(PM + (col) + part * 8), mp1 = *(const LAS f32x4*)(PM + (col) + part * 8 + 4), mn0 = *(const LAS f32x4*)(PM + 1024 + (col) + part * 8), mn1 = *(const LAS f32x4*)(PM + 1024 + (col) + part * 8 + 4); \
                _Pragma("unroll") for (int i = 0; i < 4; ++i) { sv[i] = uc_[i] + mp0[i] * (up_[i] - uc_[i]) + mn0[i] * (un_[i] - uc_[i]); sv[4 + i] = uc_[4 + i] + mp1[i] * (up_[4 + i] - uc_[4 + i]) + mn1[i] * (un_[4 + i] - uc_[4 + i]); } } while (0)
#define PA_HEAD(src, h) do { float r_[8], k_[8], v_[8]; PA_SHIFT(r_, src, 0, (h) * 64); PA_SHIFT(k_, src, 1, 256 + (h) * 64); PA_SHIFT(v_, src, 2, 512 + (h) * 64); \
                const f32x4 kk0 = *(const LAS f32x4*)(PM + 2048 + (h) * 64 + part * 8), kk1 = *(const LAS f32x4*)(PM + 2048 + (h) * 64 + part * 8 + 4), rk0 = *(const LAS f32x4*)(PM + 2304 + (h) * 64 + part * 8), rk1 = *(const LAS f32x4*)(PM + 2304 + (h) * 64 + part * 8 + 4); \
                float kr_[8]; float ss = 0.f, bs = 0.f; \
                _Pragma("unroll") for (int i = 0; i < 8; ++i) { kr_[i] = k_[i] * (i < 4 ? kk0[i & 3] : kk1[i & 3]); ss += kr_[i] * kr_[i]; bs += r_[i] * k_[i] * (i < 4 ? rk0[i & 3] : rk1[i & 3]); } \
                ss = sum8(ss); bs = sum8(bs); const float rs = rsqrtf(ss + 1e-12f); \
                h16x8 r16, k16, v16, kk16, b16; \
                _Pragma("unroll") for (int i = 0; i < 8; ++i) { r16[i] = (h16)r_[i]; k16[i] = (h16)k_[i]; v16[i] = (h16)v_[i]; kk16[i] = (h16)(kr_[i] * rs); b16[i] = (h16)(bs * v_[i]); } \
                h16* rec = RECS + (((size_t)b * 4 + (h)) * TB + p) * 256 + part * 8; \
                *(h16x8*)rec = r16; *(h16x8*)(rec + 64) = v16; *(h16x8*)(rec + 128) = kk16; *(h16x8*)(rec + 192) = k16; \
                *(h16x8*)(BONUS + (rowbase + p) * 256 + (h) * 64 + part * 8) = b16; } while (0)
            PA_LOAD(ra, 0, 0); PA_LOAD(ra, 1, 256); PA_LOAD(ra, 2, 512);
            PA_LOAD(rb, 0, 64); PA_LOAD(rb, 1, 320); PA_LOAD(rb, 2, 576);
            PA_HEAD(ra, 0);
            PA_LOAD(ra, 0, 128); PA_LOAD(ra, 1, 384); PA_LOAD(ra, 2, 640);
            PA_HEAD(rb, 1);
            PA_LOAD(rb, 0, 192); PA_LOAD(rb, 1, 448); PA_LOAD(rb, 2, 704);
            PA_HEAD(ra, 2);
            PA_LOAD(ra, 0, 768); PA_LOAD(ra, 1, 832);
            PA_HEAD(rb, 3);
            PA_LOAD(rb, 0, 896); PA_LOAD(rb, 1, 960);
            { const int c0 = wave * 32, r = lane & 15, kq = (lane >> 4) * 8; const bf16* LWl = LW + launder_i(0);
#pragma unroll
                for (int mm = 0; mm < 5; ++mm) { const bf16* Bt = mm < 2 ? LWl + (size_t)mm * 16384 : (mm < 4 ? LWl + 32768 + (size_t)(mm - 2) * 16384 : LWl + 65536); const int ldb = mm < 4 ? 64 : 128;
#pragma unroll
                    for (int nt = 0; nt < 2; ++nt)
#pragma unroll
                        for (int ks = 0; ks < 4; ++ks) if (ks < (mm < 4 ? 2 : 4)) Bf[mm][nt][ks] = *(const bf16x8*)(Bt + (size_t)(c0 + nt * 16 + r) * ldb + ks * 32 + kq); } }
            { float sv[8]; PA_SHIFT(sv, ra, 0, 768);
#pragma unroll
                for (int i = 0; i < 8; ++i) sv[i] = tanh_fast(sv[i]);
                *(LAS u32x4*)(WLi + t * LD64 + part * 8) = pack8(sv);
                PA_SHIFT(sv, ra, 1, 832); *(LAS u32x4*)(ALi + t * LD64 + part * 8) = pack8(sv); }
            { float sv[8]; PA_SHIFT(sv, rb, 0, 896);
#pragma unroll
                for (int i = 0; i < 8; ++i) sv[i] = sigm(sv[i]);
                *(LAS u32x4*)(GSi + t * LDG + part * 8) = pack8(sv);
                PA_SHIFT(sv, rb, 1, 960);
#pragma unroll
                for (int i = 0; i < 8; ++i) sv[i] = sigm(sv[i]);
                *(LAS u32x4*)(GSi + t * LDG + 64 + part * 8) = pack8(sv); }
#undef PA_LOAD
#undef PA_SHIFT
#undef PA_HEAD
        }
        LDS_BARRIER();
        TS_E(21); TS_B(23);
        SUBREP(3) { const int c0 = wave * 32, h = wave >> 1, lr = (lane >> 4) * 4, lc = lane & 15;
#pragma unroll
            for (int mm = 0; mm < 5; ++mm) {
                const LAS bf16* Ai = mm < 2 ? WLi : (mm < 4 ? ALi : GSi); const int lda = mm < 4 ? LD64 : LDG, nks = mm < 4 ? 2 : 4;
                f32x4 acc[4][2];
#pragma unroll
                for (int tt = 0; tt < 4; ++tt)
#pragma unroll
                    for (int nt = 0; nt < 2; ++nt) acc[tt][nt] = (f32x4){0.f, 0.f, 0.f, 0.f};
#pragma unroll
                for (int ks = 0; ks < 4; ++ks) if (ks < nks)
#pragma unroll
                    for (int tt = 0; tt < 4; ++tt) { const bf16x8 af = *(const LAS bf16x8*)(Ai + (tt * 16 + (lane & 15)) * lda + ks * 32 + (lane >> 4) * 8);
#pragma unroll
                        for (int nt = 0; nt < 2; ++nt) acc[tt][nt] = __builtin_amdgcn_mfma_f32_16x16x32_bf16(af, Bf[mm][nt][ks], acc[tt][nt], 0, 0, 0); }
                LAS h16* STG = (LAS h16*)(F.lds + 10240) + (mm & 1) * (64 * 264);
#pragma unroll
                for (int nt = 0; nt < 2; ++nt) { const int c = c0 + nt * 16 + lc;
                    const float bias = mm < 4 ? pbias[mm < 4 ? mm : 0][nt] : 0.f;
#pragma unroll
                    for (int tt = 0; tt < 4; ++tt)
#pragma unroll
                        for (int i = 0; i < 4; ++i) { const float x = acc[tt][nt][i] + bias; const float sg = sigm(x);
                            const float o = mm < 2 ? 1.f - __expf(-0.60653066f * sg) : (mm < 4 ? sg : x);
                            STG[(tt * 16 + lr + i) * 264 + c] = (h16)o; } }
                LDS_BARRIER();
#pragma unroll
                for (int i = 0; i < 4; ++i) { const int id = tid + 512 * i, t = id >> 5, ch = id & 31, hh = ch >> 3;
                    const h16x8 v = *(const LAS h16x8*)(STG + t * 264 + ch * 8);
                    h16* dst = mm < 2 ? RECD + ((((size_t)b * 4 + hh) * 2 + mm) * TB + p0 + t) * 128 + (ch & 7) * 8
                             : (mm < 4 ? RECD + ((((size_t)b * 4 + hh) * 2 + (mm - 2)) * TB + p0 + t) * 128 + 64 + (ch & 7) * 8 : GATE + (rowbase + p0 + t) * 256 + ch * 8);
                    *(h16x8*)dst = v; }
            } }
        TS_E(23);
    }
}

__device__ __forceinline__ f32x4 mma16(f32x4 acc, const LAS bf16* A, int lda, const LAS bf16* Bt, int ldb, int lane) {
    const int r = lane & 15, kq = (lane >> 4) * 8;
    const bf16x8 a = *(const LAS bf16x8*)(A + r * lda + kq);
    const bf16x8 b = *(const LAS bf16x8*)(Bt + r * ldb + kq);
    return __builtin_amdgcn_mfma_f32_16x16x32_bf16(a, b, acc, 0, 0, 0);
}
typedef short v4i16 __attribute__((ext_vector_type(4)));
__device__ __forceinline__ bf16x8 frag_tr(const LAS bf16* T, int ld, int k0, int c0, int lane) {
    const int g = lane >> 4, q = (lane & 15) >> 2, p = lane & 3;
    const LAS bf16* a = T + (k0 + 8 * g + q) * ld + c0 + 4 * p;
    const v4i16 lo = __builtin_amdgcn_ds_read_tr16_b64_v4i16((LAS v4i16*)a);
    const v4i16 hi = __builtin_amdgcn_ds_read_tr16_b64_v4i16((LAS v4i16*)(a + 4 * ld));
    return (bf16x8){lo[0], lo[1], lo[2], lo[3], hi[0], hi[1], hi[2], hi[3]};
}
__device__ __forceinline__ bf16x8 frag_row(const LAS bf16* A, int lda, int lane) { return *(const LAS bf16x8*)(A + (lane & 15) * lda + (lane >> 4) * 8); }
template <int MT, int NT, int KS> __device__ __forceinline__ void mm_block(f32x4 (&acc)[MT][NT], const LAS bf16* A, int lda, const LAS bf16* Bt, int ldb, int lane) {
    bf16x8 af[MT][KS], bfr[NT][KS];
#pragma unroll
    for (int mi = 0; mi < MT; ++mi)
#pragma unroll
        for (int ks = 0; ks < KS; ++ks) af[mi][ks] = frag_row(A + mi * 16 * lda + ks * 32, lda, lane);
#pragma unroll
    for (int nt = 0; nt < NT; ++nt)
#pragma unroll
        for (int ks = 0; ks < KS; ++ks) bfr[nt][ks] = frag_row(Bt + nt * 16 * ldb + ks * 32, ldb, lane);
#pragma unroll
    for (int mi = 0; mi < MT; ++mi)
#pragma unroll
        for (int nt = 0; nt < NT; ++nt)
#pragma unroll
            for (int ks = 0; ks < KS; ++ks) acc[mi][nt] = __builtin_amdgcn_mfma_f32_16x16x32_bf16(af[mi][ks], bfr[nt][ks], acc[mi][nt], 0, 0, 0);
}
__device__ __forceinline__ float scan_incl(float v, int lane, bool rev) {
#pragma unroll
    for (int o = 1; o < 64; o <<= 1) { const float t = rev ? __shfl_down(v, o) : __shfl_up(v, o); if (rev ? (lane + o < 64) : (lane >= o)) v += t; }
    return v;
}


__device__ __forceinline__ void gla_bcs(const Frame& F, const AS4 Args* KA, size_t row0, LAS float* LG, LAS float* GLT, LAS float* HT) {
    const int tid = F.tid;
    const float* UM = (const float*)(F.ws + WS_UMISC); const float* ga2 = LP(28, 2 * 16 * 128); const float* gb = LP(29, 256);
    const int d = (tid >> 7) & 1, ch = tid & 127;
    float w[16]; float bias = 0.f; f32x4 um = {0.f, 0.f, 0.f, 0.f};
    if (tid < 256) {
#pragma unroll
        for (int j = 0; j < 16; ++j) w[j] = ga2[(size_t)(d * 16 + j) * 128 + ch];
        bias = gb[d * 128 + ch];
        um = *(const f32x4*)(UM + (row0 + (tid >> 2)) * 32 + 8 + (tid & 3) * 4); }
    LDS_BARRIER();
    if (tid < 256) *(LAS f32x4*)(GLT + (tid >> 2) * 16 + (tid & 3) * 4) = um;
    LDS_BARRIER();
    if (tid < 256) { float run = 0.f;
#pragma unroll 8
        for (int t = 0; t < 64; ++t) { const int s = d ? 63 - t : t; float z = bias;
#pragma unroll
            for (int j4 = 0; j4 < 4; ++j4) { const f32x4 g4 = *(const LAS f32x4*)(GLT + s * 16 + j4 * 4); z += g4.x * w[j4 * 4] + g4.y * w[j4 * 4 + 1] + g4.z * w[j4 * 4 + 2] + g4.w * w[j4 * 4 + 3]; }
            const float ls = z < -20.f ? z : -__logf(1.f + __expf(-z));
            run += ls * (1.f / 16.f); LG[(d * 64 + s) * 128 + ch] = run; } }
    LDS_BARRIER();
}
__device__ __forceinline__ void phase_combine_gla(const Frame& F0) {
    PH_ENTER(F0);
    const int gid = F.bid * 512 + F.tid;
    if (gid >= 64 * 1024) return;
    const int chain = gid >> 10, e0 = (gid & 1023) * 2, d = chain & 1, bh = chain >> 1, b = bh >> 2, h = bh & 3;
    bf16* GS = (bf16*)(F.ws + WS_GS) + (size_t)chain * NTILE64 * 2048 + e0; const float* GDEC = (const float*)(F.ws + WS_GDEC) + (size_t)b * NTILE64 * 256 + d * 128 + h * 32 + (e0 & 31);
    float S0 = 0.f, S1 = 0.f;
#pragma unroll 4
    for (int it = 0; it < NTILE64; ++it) {
        const int c = d == 0 ? it : (it < 4 ? 3 - it : 131 - (it - 4));
        unsigned* p = (unsigned*)(GS + (size_t)c * 2048); const unsigned st = *p; const f32x2 dec = *(const f32x2*)(GDEC + (size_t)c * 256);
        *p = pk2(S0, S1);
        S0 = S0 * dec.x + __uint_as_float(st << 16); S1 = S1 * dec.y + __uint_as_float(st & 0xffff0000u);
    }
}
__device__ __forceinline__ void phase_finish_gla(const Frame& F0) {
    PH_ENTER(F0);
    const AS4 Args* KA = kargs();
    const int tid = F.tid, lane = F.lane, wave = F.wave;
    const bf16* UG = (const bf16*)(F.ws + WS_UGLA); const bf16* GS = (const bf16*)(F.ws + WS_GS); bf16* MIX = (bf16*)((unsigned char*)F.out + OUT_MIX);
    const float* gln = LP(30, 256);
    constexpr int LD32 = 40;
    LAS float* LG = (LAS float*)F.lds;
    LAS bf16* QE = (LAS bf16*)(F.lds + 65536);
    LAS bf16* KE = (LAS bf16*)(F.lds + 86016);
    LAS bf16* VT = (LAS bf16*)(F.lds + 96256);
    LAS bf16* ST = (LAS bf16*)(F.lds + 105472);
    LAS bf16* ATT = (LAS bf16*)(F.lds + 115712);
    LAS bf16* OB = (LAS bf16*)(F.lds + 124928);
    LAS float* RSQ = (LAS float*)(F.lds + 134144);
    LAS float* GLT = (LAS float*)(F.lds + 134656);
    LAS bf16* RT = (LAS bf16*)(F.lds + 138752);
    const int lt = wave & 3, cth = wave >> 2, lr = (lane >> 4) * 4, lc = lane & 15;
    const bool skipctx = F.l == 1;
    for (int j_ = F.G - 1 - F.bid; j_ < n_units(skipctx); j_ += F.G) {
        const int u = unit_of(skipctx, j_);
        const int b = u / NTILE64, c = u % NTILE64; const size_t row0 = (size_t)b * TB + (size_t)c * 64;
        u32x2 pq, pk; u32x4 pv, pst, prt;
        { const int l = tid >> 3, g4 = (tid & 7) * 4; const bf16* ur = UG + (row0 + l) * 768;
            pq = *(const u32x2*)(ur + g4); pk = *(const u32x2*)(ur + 128 + g4);
            pv = *(const u32x4*)(UG + (row0 + (tid & 63)) * 768 + 256 + (tid >> 6) * 8);
            { const int d = tid >> 8, r = (tid & 255) >> 2, ch = tid & 3; pst = *(const u32x4*)(GS + ((((size_t)b * 4) * 2 + d) * NTILE64 + c) * 2048 + r * 32 + ch * 8); }
            prt = *(const u32x4*)(UG + (row0 + (tid >> 3)) * 768 + 512 + (tid & 7) * 8); }
        gla_bcs(F, KA, row0, LG, GLT, (LAS float*)(F.lds + 138752));
#pragma unroll 1
        for (int h = 0; h < 4; ++h) {
            { const int l = tid >> 3, g4 = (tid & 7) * 4, ch = h * 32 + g4;
                const u32x2 qr = pq, kr = pk;
                const float q[4] = { bf2f(qr.x & 0xffff) * 0.17677669529663687f, bf2f(qr.x >> 16) * 0.17677669529663687f, bf2f(qr.y & 0xffff) * 0.17677669529663687f, bf2f(qr.y >> 16) * 0.17677669529663687f };
                const float k[4] = { bf2f(kr.x & 0xffff), bf2f(kr.x >> 16), bf2f(kr.y & 0xffff), bf2f(kr.y >> 16) };
#pragma unroll
                for (int d = 0; d < 2; ++d) { const f32x4 bc = *(const LAS f32x4*)(LG + (d * 64 + l) * 128 + ch), rf = *(const LAS f32x4*)(LG + (d * 64 + 32) * 128 + ch);
                    float qe[4], ke[4], qb[4];
#pragma unroll
                    for (int i = 0; i < 4; ++i) { qe[i] = q[i] * __expf(bc[i] - rf[i]); ke[i] = k[i] * __expf(rf[i] - bc[i]); qb[i] = q[i] * __expf(bc[i]); }
                    u32x2 w; w.x = pk2(qe[0], qe[1]); w.y = pk2(qe[2], qe[3]); *(LAS u32x2*)(QE + (d * 64 + l) * LD32 + g4) = w;
                    w.x = pk2(qb[0], qb[1]); w.y = pk2(qb[2], qb[3]); *(LAS u32x2*)(QE + ((2 + d) * 64 + l) * LD32 + g4) = w;
                    w.x = pk2(ke[0], ke[1]); w.y = pk2(ke[2], ke[3]); *(LAS u32x2*)(KE + (d * 64 + l) * LD32 + g4) = w; } }
            { const int s = tid & 63, g8 = tid >> 6; const unsigned w[4] = {pv.x, pv.y, pv.z, pv.w};
#pragma unroll
                for (int i = 0; i < 8; ++i) VT[(g8 * 8 + i) * LD64 + s] = (bf16)(i & 1 ? w[i >> 1] >> 16 : w[i >> 1] & 0xffffu); }
            { const int d = tid >> 8, r = (tid & 255) >> 2, ch = tid & 3; *(LAS u32x4*)(ST + (d * 64 + r) * LD32 + ch * 8) = pst; }
            *(LAS u32x4*)(RT + (tid >> 3) * LD64 + (tid & 7) * 8) = prt;
            { const int hn = h < 3 ? h + 1 : 3; const int l = tid >> 3, g4 = (tid & 7) * 4; const bf16* ur = UG + (row0 + l) * 768;
                pq = *(const u32x2*)(ur + hn * 32 + g4); pk = *(const u32x2*)(ur + 128 + hn * 32 + g4);
                pv = *(const u32x4*)(UG + (row0 + (tid & 63)) * 768 + 256 + hn * 64 + (tid >> 6) * 8);
                { const int d = tid >> 8, r = (tid & 255) >> 2, ch = tid & 3; pst = *(const u32x4*)(GS + ((((size_t)b * 4 + hn) * 2 + d) * NTILE64 + c) * 2048 + r * 32 + ch * 8); }
                prt = *(const u32x4*)(UG + (row0 + (tid >> 3)) * 768 + 512 + hn * 64 + (tid & 7) * 8); }
            LDS_BARRIER();
#pragma unroll
            for (int j = 0; j < 2; ++j) { const int st = 2 * cth + j; const f32x4 z4 = {0.f, 0.f, 0.f, 0.f};
                const f32x4 af = mma16(z4, QE + (lt * 16) * LD32, LD32, KE + (st * 16) * LD32, LD32, lane);
                const f32x4 ab = mma16(z4, QE + (64 + lt * 16) * LD32, LD32, KE + (64 + st * 16) * LD32, LD32, lane);
                const int s = st * 16 + lc;
#pragma unroll
                for (int i = 0; i < 4; ++i) { const int l = lt * 16 + lr + i; ATT[l * LD64 + s] = (bf16)f2bf((s <= l ? af[i] : 0.f) + (s >= l ? ab[i] : 0.f)); } }
            LDS_BARRIER();
            f32x4 o[2];
#pragma unroll
            for (int j = 0; j < 2; ++j) { const int vt = 2 * cth + j; f32x4 acc = {0.f, 0.f, 0.f, 0.f};
#pragma unroll
                for (int ks = 0; ks < 2; ++ks) acc = mma16(acc, ATT + lt * 16 * LD64 + ks * 32, LD64, VT + vt * 16 * LD64 + ks * 32, LD64, lane);
                acc = mma16(acc, QE + (128 + lt * 16) * LD32, LD32, ST + (vt * 16) * LD32, LD32, lane);
                acc = mma16(acc, QE + (192 + lt * 16) * LD32, LD32, ST + (64 + vt * 16) * LD32, LD32, lane);
                o[j] = acc; }
#pragma unroll
            for (int i = 0; i < 4; ++i) { const float t = sum16(o[0][i] * o[0][i] + o[1][i] * o[1][i]); if (lc == 0) RSQ[cth * 64 + lt * 16 + lr + i] = t; }
            LDS_BARRIER();
#pragma unroll
            for (int j = 0; j < 2; ++j) { const int dv = (2 * cth + j) * 16 + lc; const float gn = gln[h * 64 + dv];
#pragma unroll
                for (int i = 0; i < 4; ++i) { const int l = lt * 16 + lr + i; const float scl = rsqrtf((RSQ[l] + RSQ[64 + l]) * (1.f / 64.f) + 1e-6f);
                    const float r = bf2f(RT[l * LD64 + dv]);
                    OB[l * LD64 + dv] = (bf16)f2bf(o[j][i] * scl * gn * siluf(r)); } }
            LDS_BARRIER();
            { const int r = tid >> 3, ch = tid & 7; *(u32x4*)(MIX + (row0 + r) * D + 768 + h * 64 + ch * 8) = *(const LAS u32x4*)(OB + r * LD64 + ch * 8); }
        }
    }
}

__device__ __forceinline__ void phase_states(const Frame& F0) {
    PH_ENTER(F0);
    const AS4 Args* KA = kargs();
    const int tid = F.tid, lane = F.lane, wave = F.wave;
    const bf16* XBCA = (const bf16*)((const unsigned char*)F.out + OUT_XBCA); const float* UM = (const float*)(F.ws + WS_UMISC);
    bf16* SS = (bf16*)(F.ws + WS_SS); float* SDEC = (float*)(F.ws + WS_SDEC);
    const float* dtb = LP(24, 16); const float* alog = LP(25, 16);
    LAS bf16* CT = (LAS bf16*)F.lds;
    LAS bf16* XTW = (LAS bf16*)(F.lds + 99328);
    LAS bf16* BT = (LAS bf16*)(F.lds + 117760);
    LAS float* WTS = (LAS float*)(F.lds + 136192);
    const bf16* UG = (const bf16*)(F.ws + WS_UGLA); bf16* GS = (bf16*)(F.ws + WS_GS); float* GDEC = (float*)(F.ws + WS_GDEC);
    LAS float* LG = (LAS float*)F.lds;
    LAS bf16* VT4 = (LAS bf16*)(F.lds + 65536);
    LAS bf16* KTE = (LAS bf16*)(F.lds + 102400);
    LAS float* GLT = (LAS float*)(F.lds + 139264);
    u32x4 pt[12];
#define ST_LOAD(uu) do { const int b_ = (uu) / NTILE64, c_ = (uu) % NTILE64; const size_t r0_ = (size_t)b_ * TB + (size_t)c_ * 64; \
        _Pragma("unroll") for (int i = 0; i < 12; ++i) { const int id = launder_i(tid) + 512 * i, r = id / 96, ch = id % 96; pt[i] = *(const u32x4*)(XBCA + (r0_ + r) * 768 + ch * 8); } } while (0)
    if (F.G - 1 - F.bid < NUNIT64) ST_LOAD(F.G - 1 - F.bid);
    for (int u = F.G - 1 - F.bid; u < NUNIT64; u += F.G) {
        const int b = u / NTILE64, c = u % NTILE64; const size_t row0 = (size_t)b * TB + (size_t)c * 64;
        TS_B(1);
        LDS_BARRIER();
#pragma unroll
        for (int i = 0; i < 12; ++i) { const int id = tid + 512 * i, r = id / 96, ch = id % 96;
            *(LAS u32x4*)(CT + r * 776 + ch * 8) = pt[i]; }
#pragma unroll
        for (int j = 0; j < 2; ++j) { const int q = wave * 2 + j, h = q >> 1, d = q & 1;
            const float dtp = softplusf_(UM[(row0 + lane) * 32 + h] + dtb[d * 8 + h]);
            const float dA = -__expf(alog[d * 8 + h]) * dtp;
            const float cs = scan_incl(dA, lane, d == 1);
            const float ce = __shfl(cs, d == 0 ? 63 : 0);
            WTS[q * 64 + lane] = __expf(ce - cs) * dtp;
            if (lane == 0) SDEC[((size_t)b * NTILE64 + c) * 16 + q] = __expf(ce); }
        LDS_BARRIER();
        TS_E(1); TS_B(2);
#pragma unroll 1
        for (int hp = 0; hp < 4; ++hp) {
            { const int sr = tid >> 3, ch = tid & 7, g = hp >> 1; float bv[8]; unpack8(*(const LAS u32x4*)(CT + sr * 776 + 512 + g * 64 + ch * 8), bv);
#pragma unroll
                for (int q = 0; q < 4; ++q) { const float w = WTS[(hp * 4 + q) * 64 + sr]; float o[8];
#pragma unroll
                    for (int i = 0; i < 8; ++i) o[i] = bv[i] * w;
                    *(LAS u32x4*)(XTW + (q * 64 + sr) * LD64 + ch * 8) = pack8(o); } }
            LDS_BARRIER();
            { const int d = wave >> 2, mt = wave & 3;
#pragma unroll
                for (int hh = 0; hh < 2; ++hh) { const int h = hp * 2 + hh;
                    bf16* dst = SS + ((((size_t)b * 8 + h) * 2 + d) * NTILE64 + c) * 4096;
                    bf16x8 af[2];
#pragma unroll
                    for (int ks = 0; ks < 2; ++ks) af[ks] = frag_tr(CT, 776, ks * 32, h * 64 + mt * 16, lane);
#pragma unroll
                    for (int nt = 0; nt < 4; ++nt) { f32x4 acc = {0.f, 0.f, 0.f, 0.f};
#pragma unroll
                        for (int ks = 0; ks < 2; ++ks) acc = __builtin_amdgcn_mfma_f32_16x16x32_bf16(af[ks], frag_tr(XTW + (hh * 2 + d) * 64 * LD64, LD64, ks * 32, nt * 16, lane), acc, 0, 0, 0);
#pragma unroll
                        for (int i = 0; i < 4; ++i) dst[(mt * 16 + (lane >> 4) * 4 + i) * 64 + nt * 16 + (lane & 15)] = (bf16)f2bf(acc[i]); } } }
            LDS_BARRIER();
        }
        TS_E(2); TS_B(3);
        if (u + F.G < NUNIT64) ST_LOAD(u + F.G);
        gla_bcs(F, KA, row0, LG, GLT, (LAS float*)(F.lds + 143360));
        if (tid < 256) GDEC[((size_t)b * NTILE64 + c) * 256 + tid] = __expf(LG[((tid >> 7) * 64 + ((tid >> 7) ? 0 : 63)) * 128 + (tid & 127)]);
        { const int sr = tid >> 3, q8 = tid & 7; const bf16* ur = UG + (row0 + sr) * 768;
#pragma unroll
            for (int i = 0; i < 4; ++i) { const int col = (q8 * 4 + i) * 8; *(LAS u32x4*)(VT4 + sr * 264 + col) = *(const u32x4*)(ur + 256 + col); }
#pragma unroll
            for (int i = 0; i < 2; ++i) { const int col = (q8 * 2 + i) * 8; float kv[8]; unpack8(*(const u32x4*)(ur + 128 + col), kv);
#pragma unroll
                for (int d = 0; d < 2; ++d) { const LAS float* be = LG + (d * 64 + (d ? 0 : 63)) * 128 + col; const LAS float* bc = LG + (d * 64 + sr) * 128 + col; float o[8];
#pragma unroll
                    for (int k = 0; k < 8; ++k) o[k] = kv[k] * __expf(be[k] - bc[k]);
                    *(LAS u32x4*)(KTE + (d * 64 + sr) * 136 + col) = pack8(o); } } }
        LDS_BARRIER();
        { const int d = wave >> 2, mt = wave & 3;
#pragma unroll
            for (int h = 0; h < 4; ++h) { bf16* dst = GS + ((((size_t)b * 4 + h) * 2 + d) * NTILE64 + c) * 2048;
                bf16x8 af[2];
#pragma unroll
                for (int ks = 0; ks < 2; ++ks) af[ks] = frag_tr(VT4, 264, ks * 32, h * 64 + mt * 16, lane);
#pragma unroll
                for (int nt = 0; nt < 2; ++nt) { f32x4 acc = {0.f, 0.f, 0.f, 0.f};
#pragma unroll
                    for (int ks = 0; ks < 2; ++ks) acc = __builtin_amdgcn_mfma_f32_16x16x32_bf16(af[ks], frag_tr(KTE + d * 64 * 136, 136, ks * 32, h * 32 + nt * 16, lane), acc, 0, 0, 0);
#pragma unroll
                    for (int i = 0; i < 4; ++i) dst[(mt * 16 + (lane >> 4) * 4 + i) * 32 + nt * 16 + (lane & 15)] = (bf16)f2bf(acc[i]); } } }
        TS_E(3);
    }
#undef ST_LOAD
}
__device__ __forceinline__ void phase_combine_ssd(const Frame& F0) {
    PH_ENTER(F0);
    const int gid = F.bid * 512 + F.tid;
    if (gid >= 128 * 1024) return;
    const int chain = gid >> 10, e0 = (gid & 1023) * 4, d = chain & 1, bh = chain >> 1, b = bh >> 3, h = bh & 7;
    bf16* SS = (bf16*)(F.ws + WS_SS) + (size_t)chain * NTILE64 * 4096 + e0; const float* SDEC = (const float*)(F.ws + WS_SDEC) + (size_t)b * NTILE64 * 16 + h * 2 + d;
    float S0 = 0.f, S1 = 0.f, S2 = 0.f, S3 = 0.f;
#pragma unroll 4
    for (int it = 0; it < NTILE64; ++it) {
        const int c = d == 0 ? it : (it < 4 ? 3 - it : 131 - (it - 4));
        u32x2* p = (u32x2*)(SS + (size_t)c * 4096); const u32x2 st = *p; const float dec = SDEC[c * 16];
        u32x2 o; o.x = pk2(S0, S1); o.y = pk2(S2, S3); *p = o;
        S0 = S0 * dec + __uint_as_float(st.x << 16); S1 = S1 * dec + __uint_as_float(st.x & 0xffff0000u); S2 = S2 * dec + __uint_as_float(st.y << 16); S3 = S3 * dec + __uint_as_float(st.y & 0xffff0000u);
    }
}
__device__ __forceinline__ void phase_finish_ssd(const Frame& F0) {
    PH_ENTER(F0);
    const AS4 Args* KA = kargs();
    const int tid = F.tid, lane = F.lane, wave = F.wave;
    const bf16* XBCA = (const bf16*)((const unsigned char*)F.out + OUT_XBCA); const float* UM = (const float*)(F.ws + WS_UMISC); const bf16* UZ = (const bf16*)(F.ws + WS_UZ);
    const bf16* SS = (const bf16*)(F.ws + WS_SS); bf16* MIX = (bf16*)((unsigned char*)F.out + OUT_MIX);
    const float* dtb = LP(24, 16); const float* alog = LP(25, 16); const float* dsk = LP(26, 8); const float* sng = LP(27, 512);
    LAS bf16* CB = (LAS bf16*)F.lds;
    LAS bf16* BI = (LAS bf16*)(F.lds + 18432);
    LAS bf16* XT = (LAS bf16*)(F.lds + 18432);
    LAS bf16* MI = (LAS bf16*)(F.lds + 27648);
    LAS bf16* SFB = (LAS bf16*)(F.lds + 36864);
    LAS float* ACS = (LAS float*)(F.lds + 55296);
    LAS float* RSQ = (LAS float*)(F.lds + 63488);
    LAS bf16* GB = (LAS bf16*)(F.lds + 64000);
    LAS bf16* ZT = (LAS bf16*)(F.lds + 129536);
    const int lt = wave & 3, cth = wave >> 2, lr = (lane >> 4) * 4, lc = lane & 15;
    const bool skipctx = F.l == 1;
    for (int j_ = F.bid; j_ < n_units(skipctx); j_ += F.G) {
        const int u = unit_of(skipctx, j_);
        const int b = u / NTILE64, c = u % NTILE64; const size_t row0 = (size_t)b * TB + (size_t)c * 64;
        u32x4 pxt, psf, psb, pzt;
        { const int s_ = tid & 63, pg = tid >> 6, r = tid >> 3, ch = tid & 7;
            pxt = *(const u32x4*)(XBCA + (row0 + r) * 768 + ch * 8);
            psf = *(const u32x4*)(SS + ((((size_t)b * 8) * 2 + 0) * NTILE64 + c) * 4096 + r * 64 + ch * 8); psb = *(const u32x4*)(SS + ((((size_t)b * 8) * 2 + 1) * NTILE64 + c) * 4096 + r * 64 + ch * 8);
            pzt = *(const u32x4*)(UZ + (row0 + r) * 512 + ch * 8); }
        LDS_BARRIER();
#pragma unroll
        for (int i = 0; i < 4; ++i) { const int id = tid + 512 * i, r = id >> 5, ch = id & 31;
            const int which = ch >> 3;
            LAS bf16* dst = (which < 2 ? BI + (which * 64 + r) * LD64 : CB + ((which - 2) * 64 + r) * LD64) + (ch & 7) * 8;
            *(LAS u32x4*)dst = *(const u32x4*)(XBCA + (row0 + r) * 768 + 512 + ch * 8); }
        { const int h = wave;
#pragma unroll
            for (int d = 0; d < 2; ++d) { const float dtp = softplusf_(UM[(row0 + lane) * 32 + h] + dtb[d * 8 + h]);
                const float cs = scan_incl(-__expf(alog[d * 8 + h]) * dtp, lane, d == 1);
                ACS[(d * 8 + h) * 64 + lane] = cs; ACS[((2 + d) * 8 + h) * 64 + lane] = dtp; } }
        LDS_BARRIER();
        f32x4 G00 = {0.f, 0.f, 0.f, 0.f}, G01 = G00, G10 = G00, G11 = G00;
#pragma unroll
        for (int ks = 0; ks < 2; ++ks) {
            G00 = mma16(G00, CB + (lt * 16) * LD64 + ks * 32, LD64, BI + ((2 * cth) * 16) * LD64 + ks * 32, LD64, lane);
            G01 = mma16(G01, CB + (lt * 16) * LD64 + ks * 32, LD64, BI + ((2 * cth + 1) * 16) * LD64 + ks * 32, LD64, lane);
            G10 = mma16(G10, CB + (64 + lt * 16) * LD64 + ks * 32, LD64, BI + (64 + (2 * cth) * 16) * LD64 + ks * 32, LD64, lane);
            G11 = mma16(G11, CB + (64 + lt * 16) * LD64 + ks * 32, LD64, BI + (64 + (2 * cth + 1) * 16) * LD64 + ks * 32, LD64, lane); }
        LDS_BARRIER();
        f32x4 rsq = {0.f, 0.f, 0.f, 0.f};
#pragma unroll 1
        for (int h = 0; h < 8; ++h) {
            const int g = h >> 2;
            { const int r = tid >> 3, ch = tid & 7;
                *(LAS u32x4*)(XT + r * LD64 + ch * 8) = pxt;
                *(LAS u32x4*)(SFB + r * LD64 + ch * 8) = psf; *(LAS u32x4*)(SFB + (64 + r) * LD64 + ch * 8) = psb; *(LAS u32x4*)(ZT + r * LD64 + ch * 8) = pzt;
                const int hn = h < 7 ? h + 1 : 7;
                pxt = *(const u32x4*)(XBCA + (row0 + r) * 768 + hn * 64 + ch * 8);
                psf = *(const u32x4*)(SS + ((((size_t)b * 8 + hn) * 2 + 0) * NTILE64 + c) * 4096 + r * 64 + ch * 8); psb = *(const u32x4*)(SS + ((((size_t)b * 8 + hn) * 2 + 1) * NTILE64 + c) * 4096 + r * 64 + ch * 8);
                pzt = *(const u32x4*)(UZ + (row0 + r) * 512 + hn * 64 + ch * 8); }
            const LAS float* af = ACS + h * 64; const LAS float* ab = ACS + (8 + h) * 64; const LAS float* pf = ACS + (16 + h) * 64; const LAS float* pb = ACS + (24 + h) * 64;
            const f32x4 afl = *(const LAS f32x4*)(af + lt * 16 + lr), abl = *(const LAS f32x4*)(ab + lt * 16 + lr);
#pragma unroll
            for (int j = 0; j < 2; ++j) { const int s = (2 * cth + j) * 16 + lc; const float afs = af[s], abs_ = ab[s], pfs = pf[s], pbs = pb[s];
                const f32x4 gt = g ? (j ? G11 : G10) : (j ? G01 : G00);
#pragma unroll
                for (int i = 0; i < 4; ++i) { const int l = lt * 16 + lr + i;
                    const float ef = __expf(fminf(afl[i] - afs, 0.f)) * pfs, eb = __expf(fminf(abl[i] - abs_, 0.f)) * pbs;
                    const float wf = s <= l ? ef : 0.f, wb = s >= l ? eb : 0.f;
                    MI[l * LD64 + s] = (bf16)f2bf(gt[i] * (wf + wb)); } }
            LDS_BARRIER();
#pragma unroll
            for (int j = 0; j < 2; ++j) { const int pt = 2 * cth + j; f32x4 acc = {0.f, 0.f, 0.f, 0.f}, tf = {0.f, 0.f, 0.f, 0.f}, tb = {0.f, 0.f, 0.f, 0.f};
#pragma unroll
                for (int ks = 0; ks < 2; ++ks) { acc = __builtin_amdgcn_mfma_f32_16x16x32_bf16(frag_row(MI + lt * 16 * LD64 + ks * 32, LD64, lane), frag_tr(XT, LD64, ks * 32, pt * 16, lane), acc, 0, 0, 0);
                    tf = mma16(tf, CB + (g * 64 + lt * 16) * LD64 + ks * 32, LD64, SFB + pt * 16 * LD64 + ks * 32, LD64, lane);
                    tb = mma16(tb, CB + (g * 64 + lt * 16) * LD64 + ks * 32, LD64, SFB + (64 + pt * 16) * LD64 + ks * 32, LD64, lane); }
                const int p = pt * 16 + lc; const float ds = dsk[h];
#pragma unroll
                for (int i = 0; i < 4; ++i) { const int l = lt * 16 + lr + i;
                    const float y = acc[i] + __expf(afl[i]) * tf[i] + __expf(abl[i]) * tb[i];
                    const float xs = bf2f(XT[l * LD64 + p]), z = bf2f(ZT[l * LD64 + p]);
                    const float gv = (y + ds * xs) * siluf(z); GB[l * 512 + h * 64 + p] = (bf16)f2bf(gv); rsq[i] += gv * gv; } }
            LDS_BARRIER();
        }
#pragma unroll
        for (int i = 0; i < 4; ++i) { const float t = sum16(rsq[i]); if (lc == 0) RSQ[cth * 64 + lt * 16 + lr + i] = t; }
        LDS_BARRIER();
#pragma unroll
        for (int i = 0; i < 8; ++i) { const int id = tid + 512 * i, r = id >> 6, ch = id & 63;
            const float scl = rsqrtf((RSQ[r] + RSQ[64 + r]) * (1.f / 512.f) + 1e-6f);
            float v[8]; unpack8(*(const LAS u32x4*)(GB + r * 512 + ch * 8), v);
            const f32x4 n0 = *(const f32x4*)(sng + ch * 8), n1 = *(const f32x4*)(sng + ch * 8 + 4);
#pragma unroll
            for (int k = 0; k < 4; ++k) { v[k] *= scl * n0[k]; v[4 + k] *= scl * n1[k]; }
            *(u32x4*)(MIX + (row0 + r) * D + 256 + ch * 8) = pack8(v); }
    }
}


__device__ __forceinline__ bf16* rw_out(unsigned char* ws, int b, int h, int d, int c, int which) {
    h16* RECS = (h16*)(ws + WS_RECS); h16* RECD = (h16*)(ws + WS_RECD); const size_t p0 = (size_t)c * 64;
    if (d == 0) return (bf16*)(RECS + (((size_t)b * 4 + h) * TB + p0) * 256) + which * 4096;
    return (bf16*)(RECD + ((((size_t)b * 4 + h) * 2 + (which >> 1)) * TB + p0) * 128) + (which & 1) * 4096;
}
__device__ __forceinline__ void phase_rwkv_local(const Frame& F0) {
    PH_ENTER(F0);
    const AS4 Args* KA = kargs();
    const int tid0 = F.tid, wave = F.wave;
#define RL_STEP const int tid = launder_i(tid0); const int lane = tid & 63; const int lr = (lane >> 4) * 4, lc = lane & 15;
    const h16* RECS = (const h16*)(F.ws + WS_RECS); const h16* RECD = (const h16*)(F.ws + WS_RECD);
    float* RPL = (float*)(F.ws + WS_RPL);
    const float* k_a = LP(18, 256);
    constexpr int LDS_S = 264, LDS_D = 136, LDF = 68;
    LAS h16* STS = (LAS h16*)F.lds;
    LAS h16* STD = (LAS h16*)(F.lds + 33792);
    LAS float* AABF = (LAS float*)(F.lds + 33792);
    LAS bf16* ULT = (LAS bf16*)(F.lds + 33792);
    LAS float* TF = (LAS float*)(F.lds + 51200);
    LAS bf16* AVT = (LAS bf16*)(F.lds + 51200); LAS bf16* W0T = (LAS bf16*)(F.lds + 60416);
    LAS bf16* NAT = (LAS bf16*)(F.lds + 69632);
    LAS bf16* TRN = (LAS bf16*)(F.lds + 106496);
    LAS bf16* R0I = (LAS bf16*)(F.lds + 143360);
    LAS float* M1 = (LAS float*)(F.lds + 152576);
    LAS float* GSUM = (LAS float*)(F.lds + 157184);
    h16x8 ps[4], pd[2];
#define RL_LOAD_S(uu) do { const int h_ = (uu) & 3, bc_ = (uu) >> 2, b_ = bc_ / NTILE64, c_ = bc_ % NTILE64; const h16* src = RECS + (((size_t)b_ * 4 + h_) * TB + (size_t)c_ * 64) * 256; \
        _Pragma("unroll") for (int i = 0; i < 4; ++i) { const int id = launder_i(tid0) + 512 * i, r = id >> 5, ch = id & 31; ps[i] = *(const h16x8*)(src + (size_t)r * 256 + ch * 8); } } while (0)
#define RL_LOAD_D(uu, dd) do { const int h_ = (uu) & 3, bc_ = (uu) >> 2, b_ = bc_ / NTILE64, c_ = bc_ % NTILE64; const h16* src = RECD + ((((size_t)b_ * 4 + h_) * 2 + (dd)) * TB + (size_t)c_ * 64) * 128; \
        _Pragma("unroll") for (int i = 0; i < 2; ++i) { const int id = launder_i(tid0) + 512 * i, r = id >> 4, ch = id & 15; pd[i] = *(const h16x8*)(src + (size_t)r * 128 + ch * 8); } } while (0)
    if (F.bid < NUNIT64 * 4) { RL_LOAD_S(F.bid); RL_LOAD_D(F.bid, 0); }
    for (int u = F.bid; u < NUNIT64 * 4; u += F.G) {
        const int h = u & 3, bc = u >> 2, b = bc / NTILE64, c = bc % NTILE64;
        LDS_BARRIER();
        { RL_STEP
#pragma unroll
            for (int i = 0; i < 4; ++i) { const int id = tid + 512 * i, r = id >> 5, ch = id & 31; *(LAS h16x8*)(STS + r * LDS_S + ch * 8) = ps[i]; } }
#pragma unroll 1
        for (int d = 0; d < 2; ++d) {
            TS_B(11);
            LDS_BARRIER();
            { RL_STEP
#pragma unroll
                for (int i = 0; i < 2; ++i) { const int id = tid + 512 * i, r = id >> 4, ch = id & 15; *(LAS h16x8*)(STD + r * LDS_D + ch * 8) = pd[i]; } }
            if (d == 0) RL_LOAD_D(u, 1); else if (u + F.G < NUNIT64 * 4) { RL_LOAD_S(u + F.G); RL_LOAD_D(u + F.G, 0); }
            LDS_BARRIER();
            SUBREP(8) { RL_STEP const int kp = tid & 31, tg = tid >> 5, k = 2 * kp;
                f32x2 wv[4], li[4]; f32x2 run = {1.f, 1.f};
#pragma unroll
                for (int i = 0; i < 4; ++i) { const int t = tg * 4 + i, srow = d ? 63 - t : t; const unsigned raw = *(const LAS unsigned*)(STD + srow * LDS_D + k);
                    const h16 o0 = __builtin_bit_cast(h16, (unsigned short)(raw & 0xffff)), o1 = __builtin_bit_cast(h16, (unsigned short)(raw >> 16));
                    wv[i] = (f32x2){1.f - (float)o0, 1.f - (float)o1}; run = run * wv[i]; li[i] = run; }
                *(LAS f32x2*)(GSUM + tg * 64 + k) = run;
                for (int i = tid; i < 64 * LDF; i += 512) TF[i] = 0.f;
                LDS_BARRIER();
                f32x2 off = {1.f, 1.f}, pref = {1.f, 1.f}, pend = {1.f, 1.f};
#pragma unroll
                for (int g = 0; g < 16; ++g) { const f32x2 gs = *(const LAS f32x2*)(GSUM + g * 64 + k); if (g < tg) off = off * gs; if (g < 8) pref = pref * gs; pend = pend * gs; }
                const f32x2 kac = *(const f32x2*)(k_a + h * 64 + k);
                const f32x2 ipref = {frcp(pref.x), frcp(pref.y)};
                f32x2 pexcl = off;
                unsigned vt[4], a0t[4], bht[4], kht[4];
#pragma unroll
                for (int i = 0; i < 4; ++i) { const int t = tg * 4 + i, srow = d ? 63 - t : t;
                    const f32x2 pin = off * li[i];
                    const unsigned rr = *(const LAS unsigned*)(STS + srow * LDS_S + k), vr = *(const LAS unsigned*)(STS + srow * LDS_S + 64 + k), kkr = *(const LAS unsigned*)(STS + srow * LDS_S + 128 + k), kxr = *(const LAS unsigned*)(STS + srow * LDS_S + 192 + k);
                    const unsigned ar_ = *(const LAS unsigned*)(STD + srow * LDS_D + 64 + k);
#define H2F(x, hi) ((float)__builtin_bit_cast(h16, (unsigned short)((hi) ? ((x) >> 16) : ((x) & 0xffff))))
                    const f32x2 r = {H2F(rr, 0), H2F(rr, 1)}, vv = {H2F(vr, 0), H2F(vr, 1)}, kk = {H2F(kkr, 0), H2F(kkr, 1)}, kx = {H2F(kxr, 0), H2F(kxr, 1)}, av = {H2F(ar_, 0), H2F(ar_, 1)};
#undef H2F
                    const f32x2 kmod = kx * ((av - 1.f) * kac + 1.f), bb = kk * av;
                    const f32x2 ipin = {frcp(pin.x), frcp(pin.y)};
                    const f32x2 e1 = pexcl * ipref, e2 = pin * ipref, e3 = pref * ipin, eL = pend * ipin;
                    const f32x2 at = -kk * e1, rt = r * e2, bt = bb * e3, kt = kmod * e3, r0 = r * pin, a0 = -kk * pexcl, bh = bb * eL, kh = kmod * eL;
                    *(LAS unsigned*)(NAT + (0 * 64 + t) * LD64 + k) = pk2(at.x, at.y); *(LAS unsigned*)(NAT + (1 * 64 + t) * LD64 + k) = pk2(rt.x, rt.y);
                    *(LAS unsigned*)(NAT + (2 * 64 + t) * LD64 + k) = pk2(bt.x, bt.y); *(LAS unsigned*)(NAT + (3 * 64 + t) * LD64 + k) = pk2(kt.x, kt.y);
                    *(LAS unsigned*)(R0I + t * LD64 + k) = pk2(r0.x, r0.y);
                    vt[i] = pk2(vv.x, vv.y); a0t[i] = pk2(a0.x, a0.y); bht[i] = pk2(bh.x, bh.y); kht[i] = pk2(kh.x, kh.y);
                    pexcl = pin; }
#define TR_WR(SLOT, ARR) do { u32x2 lo, hi; lo.x = (ARR[0] & 0xffffu) | (ARR[1] << 16); lo.y = (ARR[2] & 0xffffu) | (ARR[3] << 16); hi.x = (ARR[0] >> 16) | (ARR[1] & 0xffff0000u); hi.y = (ARR[2] >> 16) | (ARR[3] & 0xffff0000u); \
                    *(LAS u32x2*)(TRN + ((SLOT) * 64 + k) * LD64 + tg * 4) = lo; *(LAS u32x2*)(TRN + ((SLOT) * 64 + k + 1) * LD64 + tg * 4) = hi; } while (0)
                TR_WR(0, vt); TR_WR(1, a0t); TR_WR(2, bht); TR_WR(3, kht);
#undef TR_WR
                if (tg == 15) *(f32x2*)(RPL + (((((size_t)b * 4 + h) * 2 + d) * NTILE64) + c) * 64 + k) = pend; }
            LDS_BARRIER();
            TS_E(11); TS_B(12);
            { RL_STEP const int pr = wave >> 1, rh = wave & 1;
                const LAS bf16* Aimg = NAT + ((pr >> 1) * 64) * LD64; const LAS bf16* Bimg = NAT + ((2 + (pr & 1)) * 64) * LD64;
                f32x4 acc[2][4];
#define S3_MM(RH) do { constexpr int MT0 = (RH), MT1 = 3 - (RH); bf16x8 af[2][2], bfr[4][2]; \
                    _Pragma("unroll") for (int ks = 0; ks < 2; ++ks) { af[0][ks] = frag_row(Aimg + MT0 * 16 * LD64 + ks * 32, LD64, lane); af[1][ks] = frag_row(Aimg + MT1 * 16 * LD64 + ks * 32, LD64, lane); } \
                    _Pragma("unroll") for (int nt = 0; nt < 4; ++nt) if (nt <= MT1) { _Pragma("unroll") for (int ks = 0; ks < 2; ++ks) bfr[nt][ks] = frag_row(Bimg + nt * 16 * LD64 + ks * 32, LD64, lane); } \
                    _Pragma("unroll") for (int mi = 0; mi < 2; ++mi) _Pragma("unroll") for (int nt = 0; nt < 4; ++nt) { f32x4 a4 = {0.f, 0.f, 0.f, 0.f}; \
                        if (nt <= (mi ? MT1 : MT0)) { _Pragma("unroll") for (int ks = 0; ks < 2; ++ks) a4 = __builtin_amdgcn_mfma_f32_16x16x32_bf16(af[mi][ks], bfr[nt][ks], a4, 0, 0, 0); } \
                        acc[mi][nt] = a4; } } while (0)
                if (rh == 0) S3_MM(0); else S3_MM(1);
#undef S3_MM
                LDS_BARRIER();
#define S3_EPI(RH) do { constexpr int MT0 = (RH), MT1 = 3 - (RH); \
                    _Pragma("unroll") for (int mi = 0; mi < 2; ++mi) _Pragma("unroll") for (int nt = 0; nt < 4; ++nt) _Pragma("unroll") for (int i = 0; i < 4; ++i) { \
                        const int mt = mi ? MT1 : MT0, t = mt * 16 + lr + i, ii = nt * 16 + lc; \
                        const float v = nt < mt ? acc[mi][nt][i] : (nt > mt ? 0.f : ((pr < 2 ? ii < t : ii <= t) ? acc[mi][nt][i] : 0.f)); \
                        if (pr == 0) AABF[t * LDF + ii] = v; else NAT[((pr - 1) * 64 + t) * LD64 + ii] = (bf16)f2bf(v); } } while (0)
                if (rh == 0) S3_EPI(0); else S3_EPI(1);
#undef S3_EPI
            }
            LDS_BARRIER();
            TS_E(12); TS_B(13);
            SUBREP(9) if (wave == 0) { RL_STEP const int blk = lane >> 4, j = lane & 15; float Tr[16]; const LAS float* ab = AABF + (blk * 16) * LDF + blk * 16;
#pragma unroll
                for (int t = 0; t < 16; ++t) { float a0 = (j == t) ? 1.f : 0.f, a1 = 0.f;
#pragma unroll
                    for (int i4 = 0; i4 < t; i4 += 4) { const f32x4 av = *(const LAS f32x4*)(ab + t * LDF + i4);
                        a0 += av.x * Tr[i4]; if (i4 + 1 < t) a1 += av.y * Tr[i4 + 1]; if (i4 + 2 < t) a0 += av.z * Tr[i4 + 2]; if (i4 + 3 < t) a1 += av.w * Tr[i4 + 3]; }
                    Tr[t] = a0 + a1; TF[(blk * 16 + t) * LDF + blk * 16 + j] = Tr[t]; } }
            LDS_BARRIER();
            TS_E(13); TS_B(14);
            SUBREP(10) {
#define RL_LEVEL(M, ACTIVE, PP, TT, J0) do { \
                { RL_STEP if (ACTIVE) { const int pp = (PP), t = (TT), j0 = (J0), rb = pp * 2 * (M) + (M), cb = pp * 2 * (M); f32x2 mm = {0.f, 0.f}; \
                    _Pragma("unroll") for (int i = 0; i < (M); i += 4) { const f32x4 av = *(const LAS f32x4*)(AABF + (rb + t) * LDF + cb + i); \
                        mm += av.x * *(const LAS f32x2*)(TF + (cb + i) * LDF + cb + j0) + av.y * *(const LAS f32x2*)(TF + (cb + i + 1) * LDF + cb + j0) + av.z * *(const LAS f32x2*)(TF + (cb + i + 2) * LDF + cb + j0) + av.w * *(const LAS f32x2*)(TF + (cb + i + 3) * LDF + cb + j0); } \
                    *(LAS f32x2*)(M1 + pp * 576 + t * 36 + j0) = mm; } } \
                LDS_BARRIER(); \
                { RL_STEP if (ACTIVE) { const int pp = (PP), t = (TT), j0 = (J0), rb = pp * 2 * (M) + (M), cb = pp * 2 * (M); f32x2 xx = {0.f, 0.f}; \
                    _Pragma("unroll") for (int q = 0; q < (M); q += 4) { const f32x4 tv = *(const LAS f32x4*)(TF + (rb + t) * LDF + rb + q); \
                        xx += tv.x * *(const LAS f32x2*)(M1 + pp * 576 + q * 36 + j0) + tv.y * *(const LAS f32x2*)(M1 + pp * 576 + (q + 1) * 36 + j0) + tv.z * *(const LAS f32x2*)(M1 + pp * 576 + (q + 2) * 36 + j0) + tv.w * *(const LAS f32x2*)(M1 + pp * 576 + (q + 3) * 36 + j0); } \
                    *(LAS f32x2*)(TF + (rb + t) * LDF + cb + j0) = xx; } } \
                LDS_BARRIER(); } while (0)
                RL_LEVEL(16, tid < 256, tid >> 7, (tid >> 3) & 15, (tid & 7) * 2);
                RL_LEVEL(32, true, 0, tid >> 4, (tid & 15) * 2);
#undef RL_LEVEL
            }
            { RL_STEP const int t = tid >> 3, i0 = (tid & 7) * 8; float v[8];
#pragma unroll
                for (int i = 0; i < 8; ++i) v[i] = TF[t * LDF + i0 + i];
                *(LAS u32x4*)(NAT + (3 * 64 + t) * LD64 + i0) = pack8(v); }
            LDS_BARRIER();
            TS_E(14); TS_B(15);
            SUBREP(11) { RL_STEP const int pr = wave >> 2, mt = wave & 3; f32x4 acc[4];
#pragma unroll
                for (int nt = 0; nt < 4; ++nt) acc[nt] = (f32x4){0.f, 0.f, 0.f, 0.f};
                { f32x4 (&a2)[1][4] = *reinterpret_cast<f32x4 (*)[1][4]>(&acc); mm_block<1, 4, 2>(a2, TRN + (pr * 64 + mt * 16) * LD64, LD64, NAT + ((pr ? 3 : 0) * 64) * LD64, LD64, lane); }
                LAS bf16* dst = pr ? W0T : AVT;
#pragma unroll
                for (int nt = 0; nt < 4; ++nt)
#pragma unroll
                    for (int i = 0; i < 4; ++i) dst[(mt * 16 + lr + i) * LD64 + nt * 16 + lc] = (bf16)f2bf(acc[nt][i]); }
            LDS_BARRIER();
            SUBREP(11) { RL_STEP const int mt = wave & 3, nh = wave >> 2;
#pragma unroll
                for (int nn = 0; nn < 2; ++nn) { const int nt = 2 * nh + nn; f32x4 a4 = {0.f, 0.f, 0.f, 0.f};
#pragma unroll
                    for (int ks = 0; ks < 2; ++ks) a4 = mma16(a4, AVT + (mt * 16) * LD64 + ks * 32, LD64, NAT + (3 * 64 + nt * 16) * LD64 + ks * 32, LD64, lane);
#pragma unroll
                    for (int i = 0; i < 4; ++i) ULT[(mt * 16 + lr + i) * LD64 + nt * 16 + lc] = (bf16)f2bf(a4[i]); } }
            LDS_BARRIER();
            TS_E(15); TS_B(16);
            { RL_STEP const int o = wave >> 1, rh = wave & 1;
                const LAS bf16* A1 = o == 0 ? TRN + 2 * 64 * LD64 : (o == 1 ? ULT : NAT + 1 * 64 * LD64);
                const LAS bf16* B1 = o == 0 ? W0T : (o == 1 ? TRN + 2 * 64 * LD64 : (o == 2 ? W0T : ULT));
                const LAS bf16* A2 = o == 1 ? TRN : NAT + 2 * 64 * LD64;
                const LAS bf16* B2 = o == 1 ? TRN + 3 * 64 * LD64 : TRN;
                f32x4 res[2][4];
#pragma unroll
                for (int mi = 0; mi < 2; ++mi)
#pragma unroll
                    for (int nt = 0; nt < 4; ++nt) res[mi][nt] = (f32x4){0.f, 0.f, 0.f, 0.f};
                mm_block<2, 4, 2>(res, A1 + (2 * rh * 16) * LD64, LD64, B1, LD64, lane);
                if (o == 1 || o == 3) mm_block<2, 4, 2>(res, A2 + (2 * rh * 16) * LD64, LD64, B2, LD64, lane);
                if (o == 2) {
#pragma unroll
                    for (int mi = 0; mi < 2; ++mi)
#pragma unroll
                        for (int nt = 0; nt < 4; ++nt)
#pragma unroll
                            for (int i = 0; i < 4; ++i) { const int rr = (2 * rh + mi) * 16 + lr + i, cc = nt * 16 + lc; res[mi][nt][i] += bf2f(R0I[rr * LD64 + cc]); } }
                LDS_BARRIER();
#pragma unroll
                for (int mi = 0; mi < 2; ++mi)
#pragma unroll
                    for (int nt = 0; nt < 4; ++nt)
#pragma unroll
                        for (int i = 0; i < 4; ++i) NAT[o * 4096 + ((2 * rh + mi) * 16 + lr + i) * 64 + nt * 16 + lc] = (bf16)f2bf(res[mi][nt][i]);
                LDS_BARRIER();
#pragma unroll
                for (int i = 0; i < 4; ++i) { const int id = tid + 512 * i, oo = id >> 9, ch = id & 511; *(u32x4*)(rw_out(F.ws, b, h, d, c, oo) + ch * 8) = *(const LAS u32x4*)(NAT + oo * 4096 + ch * 8); } }
            TS_E(16);
        }
    }
#undef RL_STEP
#undef RL_LOAD_S
#undef RL_LOAD_D
}
template <bool DRY> __device__ __forceinline__ void phase_rwkv_combine(const Frame& F0) {
    PH_ENTER(F0);
    const int lane = F.lane;
    if (F.wave != 0 || F.bid >= 256) return;
    const int chain = F.bid >> 2, q = F.bid & 3, d = chain & 1, bh = chain >> 1, b = bh >> 2, h = bh & 3;
    constexpr int LA = 5, NSLOT = LA + 1, SLOT_B = 8192 + 2048 + 256;
    static_assert(NTILE64 % NSLOT == 0, "ring period");
    LAS unsigned char* RING = F.lds;
    LAS bf16* SA = (LAS bf16*)(F.lds + NSLOT * SLOT_B);
    const float* RPL = (const float*)(F.ws + WS_RPL) + (size_t)chain * NTILE64 * 64;
    const int lr = (lane >> 4) * 4, lc = lane & 15, ar = lane & 15, akq = (lane >> 4) * 8;
    const unsigned vphi = (unsigned)(ar * 64 + akq) * 2u;
    f32x4 S[4];
#pragma unroll
    for (int nt = 0; nt < 4; ++nt) S[nt] = (f32x4){0.f, 0.f, 0.f, 0.f};
#define RWC_CIDX(k) (d == 0 ? (k) : ((k) < 4 ? 3 - (k) : 131 - ((k) - 4)))
#define RWC_ISSUE(k, SLOT) do { const int c_ = RWC_CIDX(k); LAS unsigned char* sl_ = RING + (SLOT) * SLOT_B; \
        const GAS char* phit = (const GAS char*)rw_out(F.ws, b, h, d, c_, 0) + vphi; const GAS char* psip = (const GAS char*)(rw_out(F.ws, b, h, d, c_, 1) + (size_t)q * 16 * 64) + lane * 16; \
        _Pragma("unroll") for (int nt = 0; nt < 4; ++nt) _Pragma("unroll") for (int ks = 0; ks < 2; ++ks) \
            __builtin_amdgcn_global_load_lds((const GAS unsigned*)(phit + nt * 2048 + ks * 64), (LAS unsigned*)(sl_ + (nt * 2 + ks) * 1024), 16, 0, 0); \
        _Pragma("unroll") for (int i = 0; i < 2; ++i) __builtin_amdgcn_global_load_lds((const GAS unsigned*)(psip + i * 1024), (LAS unsigned*)(sl_ + 8192 + i * 1024), 16, 0, 0); \
        __builtin_amdgcn_global_load_lds((const GAS unsigned*)(RPL + (size_t)c_ * 64 + lane), (LAS unsigned*)(sl_ + 10240), 4, 0, 0); } while (0)
    RWC_ISSUE(0, 0); RWC_ISSUE(1, 1); RWC_ISSUE(2, 2); RWC_ISSUE(3, 3); RWC_ISSUE(4, 4);
#pragma unroll 1
    for (int k6 = 0; k6 < NTILE64; k6 += NSLOT) {
#pragma unroll
        for (int j = 0; j < NSLOT; ++j) {
            const int k = k6 + j, c = RWC_CIDX(k);
            const LAS unsigned char* sl = RING + j * SLOT_B;
#pragma unroll
            for (int nt = 0; nt < 4; ++nt)
#pragma unroll
                for (int i = 0; i < 4; ++i) SA[(lr + i) * LD64 + nt * 16 + lc] = (bf16)f2bf(S[nt][i]);
            if (k6 + NSLOT >= NTILE64) asm volatile("s_waitcnt vmcnt(0)" ::: "memory");
            else if (DRY || (k6 == 0 && j < 4)) asm volatile("s_waitcnt vmcnt(44)" ::: "memory");
            else asm volatile("s_waitcnt vmcnt(52)" ::: "memory");
            bf16x8 bfr[4][2]; f32x4 init[4];
#pragma unroll
            for (int nt = 0; nt < 4; ++nt) {
#pragma unroll
                for (int ks = 0; ks < 2; ++ks) bfr[nt][ks] = *(const LAS bf16x8*)(sl + (nt * 2 + ks) * 1024 + lane * 16);
                const float pl = *(const LAS float*)(sl + 10240 + (nt * 16 + lc) * 4);
#pragma unroll
                for (int i = 0; i < 4; ++i) init[nt][i] = S[nt][i] * pl + bf2f(*(const LAS unsigned short*)(sl + 8192 + ((lr + i) * 64 + nt * 16 + lc) * 2)); }
            LDS_WAIT();
            const bf16x8 a0 = *(const LAS bf16x8*)(SA + ar * LD64 + akq), a1 = *(const LAS bf16x8*)(SA + ar * LD64 + 32 + akq);
            if (!DRY) { bf16* s0p = rw_out(F.ws, b, h, d, c, 1) + (size_t)q * 16 * 64;
#pragma unroll
                for (int i = 0; i < 2; ++i) { const int id = lane + 64 * i, r = id >> 3, ch = id & 7; *(u32x4*)(s0p + r * 64 + ch * 8) = *(const LAS u32x4*)(SA + r * LD64 + ch * 8); } }
            LDS_WAIT();
            if (k + LA < NTILE64) RWC_ISSUE(k + LA, (j + LA) % NSLOT);
#pragma unroll
            for (int nt = 0; nt < 4; ++nt) { f32x4 a4 = init[nt];
                a4 = __builtin_amdgcn_mfma_f32_16x16x32_bf16(a0, bfr[nt][0], a4, 0, 0, 0); a4 = __builtin_amdgcn_mfma_f32_16x16x32_bf16(a1, bfr[nt][1], a4, 0, 0, 0); S[nt] = a4; }
        }
    }
    asm volatile("s_waitcnt vmcnt(0)" ::: "memory");
#undef RWC_ISSUE
#undef RWC_CIDX
}
template <bool DRY> __device__ __forceinline__ void phase_combine_side(const Frame& F0) {
    PH_ENTER(F0);
    if (F.wave < 4 || F.G != 256) return;
    const int lgid = F.bid * 256 + (F.tid - 256);
    const int sch = lgid >> 9, sd = sch & 1, sbh = sch >> 1; bf16* SSp = (bf16*)(F.ws + WS_SS) + (size_t)sch * NTILE64 * 4096 + (lgid & 511) * 8;
    const float* SDp = (const float*)(F.ws + WS_SDEC) + (size_t)(sbh >> 3) * NTILE64 * 16 + (sbh & 7) * 2 + sd;
    const int gch = lgid >> 10, gd = gch & 1, gbh = gch >> 1, ge0 = (lgid & 1023) * 2; bf16* GSp = (bf16*)(F.ws + WS_GS) + (size_t)gch * NTILE64 * 2048 + ge0;
    const float* GDp = (const float*)(F.ws + WS_GDEC) + (size_t)(gbh >> 2) * NTILE64 * 256 + gd * 128 + (gbh & 3) * 32 + (ge0 & 31);
    float cS[8] = {0.f, 0.f, 0.f, 0.f, 0.f, 0.f, 0.f, 0.f}, cG0 = 0.f, cG1 = 0.f;
    u32x4 pS[8]; float pSd[8]; unsigned pG[8]; f32x2 pGd[8];
#define CS_CIDX(k, dd) ((dd) == 0 ? (k) : ((k) < 4 ? 3 - (k) : 131 - ((k) - 4)))
#define CS_LOAD(SET, k) do { const int cs_ = CS_CIDX(k, sd), cg_ = CS_CIDX(k, gd); pS[SET] = *(const u32x4*)(SSp + (size_t)cs_ * 4096); pSd[SET] = SDp[cs_ * 16]; \
        pG[SET] = *(const unsigned*)(GSp + (size_t)cg_ * 2048); pGd[SET] = *(const f32x2*)(GDp + (size_t)cg_ * 256); } while (0)
    CS_LOAD(0, 0); CS_LOAD(1, 1); CS_LOAD(2, 2); CS_LOAD(3, 3); CS_LOAD(4, 4); CS_LOAD(5, 5);
#pragma unroll 1
    for (int k8 = 0; k8 < NTILE64; k8 += 8) {
#pragma unroll
        for (int j = 0; j < 8; ++j) { const int k = k8 + j, cs = CS_CIDX(k, sd), cg = CS_CIDX(k, gd);
            if (k >= NTILE64) break;
            float f[8]; unpack8(pS[j], f); const float dec = pSd[j]; const unsigned gt = pG[j]; const f32x2 gdec = pGd[j];
            asm volatile("" : "+v"(f[0]), "+v"(f[7]) : "v"(dec), "v"(gt), "v"(gdec.x), "v"(gdec.y) : "memory");
            if (k + 6 < NTILE64) CS_LOAD((j + 6) & 7, k + 6);
            u32x4 o; o.x = pk2(cS[0], cS[1]); o.y = pk2(cS[2], cS[3]); o.z = pk2(cS[4], cS[5]); o.w = pk2(cS[6], cS[7]); if (!DRY) *(u32x4*)(SSp + (size_t)cs * 4096) = o;
#pragma unroll
            for (int i = 0; i < 8; ++i) cS[i] = cS[i] * dec + f[i];
            if (!DRY) *(unsigned*)(GSp + (size_t)cg * 2048) = pk2(cG0, cG1);
            cG0 = cG0 * gdec.x + __uint_as_float(gt << 16); cG1 = cG1 * gdec.y + __uint_as_float(gt & 0xffff0000u); }
    }
#undef CS_LOAD
#undef CS_CIDX
}
__device__ __forceinline__ void phase_finish_rwkv(const Frame& F0) {
    PH_ENTER(F0);
    const AS4 Args* KA = kargs();
    const int lane = F.lane, wave = F.wave;
    const h16* BONUS = (const h16*)(F.ws + WS_BONUS); const h16* GATE = (const h16*)(F.ws + WS_GATE);
    bf16* MIX = (bf16*)((unsigned char*)F.out + OUT_MIX);
    const float* gng = LP(20, 256); const float* gnb = LP(21, 256);
    const int h = wave >> 1, rh = wave & 1, lr = (lane >> 4) * 4, lc = lane & 15, ar = lane & 15, akq = (lane >> 4) * 8;
    const bool skipctx = F.l == 1;
    for (int j_ = (F.bid + F.G / 2) % F.G; j_ < n_units(skipctx); j_ += F.G) {
        const int u = unit_of(skipctx, j_);
        const int b = u / NTILE64, c = u % NTILE64; const size_t row0 = (size_t)b * TB + (size_t)c * 64;
        f32x4 acc[2][4];
#pragma unroll
        for (int mi = 0; mi < 2; ++mi)
#pragma unroll
            for (int nt = 0; nt < 4; ++nt) acc[mi][nt] = (f32x4){0.f, 0.f, 0.f, 0.f};
#pragma unroll
        for (int d = 0; d < 2; ++d) { const bf16* om = rw_out(F.ws, b, h, d, c, 2); const bf16* s0 = rw_out(F.ws, b, h, d, c, 1); const bf16* yl = rw_out(F.ws, b, h, d, c, 3);
#pragma unroll
            for (int mi = 0; mi < 2; ++mi) { const int srow = (2 * rh + mi) * 16 + ar, trow = d ? 63 - srow : srow;
                const bf16x8 a0 = *(const bf16x8*)(om + trow * 64 + akq), a1 = *(const bf16x8*)(om + trow * 64 + 32 + akq);
#pragma unroll
                for (int nt = 0; nt < 4; ++nt) { const bf16x8 b0 = *(const bf16x8*)(s0 + (nt * 16 + ar) * 64 + akq), b1 = *(const bf16x8*)(s0 + (nt * 16 + ar) * 64 + 32 + akq);
                    f32x4 a4 = acc[mi][nt];
                    a4 = __builtin_amdgcn_mfma_f32_16x16x32_bf16(a0, b0, a4, 0, 0, 0); a4 = __builtin_amdgcn_mfma_f32_16x16x32_bf16(a1, b1, a4, 0, 0, 0);
#pragma unroll
                    for (int i = 0; i < 4; ++i) { const int s = (2 * rh + mi) * 16 + lr + i, t = d ? 63 - s : s; a4[i] += bf2f(yl[t * 64 + nt * 16 + lc]); }
                    acc[mi][nt] = a4; } } }
#pragma unroll
        for (int mi = 0; mi < 2; ++mi)
#pragma unroll
            for (int i = 0; i < 4; ++i) { const int s = (2 * rh + mi) * 16 + lr + i; const size_t r = row0 + s;
                float y0 = acc[mi][0][i], y1 = acc[mi][1][i], y2 = acc[mi][2][i], y3 = acc[mi][3][i];
                const float mu = sum16((y0 + y1) + (y2 + y3)) * (1.f / 64.f);
                y0 -= mu; y1 -= mu; y2 -= mu; y3 -= mu;
                const float rs = rsqrtf(sum16((y0 * y0 + y1 * y1) + (y2 * y2 + y3 * y3)) * (1.f / 64.f) + 64e-5f);
                const float yy[4] = {y0, y1, y2, y3};
#pragma unroll
                for (int nt = 0; nt < 4; ++nt) { const int cc = h * 64 + nt * 16 + lc;
                    const float o = (yy[nt] * rs * gng[cc] + gnb[cc] + (float)BONUS[r * 256 + cc]) * (float)GATE[r * 256 + cc];
                    MIX[r * D + cc] = (bf16)f2bf(o); } }
    }
}
__device__ __forceinline__ void phase_router(const Frame& F0) {
    PH_ENTER(F0);
    const AS4 Args* KA = kargs();
    const int tid = F.tid, lane = F.lane, wave = F.wave;
    LAS float* WT = (LAS float*)F.lds;
    LAS float* AV = (LAS float*)(F.lds + 100352);
    LAS float* BV = AV + 1024;
    LAS float* CST = BV + 1024;
    LAS float* SQ = CST + 8 * 528;
    LAS float* BW = SQ + 512;
    LAS float* RS = BW + 192;
    LAS int* lcnt = (LAS int*)(RS + 64);
    const float* rgw = LP(31, D * 4); const float* rew = LP(33, D * 16); const float* rgb = LP(32, 4); const float* reb = LP(34, 16);
    for (int k = tid; k < D; k += 512) { LAS float* wr = WT + k * 24 + ((k >> 7) << 4);
#pragma unroll
        for (int e = 0; e < 4; ++e) wr[e] = rgw[k * 4 + e];
#pragma unroll
        for (int e = 0; e < 16; ++e) wr[4 + e] = rew[k * 16 + e];
#pragma unroll
        for (int e = 20; e < 24; ++e) wr[e] = 0.f; }
    if (tid < NCLS) lcnt[tid] = 0;
    const float* g = LP(7, D);
    const float* mod = (const float*)(F.ws + WS_MOD) + (size_t)F.l * 9 * 6144;
    bf16* TOK = (bf16*)(F.ws + WS_ACT); const bf16* XB = (const bf16*)(F.ws + WS_XB);
    int4* TI = (int4*)(F.ws + WS_TOKINFO);
    int* CNT = (int*)(F.ws + WS_CNT);
    const bool skipctx = F.l == 1;
    if (skipctx && F.bid < 32 && tid < NCLS) CNT[((F.bid >> 2) * NTILE64 + (F.bid & 3)) * NCLS + tid] = 0;
    const int rt = wave >> 1, hf = wave & 1, r = lane & 15, gq = lane >> 4, kb = 512 * hf + 128 * gq;
    u32x4 raw[8];
    for (int j_ = F.bid; j_ < n_units(skipctx); j_ += F.G) {
        const int u = unit_of(skipctx, j_);
        const int row = u * 64 + rt * 16 + r;
        const bf16* xr = XB + (size_t)row * D + kb;
        LDS_BARRIER();
        { const float* mrow = mod + (size_t)mod_index(u * 64) * 6144; float p[20];
#pragma unroll
            for (int e = 0; e < 20; ++e) p[e] = 0.f;
#pragma unroll
            for (int i = 0; i < 2; ++i) { const int c = tid + 512 * i; const float bv = mrow[3 * D + c]; AV[c] = g[c] * (mrow[4 * D + c] + 1.f); BV[c] = bv;
                const LAS float* wr = WT + c * 24 + ((c >> 7) << 4);
#pragma unroll
                for (int e = 0; e < 20; ++e) p[e] += bv * wr[e]; }
#pragma unroll
            for (int e = 0; e < 20; ++e) { const float t = wave_sum(p[e]); if (lane == 0) BW[wave * 20 + e] = t; } }
        LDS_BARRIER();
        if (tid < 20) { float t = 0.f;
#pragma unroll
            for (int w = 0; w < 8; ++w) t += BW[w * 20 + tid];
            BW[160 + tid] = t; }
        u32x4 ap[16]; f32x4 acc0 = {0.f, 0.f, 0.f, 0.f}, acc1 = {0.f, 0.f, 0.f, 0.f}; float sq = 0.f;
        const LAS float* wb0 = WT + kb * 24 + ((4 * hf + gq) << 4) + r; const LAS float* wb1 = wb0 + 16 - r + (r & 7);
#pragma unroll
        for (int half = 0; half < 2; ++half) {
#pragma unroll
            for (int s8 = 0; s8 < 8; ++s8) raw[s8] = *(const u32x4*)(xr + (half * 8 + s8) * 8);
#pragma unroll
            for (int s8 = 0; s8 < 8; ++s8) { const int s = half * 8 + s8, k0 = kb + 8 * s;
                float x[8], a[8]; { u32x4 rw = raw[s8]; asm volatile("" : "+v"(rw)); unpack8(rw, x); }
                const f32x4 a0 = *(const LAS f32x4*)(AV + k0), a1 = *(const LAS f32x4*)(AV + k0 + 4);
#pragma unroll
                for (int j = 0; j < 8; ++j) { a[j] = x[j] * (j < 4 ? a0[j & 3] : a1[j & 3]); sq += x[j] * x[j]; }
                { u32x4 pk = pack8(a); asm volatile("" : "+v"(pk)); ap[s] = pk; }
#pragma unroll
                for (int j = 0; j < 8; ++j) { const float b0 = wb0[(8 * s + j) * 24], b1 = wb1[(8 * s + j) * 24];
                    acc0 = __builtin_amdgcn_mfma_f32_16x16x4f32(a[j], b0, acc0, 0, 0, 0); acc1 = __builtin_amdgcn_mfma_f32_16x16x4f32(a[j], b1, acc1, 0, 0, 0); }
                __builtin_amdgcn_sched_barrier(0); } }
#pragma unroll
        for (int i = 0; i < 4; ++i) { CST[wave * 528 + (4 * gq + i) * 33 + r] = acc0[i]; CST[wave * 528 + (4 * gq + i) * 33 + 16 + r] = acc1[i]; }
        SQ[wave * 64 + r * 4 + gq] = sq;
        LDS_BARRIER();
        if (tid < 64) { const int rr = tid, rt_ = rr >> 4, r_ = rr & 15;
            float ss = 0.f;
#pragma unroll
            for (int i = 0; i < 4; ++i) ss += SQ[(2 * rt_) * 64 + r_ * 4 + i] + SQ[(2 * rt_ + 1) * 64 + r_ * 4 + i];
            const float rs = rsqrtf(ss * (1.f / D) + 1e-6f);
            float lg[20];
#pragma unroll
            for (int e = 0; e < 20; ++e) lg[e] = (CST[(2 * rt_) * 528 + r_ * 33 + e] + CST[(2 * rt_ + 1) * 528 + r_ * 33 + e]) * rs + BW[160 + e];
            float gl0 = lg[0] + rgb[0], gl1 = lg[1] + rgb[1], gl2 = lg[2] + rgb[2], gl3 = lg[3] + rgb[3];
            int gs = 0; float gm = gl0;
            if (gl1 > gm) { gm = gl1; gs = 1; } if (gl2 > gm) { gm = gl2; gs = 2; } if (gl3 > gm) { gm = gl3; gs = 3; }
            const float pg = 1.f / (__expf(gl0 - gm) + __expf(gl1 - gm) + __expf(gl2 - gm) + __expf(gl3 - gm));
            float e0, e1, e2, e3;
            e0 = gs == 0 ? lg[4] : (gs == 1 ? lg[8] : (gs == 2 ? lg[12] : lg[16])); e1 = gs == 0 ? lg[5] : (gs == 1 ? lg[9] : (gs == 2 ? lg[13] : lg[17]));
            e2 = gs == 0 ? lg[6] : (gs == 1 ? lg[10] : (gs == 2 ? lg[14] : lg[18])); e3 = gs == 0 ? lg[7] : (gs == 1 ? lg[11] : (gs == 2 ? lg[15] : lg[19]));
            e0 += reb[gs * 4 + 0]; e1 += reb[gs * 4 + 1]; e2 += reb[gs * 4 + 2]; e3 += reb[gs * 4 + 3];
            int i1 = 0; float m1 = e0;
            if (e1 > m1) { m1 = e1; i1 = 1; } if (e2 > m1) { m1 = e2; i1 = 2; } if (e3 > m1) { m1 = e3; i1 = 3; }
            int i2 = -1; float m2 = -3.0e38f;
            if (i1 != 0 && e0 > m2) { m2 = e0; i2 = 0; } if (i1 != 1 && e1 > m2) { m2 = e1; i2 = 1; } if (i1 != 2 && e2 > m2) { m2 = e2; i2 = 2; } if (i1 != 3 && e3 > m2) { m2 = e3; i2 = 3; }
            const float p1 = 1.f, p2 = __expf(m2 - m1);
            const float w1 = pg * p1 / (p1 + p2), w2 = pg * p2 / (p1 + p2);
            const int lo = i1 < i2 ? i1 : i2, hi = i1 < i2 ? i2 : i1;
            const int pr = lo == 0 ? hi - 1 : (lo == 1 ? hi + 1 : 5);
            const int cls = gs * 6 + pr;
            const float wa = i1 < i2 ? w1 : w2, wb = i1 < i2 ? w2 : w1;
            const int rank = atomicAdd((int*)(lcnt + cls), 1);
            TI[u * 64 + rr] = make_int4(cls, __float_as_int(wa), __float_as_int(wb), rank); }
        { const f32x4 q0 = *(const LAS f32x4*)(SQ + (2 * rt) * 64 + r * 4), q1 = *(const LAS f32x4*)(SQ + (2 * rt + 1) * 64 + r * 4);
            const float rs = rsqrtf((((q0.x + q1.x) + (q0.y + q1.y)) + ((q0.z + q1.z) + (q0.w + q1.w))) * (1.f / D) + 1e-6f); bf16* tr = TOK + (size_t)row * D + kb;
#pragma unroll
            for (int s = 0; s < 16; ++s) { const int k0 = kb + 8 * s; float a[8]; { u32x4 pk = ap[s]; asm volatile("" : "+v"(pk)); unpack8(pk, a); }
                const f32x4 b0 = *(const LAS f32x4*)(BV + k0), b1 = *(const LAS f32x4*)(BV + k0 + 4);
#pragma unroll
                for (int j = 0; j < 8; ++j) a[j] = a[j] * rs + (j < 4 ? b0[j & 3] : b1[j & 3]);
                *(u32x4*)(tr + 8 * s) = pack8(a); __builtin_amdgcn_sched_barrier(0); } }
        if (tid < NCLS) { CNT[u * NCLS + tid] = lcnt[tid]; lcnt[tid] = 0; }
    }
}

__device__ __forceinline__ void phase_scatter(const Frame& F0) {
    PH_ENTER(F0);
    const int tid = F.tid, lane = F.lane, wave = F.wave;
    LAS int* C = (LAS int*)F.lds;
    LAS int* tot = (LAS int*)(F.lds + 102400);
    LAS int* cs = (LAS int*)(F.lds + 102400 + 128);
    LAS int* base = (LAS int*)(F.lds + 102400 + 256);
    const int* CNT = (const int*)(F.ws + WS_CNT);
    int* MI = (int*)(F.ws + WS_CNT) + NUNIT64 * NCLS;
    for (int i = tid; i < NUNIT64 * NCLS; i += 512) C[i] = CNT[i];
    LDS_BARRIER();
    if (tid < NCLS * 16) { const int c = tid >> 4, s16 = tid & 15; int part = 0; for (int uu = s16; uu < NUNIT64; uu += 16) part += C[uu * NCLS + c];
        const float pf = sum16((float)part); if (s16 == 0) tot[c] = (int)pf; }
    LDS_BARRIER();
    if (tid == 0) { int s = 0; for (int c = 0; c < NCLS; ++c) { cs[c] = s; s += (tot[c] + 255) & ~255; } cs[NCLS] = s; }
    LDS_BARRIER();
    if (F.bid == 0 && tid <= NCLS) MI[tid] = cs[tid];
    const int4* TI = (const int4*)(F.ws + WS_TOKINFO);
    int* LIST = (int*)(F.ws + WS_LIST); f32x2* WSL = (f32x2*)(F.ws + WS_WSLOT);
    for (int c = F.bid; c < NCLS; c += F.G) {
        const int s0 = cs[c] + tot[c], s1 = cs[c + 1];
        for (int s = s0 + tid; s < s1; s += 512) { LIST[s] = -1; WSL[s] = (f32x2){0.f, 0.f}; }
    }
    const bool skipctx = F.l == 1;
    for (int j_ = F.bid; j_ < n_units(skipctx); j_ += F.G) {
        const int u = unit_of(skipctx, j_);
        LDS_BARRIER();
        if (tid < NCLS * 16) { const int c = tid >> 4, s = tid & 15; int part = 0; for (int uu = s; uu < u; uu += 16) part += C[uu * NCLS + c];
            float pf = sum16((float)part);
            if (s == 0) base[c] = cs[c] + (int)pf; }
        LDS_BARRIER();
        {
#pragma unroll
            for (int rr = 0; rr < 8; ++rr) { const int row = u * 64 + wave * 8 + rr;
                if (lane == 0) { const int4 ti = TI[row]; const int slot = base[ti.x] + ti.w; LIST[slot] = row; WSL[slot] = (f32x2){__int_as_float(ti.y), __int_as_float(ti.z)}; } } }
    }
}

__device__ __forceinline__ void phase_final(const Frame& F0) {
    PH_ENTER(F0);
    const AS4 Args* KA = kargs();
    const int gw = F.bid * 8 + F.wave, NGW = F.G * 8, lane = F.lane;
    const float* g = INP(38);
    constexpr int NR = NB * TL; const int R = (NR + NGW - 1) / NGW, r0 = gw * R, r1 = min(NR, r0 + R);
    const bf16* XB = (const bf16*)(F.ws + WS_XB);
    f32x4 G4[4]; u32x2 nv[4];
#pragma unroll
    for (int j = 0; j < 4; ++j) G4[j] = *(const f32x4*)(g + 4 * lane + 256 * j);
#define FN_ROW(r) (XB + ((size_t)((r) / TL) * TB + TC + (r) % TL) * D)
    if (r0 < r1) { const u32x2* xr = (const u32x2*)FN_ROW(r0) + lane;
#pragma unroll
        for (int j = 0; j < 4; ++j) nv[j] = xr[64 * j]; }
    for (int row = r0; row < r1; ++row) {
        f32x4 v[4];
#pragma unroll
        for (int j = 0; j < 4; ++j) v[j] = bf4(nv[j]);
        if (row + 1 < r1) { const u32x2* xn = (const u32x2*)FN_ROW(row + 1) + lane;
#pragma unroll
            for (int j = 0; j < 4; ++j) nv[j] = xn[64 * j]; }
        float s = 0.f;
#pragma unroll
        for (int j = 0; j < 4; ++j) s += (v[j].x * v[j].x + v[j].y * v[j].y) + (v[j].z * v[j].z + v[j].w * v[j].w);
        const float rs = rsqrtf(wave_sum(s) * (1.f / D) + 1e-6f);
        f32x4* xr = (f32x4*)(F.out + (size_t)row * D) + lane;
#pragma unroll
        for (int j = 0; j < 4; ++j) xr[64 * j] = v[j] * rs * G4[j];
    }
#undef FN_ROW
}

constexpr int PH_PER_LAYER = 12, PH_FINAL = 1 + 2 * PH_PER_LAYER, PH_END = PH_FINAL + 1;
template <int L> __device__ __forceinline__ void run_layer(Frame& F0, const XcdBarrier& bar, const int lo, const int hi) {
    constexpr int l = L;
#define IN(k) (lo <= (k) && (k) < hi)
#define SEAM(k) do { if (IN(k) && IN((k) + 1)) { XcdBarrier bb = bar; GAS unsigned* _b = (GAS unsigned*)bb.bar; asm volatile("" : "+s"(_b)); bb.bar = (unsigned*)_b; xcd_barrier(bb); STAMP(F0); } } while (0)
        F0.l = l;
        const int pb = 1 + PH_PER_LAYER * l;
        if (HAS(1) && IN(pb + 1)) { for (int rep = 0; rep < REP(1); ++rep) phase_norm1(F0); if (l == 1 && HAS(0)) phase_convert(F0); } SEAM(pb + 1);
        if (HAS(2) && IN(pb + 2)) {
            PH_ENTER(F0);
            SchedStatic S; S.nM = T / 256; S.nN = IN_PAD / 256; S.nwg = S.nM * S.nN; S.G = F.G; S.c = F.bid; S.ws = F.ws; S.wsA = F.ws; S.offA = WS_ACT; S.offB = WS_WIN; S.skipctx = 0; S.split = 0;
            EpiU E{F.ws};
            for (int rep = 0; rep < REP(2); ++rep) pg8::gemm_phase<EpiU, SchedStatic, true, false, 1024>(F.lds, F.tid, S, E);
        } SEAM(pb + 2);
        if (HAS(3) && IN(pb + 3)) { phase_conv(F0); for (int rep = 0; rep < REP(3); ++rep) phase_prep(F0); } SEAM(pb + 3);
#define GBAR() do { if (hi - lo > 1) { XcdBarrier bb = bar; GAS unsigned* _b = (GAS unsigned*)bb.bar; asm volatile("" : "+s"(_b)); bb.bar = (unsigned*)_b; xcd_barrier(bb); STAMP(F0); } } while (0)
        if (HAS(4) && IN(pb + 5)) {
            if (MK_PROBE_RW >= 1) { phase_rwkv_local(F0); GBAR(); if (MK_PROBE_RW >= 2) { phase_rwkv_combine<false>(F0); GBAR(); } phase_prep(F0); GBAR(); }
            if (MK_PROBE_RW == 0) { for (int rep = 0; rep < REP(4); ++rep) phase_states(F0); } phase_rwkv_local(F0); if (MK_PROBE_RW) { GBAR(); phase_states(F0); GBAR(); } if (F0.G != 256) { phase_combine_ssd(F0); phase_combine_gla(F0); } GBAR(); if (MK_PROBE_COMB & 1) phase_rwkv_combine<true>(F0); if (MK_PROBE_COMB & 2) phase_combine_side<true>(F0); if (MK_PROBE_COMB) GBAR(); phase_rwkv_combine<false>(F0); phase_combine_side<false>(F0); } SEAM(pb + 5);
        if (HAS(6) && IN(pb + 6)) { phase_finish_rwkv(F0); phase_finish_ssd(F0); phase_finish_gla(F0); } SEAM(pb + 6);
#undef GBAR
        if (HAS(7) && IN(pb + 7)) {
            PH_ENTER(F0);
            const AS4 Args* KA = kargs();
            SchedStatic S; S.skipctx = (F.l == 1); S.nM = S.skipctx ? NB * TL / 256 : T / 256; S.nN = D / 256; S.nwg = S.nM * S.nN; S.G = F.G; S.c = F.bid; S.ws = F.ws; S.wsA = (const unsigned char*)F.out; S.offA = OUT_MIX; S.offB = WS_WOUT; S.split = 1;
            EpiRes E{INP(0), INP(2), F.ws, F.l};
            pg8::gemm_phase<EpiRes, SchedStatic, true, false, 1024, false, true>(F.lds, F.tid, S, E);
        } SEAM(pb + 7);
        if (HAS(8) && IN(pb + 8)) { for (int rep = 0; rep < REP(8); ++rep) phase_router(F0); } SEAM(pb + 8);
        if (HAS(9) && IN(pb + 9)) { for (int rep = 0; rep < REP(9); ++rep) phase_scatter(F0); } SEAM(pb + 9);
        if (IN(pb + 10) || IN(pb + 11)) {
            PH_ENTER(F0);
            LAS int* cs = (LAS int*)(F.lds + CSTAB_OFF);
            const int* MI = (const int*)(F.ws + WS_CNT) + NUNIT64 * NCLS;
            __syncthreads();
            if (F.tid <= NCLS) cs[F.tid] = MI[F.tid];
            __syncthreads();
        }
        if (HAS(10) && IN(pb + 10)) {
            PH_ENTER(F0);
            LAS int* cs = (LAS int*)(F.lds + CSTAB_OFF);
            SchedMoE<8> S; S.ntiles = cs[NCLS] / 256; S.G = F.G; S.c = F.bid; S.cs = cs; S.ws = F.ws;
            EpiSwiGLU E{F.ws};
            for (int rep = 0; rep < REP(10); ++rep) pg8::gemm_phase<EpiSwiGLU, SchedMoE<8>, true, false, 1024, true>(F.lds, F.tid, S, E);
        } SEAM(pb + 10);
        if (HAS(11) && IN(pb + 11)) {
            PH_ENTER(F0);
            LAS int* cs = (LAS int*)(F.lds + CSTAB_OFF);
            SchedMoE<4> S; S.ntiles = cs[NCLS] / 256; S.G = F.G; S.c = F.bid; S.cs = cs; S.ws = F.ws;
            EpiScatter E{F.ws, F.l};
            pg8::gemm_phase<EpiScatter, SchedMoE<4>, true, true, 512, false, true>(F.lds, F.tid, S, E);
        } SEAM(pb + 11);
    }
#undef IN
#undef SEAM
__global__ void __launch_bounds__(512, 2) mk_fwd(Args args) {
    extern __shared__ __attribute__((aligned(16))) unsigned char lds_raw[];
    Frame F0;
    F0.lds = (LAS unsigned char*)lds_raw;
    F0.tid = threadIdx.x; F0.lane = F0.tid & 63; F0.wave = __builtin_amdgcn_readfirstlane(F0.tid >> 6);
    F0.G = gridDim.x; F0.bid = blockIdx.x; F0.out = args.out; F0.ws = args.ws; F0.l = 0;
    F0.seamc = 0; F0.tA = MK_TB >= 0 ? (unsigned)__builtin_amdgcn_s_memrealtime() : 0u; F0.tB = F0.tA;
    for (int u = F0.tid; u < (LDS_BYTES - LDSCTL_OFF) / 4; u += 512) ((LAS unsigned*)(F0.lds + LDSCTL_OFF))[u] = 0u;
    __syncthreads();
    const int lo = args.ph_lo, hi = args.ph_hi;
    const bool use_bar = (hi - lo) > 1;
    XcdBarrier bar; bar.bar = (unsigned*)(F0.ws + WS_CTL) + CW_BAR; bar.x = 0; bar.st = nullptr;
    if (use_bar) bar = xcd_barrier_post((unsigned*)(F0.ws + WS_CTL) + CW_BAR, (volatile LAS unsigned*)(F0.lds + MISC_OFF) + 8);
#define IN(k) (lo <= (k) && (k) < hi)
#define SEAM(k) do { if (IN(k) && IN((k) + 1)) { XcdBarrier bb = bar; GAS unsigned* _b = (GAS unsigned*)bb.bar; asm volatile("" : "+s"(_b)); bb.bar = (unsigned*)_b; xcd_barrier(bb); STAMP(F0); } } while (0)
    if (HAS(12) && IN(0)) { phase_mods(F0); } if (HAS(0) && IN(0)) { F0.l = 0; phase_convert(F0); } SEAM(0);
    run_layer<0>(F0, bar, lo, hi);
    run_layer<1>(F0, bar, lo, hi);
    if (HAS(13) && IN(PH_FINAL)) { phase_final(F0); }
    if (MK_TSEC != 0 && F0.bid == 0 && F0.tid == 0) { const unsigned t0_ = (unsigned)__builtin_amdgcn_s_memrealtime(), span = (unsigned)MK_TK * *(LAS unsigned*)(F0.lds + MISC_OFF + 128); while ((unsigned)__builtin_amdgcn_s_memrealtime() - t0_ < span) __builtin_amdgcn_s_sleep(8); }
    if (MK_TB >= 0) { if (MK_TB >= 100) F0.tB = (unsigned)__builtin_amdgcn_s_memrealtime(); if (F0.bid == 0 && F0.tid == 0) { const unsigned t0_ = (unsigned)__builtin_amdgcn_s_memrealtime(), span = (unsigned)MK_TK * (F0.tB - F0.tA); while ((unsigned)__builtin_amdgcn_s_memrealtime() - t0_ < span) __builtin_amdgcn_s_sleep(8); } }
#undef IN
#undef SEAM
}

extern "C" void kernel_launch(void* const* d_in, const int* in_sizes, int n_in, void* d_out, int out_size, void* d_ws, size_t ws_size, hipStream_t stream) {
    static int grid = 0;
    if (grid == 0) {
        if (n_in != 39 || ws_size < WS_END) { fprintf(stderr, "kernel_launch: unexpected n_in %d / ws %zu\n", n_in, ws_size); grid = -1; return; }
        int dev = 0, cus = 0;
        if (hipGetDevice(&dev) != hipSuccess || hipDeviceGetAttribute(&cus, hipDeviceAttributeMultiprocessorCount, dev) != hipSuccess) { grid = -1; return; }
        if (hipFuncSetAttribute((const void*)mk_fwd, hipFuncAttributeMaxDynamicSharedMemorySize, LDS_BYTES) != hipSuccess) { fprintf(stderr, "kernel_launch: hipFuncSetAttribute failed\n"); grid = -1; return; }
        int per_cu = 0;
        (void)hipOccupancyMaxActiveBlocksPerMultiprocessor(&per_cu, (const void*)mk_fwd, 512, LDS_BYTES);
        (void)hipGetLastError();
        grid = cus;
    }
    if (grid < 0) return;
    (void)hipMemsetAsync((char*)d_ws + WS_CTL, 0, CTL_ZERO_BYTES, stream);
    Args a{};
    for (int i = 0; i < 39; ++i) a.in[i] = (const float*)d_in[i];
    a.out = (float*)d_out; a.ws = (unsigned char*)d_ws;
#if MK_ONE_LAUNCH
    a.ph_lo = 0; a.ph_hi = PH_END;
    hipLaunchKernelGGL(mk_fwd, dim3(grid), dim3(512), LDS_BYTES, stream, a);
#else
    for (int ph = 0; ph < PH_END; ++ph) { a.ph_lo = ph; a.ph_hi = ph + 1; hipLaunchKernelGGL(mk_fwd, dim3(grid), dim3(512), LDS_BYTES, stream, a); }
#endif
}
```
